# Optimizing an MI355X kernel written in HIP

```python
import jax
import jax.numpy as jnp
from jax import lax
import numpy as np

D_MODEL = 1024
BATCH = 2
SEQ = 16384
DEPTH = 1

GRID_W = 64
CTX_LEN = 256
CHUNK = 64
GLA_HEADS = 4
GLA_DK = 64
GLA_DV = 128
GLA_GATE_RANK = 16
GLA_GATE_TAU = 16.0
RET_HEADS = 4
RET_DK = 128
RET_DV = 128
RET_GAMMA_EXP0 = 5
ROPE_BASE = 10000.0
N_EXPERTS = 16
EC_CAPACITY_FACTOR = 2
EXPERT_FF = 1408
N_ADA = 6
EPS = 1e-6

GLA_QK = GLA_HEADS * GLA_DK
GLA_V = GLA_HEADS * GLA_DV
RET_QK = RET_HEADS * RET_DK
RET_V = RET_HEADS * RET_DV
MIX_WIDTH = GLA_V + RET_V
IN_WIDTHS = (GLA_QK, GLA_QK, GLA_V, 2 * GLA_GATE_RANK, GLA_V, RET_QK, RET_QK, RET_V, RET_V)
IN_WIDTH = sum(IN_WIDTHS)
IN_SPLIT_POINTS = tuple(int(p) for p in np.cumsum(IN_WIDTHS)[:-1])

kernel_name = 'hybrid_gla_retention_ec_moe_dit_block'

F32 = jnp.float32


def _rmsnorm(x, w):
    xf = x.astype(F32)
    y = xf * lax.rsqrt(jnp.mean(xf * xf, axis=-1, keepdims=True) + EPS)
    return (y * w).astype(x.dtype)


def _head_rmsnorm(o, w):
    B, T, H, d = o.shape
    of = o.astype(F32)
    y = of * lax.rsqrt(jnp.mean(of * of, axis=-1, keepdims=True) + EPS)
    return y.reshape(B, T, H * d) * w


def _head_layernorm(o, w):
    B, T, H, d = o.shape
    of = o.astype(F32)
    mu = jnp.mean(of, axis=-1, keepdims=True)
    var = jnp.mean(jnp.square(of - mu), axis=-1, keepdims=True)
    return ((of - mu) * lax.rsqrt(var + EPS)).reshape(B, T, H * d) * w


def _flip(a):
    return jnp.flip(a, axis=1)


def _to_chunks(a):
    B, T, H, d = a.shape
    return a.reshape(B, T // CHUNK, CHUNK, H, d).transpose(1, 0, 3, 2, 4)


def _from_chunks(a):
    N, B, H, C, d = a.shape
    return a.transpose(1, 0, 3, 2, 4).reshape(B, N * C, H, d)


def _grid_rope_angles(n_tok):
    rows = n_tok // GRID_W
    row = jnp.broadcast_to(jnp.arange(rows)[:, None], (rows, GRID_W)).reshape(-1).astype(F32)
    col = jnp.broadcast_to(jnp.arange(GRID_W)[None, :], (rows, GRID_W)).reshape(-1).astype(F32)
    n_freq = RET_DK // 4
    inv = ROPE_BASE ** (-jnp.arange(n_freq, dtype=F32) / n_freq)
    return jnp.concatenate([row[:, None] * inv, col[:, None] * inv], axis=-1)


def _apply_rope(a, ang):
    half = a.shape[-1] // 2
    cos = jnp.cos(ang)[None, :, None, :]
    sin = jnp.sin(ang)[None, :, None, :]
    a1, a2 = a[..., :half], a[..., half:]
    return jnp.concatenate([a1 * cos - a2 * sin, a1 * sin + a2 * cos], axis=-1)


def _gla_chunked(q, k, v, log_a, s0):
    mask = jnp.tril(jnp.ones((CHUNK, CHUNK), dtype=bool))[:, :, None]

    def step(s, xs):
        qc, kc, vc, gc = xs
        b = jnp.cumsum(gc, axis=2)
        b_end = b[:, :, -1:, :]
        decay = jnp.exp(jnp.where(mask, b[:, :, :, None, :] - b[:, :, None, :, :], -jnp.inf))
        scores = jnp.einsum('bhik,bhjk,bhijk->bhij', qc, kc, decay)
        o = jnp.einsum('bhij,bhjv->bhiv', scores, vc) + jnp.einsum('bhik,bhkv->bhiv', qc * jnp.exp(b), s)
        s = jnp.exp(b_end)[:, :, 0, :, None] * s + jnp.einsum('bhjk,bhjv->bhkv', kc * jnp.exp(b_end - b), vc)
        return s, o

    s_end, o = lax.scan(step, s0, (_to_chunks(q), _to_chunks(k), _to_chunks(v), _to_chunks(log_a)))
    return _from_chunks(o), s_end


def _retention_chunked(q, k, v, log_gamma, s0):
    pos = jnp.arange(CHUNK, dtype=F32)
    lg = log_gamma.astype(F32)[:, None, None]
    rel = pos[:, None] - pos[None, :]
    d_intra = jnp.where(rel >= 0, jnp.exp(lg * jnp.maximum(rel, 0.0)), 0.0)
    q_decay = jnp.exp(lg * (pos + 1.0)[:, None])
    k_decay = jnp.exp(lg * (CHUNK - 1.0 - pos)[:, None])
    c_decay = jnp.exp(lg * CHUNK)

    def step(s, xs):
        qc, kc, vc = xs
        scores = jnp.einsum('bhik,bhjk->bhij', qc, kc) * d_intra
        o = jnp.einsum('bhij,bhjv->bhiv', scores, vc) + jnp.einsum('bhik,bhkv->bhiv', qc * q_decay, s)
        s = c_decay * s + jnp.einsum('bhjk,bhjv->bhkv', kc * k_decay, vc)
        return s, o

    s_end, o = lax.scan(step, s0, (_to_chunks(q), _to_chunks(k), _to_chunks(v)))
    return _from_chunks(o), s_end


def _gla_final_state(k, v, log_a):
    b = jnp.cumsum(log_a, axis=1)
    w = jnp.exp(b[:, -1:] - b)
    return jnp.einsum('bthk,bthv->bhkv', k * w, v)


def _ret_final_state(k, v, log_gamma):
    T = k.shape[1]
    w = jnp.exp(log_gamma.astype(F32)[None, :] * jnp.arange(T - 1, -1, -1, dtype=F32)[:, None])
    return jnp.einsum('bthk,bthv->bhkv', k * w[None, :, :, None], v)


def _project(h, w_in, gla_gate_w, gla_gate_b, rope):
    B, T, _ = h.shape
    gq, gk, gv, gz, gg, rq, rk, rv, rg = jnp.split(h @ w_in, IN_SPLIT_POINTS, axis=-1)
    gq = gq.reshape(B, T, GLA_HEADS, GLA_DK) * (GLA_DK ** -0.5)
    gk = gk.reshape(B, T, GLA_HEADS, GLA_DK)
    gv = gv.reshape(B, T, GLA_HEADS, GLA_DV)
    pre = jnp.einsum('btdr,drk->btdk', gz.reshape(B, T, 2, GLA_GATE_RANK), gla_gate_w) + gla_gate_b
    log_a = (jax.nn.log_sigmoid(pre.astype(F32)) / GLA_GATE_TAU).reshape(B, T, 2, GLA_HEADS, GLA_DK)
    rq = rq.reshape(B, T, RET_HEADS, RET_DK)
    rk = rk.reshape(B, T, RET_HEADS, RET_DK) * (RET_DK ** -0.5)
    if rope is not None:
        rq = _apply_rope(rq, rope)
        rk = _apply_rope(rk, rope)
    rv = rv.reshape(B, T, RET_HEADS, RET_DV)
    return gq, gk, gv, log_a, gg, rq, rk, rv, rg


def _zero_states(B):
    g = jnp.zeros((B, GLA_HEADS, GLA_DK, GLA_DV), F32)
    r = jnp.zeros((B, RET_HEADS, RET_DK, RET_DV), F32)
    return (g, g, r, r)


def _token_mixer(h, w_in, gla_gate_w, gla_gate_b, ret_decay_logit, gla_norm_w, ret_norm_w, w_out, init_states, rope):
    gq, gk, gv, log_a, gg, rq, rk, rv, rg = _project(h, w_in, gla_gate_w, gla_gate_b, rope)
    log_gamma = jax.nn.log_sigmoid(ret_decay_logit.astype(F32))
    s_gf, s_gb, s_rf, s_rb = init_states
    o_gf, s_gf = _gla_chunked(gq, gk, gv, log_a[:, :, 0], s_gf)
    o_gb, s_gb = _gla_chunked(_flip(gq), _flip(gk), _flip(gv), _flip(log_a[:, :, 1]), s_gb)
    o_rf, s_rf = _retention_chunked(rq, rk, rv, log_gamma[0], s_rf)
    o_rb, s_rb = _retention_chunked(_flip(rq), _flip(rk), _flip(rv), log_gamma[1], s_rb)
    o_g = _head_rmsnorm(o_gf + _flip(o_gb), gla_norm_w) * jax.nn.silu(gg)
    o_r = _head_layernorm(o_rf + _flip(o_rb), ret_norm_w) * jax.nn.silu(rg)
    out = jnp.concatenate([o_g, o_r], axis=-1) @ w_out
    return out, (s_gf, s_gb, s_rf, s_rb)


def _context_states(hc, w_in, gla_gate_w, gla_gate_b, ret_decay_logit):
    _, gk, gv, log_a, _, _, rk, rv, _ = _project(hc, w_in, gla_gate_w, gla_gate_b, None)
    log_gamma = jax.nn.log_sigmoid(ret_decay_logit.astype(F32))
    s_gf = _gla_final_state(gk, gv, log_a[:, :, 0])
    s_gb = _gla_final_state(_flip(gk), _flip(gv), _flip(log_a[:, :, 1]))
    s_rf = _ret_final_state(rk, rv, log_gamma[0])
    s_rb = _ret_final_state(_flip(rk), _flip(rv), log_gamma[1])
    return (s_gf, s_gb, s_rf, s_rb)


def _expert_choice_ffn(h, w_router, w_gate, w_up, w_down):
    B, T, _ = h.shape
    cap = EC_CAPACITY_FACTOR * T // N_EXPERTS
    aff = jax.nn.softmax((h @ w_router).astype(F32), axis=-1)
    gate, idx = lax.top_k(jnp.swapaxes(aff, 1, 2), cap)
    bidx = jnp.arange(B)[:, None, None]
    xe = h[bidx, idx]
    a = jnp.einsum('becd,edf->becf', xe, w_gate)
    u = jnp.einsum('becd,edf->becf', xe, w_up)
    ye = jnp.einsum('becf,efd->becd', jax.nn.silu(a) * u, w_down) * gate[..., None]
    return jnp.zeros_like(h).at[bidx, idx].add(ye.astype(h.dtype))


def setup_inputs(seed: int = 0) -> dict:
    key = jax.random.key(seed)
    ks = jax.random.split(key, 24)
    n = lambda k, shape, s: jax.random.normal(k, shape, F32) * s
    logit0 = jnp.asarray(np.log(2.0 ** (RET_GAMMA_EXP0 + np.arange(RET_HEADS)) - 1.0), F32)
    return {
        'x': n(ks[0], (BATCH, SEQ, D_MODEL), 1.0),
        'c': n(ks[1], (BATCH, D_MODEL), 1.0),
        'ctx': n(ks[2], (BATCH, CTX_LEN, D_MODEL), 1.0),
        'c_ctx': n(ks[3], (D_MODEL,), 1.0),
        'w_ada': n(ks[4], (DEPTH, D_MODEL, N_ADA * D_MODEL), 0.02),
        'b_ada': n(ks[5], (DEPTH, N_ADA * D_MODEL), 0.02),
        'norm1_w': 1.0 + n(ks[6], (DEPTH, D_MODEL), 0.02),
        'w_in': n(ks[7], (DEPTH, D_MODEL, IN_WIDTH), D_MODEL ** -0.5),
        'gla_gate_w': n(ks[8], (DEPTH, 2, GLA_GATE_RANK, GLA_QK), GLA_GATE_RANK ** -0.5),
        'gla_gate_b': n(ks[9], (DEPTH, 2, GLA_QK), 0.1),
        'ret_decay_logit': logit0[None, None, :] + n(ks[10], (DEPTH, 2, RET_HEADS), 0.05),
        'gla_norm_w': 1.0 + n(ks[11], (DEPTH, GLA_V), 0.02),
        'ret_norm_w': 1.0 + n(ks[12], (DEPTH, RET_V), 0.02),
        'w_out': n(ks[13], (DEPTH, MIX_WIDTH, D_MODEL), MIX_WIDTH ** -0.5),
        'norm2_w': 1.0 + n(ks[14], (DEPTH, D_MODEL), 0.02),
        'w_router': n(ks[15], (DEPTH, D_MODEL, N_EXPERTS), D_MODEL ** -0.5),
        'w_exp_gate': n(ks[16], (DEPTH, N_EXPERTS, D_MODEL, EXPERT_FF), D_MODEL ** -0.5),
        'w_exp_up': n(ks[17], (DEPTH, N_EXPERTS, D_MODEL, EXPERT_FF), D_MODEL ** -0.5),
        'w_exp_down': n(ks[18], (DEPTH, N_EXPERTS, EXPERT_FF, D_MODEL), EXPERT_FF ** -0.5),
        'final_norm_w': 1.0 + n(ks[19], (D_MODEL,), 0.02),
    }


def reference(x, c, ctx, c_ctx, w_ada, b_ada, norm1_w, w_in, gla_gate_w, gla_gate_b, ret_decay_logit,
              gla_norm_w, ret_norm_w, w_out, norm2_w, w_router, w_exp_gate, w_exp_up, w_exp_down, final_norm_w):
    B, n_lat, D = x.shape
    rope = _grid_rope_angles(n_lat)
    for i in range(DEPTH):
        last = i == DEPTH - 1
        mod = (jax.nn.silu(c) @ w_ada[i] + b_ada[i]).reshape(B, N_ADA, D)[:, :, None, :]
        mod_c = (jax.nn.silu(c_ctx) @ w_ada[i] + b_ada[i]).reshape(N_ADA, D)
        hc = _rmsnorm(ctx, norm1_w[i]) * (1.0 + mod_c[1]) + mod_c[0]
        if last:
            ctx_states = _context_states(hc, w_in[i], gla_gate_w[i], gla_gate_b[i], ret_decay_logit[i])
        else:
            ctx_out, ctx_states = _token_mixer(hc, w_in[i], gla_gate_w[i], gla_gate_b[i], ret_decay_logit[i],
                                               gla_norm_w[i], ret_norm_w[i], w_out[i], _zero_states(B), None)
        h = _rmsnorm(x, norm1_w[i]) * (1.0 + mod[:, 1]) + mod[:, 0]
        x_out, _ = _token_mixer(h, w_in[i], gla_gate_w[i], gla_gate_b[i], ret_decay_logit[i],
                                gla_norm_w[i], ret_norm_w[i], w_out[i], ctx_states, rope)
        x = x + mod[:, 2] * x_out
        h2 = _rmsnorm(x, norm2_w[i]) * (1.0 + mod[:, 4]) + mod[:, 3]
        x = x + mod[:, 5] * _expert_choice_ffn(h2, w_router[i], w_exp_gate[i], w_exp_up[i], w_exp_down[i])
        if not last:
            ctx = ctx + mod_c[2] * ctx_out
            hc2 = _rmsnorm(ctx, norm2_w[i]) * (1.0 + mod_c[4]) + mod_c[3]
            ctx = ctx + mod_c[5] * _expert_choice_ffn(hc2, w_router[i], w_exp_gate[i], w_exp_up[i], w_exp_down[i])
    return _rmsnorm(x, final_norm_w)
```

```cpp
#include <hip/hip_runtime.h>
#include <stdint.h>
#include <stdio.h>

typedef unsigned short bf16_t;
typedef unsigned int u32;

constexpr int D = 1024, BATCH = 2, SEQ = 16384, CTX = 256;
constexpr int NLAT = BATCH * SEQ;
constexpr int NCTX = BATCH * CTX;
constexpr int NROWS = NLAT + NCTX;
constexpr int NADA = 6;
constexpr int NE = 16, CAP = 2048, FF = 1408;
constexpr int NSLOT = BATCH * NE * CAP;
constexpr float EPS = 1e-6f;
constexpr int C_GQ = 0, C_GK = 256, C_GV = 512, C_GG = 1024, C_RQ = 1536, C_RK = 2048, C_RV = 2560, C_RG = 3072, C_GZ = 3584;
constexpr int PW = 3584;
constexpr int NPROJ = 3616, NPROJ_PAD = 3840;

constexpr size_t MiB = 1u << 20;
constexpr size_t WS_CTL = 0;
constexpr size_t WS_MOD = 1 * MiB;
constexpr size_t WS_ROPE = WS_MOD + 128 * 1024;
constexpr size_t WS_DCH = 2 * MiB;
constexpr size_t WS_WIN = 4 * MiB;
constexpr size_t WS_WOUT = 12 * MiB;
constexpr size_t WS_GZ = 14 * MiB;
constexpr size_t WS_H = 19 * MiB;
constexpr size_t WS_P = 84 * MiB;
constexpr size_t WS_US = 312 * MiB;
constexpr size_t WS_WGU = 84 * MiB;
constexpr size_t WS_WD = 172 * MiB;
constexpr size_t WS_ACT = 216 * MiB;
constexpr size_t WS_AFF = 392 * MiB;
constexpr size_t WS_IDX = 394 * MiB;
constexpr size_t WS_GATE = 395 * MiB;
constexpr size_t WS_INV = 396 * MiB;
constexpr size_t WS_YE = 19 * MiB;
constexpr size_t WS_OF = 312 * MiB;
constexpr size_t WS_END = 508 * MiB;

__device__ __forceinline__ float bf2f(bf16_t v) { return __uint_as_float(((u32)v) << 16); }
__device__ __forceinline__ bf16_t f2bf(float f) { u32 u = __float_as_uint(f); return (bf16_t)((u + 0x7fffu + ((u >> 16) & 1u)) >> 16); }
__device__ __forceinline__ float siluf(float x) { return x / (1.0f + __expf(-x)); }
__device__ __forceinline__ float log_sigmoidf(float x) { return fminf(x, 0.f) - log1pf(__expf(-fabsf(x))); }
__device__ __forceinline__ float wave_sum(float v) {
#pragma unroll
    for (int o = 1; o < 64; o <<= 1) v += __shfl_xor(v, o);
    return v;
}
__device__ __forceinline__ float dot_bf16(const bf16_t* __restrict__ a, const bf16_t* __restrict__ b, int K) {
    float acc = 0.f;
    for (int k = 0; k < K; k += 8) {
        const uint4 va = *(const uint4*)(a + k), vb = *(const uint4*)(b + k);
        const u32 wa[4] = {va.x, va.y, va.z, va.w}, wb[4] = {vb.x, vb.y, vb.z, vb.w};
#pragma unroll
        for (int i = 0; i < 4; ++i) {
            acc += __uint_as_float(wa[i] << 16) * __uint_as_float(wb[i] << 16);
            acc += __uint_as_float(wa[i] & 0xffff0000u) * __uint_as_float(wb[i] & 0xffff0000u);
        }
    }
    return acc;
}
__host__ __device__ inline int proj_src_col(int n) {
    if (n < 1024) return n;
    if (n < 1536) return 1056 + (n - 1024);
    if (n < 2560) {
        const int base = (n < 2048) ? 1568 : 2080, m = (n < 2048) ? n - 1536 : n - 2048;
        const int hd = m >> 7, p = m & 127, g = p >> 3, nn = (p >> 2) & 1, e = p & 3;
        return base + hd * 128 + 64 * nn + 4 * g + e;
    }
    if (n < 3072) return 2592 + (n - 2560);
    if (n < 3584) return 3104 + (n - 3072);
    return 1024 + (n - 3584);
}

struct Ptrs {
    const float *x, *c, *ctx, *c_ctx, *w_ada, *b_ada, *norm1_w, *w_in, *gla_gate_w, *gla_gate_b, *ret_decay_logit, *gla_norm_w, *ret_norm_w,
        *w_out, *norm2_w, *w_router, *w_exp_gate, *w_exp_up, *w_exp_down, *final_norm_w;
    float* out;
    unsigned char* ws;
};

__global__ void k_mod(Ptrs p) {
    const int idx = blockIdx.x * blockDim.x + threadIdx.x;
    if (idx >= 3 * NADA * D) return;
    const int r = idx / (NADA * D), j = idx % (NADA * D);
    const float* cv = (r < 2) ? p.c + r * D : p.c_ctx;
    float acc = 0.f;
    for (int k = 0; k < D; ++k) acc += siluf(cv[k]) * p.w_ada[(size_t)k * (NADA * D) + j];
    ((float*)(p.ws + WS_MOD))[idx] = acc + p.b_ada[j];
}
__global__ void k_rope(Ptrs p) {
    const int idx = blockIdx.x * blockDim.x + threadIdx.x;
    if (idx >= 256 * 32) return;
    const int pos = idx >> 5, f = idx & 31;
    const float inv = powf(10000.0f, -(float)f / 32.0f);
    const float ang = (float)pos * inv;
    float* T = (float*)(p.ws + WS_ROPE);
    T[2 * idx] = (float)cos((double)ang); T[2 * idx + 1] = (float)sin((double)ang);
}
__global__ void k_prep_win(Ptrs p) {
    const size_t idx = (size_t)blockIdx.x * blockDim.x + threadIdx.x;
    if (idx >= (size_t)NPROJ_PAD * D) return;
    const int n = (int)(idx / D), k = (int)(idx % D);
    bf16_t v = 0;
    if (n < NPROJ) v = f2bf(p.w_in[(size_t)k * NPROJ + proj_src_col(n)]);
    ((bf16_t*)(p.ws + WS_WIN))[idx] = v;
}
__global__ void k_prep_wout(Ptrs p) {
    const size_t idx = (size_t)blockIdx.x * blockDim.x + threadIdx.x;
    if (idx >= (size_t)D * D) return;
    const int n = (int)(idx / D), k = (int)(idx % D);
    ((bf16_t*)(p.ws + WS_WOUT))[idx] = f2bf(p.w_out[(size_t)k * D + n]);
}
__global__ void k_prep_wgu(Ptrs p) {
    const size_t idx = (size_t)blockIdx.x * blockDim.x + threadIdx.x;
    if (idx >= (size_t)NE * 2816 * D) return;
    const int k = (int)(idx % D); const size_t rr = idx / D; const int e = (int)(rr / 2816), r = (int)(rr % 2816);
    const int pn = r >> 8, half = (r >> 7) & 1, j = r & 127, f = pn * 128 + j;
    const float* W = half ? p.w_exp_up : p.w_exp_gate;
    ((bf16_t*)(p.ws + WS_WGU))[idx] = f2bf(W[((size_t)e * D + k) * FF + f]);
}
__global__ void k_prep_wd(Ptrs p) {
    const size_t idx = (size_t)blockIdx.x * blockDim.x + threadIdx.x;
    if (idx >= (size_t)NE * D * FF) return;
    const int k = (int)(idx % FF); const size_t rr = idx / FF; const int e = (int)(rr / D), n = (int)(rr % D);
    ((bf16_t*)(p.ws + WS_WD))[idx] = f2bf(p.w_exp_down[((size_t)e * FF + k) * D + n]);
}
__global__ void k_h(Ptrs p) {
    const int row = blockIdx.x * (blockDim.x >> 6) + (threadIdx.x >> 6), lane = threadIdx.x & 63;
    if (row >= NROWS) return;
    const float* src; int m;
    if (row < NLAT) { src = p.x + (size_t)row * D; m = row / SEQ; } else { src = p.ctx + (size_t)(row - NLAT) * D; m = 2; }
    const float* mod = (const float*)(p.ws + WS_MOD) + m * NADA * D;
    float v[16]; float ss = 0.f;
#pragma unroll
    for (int j = 0; j < 4; ++j) { const float4 t = *(const float4*)(src + j * 256 + lane * 4); v[4 * j] = t.x; v[4 * j + 1] = t.y; v[4 * j + 2] = t.z; v[4 * j + 3] = t.w; ss += t.x * t.x + t.y * t.y + t.z * t.z + t.w * t.w; }
    const float rstd = rsqrtf(wave_sum(ss) * (1.0f / D) + EPS);
    bf16_t* dst = (bf16_t*)(p.ws + WS_H) + (size_t)row * D;
#pragma unroll
    for (int j = 0; j < 4; ++j)
#pragma unroll
        for (int e = 0; e < 4; ++e) { const int d = j * 256 + lane * 4 + e; dst[d] = f2bf(v[4 * j + e] * rstd * p.norm1_w[d] * (1.0f + mod[D + d]) + mod[d]); }
}
__device__ __forceinline__ void rope_pair(const float* tab, int row, int pidx  , float a1, float a2, float& o1, float& o2) {
    if (row >= NLAT) { o1 = a1; o2 = a2; return; }
    const int t = row & (SEQ - 1), pos = (pidx < 32) ? (t >> 6) : (t & 63), f = pidx & 31;
    const float cs = tab[2 * (pos * 32 + f)], sn = tab[2 * (pos * 32 + f) + 1];
    o1 = a1 * cs - a2 * sn; o2 = a1 * sn + a2 * cs;
}
__global__ void k_gemm1_naive(Ptrs p) {
    const int col = blockIdx.x * 16 + (threadIdx.x & 15), row = blockIdx.y * 16 + (threadIdx.x >> 4);
    if (col >= NPROJ || row >= NROWS) return;
    const bf16_t* H = (const bf16_t*)(p.ws + WS_H) + (size_t)row * D;
    const bf16_t* W = (const bf16_t*)(p.ws + WS_WIN);
    bf16_t* P = (bf16_t*)(p.ws + WS_P) + (size_t)row * PW;
    if (col >= C_GZ) { ((float*)(p.ws + WS_GZ))[(size_t)row * 32 + (col - C_GZ)] = dot_bf16(H, W + (size_t)col * D, D); return; }
    if (col >= C_RQ && col < C_RV) {
        const int m = (col - C_RQ) & 127;
        if ((m >> 2) & 1) return;
        float a1 = dot_bf16(H, W + (size_t)col * D, D), a2 = dot_bf16(H, W + (size_t)(col + 4) * D, D);
        if (col >= C_RK) { a1 *= 0.08838834764831845f; a2 *= 0.08838834764831845f; }
        const int pidx = 4 * (m >> 3) + (m & 3);
        float o1, o2; rope_pair((const float*)(p.ws + WS_ROPE), row, pidx, a1, a2, o1, o2);
        P[col] = f2bf(o1); P[col + 4] = f2bf(o2); return;
    }
    float a = dot_bf16(H, W + (size_t)col * D, D);
    if (col < C_GK) a *= 0.125f;
    else if ((col >= C_GG && col < C_RQ) || col >= C_RG) a = siluf(a);
    P[col] = f2bf(a);
}
template <int DK, int G>
__global__ void __launch_bounds__(128) k_scan_naive(Ptrs p, float* Of, float* Ob) {
    __shared__ bf16_t qs[64][DK + 2], ks[64][DK + 2]; __shared__ float as[64][65];
    const int v = threadIdx.x, chain = blockIdx.x, b = chain >> 3, h = (chain >> 1) & 3, dir = chain & 1;
    const bf16_t* P = (const bf16_t*)(p.ws + WS_P);
    const float* GZ = (const float*)(p.ws + WS_GZ);
    const int qoff = G ? C_RQ + h * 128 : C_GQ + h * 64, koff = G ? C_RK + h * 128 : C_GK + h * 64, voff = G ? C_RV + h * 128 : C_GV + h * 128;
    float gamma = 1.f;
    if (G) { const float lg = p.ret_decay_logit[dir * 4 + h]; gamma = 1.0f / (1.0f + __expf(-lg)); }
    float S[DK];
#pragma unroll
    for (int k = 0; k < DK; ++k) S[k] = 0.f;
    float* O = dir ? Ob : Of;
    const int nchunk = 4 + 256;
    for (int ci = 0; ci < nchunk; ++ci) {
        const bool isctx = ci < 4; int cpos = isctx ? ci : ci - 4; const int nc = isctx ? 4 : 256; if (dir) cpos = nc - 1 - cpos;
        const int row0 = isctx ? NLAT + b * CTX + cpos * 64 : b * SEQ + cpos * 64;
        __syncthreads();
        for (int i = threadIdx.x; i < 64 * DK; i += 128) { const int t = i / DK, k = i % DK; qs[t][k] = P[(size_t)(row0 + t) * PW + qoff + k]; ks[t][k] = P[(size_t)(row0 + t) * PW + koff + k]; }
        if (!G) for (int i = threadIdx.x; i < 64 * 64; i += 128) { const int t = i >> 6, k = i & 63;
            float pre = p.gla_gate_b[dir * 256 + h * 64 + k];
            for (int r = 0; r < 16; ++r) pre += GZ[(size_t)(row0 + t) * 32 + dir * 16 + r] * p.gla_gate_w[(dir * 16 + r) * 256 + h * 64 + k];
            as[t][k] = __expf(log_sigmoidf(pre) * (1.0f / 16.0f)); }
        __syncthreads();
        for (int tt = 0; tt < 64; ++tt) {
            const int t = dir ? 63 - tt : tt;
            const float vv = bf2f(P[(size_t)(row0 + t) * PW + voff + v]);
            float o = 0.f;
#pragma unroll
            for (int k = 0; k < DK; ++k) { const float a = G ? gamma : as[t][k & 63]; S[k] = a * S[k] + bf2f(ks[t][k]) * vv; o += bf2f(qs[t][k]) * S[k]; }
            if (!isctx) O[(size_t)(row0 + t) * 1024 + G * 512 + h * 128 + v] = o;
        }
    }
}
__global__ void k_headnorm_naive(Ptrs p, const float* Of, const float* Ob) {
    const int wid = blockIdx.x * (blockDim.x >> 6) + (threadIdx.x >> 6), lane = threadIdx.x & 63;
    if (wid >= NLAT * 8) return;
    const int row = wid >> 3, hh = wid & 7, g = hh >> 2, h = hh & 3;
    const size_t base = (size_t)row * 1024 + hh * 128;
    const float o0 = Of[base + lane] + Ob[base + lane], o1 = Of[base + 64 + lane] + Ob[base + 64 + lane];
    const bf16_t* P = (const bf16_t*)(p.ws + WS_P) + (size_t)row * PW + (g ? C_RG : C_GG) + h * 128;
    const float g0 = bf2f(P[lane]), g1 = bf2f(P[64 + lane]);
    float y0, y1;
    if (!g) { const float r = rsqrtf(wave_sum(o0 * o0 + o1 * o1) * (1.f / 128.f) + EPS); y0 = o0 * r * p.gla_norm_w[h * 128 + lane]; y1 = o1 * r * p.gla_norm_w[h * 128 + 64 + lane]; }
    else { const float mu = wave_sum(o0 + o1) * (1.f / 128.f); const float d0 = o0 - mu, d1 = o1 - mu; const float r = rsqrtf(wave_sum(d0 * d0 + d1 * d1) * (1.f / 128.f) + EPS);
        y0 = d0 * r * p.ret_norm_w[h * 128 + lane]; y1 = d1 * r * p.ret_norm_w[h * 128 + 64 + lane]; }
    bf16_t* Y = (bf16_t*)(p.ws + WS_H) + base;
    Y[lane] = f2bf(y0 * g0); Y[64 + lane] = f2bf(y1 * g1);
}
__global__ void k_gemm2_naive(Ptrs p) {
    const int col = blockIdx.x * 16 + (threadIdx.x & 15), row = blockIdx.y * 16 + (threadIdx.x >> 4);
    const bf16_t* Y = (const bf16_t*)(p.ws + WS_H) + (size_t)row * D;
    const float a = dot_bf16(Y, (const bf16_t*)(p.ws + WS_WOUT) + (size_t)col * D, D);
    const float* mod = (const float*)(p.ws + WS_MOD) + (row / SEQ) * NADA * D;
    p.out[(size_t)row * D + col] = p.x[(size_t)row * D + col] + mod[2 * D + col] * a;
}
__global__ void k_norm2_router(Ptrs p) {
    const int row = blockIdx.x * (blockDim.x >> 6) + (threadIdx.x >> 6), lane = threadIdx.x & 63;
    if (row >= NLAT) return;
    const int b = row / SEQ, t = row % SEQ;
    const float* src = p.out + (size_t)row * D;
    const float* mod = (const float*)(p.ws + WS_MOD) + b * NADA * D;
    float v[16]; float ss = 0.f;
#pragma unroll
    for (int j = 0; j < 4; ++j) { const float4 q = *(const float4*)(src + j * 256 + lane * 4); v[4 * j] = q.x; v[4 * j + 1] = q.y; v[4 * j + 2] = q.z; v[4 * j + 3] = q.w; ss += q.x * q.x + q.y * q.y + q.z * q.z + q.w * q.w; }
    const float rstd = rsqrtf(wave_sum(ss) * (1.0f / D) + EPS);
    bf16_t* dst = (bf16_t*)(p.ws + WS_H) + (size_t)row * D;
    float lg[NE];
#pragma unroll
    for (int e = 0; e < NE; ++e) lg[e] = 0.f;
#pragma unroll
    for (int j = 0; j < 4; ++j)
#pragma unroll
        for (int e4 = 0; e4 < 4; ++e4) { const int d = j * 256 + lane * 4 + e4; const float hv = v[4 * j + e4] * rstd * p.norm2_w[d] * (1.0f + mod[4 * D + d]) + mod[3 * D + d];
            dst[d] = f2bf(hv);
            const float4* wr = (const float4*)(p.w_router + (size_t)d * NE);
#pragma unroll
            for (int q = 0; q < 4; ++q) { const float4 w = wr[q]; lg[4 * q] += hv * w.x; lg[4 * q + 1] += hv * w.y; lg[4 * q + 2] += hv * w.z; lg[4 * q + 3] += hv * w.w; } }
    float mx = -1e30f;
#pragma unroll
    for (int e = 0; e < NE; ++e) { lg[e] = wave_sum(lg[e]); mx = fmaxf(mx, lg[e]); }
    float den = 0.f;
#pragma unroll
    for (int e = 0; e < NE; ++e) { lg[e] = __expf(lg[e] - mx); den += lg[e]; }
    float* AFF = (float*)(p.ws + WS_AFF);
    float mine = 0.f;
#pragma unroll
    for (int e = 0; e < NE; ++e) if (lane == e) mine = lg[e] / den;
    if (lane < NE) AFF[((size_t)b * NE + lane) * SEQ + t] = mine;
}
__global__ void __launch_bounds__(256) k_topk_naive(Ptrs p) {
    __shared__ float sa[SEQ];
    const int be = blockIdx.x, part = blockIdx.y;
    const float* A = (const float*)(p.ws + WS_AFF) + (size_t)be * SEQ;
    for (int i = threadIdx.x; i < SEQ; i += 256) sa[i] = A[i];
    __syncthreads();
    int* IDX = (int*)(p.ws + WS_IDX); float* GATE = (float*)(p.ws + WS_GATE); int* INV = (int*)(p.ws + WS_INV);
    const int b = be / NE, e = be % NE;
    for (int t = part * 1024 + threadIdx.x; t < part * 1024 + 1024; t += 256) {
        const float a = sa[t]; int rank = 0;
        for (int u = 0; u < SEQ; ++u) { const float o = sa[u]; rank += (o > a || (o == a && u < t)) ? 1 : 0; }
        if (rank < CAP) { IDX[be * CAP + rank] = t; GATE[be * CAP + rank] = a; INV[((size_t)b * SEQ + t) * NE + e] = rank; }
        else INV[((size_t)b * SEQ + t) * NE + e] = -1;
    }
}
__global__ void k_moe_up_naive(Ptrs p) {
    const int f = blockIdx.x * 16 + (threadIdx.x & 15), R = blockIdx.y * 16 + (threadIdx.x >> 4);
    const int be = R / CAP, b = be / NE, e = be % NE;
    const int tok = ((const int*)(p.ws + WS_IDX))[R];
    const bf16_t* h2 = (const bf16_t*)(p.ws + WS_H) + ((size_t)b * SEQ + tok) * D;
    const bf16_t* W = (const bf16_t*)(p.ws + WS_WGU) + ((size_t)e * 2816 + (f >> 7) * 256 + (f & 127)) * D;
    const float a = dot_bf16(h2, W, D), u = dot_bf16(h2, W + (size_t)128 * D, D);
    ((bf16_t*)(p.ws + WS_ACT))[(size_t)R * FF + f] = f2bf(siluf(a) * u);
}
__global__ void k_moe_down_naive(Ptrs p) {
    const int n = blockIdx.x * 16 + (threadIdx.x & 15), R = blockIdx.y * 16 + (threadIdx.x >> 4);
    const int e = (R / CAP) % NE;
    const float a = dot_bf16((const bf16_t*)(p.ws + WS_ACT) + (size_t)R * FF, (const bf16_t*)(p.ws + WS_WD) + ((size_t)e * D + n) * FF, FF);
    ((bf16_t*)(p.ws + WS_YE))[(size_t)R * D + n] = f2bf(a * ((const float*)(p.ws + WS_GATE))[R]);
}
__global__ void k_final(Ptrs p) {
    const int row = blockIdx.x * (blockDim.x >> 6) + (threadIdx.x >> 6), lane = threadIdx.x & 63;
    if (row >= NLAT) return;
    const int b = row / SEQ;
    float* xr = p.out + (size_t)row * D;
    const float* mod = (const float*)(p.ws + WS_MOD) + b * NADA * D + 5 * D;
    const int* inv = (const int*)(p.ws + WS_INV) + (size_t)row * NE;
    const bf16_t* YE = (const bf16_t*)(p.ws + WS_YE);
    float acc[16];
#pragma unroll
    for (int i = 0; i < 16; ++i) acc[i] = 0.f;
    for (int e = 0; e < NE; ++e) { const int s = inv[e]; if (s < 0) continue;
        const bf16_t* y = YE + ((size_t)(b * NE + e) * CAP + s) * D;
#pragma unroll
        for (int j = 0; j < 4; ++j) { const uint2 w = *(const uint2*)(y + j * 256 + lane * 4);
            acc[4 * j] += __uint_as_float(w.x << 16); acc[4 * j + 1] += __uint_as_float(w.x & 0xffff0000u); acc[4 * j + 2] += __uint_as_float(w.y << 16); acc[4 * j + 3] += __uint_as_float(w.y & 0xffff0000u); } }
    float v[16]; float ss = 0.f;
#pragma unroll
    for (int j = 0; j < 4; ++j) { const float4 q = *(const float4*)(xr + j * 256 + lane * 4); const float4 m = *(const float4*)(mod + j * 256 + lane * 4);
        v[4 * j] = q.x + m.x * acc[4 * j]; v[4 * j + 1] = q.y + m.y * acc[4 * j + 1]; v[4 * j + 2] = q.z + m.z * acc[4 * j + 2]; v[4 * j + 3] = q.w + m.w * acc[4 * j + 3];
        ss += v[4 * j] * v[4 * j] + v[4 * j + 1] * v[4 * j + 1] + v[4 * j + 2] * v[4 * j + 2] + v[4 * j + 3] * v[4 * j + 3]; }
    const float rstd = rsqrtf(wave_sum(ss) * (1.0f / D) + EPS);
#pragma unroll
    for (int j = 0; j < 4; ++j) { const float4 w = *(const float4*)(p.final_norm_w + j * 256 + lane * 4);
        *(float4*)(xr + j * 256 + lane * 4) = make_float4(v[4 * j] * rstd * w.x, v[4 * j + 1] * rstd * w.y, v[4 * j + 2] * rstd * w.z, v[4 * j + 3] * rstd * w.w); }
}

extern "C" void kernel_launch(void* const* d_in, const int* in_sizes, int n_in, void* d_out, int out_size, void* d_ws, size_t ws_size, hipStream_t stream) {
    if (n_in != 20 || ws_size < WS_END) { fprintf(stderr, "kernel_launch: unexpected n_in %d / ws_size %zu\n", n_in, ws_size); return; }
    Ptrs p{};
    const float** f = (const float**)&p;
    for (int i = 0; i < 20; ++i) f[i] = (const float*)d_in[i];
    p.out = (float*)d_out; p.ws = (unsigned char*)d_ws;
    float* Of = (float*)((unsigned char*)d_ws + WS_OF); float* Ob = (float*)d_out;
    k_mod<<<(3 * NADA * D + 255) / 256, 256, 0, stream>>>(p);
    k_rope<<<32, 256, 0, stream>>>(p);
    k_prep_win<<<(NPROJ_PAD * D + 255) / 256, 256, 0, stream>>>(p);
    k_prep_wout<<<(D * D + 255) / 256, 256, 0, stream>>>(p);
    k_h<<<NROWS / 4, 256, 0, stream>>>(p);
    k_gemm1_naive<<<dim3(NPROJ / 16, NROWS / 16), 256, 0, stream>>>(p);
    k_scan_naive<64, 0><<<16, 128, 0, stream>>>(p, Of, Ob);
    k_scan_naive<128, 1><<<16, 128, 0, stream>>>(p, Of, Ob);
    k_headnorm_naive<<<NLAT * 8 / 4, 256, 0, stream>>>(p, Of, Ob);
    k_gemm2_naive<<<dim3(D / 16, NLAT / 16), 256, 0, stream>>>(p);
    k_prep_wgu<<<(unsigned)(((size_t)NE * 2816 * D + 255) / 256), 256, 0, stream>>>(p);
    k_prep_wd<<<(unsigned)(((size_t)NE * D * FF + 255) / 256), 256, 0, stream>>>(p);
    k_norm2_router<<<NLAT / 4, 256, 0, stream>>>(p);
    k_topk_naive<<<dim3(32, 16), 256, 0, stream>>>(p);
    k_moe_up_naive<<<dim3(FF / 16, NSLOT / 16), 256, 0, stream>>>(p);
    k_moe_down_naive<<<dim3(D / 16, NSLOT / 16), 256, 0, stream>>>(p);
    k_final<<<NLAT / 4, 256, 0, stream>>>(p);
}
```

```cpp
#include <hip/hip_runtime.h>
#include <stdint.h>
#include <stdio.h>

typedef unsigned short bf16_t;
typedef unsigned int u32;

constexpr int D = 1024, BATCH = 2, SEQ = 16384, CTX = 256;
constexpr int NLAT = BATCH * SEQ;
constexpr int NCTX = BATCH * CTX;
constexpr int NROWS = NLAT + NCTX;
constexpr int NADA = 6;
constexpr int NE = 16, CAP = 2048, FF = 1408;
constexpr int NSLOT = BATCH * NE * CAP;
constexpr float EPS = 1e-6f;
constexpr int C_GQ = 0, C_GK = 256, C_GV = 512, C_GG = 1024, C_RQ = 1536, C_RK = 2048, C_RV = 2560, C_RG = 3072, C_GZ = 3584;
constexpr int PW = 3584;
constexpr int NPROJ = 3616, NPROJ_PAD = 3840;

constexpr size_t MiB = 1u << 20;
constexpr size_t WS_CTL = 0;
constexpr size_t WS_MOD = 1 * MiB;
constexpr size_t WS_ROPE = WS_MOD + 128 * 1024;
constexpr size_t WS_DCH = 2 * MiB;
constexpr size_t WS_WIN = 4 * MiB;
constexpr size_t WS_WOUT = 12 * MiB;
constexpr size_t WS_GZ = 14 * MiB;
constexpr size_t WS_H = 19 * MiB;
constexpr size_t WS_P = 84 * MiB;
constexpr size_t WS_US = 312 * MiB;
constexpr size_t WS_WGU = 84 * MiB;
constexpr size_t WS_WD = 172 * MiB;
constexpr size_t WS_ACT = 216 * MiB;
constexpr size_t WS_AFF = 392 * MiB;
constexpr size_t WS_IDX = 394 * MiB;
constexpr size_t WS_GATE = 395 * MiB;
constexpr size_t WS_INV = 396 * MiB;
constexpr size_t WS_YE = 19 * MiB;
constexpr size_t WS_OF = 312 * MiB;
constexpr size_t WS_END = 508 * MiB;

__device__ __forceinline__ float bf2f(bf16_t v) { return __uint_as_float(((u32)v) << 16); }
__device__ __forceinline__ bf16_t f2bf(float f) { u32 u = __float_as_uint(f); return (bf16_t)((u + 0x7fffu + ((u >> 16) & 1u)) >> 16); }
__device__ __forceinline__ float siluf(float x) { return x / (1.0f + __expf(-x)); }
__device__ __forceinline__ float log_sigmoidf(float x) { return fminf(x, 0.f) - log1pf(__expf(-fabsf(x))); }
__device__ __forceinline__ float wave_sum(float v) {
#pragma unroll
    for (int o = 1; o < 64; o <<= 1) v += __shfl_xor(v, o);
    return v;
}
__device__ __forceinline__ float dot_bf16(const bf16_t* __restrict__ a, const bf16_t* __restrict__ b, int K) {
    float acc = 0.f;
    for (int k = 0; k < K; k += 8) {
        const uint4 va = *(const uint4*)(a + k), vb = *(const uint4*)(b + k);
        const u32 wa[4] = {va.x, va.y, va.z, va.w}, wb[4] = {vb.x, vb.y, vb.z, vb.w};
#pragma unroll
        for (int i = 0; i < 4; ++i) {
            acc += __uint_as_float(wa[i] << 16) * __uint_as_float(wb[i] << 16);
            acc += __uint_as_float(wa[i] & 0xffff0000u) * __uint_as_float(wb[i] & 0xffff0000u);
        }
    }
    return acc;
}
__host__ __device__ inline int proj_src_col(int n) {
    if (n < 1024) return n;
    if (n < 1536) return 1056 + (n - 1024);
    if (n < 2560) {
        const int base = (n < 2048) ? 1568 : 2080, m = (n < 2048) ? n - 1536 : n - 2048;
        const int hd = m >> 7, p = m & 127, g = p >> 3, nn = (p >> 2) & 1, e = p & 3;
        return base + hd * 128 + 64 * nn + 4 * g + e;
    }
    if (n < 3072) return 2592 + (n - 2560);
    if (n < 3584) return 3104 + (n - 3072);
    return 1024 + (n - 3584);
}

struct Ptrs {
    const float *x, *c, *ctx, *c_ctx, *w_ada, *b_ada, *norm1_w, *w_in, *gla_gate_w, *gla_gate_b, *ret_decay_logit, *gla_norm_w, *ret_norm_w,
        *w_out, *norm2_w, *w_router, *w_exp_gate, *w_exp_up, *w_exp_down, *final_norm_w;
    float* out;
    unsigned char* ws;
};

__global__ void k_mod(Ptrs p) {
    const int idx = blockIdx.x * blockDim.x + threadIdx.x;
    if (idx >= 3 * NADA * D) return;
    const int r = idx / (NADA * D), j = idx % (NADA * D);
    const float* cv = (r < 2) ? p.c + r * D : p.c_ctx;
    float acc = 0.f;
    for (int k = 0; k < D; ++k) acc += siluf(cv[k]) * p.w_ada[(size_t)k * (NADA * D) + j];
    ((float*)(p.ws + WS_MOD))[idx] = acc + p.b_ada[j];
}
__global__ void k_rope(Ptrs p) {
    const int idx = blockIdx.x * blockDim.x + threadIdx.x;
    if (idx >= 256 * 32) return;
    const int pos = idx >> 5, f = idx & 31;
    const float inv = powf(10000.0f, -(float)f / 32.0f);
    const float ang = (float)pos * inv;
    float* T = (float*)(p.ws + WS_ROPE);
    T[2 * idx] = (float)cos((double)ang); T[2 * idx + 1] = (float)sin((double)ang);
}
__global__ void k_prep_win(Ptrs p) {
    const size_t idx = (size_t)blockIdx.x * blockDim.x + threadIdx.x;
    if (idx >= (size_t)NPROJ_PAD * D) return;
    const int n = (int)(idx / D), k = (int)(idx % D);
    bf16_t v = 0;
    if (n < NPROJ) v = f2bf(p.w_in[(size_t)k * NPROJ + proj_src_col(n)]);
    ((bf16_t*)(p.ws + WS_WIN))[idx] = v;
}
__global__ void k_prep_wout(Ptrs p) {
    const size_t idx = (size_t)blockIdx.x * blockDim.x + threadIdx.x;
    if (idx >= (size_t)D * D) return;
    const int n = (int)(idx / D), k = (int)(idx % D);
    ((bf16_t*)(p.ws + WS_WOUT))[idx] = f2bf(p.w_out[(size_t)k * D + n]);
}
__global__ void k_prep_wgu(Ptrs p) {
    const size_t idx = (size_t)blockIdx.x * blockDim.x + threadIdx.x;
    if (idx >= (size_t)NE * 2816 * D) return;
    const int k = (int)(idx % D); const size_t rr = idx / D; const int e = (int)(rr / 2816), r = (int)(rr % 2816);
    const int pn = r >> 8, half = (r >> 7) & 1, j = r & 127, f = pn * 128 + j;
    const float* W = half ? p.w_exp_up : p.w_exp_gate;
    ((bf16_t*)(p.ws + WS_WGU))[idx] = f2bf(W[((size_t)e * D + k) * FF + f]);
}
__global__ void k_prep_wd(Ptrs p) {
    const size_t idx = (size_t)blockIdx.x * blockDim.x + threadIdx.x;
    if (idx >= (size_t)NE * D * FF) return;
    const int k = (int)(idx % FF); const size_t rr = idx / FF; const int e = (int)(rr / D), n = (int)(rr % D);
    ((bf16_t*)(p.ws + WS_WD))[idx] = f2bf(p.w_exp_down[((size_t)e * FF + k) * D + n]);
}
__global__ void k_h(Ptrs p) {
    const int row = blockIdx.x * (blockDim.x >> 6) + (threadIdx.x >> 6), lane = threadIdx.x & 63;
    if (row >= NROWS) return;
    const float* src; int m;
    if (row < NLAT) { src = p.x + (size_t)row * D; m = row / SEQ; } else { src = p.ctx + (size_t)(row - NLAT) * D; m = 2; }
    const float* mod = (const float*)(p.ws + WS_MOD) + m * NADA * D;
    float v[16]; float ss = 0.f;
#pragma unroll
    for (int j = 0; j < 4; ++j) { const float4 t = *(const float4*)(src + j * 256 + lane * 4); v[4 * j] = t.x; v[4 * j + 1] = t.y; v[4 * j + 2] = t.z; v[4 * j + 3] = t.w; ss += t.x * t.x + t.y * t.y + t.z * t.z + t.w * t.w; }
    const float rstd = rsqrtf(wave_sum(ss) * (1.0f / D) + EPS);
    bf16_t* dst = (bf16_t*)(p.ws + WS_H) + (size_t)row * D;
#pragma unroll
    for (int j = 0; j < 4; ++j)
#pragma unroll
        for (int e = 0; e < 4; ++e) { const int d = j * 256 + lane * 4 + e; dst[d] = f2bf(v[4 * j + e] * rstd * p.norm1_w[d] * (1.0f + mod[D + d]) + mod[d]); }
}
__device__ __forceinline__ void rope_pair(const float* tab, int row, int pidx  , float a1, float a2, float& o1, float& o2) {
    if (row >= NLAT) { o1 = a1; o2 = a2; return; }
    const int t = row & (SEQ - 1), pos = (pidx < 32) ? (t >> 6) : (t & 63), f = pidx & 31;
    const float cs = tab[2 * (pos * 32 + f)], sn = tab[2 * (pos * 32 + f) + 1];
    o1 = a1 * cs - a2 * sn; o2 = a1 * sn + a2 * cs;
}
__global__ void k_gemm1_naive(Ptrs p) {
    const int col = blockIdx.x * 16 + (threadIdx.x & 15), row = blockIdx.y * 16 + (threadIdx.x >> 4);
    if (col >= NPROJ || row >= NROWS) return;
    const bf16_t* H = (const bf16_t*)(p.ws + WS_H) + (size_t)row * D;
    const bf16_t* W = (const bf16_t*)(p.ws + WS_WIN);
    bf16_t* P = (bf16_t*)(p.ws + WS_P) + (size_t)row * PW;
    if (col >= C_GZ) { ((float*)(p.ws + WS_GZ))[(size_t)row * 32 + (col - C_GZ)] = dot_bf16(H, W + (size_t)col * D, D); return; }
    if (col >= C_RQ && col < C_RV) {
        const int m = (col - C_RQ) & 127;
        if ((m >> 2) & 1) return;
        float a1 = dot_bf16(H, W + (size_t)col * D, D), a2 = dot_bf16(H, W + (size_t)(col + 4) * D, D);
        if (col >= C_RK) { a1 *= 0.08838834764831845f; a2 *= 0.08838834764831845f; }
        const int pidx = 4 * (m >> 3) + (m & 3);
        float o1, o2; rope_pair((const float*)(p.ws + WS_ROPE), row, pidx, a1, a2, o1, o2);
        P[col] = f2bf(o1); P[col + 4] = f2bf(o2); return;
    }
    float a = dot_bf16(H, W + (size_t)col * D, D);
    if (col < C_GK) a *= 0.125f;
    else if ((col >= C_GG && col < C_RQ) || col >= C_RG) a = siluf(a);
    P[col] = f2bf(a);
}
template <int DK, int G>
__global__ void __launch_bounds__(128) k_scan_naive(Ptrs p, float* Of, float* Ob, int zero_state) {
    __shared__ bf16_t qs[64][DK + 2], ks[64][DK + 2]; __shared__ float as[64][65];
    const int v = threadIdx.x, chain = blockIdx.x, b = chain >> 3, h = (chain >> 1) & 3, dir = chain & 1;
    const bf16_t* P = (const bf16_t*)(p.ws + WS_P);
    const float* GZ = (const float*)(p.ws + WS_GZ);
    const int qoff = G ? C_RQ + h * 128 : C_GQ + h * 64, koff = G ? C_RK + h * 128 : C_GK + h * 64, voff = G ? C_RV + h * 128 : C_GV + h * 128;
    float gamma = 1.f;
    if (G) { const float lg = p.ret_decay_logit[dir * 4 + h]; gamma = 1.0f / (1.0f + __expf(-lg)); }
    float S[DK];
#pragma unroll
    for (int k = 0; k < DK; ++k) S[k] = 0.f;
    float* O = dir ? Ob : Of;
    const int nchunk = 4 + 256;
    for (int ci = 0; ci < nchunk; ++ci) {
        const bool isctx = ci < 4; int cpos = isctx ? ci : ci - 4; const int nc = isctx ? 4 : 256; if (dir) cpos = nc - 1 - cpos;
        const int row0 = isctx ? NLAT + b * CTX + cpos * 64 : b * SEQ + cpos * 64;
        __syncthreads();
        for (int i = threadIdx.x; i < 64 * DK; i += 128) { const int t = i / DK, k = i % DK; qs[t][k] = P[(size_t)(row0 + t) * PW + qoff + k]; ks[t][k] = P[(size_t)(row0 + t) * PW + koff + k]; }
        if (!G) for (int i = threadIdx.x; i < 64 * 64; i += 128) { const int t = i >> 6, k = i & 63;
            float pre = p.gla_gate_b[dir * 256 + h * 64 + k];
            for (int r = 0; r < 16; ++r) pre += GZ[(size_t)(row0 + t) * 32 + dir * 16 + r] * p.gla_gate_w[(dir * 16 + r) * 256 + h * 64 + k];
            as[t][k] = __expf(log_sigmoidf(pre) * (1.0f / 16.0f)); }
        __syncthreads();
        if (zero_state) {
#pragma unroll
            for (int k = 0; k < DK; ++k) S[k] = 0.f; }
        for (int tt = 0; tt < 64; ++tt) {
            const int t = dir ? 63 - tt : tt;
            const float vv = bf2f(P[(size_t)(row0 + t) * PW + voff + v]);
            float o = 0.f;
#pragma unroll
            for (int k = 0; k < DK; ++k) { const float a = G ? gamma : as[t][k & 63]; S[k] = a * S[k] + bf2f(ks[t][k]) * vv; o += bf2f(qs[t][k]) * S[k]; }
            if (!isctx) O[(size_t)(row0 + t) * 1024 + G * 512 + h * 128 + v] = o;
        }
    }
}
__global__ void k_headnorm_naive(Ptrs p, const float* Of, const float* Ob) {
    const int wid = blockIdx.x * (blockDim.x >> 6) + (threadIdx.x >> 6), lane = threadIdx.x & 63;
    if (wid >= NLAT * 8) return;
    const int row = wid >> 3, hh = wid & 7, g = hh >> 2, h = hh & 3;
    const size_t base = (size_t)row * 1024 + hh * 128;
    const float o0 = Of[base + lane] + Ob[base + lane], o1 = Of[base + 64 + lane] + Ob[base + 64 + lane];
    const bf16_t* P = (const bf16_t*)(p.ws + WS_P) + (size_t)row * PW + (g ? C_RG : C_GG) + h * 128;
    const float g0 = bf2f(P[lane]), g1 = bf2f(P[64 + lane]);
    float y0, y1;
    if (!g) { const float r = rsqrtf(wave_sum(o0 * o0 + o1 * o1) * (1.f / 128.f) + EPS); y0 = o0 * r * p.gla_norm_w[h * 128 + lane]; y1 = o1 * r * p.gla_norm_w[h * 128 + 64 + lane]; }
    else { const float mu = wave_sum(o0 + o1) * (1.f / 128.f); const float d0 = o0 - mu, d1 = o1 - mu; const float r = rsqrtf(wave_sum(d0 * d0 + d1 * d1) * (1.f / 128.f) + EPS);
        y0 = d0 * r * p.ret_norm_w[h * 128 + lane]; y1 = d1 * r * p.ret_norm_w[h * 128 + 64 + lane]; }
    bf16_t* Y = (bf16_t*)(p.ws + WS_H) + base;
    Y[lane] = f2bf(y0 * g0); Y[64 + lane] = f2bf(y1 * g1);
}
__global__ void k_gemm2_naive(Ptrs p) {
    const int col = blockIdx.x * 16 + (threadIdx.x & 15), row = blockIdx.y * 16 + (threadIdx.x >> 4);
    const bf16_t* Y = (const bf16_t*)(p.ws + WS_H) + (size_t)row * D;
    const float a = dot_bf16(Y, (const bf16_t*)(p.ws + WS_WOUT) + (size_t)col * D, D);
    const float* mod = (const float*)(p.ws + WS_MOD) + (row / SEQ) * NADA * D;
    p.out[(size_t)row * D + col] = p.x[(size_t)row * D + col] + mod[2 * D + col] * a;
}
__global__ void k_norm2_router(Ptrs p) {
    const int row = blockIdx.x * (blockDim.x >> 6) + (threadIdx.x >> 6), lane = threadIdx.x & 63;
    if (row >= NLAT) return;
    const int b = row / SEQ, t = row % SEQ;
    const float* src = p.out + (size_t)row * D;
    const float* mod = (const float*)(p.ws + WS_MOD) + b * NADA * D;
    float v[16]; float ss = 0.f;
#pragma unroll
    for (int j = 0; j < 4; ++j) { const float4 q = *(const float4*)(src + j * 256 + lane * 4); v[4 * j] = q.x; v[4 * j + 1] = q.y; v[4 * j + 2] = q.z; v[4 * j + 3] = q.w; ss += q.x * q.x + q.y * q.y + q.z * q.z + q.w * q.w; }
    const float rstd = rsqrtf(wave_sum(ss) * (1.0f / D) + EPS);
    bf16_t* dst = (bf16_t*)(p.ws + WS_H) + (size_t)row * D;
    float lg[NE];
#pragma unroll
    for (int e = 0; e < NE; ++e) lg[e] = 0.f;
#pragma unroll
    for (int j = 0; j < 4; ++j)
#pragma unroll
        for (int e4 = 0; e4 < 4; ++e4) { const int d = j * 256 + lane * 4 + e4; const float hv = v[4 * j + e4] * rstd * p.norm2_w[d] * (1.0f + mod[4 * D + d]) + mod[3 * D + d];
            dst[d] = f2bf(hv);
            const float4* wr = (const float4*)(p.w_router + (size_t)d * NE);
#pragma unroll
            for (int q = 0; q < 4; ++q) { const float4 w = wr[q]; lg[4 * q] += hv * w.x; lg[4 * q + 1] += hv * w.y; lg[4 * q + 2] += hv * w.z; lg[4 * q + 3] += hv * w.w; } }
    float mx = -1e30f;
#pragma unroll
    for (int e = 0; e < NE; ++e) { lg[e] = wave_sum(lg[e]); mx = fmaxf(mx, lg[e]); }
    float den = 0.f;
#pragma unroll
    for (int e = 0; e < NE; ++e) { lg[e] = __expf(lg[e] - mx); den += lg[e]; }
    float* AFF = (float*)(p.ws + WS_AFF);
    float mine = 0.f;
#pragma unroll
    for (int e = 0; e < NE; ++e) if (lane == e) mine = lg[e] / den;
    if (lane < NE) AFF[((size_t)b * NE + lane) * SEQ + t] = mine;
}
__global__ void __launch_bounds__(256) k_topk_naive(Ptrs p) {
    __shared__ float sa[SEQ];
    const int be = blockIdx.x, part = blockIdx.y;
    const float* A = (const float*)(p.ws + WS_AFF) + (size_t)be * SEQ;
    for (int i = threadIdx.x; i < SEQ; i += 256) sa[i] = A[i];
    __syncthreads();
    int* IDX = (int*)(p.ws + WS_IDX); float* GATE = (float*)(p.ws + WS_GATE); int* INV = (int*)(p.ws + WS_INV);
    const int b = be / NE, e = be % NE;
    for (int t = part * 1024 + threadIdx.x; t < part * 1024 + 1024; t += 256) {
        const float a = sa[t]; int rank = 0;
        for (int u = 0; u < SEQ; ++u) { const float o = sa[u]; rank += (o > a || (o == a && u < t)) ? 1 : 0; }
        if (rank < CAP) { IDX[be * CAP + rank] = t; GATE[be * CAP + rank] = a; INV[((size_t)b * SEQ + t) * NE + e] = rank; }
        else INV[((size_t)b * SEQ + t) * NE + e] = -1;
    }
}
__global__ void k_moe_up_naive(Ptrs p) {
    const int f = blockIdx.x * 16 + (threadIdx.x & 15), R = blockIdx.y * 16 + (threadIdx.x >> 4);
    const int be = R / CAP, b = be / NE, e = be % NE;
    const int tok = ((const int*)(p.ws + WS_IDX))[R];
    const bf16_t* h2 = (const bf16_t*)(p.ws + WS_H) + ((size_t)b * SEQ + tok) * D;
    const bf16_t* W = (const bf16_t*)(p.ws + WS_WGU) + ((size_t)e * 2816 + (f >> 7) * 256 + (f & 127)) * D;
    const float a = dot_bf16(h2, W, D), u = dot_bf16(h2, W + (size_t)128 * D, D);
    ((bf16_t*)(p.ws + WS_ACT))[(size_t)R * FF + f] = f2bf(siluf(a) * u);
}
__global__ void k_moe_down_naive(Ptrs p) {
    const int n = blockIdx.x * 16 + (threadIdx.x & 15), R = blockIdx.y * 16 + (threadIdx.x >> 4);
    const int e = (R / CAP) % NE;
    const float a = dot_bf16((const bf16_t*)(p.ws + WS_ACT) + (size_t)R * FF, (const bf16_t*)(p.ws + WS_WD) + ((size_t)e * D + n) * FF, FF);
    ((bf16_t*)(p.ws + WS_YE))[(size_t)R * D + n] = f2bf(a * ((const float*)(p.ws + WS_GATE))[R]);
}
__global__ void k_final(Ptrs p) {
    const int row = blockIdx.x * (blockDim.x >> 6) + (threadIdx.x >> 6), lane = threadIdx.x & 63;
    if (row >= NLAT) return;
    const int b = row / SEQ;
    float* xr = p.out + (size_t)row * D;
    const float* mod = (const float*)(p.ws + WS_MOD) + b * NADA * D + 5 * D;
    const int* inv = (const int*)(p.ws + WS_INV) + (size_t)row * NE;
    const bf16_t* YE = (const bf16_t*)(p.ws + WS_YE);
    float acc[16];
#pragma unroll
    for (int i = 0; i < 16; ++i) acc[i] = 0.f;
    for (int e = 0; e < NE; ++e) { const int s = inv[e]; if (s < 0) continue;
        const bf16_t* y = YE + ((size_t)(b * NE + e) * CAP + s) * D;
#pragma unroll
        for (int j = 0; j < 4; ++j) { const uint2 w = *(const uint2*)(y + j * 256 + lane * 4);
            acc[4 * j] += __uint_as_float(w.x << 16); acc[4 * j + 1] += __uint_as_float(w.x & 0xffff0000u); acc[4 * j + 2] += __uint_as_float(w.y << 16); acc[4 * j + 3] += __uint_as_float(w.y & 0xffff0000u); } }
    float v[16]; float ss = 0.f;
#pragma unroll
    for (int j = 0; j < 4; ++j) { const float4 q = *(const float4*)(xr + j * 256 + lane * 4); const float4 m = *(const float4*)(mod + j * 256 + lane * 4);
        v[4 * j] = q.x + m.x * acc[4 * j]; v[4 * j + 1] = q.y + m.y * acc[4 * j + 1]; v[4 * j + 2] = q.z + m.z * acc[4 * j + 2]; v[4 * j + 3] = q.w + m.w * acc[4 * j + 3];
        ss += v[4 * j] * v[4 * j] + v[4 * j + 1] * v[4 * j + 1] + v[4 * j + 2] * v[4 * j + 2] + v[4 * j + 3] * v[4 * j + 3]; }
    const float rstd = rsqrtf(wave_sum(ss) * (1.0f / D) + EPS);
#pragma unroll
    for (int j = 0; j < 4; ++j) { const float4 w = *(const float4*)(p.final_norm_w + j * 256 + lane * 4);
        *(float4*)(xr + j * 256 + lane * 4) = make_float4(v[4 * j] * rstd * w.x, v[4 * j + 1] * rstd * w.y, v[4 * j + 2] * rstd * w.z, v[4 * j + 3] * rstd * w.w); }
}


constexpr int NWAVES = 8, NTHR = NWAVES * 64;
#define LAS __attribute__((address_space(3)))
#define GAS __attribute__((address_space(1)))
typedef short bf16x8 __attribute__((ext_vector_type(8)));
typedef float f32x4 __attribute__((ext_vector_type(4)));
typedef float f32x2 __attribute__((ext_vector_type(2)));
typedef unsigned u32x4 __attribute__((ext_vector_type(4)));
typedef unsigned u32x2 __attribute__((ext_vector_type(2)));
namespace pg8 {
constexpr int BM = 256, BK = 64, HALF = 128, HTB = HALF * BK * 2  , STAGE_BYTES = 8 * HTB, NXCD = 8, WGM = 8;
__host__ __device__ __forceinline__ int lds_byte(int r, int c) { const int st = (r >> 4) * 2 + (c >> 5), rr = r & 15, cc = c & 31, ob = rr * 64 + cc * 2; return st * 1024 + (ob ^ (((ob >> 9) & 1) << 5)); }
__host__ __device__ __forceinline__ void stage_rc(int b, int& R, int& C) { const int st = b / 1024, sb = b % 1024, swz = sb ^ (((sb >> 9) & 1) << 5); R = (st >> 1) * 16 + swz / 64; C = (st & 1) * 32 + (swz % 64) / 2; }
__host__ __device__ __forceinline__ int perm32(int rho) { const int n = rho >> 4, i = rho & 15; return 8 * (i >> 2) + 4 * n + (i & 3); }

struct Unit { int pm, pn; };
struct Gemm { const bf16_t* A; const bf16_t* Bt; int K; };

struct StaticOrder {
    int nM, nN, nwg, G, c;
    __device__ void init(int nM_, int nN_, int G_, int c_) { nM = nM_; nN = nN_; nwg = nM * nN; G = G_; c = c_; }
    __device__ bool next(int i, Unit& u) const {
        const long L = (long)i * G + c; if (L >= nwg) return false;
        int wgid = (int)L; { const int q = nwg / NXCD, r = nwg % NXCD, xcd = wgid % NXCD, off = wgid / NXCD; wgid = (xcd < r ? xcd * (q + 1) : r * (q + 1) + (xcd - r) * q) + off; }
        const int nig = WGM * nN, gid = wgid / nig, fm = gid * WGM, gsz = (nM - fm) < WGM ? (nM - fm) : WGM;
        u.pm = fm + ((wgid % nig) % gsz); u.pn = (wgid % nig) / gsz; return true;
    }
};
struct MoeUpOrder {
    int c;
    __device__ bool next(int i, Unit& u) const {
        if (i >= 11) return false;
        const int g = i * 8 + (c & 7), j = c >> 3, combo = 4 * g + (j >> 3), mt = j & 7, be = combo / 11, pn = combo % 11;
        u.pm = be * 8 + mt; u.pn = (be & 15) * 11 + pn; return true;
    }
};
struct MoeDownOrder {
    int c;
    __device__ bool next(int i, Unit& u) const {
        if (i >= 4) return false;
        const int be = i * 8 + (c & 7), j = c >> 3, mt = j & 7, pn = j >> 3;
        u.pm = be * 8 + mt; u.pn = (be & 15) * 4 + pn; return true;
    }
};

typedef __bf16 bf16x2_t __attribute__((ext_vector_type(2)));
__device__ __forceinline__ unsigned cvt_pk_bf16(float lo, float hi) { const f32x2 v = {lo, hi}; const bf16x2_t r = __builtin_convertvector(v, bf16x2_t); return __builtin_bit_cast(unsigned, r); }

template <class Epi, class Sched, bool GATHER>
__device__ __forceinline__ void gemm_phase(LAS unsigned char* lds, const Gemm g, const Sched& S, const Epi& E, const LAS unsigned* gtab) {
    const int tid = threadIdx.x, wid = __builtin_amdgcn_readfirstlane(tid >> 6), lane = tid & 63, wr = wid >> 2, wc = wid & 3, fr = lane & 15, fq = lane >> 4;
    const int K = g.K, nt = K / BK;
    int sR[2], sC[2];
    unsigned voffB[2], cvo[2][2], nvo[2][2];
#pragma unroll
    for (int i = 0; i < 2; ++i) { stage_rc(tid * 16 + i * 8192, sR[i], sC[i]); const int Rb = Epi::PERM ? ((sR[i] & ~31) + perm32(sR[i] & 31)) : sR[i];
        voffB[i] = (unsigned)(Rb * K + sC[i]) * 2u; }
    const size_t kstep = (size_t)(BK * 2);
    const size_t hstep = (size_t)HALF * K * 2;
    const size_t tstep = 2 * hstep;
    const unsigned ldsw = (unsigned)wid * 1024u;
    const int aoff = lds_byte(wr * 64 + fr, fq * 8), boff = lds_byte(wc * 32 + fr, fq * 8);
#define PG8_SA(b, h) (((b) * 2 + (h)) * HTB)
#define PG8_SB(b, h) ((4 + (b) * 2 + (h)) * HTB)
#define PG8_STAGE(bufoff, gbase, voff) do { _Pragma("unroll") for (int _i = 0; _i < 2; ++_i) \
        __builtin_amdgcn_global_load_lds((const unsigned*)((const char*)(gbase) + (voff)[_i]), (LAS unsigned*)(lds + (bufoff) + ldsw + _i * 8192), 16, 0, 0); } while (0)
#define PG8_LDA(dst, b, h) do { _Pragma("unroll") for (int m = 0; m < 4; ++m) _Pragma("unroll") for (int k = 0; k < 2; ++k) dst[m][k] = *(const LAS bf16x8*)(lds + PG8_SA(b, h) + aoff + m * 2048 + k * 1024); } while (0)
#define PG8_LDB(dst, b, h) do { _Pragma("unroll") for (int n = 0; n < 2; ++n) _Pragma("unroll") for (int k = 0; k < 2; ++k) dst[n][k] = *(const LAS bf16x8*)(lds + PG8_SB(b, h) + boff + n * 2048 + k * 1024); } while (0)
#define PG8_MMA(ai, bj, At, Bt) do { __builtin_amdgcn_s_setprio(1); _Pragma("unroll") for (int m = 0; m < 4; ++m) _Pragma("unroll") for (int n = 0; n < 2; ++n) _Pragma("unroll") for (int k = 0; k < 2; ++k) \
        acc[ai][bj][m][n] = __builtin_amdgcn_mfma_f32_16x16x32_bf16(Bt[n][k], At[m][k], acc[ai][bj][m][n], 0, 0, 0); __builtin_amdgcn_s_setprio(0); } while (0)
#define PG8_WAIT_V(n) asm volatile("s_waitcnt vmcnt(" #n ")" ::: "memory")
#define PG8_WAIT_L(n) asm volatile("s_waitcnt lgkmcnt(" #n ")" ::: "memory")
#define PG8_BAR __builtin_amdgcn_s_barrier()
#define PG8_SCHED __builtin_amdgcn_sched_barrier(0)
#define PG8_SETVO(vo, ui_) do { _Pragma("unroll") for (int _h = 0; _h < 2; ++_h) _Pragma("unroll") for (int _i = 0; _i < 2; ++_i) { \
        if constexpr (GATHER) vo[_h][_i] = (gtab[(ui_) * 256 + _h * HALF + sR[_i]] + (unsigned)sC[_i]) * 2u; else vo[_h][_i] = (unsigned)(sR[_i] * K + sC[_i]) * 2u; } } while (0)
#define PG8_HOFF(h) (GATHER ? (size_t)0 : (size_t)(h) * hstep)
    Unit cur, nxt; int ui = 0;
    if (!S.next(0, cur)) return;
    f32x4 acc[2][2][4][2];
#pragma unroll
    for (int a = 0; a < 2; ++a)
#pragma unroll
        for (int b = 0; b < 2; ++b)
#pragma unroll
            for (int m = 0; m < 4; ++m)
#pragma unroll
                for (int n = 0; n < 2; ++n) acc[a][b][m][n] = (f32x4){0.f, 0.f, 0.f, 0.f};
    bf16x8 At[4][2], B0[2][2], B1[2][2];
    PG8_SETVO(cvo, 0);
    const char* cA = (const char*)g.A + (GATHER ? (size_t)0 : (size_t)cur.pm * tstep); const char* cB = (const char*)g.Bt + (size_t)cur.pn * tstep;
    PG8_STAGE(PG8_SB(0, 0), cB, voffB); PG8_STAGE(PG8_SB(0, 1), cB + hstep, voffB); PG8_STAGE(PG8_SA(0, 0), cA, cvo[0]); PG8_STAGE(PG8_SA(0, 1), cA + PG8_HOFF(1), cvo[1]);
    if (wr == 1) PG8_BAR;
    PG8_WAIT_V(2); PG8_BAR;
    PG8_STAGE(PG8_SB(1, 0), cB + kstep, voffB); PG8_STAGE(PG8_SA(1, 0), cA + kstep, cvo[0]); PG8_STAGE(PG8_SB(1, 1), cB + hstep + kstep, voffB);
    PG8_WAIT_V(6); PG8_BAR;
    for (;;) {
        const bool has_next = S.next(ui + 1, nxt);
        const char* nA = GATHER ? cA : (has_next ? (const char*)g.A + (size_t)nxt.pm * tstep : cA); const char* nB = has_next ? (const char*)g.Bt + (size_t)nxt.pn * tstep : cB;
        if constexpr (GATHER) { if (has_next) PG8_SETVO(nvo, ui + 1); else { _Pragma("unroll") for (int _h = 0; _h < 2; ++_h) { nvo[_h][0] = cvo[_h][0]; nvo[_h][1] = cvo[_h][1]; } } }
        for (int t = 0; t < nt; t += 2) {
            const bool last = (t == nt - 2);
            const char* a1 = cA + (size_t)(t + 1) * kstep;
            const char* a2 = last ? nA : cA + (size_t)(t + 2) * kstep; const char* b2 = last ? nB : cB + (size_t)(t + 2) * kstep;
            const char* a3 = a2 + kstep; const char* b3 = b2 + kstep;
            unsigned v2[2][2];
#pragma unroll
            for (int _h = 0; _h < 2; ++_h)
#pragma unroll
                for (int _i = 0; _i < 2; ++_i) v2[_h][_i] = (GATHER && last) ? nvo[_h][_i] : cvo[_h][_i];
            PG8_LDB(B0, 0, 0); PG8_LDB(B1, 0, 1); PG8_SCHED; PG8_LDA(At, 0, 0); PG8_STAGE(PG8_SA(1, 1), a1 + PG8_HOFF(1), cvo[1]);
            PG8_WAIT_V(8); PG8_WAIT_L(0); PG8_BAR; PG8_MMA(0, 0, At, B0); PG8_MMA(0, 1, At, B1); PG8_BAR; PG8_SCHED;
            PG8_LDA(At, 0, 1); PG8_STAGE(PG8_SB(0, 0), b2, voffB); PG8_STAGE(PG8_SB(0, 1), b2 + hstep, voffB); PG8_STAGE(PG8_SA(0, 0), a2, v2[0]);
            PG8_WAIT_V(8); PG8_WAIT_L(0); PG8_BAR; PG8_MMA(1, 0, At, B0); PG8_MMA(1, 1, At, B1); PG8_BAR; PG8_SCHED;
            PG8_LDB(B0, 1, 0); PG8_LDB(B1, 1, 1); PG8_SCHED; PG8_LDA(At, 1, 0); PG8_STAGE(PG8_SA(0, 1), a2 + PG8_HOFF(1), v2[1]);
            PG8_WAIT_V(8); PG8_WAIT_L(0); PG8_BAR; PG8_MMA(0, 0, At, B0); PG8_MMA(0, 1, At, B1); PG8_BAR; PG8_SCHED;
            PG8_LDA(At, 1, 1); PG8_STAGE(PG8_SB(1, 0), b3, voffB); PG8_STAGE(PG8_SB(1, 1), b3 + hstep, voffB); PG8_STAGE(PG8_SA(1, 0), a3, v2[0]);
            PG8_WAIT_V(8); PG8_WAIT_L(0); PG8_BAR; PG8_MMA(1, 0, At, B0); PG8_MMA(1, 1, At, B1); PG8_BAR; PG8_SCHED;
        }
        if (wr == 0) PG8_BAR;
        E(acc, cur, ui, wr, wc, fr, fq);
        if (!has_next) break;
#pragma unroll
        for (int a = 0; a < 2; ++a)
#pragma unroll
            for (int b = 0; b < 2; ++b)
#pragma unroll
                for (int m = 0; m < 4; ++m)
#pragma unroll
                    for (int n = 0; n < 2; ++n) acc[a][b][m][n] = (f32x4){0.f, 0.f, 0.f, 0.f};
        cur = nxt; cA = nA; cB = nB; ++ui;
        if constexpr (GATHER) { _Pragma("unroll") for (int _h = 0; _h < 2; ++_h) { cvo[_h][0] = nvo[_h][0]; cvo[_h][1] = nvo[_h][1]; } }
        if (wr == 1) PG8_BAR;
    }
    PG8_WAIT_V(0);
    PG8_BAR;
#undef PG8_SA
#undef PG8_SB
#undef PG8_STAGE
#undef PG8_LDA
#undef PG8_LDB
#undef PG8_MMA
#undef PG8_WAIT_V
#undef PG8_WAIT_L
#undef PG8_BAR
#undef PG8_SCHED
#undef PG8_SETVO
#undef PG8_HOFF
}


struct EpiProj {
    static constexpr bool PERM = true;
    bf16_t* P; float* GZ; const float* tab;
    __device__ __forceinline__ void operator()(const f32x4 (&acc)[2][2][4][2], const Unit& u, int ui, int wr, int wc, int fr, int fq) const {
        const int pn = u.pn, row0 = u.pm * BM + wr * 64 + fr, colw = wc * 32 + 8 * fq;
        if (pn == 14) {
            if (wc == 0) {
#pragma unroll
                for (int ai = 0; ai < 2; ++ai)
#pragma unroll
                    for (int m = 0; m < 4; ++m) { float* o = GZ + (size_t)(row0 + ai * HALF + m * 16) * 32 + 8 * fq; *(f32x4*)o = acc[ai][0][m][0]; *(f32x4*)(o + 4) = acc[ai][0][m][1]; }
            }
            return;
        }
        const int mode = (pn == 0) ? 1 : ((pn == 4 || pn == 5 || pn >= 12) ? 2 : ((pn >= 6 && pn <= 9) ? 3 : 0));
        const float rks = (pn >= 8) ? 0.08838834764831845f : 1.0f;
        const bool lowhalf = wc < 2;
        const int f0 = (16 * wc + 4 * fq) & 31;
#pragma unroll
        for (int ai = 0; ai < 2; ++ai)
#pragma unroll
            for (int m = 0; m < 4; ++m) {
                const int row = row0 + ai * HALF + m * 16;
                bf16_t* rowp = P + (size_t)row * PW + pn * BM + colw;
                f32x4 cs0 = {1.f, 0.f, 1.f, 0.f}, cs1 = {1.f, 0.f, 1.f, 0.f};
                if (mode == 3 && row < NLAT) { const int t = row & (SEQ - 1), pos = lowhalf ? (t >> 6) : (t & 63); const float* tp = tab + 2 * (pos * 32 + f0); cs0 = *(const f32x4*)tp; cs1 = *(const f32x4*)(tp + 4); }
#pragma unroll
                for (int bj = 0; bj < 2; ++bj) {
                    f32x4 v0 = acc[ai][bj][m][0], v1 = acc[ai][bj][m][1];
                    if (mode == 1) { v0 = v0 * 0.125f; v1 = v1 * 0.125f; }
                    else if (mode == 2) {
#pragma unroll
                        for (int e = 0; e < 4; ++e) { v0[e] = v0[e] / (1.0f + __expf(-v0[e])); v1[e] = v1[e] / (1.0f + __expf(-v1[e])); }
                    } else if (mode == 3) {
                        v0 = v0 * rks; v1 = v1 * rks;
                        const float c[4] = {cs0[0], cs0[2], cs1[0], cs1[2]}, s[4] = {cs0[1], cs0[3], cs1[1], cs1[3]};
#pragma unroll
                        for (int e = 0; e < 4; ++e) { const float a1 = v0[e], a2 = v1[e]; v0[e] = a1 * c[e] - a2 * s[e]; v1[e] = a1 * s[e] + a2 * c[e]; }
                    }
                    u32x4 w; w.x = cvt_pk_bf16(v0[0], v0[1]); w.y = cvt_pk_bf16(v0[2], v0[3]); w.z = cvt_pk_bf16(v1[0], v1[1]); w.w = cvt_pk_bf16(v1[2], v1[3]);
                    *(u32x4*)(rowp + bj * HALF) = w;
                }
            }
    }
};
struct EpiOut {
    static constexpr bool PERM = false;
    const float* x; float* out; const float* mod;
    __device__ __forceinline__ void operator()(const f32x4 (&acc)[2][2][4][2], const Unit& u, int ui, int wr, int wc, int fr, int fq) const {
        const int col0 = u.pn * BM + wc * 32 + 4 * fq, b = (u.pm * BM) / SEQ;
        const float* m2 = mod + b * NADA * D + 2 * D;
        f32x4 mv[2][2];
#pragma unroll
        for (int bj = 0; bj < 2; ++bj)
#pragma unroll
            for (int n = 0; n < 2; ++n) mv[bj][n] = *(const f32x4*)(m2 + col0 + bj * HALF + n * 16);
#pragma unroll
        for (int ai = 0; ai < 2; ++ai)
#pragma unroll
            for (int m = 0; m < 4; ++m) { const size_t off = (size_t)(u.pm * BM + ai * HALF + wr * 64 + m * 16 + fr) * D + col0;
#pragma unroll
                for (int bj = 0; bj < 2; ++bj)
#pragma unroll
                    for (int n = 0; n < 2; ++n) { const f32x4 xv = *(const f32x4*)(x + off + bj * HALF + n * 16); *(f32x4*)(out + off + bj * HALF + n * 16) = xv + mv[bj][n] * acc[ai][bj][m][n]; } }
    }
};
struct EpiAct {
    static constexpr bool PERM = true;
    bf16_t* ACT;
    __device__ __forceinline__ void operator()(const f32x4 (&acc)[2][2][4][2], const Unit& u, int ui, int wr, int wc, int fr, int fq) const {
        const int pnl = u.pn % 11, col0 = pnl * HALF + wc * 32 + 8 * fq;
#pragma unroll
        for (int ai = 0; ai < 2; ++ai)
#pragma unroll
            for (int m = 0; m < 4; ++m) { bf16_t* rowp = ACT + (size_t)(u.pm * BM + ai * HALF + wr * 64 + m * 16 + fr) * FF + col0;
                f32x4 v0, v1;
#pragma unroll
                for (int e = 0; e < 4; ++e) { const float a0 = acc[ai][0][m][0][e], a1 = acc[ai][0][m][1][e]; v0[e] = a0 / (1.0f + __expf(-a0)) * acc[ai][1][m][0][e]; v1[e] = a1 / (1.0f + __expf(-a1)) * acc[ai][1][m][1][e]; }
                u32x4 w; w.x = cvt_pk_bf16(v0[0], v0[1]); w.y = cvt_pk_bf16(v0[2], v0[3]); w.z = cvt_pk_bf16(v1[0], v1[1]); w.w = cvt_pk_bf16(v1[2], v1[3]);
                *(u32x4*)rowp = w; }
    }
};
struct EpiDown {
    static constexpr bool PERM = true;
    bf16_t* YE; const float* gate;
    __device__ __forceinline__ void operator()(const f32x4 (&acc)[2][2][4][2], const Unit& u, int ui, int wr, int wc, int fr, int fq) const {
        const int col0 = (u.pn & 3) * BM + wc * 32 + 8 * fq;
#pragma unroll
        for (int ai = 0; ai < 2; ++ai)
#pragma unroll
            for (int m = 0; m < 4; ++m) { const int row = u.pm * BM + ai * HALF + wr * 64 + m * 16 + fr; const float gt = gate[row]; bf16_t* rowp = YE + (size_t)row * D + col0;
#pragma unroll
                for (int bj = 0; bj < 2; ++bj) { const f32x4 v0 = acc[ai][bj][m][0] * gt, v1 = acc[ai][bj][m][1] * gt;
                    u32x4 w; w.x = cvt_pk_bf16(v0[0], v0[1]); w.y = cvt_pk_bf16(v0[2], v0[3]); w.z = cvt_pk_bf16(v1[0], v1[1]); w.w = cvt_pk_bf16(v1[2], v1[3]);
                    *(u32x4*)(rowp + bj * HALF) = w; } }
    }
};
}

namespace scan {
constexpr int RS = 72;
constexpr int RS2 = 136;
constexpr int OS = 132;
constexpr int NSL = 260;
constexpr size_t GLA_SLOT = 128 * 64, RET_SLOT = 128 * 128;
constexpr size_t US_RET_OFF = (size_t)16 * NSL * GLA_SLOT;
__device__ __forceinline__ int slot_row0(int b, int slot) { return slot < 4 ? NLAT + b * CTX + slot * 64 : b * SEQ + (slot - 4) * 64; }
__device__ __forceinline__ int slot_at(int dir, int step) { return dir ? (step < 4 ? 3 - step : 263 - step) : step; }
__device__ __forceinline__ f32x4 mfma16(bf16x8 a, bf16x8 b, f32x4 c) { return __builtin_amdgcn_mfma_f32_16x16x32_bf16(a, b, c, 0, 0, 0); }
__device__ __forceinline__ bf16x8 lds_frag(const LAS bf16_t* base, int off) { return *(const LAS bf16x8*)(base + off); }
__device__ __forceinline__ bf16x8 lds_frag_pi(const LAS bf16_t* base, int off  ) {
    typedef short s4 __attribute__((ext_vector_type(4)));
    const s4 lo = *(const LAS s4*)(base + off), hi = *(const LAS s4*)(base + off + 16);
    return (bf16x8){lo[0], lo[1], lo[2], lo[3], hi[0], hi[1], hi[2], hi[3]};
}
__device__ __forceinline__ unsigned pk(float lo, float hi) { return pg8::cvt_pk_bf16(lo, hi); }

__device__ __forceinline__ void gla_stepA(const Ptrs& p, int h, int w, int k, const LAS float* gz_s, LAS float* tot, float (&bi)[8], float (&ci)[8], float& allf, float& allb) {
    float wf[16], wb[16];
#pragma unroll
    for (int r = 0; r < 16; ++r) { wf[r] = p.gla_gate_w[r * 256 + h * 64 + k]; wb[r] = p.gla_gate_w[(16 + r) * 256 + h * 64 + k]; }
    const float bf = p.gla_gate_b[h * 64 + k], bb = p.gla_gate_b[256 + h * 64 + k];
    float laf[8], lab[8];
#pragma unroll
    for (int tt = 0; tt < 8; ++tt) {
        const LAS f32x4* g4 = (const LAS f32x4*)(gz_s + (8 * w + tt) * 32);
        float pf = bf, pb = bb;
#pragma unroll
        for (int r4 = 0; r4 < 4; ++r4) { const f32x4 a = g4[r4], b = g4[4 + r4];
#pragma unroll
            for (int e = 0; e < 4; ++e) { pf += a[e] * wf[4 * r4 + e]; pb += b[e] * wb[4 * r4 + e]; } }
        laf[tt] = (fminf(pf, 0.f) - __logf(1.0f + __expf(-fabsf(pf)))) * 0.0625f;
        lab[tt] = (fminf(pb, 0.f) - __logf(1.0f + __expf(-fabsf(pb)))) * 0.0625f;
    }
#pragma unroll
    for (int tt = 1; tt < 8; ++tt) laf[tt] += laf[tt - 1];
#pragma unroll
    for (int tt = 6; tt >= 0; --tt) lab[tt] += lab[tt + 1];
    tot[w * 64 + k] = laf[7]; tot[512 + w * 64 + k] = lab[0];
    __syncthreads();
    float offf = 0.f, offb = 0.f; allf = 0.f; allb = 0.f;
#pragma unroll
    for (int w2 = 0; w2 < 8; ++w2) { const float tf = tot[w2 * 64 + k], tb = tot[512 + w2 * 64 + k]; allf += tf; allb += tb; if (w2 < w) offf += tf; if (w2 > w) offb += tb; }
#pragma unroll
    for (int tt = 0; tt < 8; ++tt) { bi[tt] = offf + laf[tt]; ci[tt] = offb + lab[tt]; }
}
__device__ __forceinline__ void stage_vt(const bf16_t* vsrc, LAS bf16_t* VT, int tid) {
    const int j = tid >> 3, vg = tid & 7;
    const u32x4 a = *(const u32x4*)(vsrc + (size_t)j * PW + vg * 16), b = *(const u32x4*)(vsrc + (size_t)j * PW + vg * 16 + 8);
    const unsigned wv[8] = {a.x, a.y, a.z, a.w, b.x, b.y, b.z, b.w};
#pragma unroll
    for (int e = 0; e < 8; ++e) { VT[(vg * 16 + 2 * e) * RS + j] = (bf16_t)(wv[e] & 0xffffu); VT[(vg * 16 + 2 * e + 1) * RS + j] = (bf16_t)(wv[e] >> 16); }
}

__device__ __forceinline__ void c1_gla(const Ptrs& p, LAS unsigned char* lds, int item) {
    const int tid = threadIdx.x, w = __builtin_amdgcn_readfirstlane(tid >> 6), lane = tid & 63, c = lane & 15, q = lane >> 4;
    const int slot = item % NSL, bh = item / NSL, b = bh >> 2, h = bh & 3, row0 = slot_row0(b, slot);
    LAS float* gz_s = (LAS float*)lds; LAS float* tot = (LAS float*)(lds + 8192);
    LAS bf16_t* KfT = (LAS bf16_t*)(lds + 12288); LAS bf16_t* KbT = (LAS bf16_t*)(lds + 21504); LAS bf16_t* VT = (LAS bf16_t*)(lds + 30720);
    const bf16_t* P = (const bf16_t*)(p.ws + WS_P);
    ((LAS f32x4*)gz_s)[tid] = ((const f32x4*)((const float*)(p.ws + WS_GZ) + (size_t)row0 * 32))[tid];
    stage_vt(P + (size_t)row0 * PW + C_GV + h * 128, VT, tid);
    float kk[8];
#pragma unroll
    for (int tt = 0; tt < 8; ++tt) kk[tt] = bf2f(P[(size_t)(row0 + 8 * w + tt) * PW + C_GK + h * 64 + lane]);
    __syncthreads();
    float bi[8], ci[8], allf, allb;
    gla_stepA(p, h, w, lane, gz_s, tot, bi, ci, allf, allb);
    { float ef[8], eb[8];
#pragma unroll
      for (int tt = 0; tt < 8; ++tt) { ef[tt] = kk[tt] * __expf(allf - bi[tt]); eb[tt] = kk[tt] * __expf(allb - ci[tt]); }
      u32x4 wf_, wb_; wf_.x = pk(ef[0], ef[1]); wf_.y = pk(ef[2], ef[3]); wf_.z = pk(ef[4], ef[5]); wf_.w = pk(ef[6], ef[7]);
      wb_.x = pk(eb[0], eb[1]); wb_.y = pk(eb[2], eb[3]); wb_.z = pk(eb[4], eb[5]); wb_.w = pk(eb[6], eb[7]);
      *(LAS u32x4*)(KfT + lane * RS + 8 * w) = wf_; *(LAS u32x4*)(KbT + lane * RS + 8 * w) = wb_; }
    float* DCH = (float*)(p.ws + WS_DCH);
    if (w == 0) { DCH[((size_t)(bh * 2 + 0) * NSL + slot) * 64 + lane] = __expf(allf); DCH[((size_t)(bh * 2 + 1) * NSL + slot) * 64 + lane] = __expf(allb); }
    __syncthreads();
    bf16_t* US = (bf16_t*)(p.ws + WS_US);
    const int vt = w;
    bf16x8 Bv[2];
#pragma unroll
    for (int js = 0; js < 2; ++js) Bv[js] = lds_frag(VT, (16 * vt + c) * RS + 32 * js + 8 * q);
#pragma unroll
    for (int dir = 0; dir < 2; ++dir) { const LAS bf16_t* KT = dir ? KbT : KfT;
#pragma unroll
        for (int ks = 0; ks < 2; ++ks) { f32x4 a0 = {0.f, 0.f, 0.f, 0.f}, a1 = {0.f, 0.f, 0.f, 0.f};
#pragma unroll
            for (int js = 0; js < 2; ++js) { a0 = mfma16(lds_frag(KT, (32 * ks + c) * RS + 32 * js + 8 * q), Bv[js], a0); a1 = mfma16(lds_frag(KT, (32 * ks + 16 + c) * RS + 32 * js + 8 * q), Bv[js], a1); }
            u32x4 o; o.x = pk(a0[0], a0[1]); o.y = pk(a0[2], a0[3]); o.z = pk(a1[0], a1[1]); o.w = pk(a1[2], a1[3]);
            *(u32x4*)(US + ((size_t)(bh * 2 + dir) * NSL + slot) * GLA_SLOT + ((vt * 2 + ks) * 64 + lane) * 8) = o; } }
    __syncthreads();
}
__device__ __forceinline__ void c1_ret(const Ptrs& p, LAS unsigned char* lds, int item) {
    const int tid = threadIdx.x, w = __builtin_amdgcn_readfirstlane(tid >> 6), lane = tid & 63, c = lane & 15, q = lane >> 4;
    const int slot = item % NSL, bh = item / NSL, b = bh >> 2, h = bh & 3, row0 = slot_row0(b, slot);
    LAS bf16_t* KT = (LAS bf16_t*)lds; LAS bf16_t* VfT = (LAS bf16_t*)(lds + 18432); LAS bf16_t* VbT = (LAS bf16_t*)(lds + 36864);
    const bf16_t* P = (const bf16_t*)(p.ws + WS_P);
    const float lgf = log_sigmoidf(p.ret_decay_logit[h]), lgb = log_sigmoidf(p.ret_decay_logit[4 + h]);
    { const int j = tid >> 3, g8 = tid & 7;
      const bf16_t* ks_ = P + (size_t)(row0 + j) * PW + C_RK + h * 128 + g8 * 16; const bf16_t* vs_ = P + (size_t)(row0 + j) * PW + C_RV + h * 128 + g8 * 16;
      const u32x4 ka = *(const u32x4*)ks_, kb = *(const u32x4*)(ks_ + 8), va = *(const u32x4*)vs_, vb = *(const u32x4*)(vs_ + 8);
      const unsigned kw[8] = {ka.x, ka.y, ka.z, ka.w, kb.x, kb.y, kb.z, kb.w}, vw[8] = {va.x, va.y, va.z, va.w, vb.x, vb.y, vb.z, vb.w};
      const float sf = __expf(lgf * (float)(63 - j)), sb = __expf(lgb * (float)j);
#pragma unroll
      for (int e = 0; e < 8; ++e) { const int r0 = (g8 * 16 + 2 * e) * RS + j, r1 = r0 + RS;
          KT[r0] = (bf16_t)(kw[e] & 0xffffu); KT[r1] = (bf16_t)(kw[e] >> 16);
          const float v0 = __uint_as_float(vw[e] << 16), v1 = __uint_as_float(vw[e] & 0xffff0000u);
          VfT[r0] = f2bf(v0 * sf); VfT[r1] = f2bf(v1 * sf); VbT[r0] = f2bf(v0 * sb); VbT[r1] = f2bf(v1 * sb); } }
    __syncthreads();
    bf16_t* US = (bf16_t*)(p.ws + WS_US) + US_RET_OFF;
    const int vt = w;
#pragma unroll
    for (int dir = 0; dir < 2; ++dir) { const LAS bf16_t* VT = dir ? VbT : VfT;
        bf16x8 Bv[2];
#pragma unroll
        for (int js = 0; js < 2; ++js) Bv[js] = lds_frag(VT, (16 * vt + c) * RS + 32 * js + 8 * q);
#pragma unroll
        for (int ks = 0; ks < 4; ++ks) { f32x4 a0 = {0.f, 0.f, 0.f, 0.f}, a1 = {0.f, 0.f, 0.f, 0.f};
#pragma unroll
            for (int js = 0; js < 2; ++js) { a0 = mfma16(lds_frag(KT, (32 * ks + c) * RS + 32 * js + 8 * q), Bv[js], a0); a1 = mfma16(lds_frag(KT, (32 * ks + 16 + c) * RS + 32 * js + 8 * q), Bv[js], a1); }
            u32x4 o; o.x = pk(a0[0], a0[1]); o.y = pk(a0[2], a0[3]); o.z = pk(a1[0], a1[1]); o.w = pk(a1[2], a1[3]);
            *(u32x4*)(US + ((size_t)(bh * 2 + dir) * NSL + slot) * RET_SLOT + ((vt * 4 + ks) * 64 + lane) * 8) = o; } }
    __syncthreads();
}
template <int G>
__device__ __forceinline__ void c2_scan(const Ptrs& p, int chain, int grp  ) {
    constexpr size_t SLOT = G ? RET_SLOT : GLA_SLOT;
    constexpr int NB = 13;
    const int dir = chain & 1, h = (chain >> 1) & 3;
    bf16_t* base = (bf16_t*)(p.ws + WS_US) + (G ? US_RET_OFF : 0) + (size_t)chain * NSL * SLOT + (size_t)grp * 4;
    float dconst = 0.f; const float* dch = nullptr;
    if (G) dconst = __expf(64.0f * log_sigmoidf(p.ret_decay_logit[dir * 4 + h]));
    else { const int el = grp * 4, e0 = el & 7, ln = (el >> 3) & 63, ks = (el >> 9) & 1; dch = (const float*)(p.ws + WS_DCH) + (size_t)chain * NSL * 64 + 32 * ks + 16 * (e0 >> 2) + 4 * (ln >> 4); }
    f32x4 s = {0.f, 0.f, 0.f, 0.f};
    u32x2 ub[NB]; f32x4 db[NB];
    for (int bt = 0; bt < NSL / NB; ++bt) {
#pragma unroll
        for (int i = 0; i < NB; ++i) { const int slot = slot_at(dir, bt * NB + i); ub[i] = *(const u32x2*)(base + (size_t)slot * SLOT); if (!G) db[i] = *(const f32x4*)(dch + slot * 64); }
#pragma unroll
        for (int i = 0; i < NB; ++i) { const int slot = slot_at(dir, bt * NB + i);
            u32x2 o; o.x = pk(s[0], s[1]); o.y = pk(s[2], s[3]); *(u32x2*)(base + (size_t)slot * SLOT) = o;
            const f32x4 u = {__uint_as_float(ub[i].x << 16), __uint_as_float(ub[i].x & 0xffff0000u), __uint_as_float(ub[i].y << 16), __uint_as_float(ub[i].y & 0xffff0000u)};
            if (G) s = s * dconst + u; else s = s * db[i] + u; }
    }
}
__device__ __forceinline__ void c3_gla(const Ptrs& p, LAS unsigned char* lds, int item, bf16_t* Y, int zs) {
    const int tid = threadIdx.x, w = __builtin_amdgcn_readfirstlane(tid >> 6), lane = tid & 63, c = lane & 15, q = lane >> 4;
    const int n = item & 255, bh = item >> 8, b = bh >> 2, h = bh & 3, slot = 4 + n, row0 = b * SEQ + n * 64;
    LAS float* gz_s = (LAS float*)lds; LAS float* tot = (LAS float*)(lds + 8192);
    LAS bf16_t* QF = (LAS bf16_t*)(lds + 12288); LAS bf16_t* QB = (LAS bf16_t*)(lds + 21504); LAS bf16_t* KF = (LAS bf16_t*)(lds + 30720); LAS bf16_t* KB = (LAS bf16_t*)(lds + 39936);
    LAS bf16_t* VT = (LAS bf16_t*)(lds + 49152); LAS bf16_t* Pm = (LAS bf16_t*)(lds + 67584); LAS float* Os = (LAS float*)(lds + 76800);
    const bf16_t* P = (const bf16_t*)(p.ws + WS_P);
    ((LAS f32x4*)gz_s)[tid] = ((const f32x4*)((const float*)(p.ws + WS_GZ) + (size_t)row0 * 32))[tid];
    stage_vt(P + (size_t)row0 * PW + C_GV + h * 128, VT, tid);
    float qq[8], kk[8];
#pragma unroll
    for (int tt = 0; tt < 8; ++tt) { const bf16_t* rp = P + (size_t)(row0 + 8 * w + tt) * PW + h * 64 + lane; qq[tt] = bf2f(rp[C_GQ]); kk[tt] = bf2f(rp[C_GK]); }
    const bf16_t* US = (const bf16_t*)(p.ws + WS_US);
    bf16x8 Sf[2], Sb[2];
#pragma unroll
    for (int ks = 0; ks < 2; ++ks) { Sf[ks] = *(const bf16x8*)(US + ((size_t)(bh * 2 + 0) * NSL + slot) * GLA_SLOT + ((w * 2 + ks) * 64 + lane) * 8);
                                     Sb[ks] = *(const bf16x8*)(US + ((size_t)(bh * 2 + 1) * NSL + slot) * GLA_SLOT + ((w * 2 + ks) * 64 + lane) * 8); }
    if (zs) { _Pragma("unroll") for (int ks = 0; ks < 2; ++ks) { Sf[ks] = (bf16x8){0,0,0,0,0,0,0,0}; Sb[ks] = (bf16x8){0,0,0,0,0,0,0,0}; } }
    __syncthreads();
    float bi[8], ci[8], allf, allb;
    gla_stepA(p, h, w, lane, gz_s, tot, bi, ci, allf, allb);
#pragma unroll
    for (int tt = 0; tt < 8; ++tt) { const int i = 8 * w + tt; const float eb_ = __expf(bi[tt]), ec_ = __expf(ci[tt]);
        QF[i * RS + lane] = f2bf(qq[tt] * eb_); QB[i * RS + lane] = f2bf(qq[tt] * ec_);
        KF[i * RS + lane] = f2bf(kk[tt] * __expf(-bi[tt])); KB[i * RS + lane] = f2bf(kk[tt] * __expf(-ci[tt])); }
    __syncthreads();
    { const int it = w & 3, i = 16 * it + c;
      bf16x8 qf[2], qb[2];
#pragma unroll
      for (int ks = 0; ks < 2; ++ks) { qf[ks] = lds_frag(QF, i * RS + 32 * ks + 8 * q); qb[ks] = lds_frag(QB, i * RS + 32 * ks + 8 * q); }
#pragma unroll
      for (int jj = 0; jj < 2; ++jj) { const int jt = 2 * (w >> 2) + jj; f32x4 af = {0.f, 0.f, 0.f, 0.f}, ab = {0.f, 0.f, 0.f, 0.f};
#pragma unroll
          for (int ks = 0; ks < 2; ++ks) { af = mfma16(lds_frag(KF, (16 * jt + c) * RS + 32 * ks + 8 * q), qf[ks], af); ab = mfma16(lds_frag(KB, (16 * jt + c) * RS + 32 * ks + 8 * q), qb[ks], ab); }
          float v[4];
#pragma unroll
          for (int r = 0; r < 4; ++r) { const int j = 16 * jt + 4 * q + r; v[r] = (j <= i ? af[r] : 0.f) + (j >= i ? ab[r] : 0.f); }
          u32x2 o; o.x = pk(v[0], v[1]); o.y = pk(v[2], v[3]); *(LAS u32x2*)(Pm + i * RS + 16 * jt + 4 * q) = o; } }
    __syncthreads();
    { bf16x8 Bv[2];
#pragma unroll
      for (int js = 0; js < 2; ++js) Bv[js] = lds_frag(VT, (16 * w + c) * RS + 32 * js + 8 * q);
#pragma unroll
      for (int it = 0; it < 4; ++it) { f32x4 a = {0.f, 0.f, 0.f, 0.f}; const int i = 16 * it + c;
#pragma unroll
          for (int js = 0; js < 2; ++js) a = mfma16(lds_frag(Pm, i * RS + 32 * js + 8 * q), Bv[js], a);
#pragma unroll
          for (int ks = 0; ks < 2; ++ks) { a = mfma16(lds_frag_pi(QF, i * RS + 32 * ks + 4 * q), Sf[ks], a); a = mfma16(lds_frag_pi(QB, i * RS + 32 * ks + 4 * q), Sb[ks], a); }
#pragma unroll
          for (int r = 0; r < 4; ++r) Os[(16 * it + 4 * q + r) * OS + 16 * w + c] = a[r]; } }
    __syncthreads();
#pragma unroll
    for (int tt = 0; tt < 8; ++tt) { const int i = 8 * w + tt; const f32x2 o = *(const LAS f32x2*)(Os + i * OS + 2 * lane);
        const float r = rsqrtf(wave_sum(o[0] * o[0] + o[1] * o[1]) * (1.f / 128.f) + EPS);
        const unsigned gw = *(const unsigned*)(P + (size_t)(row0 + i) * PW + C_GG + h * 128 + 2 * lane);
        const f32x2 nw = *(const f32x2*)(p.gla_norm_w + h * 128 + 2 * lane);
        *(unsigned*)(Y + (size_t)(row0 + i) * D + h * 128 + 2 * lane) = pk(o[0] * r * nw[0] * __uint_as_float(gw << 16), o[1] * r * nw[1] * __uint_as_float(gw & 0xffff0000u)); }
    __syncthreads();
}
__device__ __forceinline__ void c3_ret(const Ptrs& p, LAS unsigned char* lds, int item, bf16_t* Y, int zs) {
    const int tid = threadIdx.x, w = __builtin_amdgcn_readfirstlane(tid >> 6), lane = tid & 63, c = lane & 15, q = lane >> 4;
    const int n = item & 255, bh = item >> 8, b = bh >> 2, h = bh & 3, slot = 4 + n, row0 = b * SEQ + n * 64;
    LAS bf16_t* Qs = (LAS bf16_t*)lds; LAS bf16_t* Ks = (LAS bf16_t*)(lds + 17408); LAS bf16_t* VT = (LAS bf16_t*)(lds + 34816); LAS bf16_t* Pm = (LAS bf16_t*)(lds + 53248);
    LAS float* Os = (LAS float*)(lds + 62464); LAS float* pwf = (LAS float*)(lds + 96256); LAS float* pwb = pwf + 80;
    const bf16_t* P = (const bf16_t*)(p.ws + WS_P);
    const float lgf = log_sigmoidf(p.ret_decay_logit[h]), lgb = log_sigmoidf(p.ret_decay_logit[4 + h]);
    if (tid < 65) { pwf[tid] = __expf(lgf * (float)tid); pwb[tid] = __expf(lgb * (float)tid); }
    { const int j = tid >> 3, g8 = tid & 7; const bf16_t* rp = P + (size_t)(row0 + j) * PW + h * 128 + g8 * 16;
      *(LAS u32x4*)(Qs + j * RS2 + g8 * 16) = *(const u32x4*)(rp + C_RQ); *(LAS u32x4*)(Qs + j * RS2 + g8 * 16 + 8) = *(const u32x4*)(rp + C_RQ + 8);
      *(LAS u32x4*)(Ks + j * RS2 + g8 * 16) = *(const u32x4*)(rp + C_RK); *(LAS u32x4*)(Ks + j * RS2 + g8 * 16 + 8) = *(const u32x4*)(rp + C_RK + 8); }
    stage_vt(P + (size_t)row0 * PW + C_RV + h * 128, VT, tid);
    const bf16_t* US = (const bf16_t*)(p.ws + WS_US) + US_RET_OFF;
    bf16x8 Sf[4], Sb[4];
#pragma unroll
    for (int ks = 0; ks < 4; ++ks) { Sf[ks] = *(const bf16x8*)(US + ((size_t)(bh * 2 + 0) * NSL + slot) * RET_SLOT + ((w * 4 + ks) * 64 + lane) * 8);
                                     Sb[ks] = *(const bf16x8*)(US + ((size_t)(bh * 2 + 1) * NSL + slot) * RET_SLOT + ((w * 4 + ks) * 64 + lane) * 8); }
    if (zs) { _Pragma("unroll") for (int ks = 0; ks < 4; ++ks) { Sf[ks] = (bf16x8){0,0,0,0,0,0,0,0}; Sb[ks] = (bf16x8){0,0,0,0,0,0,0,0}; } }
    __syncthreads();
    { const int it = w & 3, i = 16 * it + c;
      bf16x8 qf[4];
#pragma unroll
      for (int ks = 0; ks < 4; ++ks) qf[ks] = lds_frag(Qs, i * RS2 + 32 * ks + 8 * q);
#pragma unroll
      for (int jj = 0; jj < 2; ++jj) { const int jt = 2 * (w >> 2) + jj; f32x4 a = {0.f, 0.f, 0.f, 0.f};
#pragma unroll
          for (int ks = 0; ks < 4; ++ks) a = mfma16(lds_frag(Ks, (16 * jt + c) * RS2 + 32 * ks + 8 * q), qf[ks], a);
          float v[4];
#pragma unroll
          for (int r = 0; r < 4; ++r) { const int j = 16 * jt + 4 * q + r; const int dd = i - j; const float dm = (dd >= 0 ? pwf[dd >= 0 ? dd : 0] : 0.f) + (dd <= 0 ? pwb[dd <= 0 ? -dd : 0] : 0.f); v[r] = a[r] * dm; }
          u32x2 o; o.x = pk(v[0], v[1]); o.y = pk(v[2], v[3]); *(LAS u32x2*)(Pm + i * RS + 16 * jt + 4 * q) = o; } }
    __syncthreads();
    { bf16x8 Bv[2];
#pragma unroll
      for (int js = 0; js < 2; ++js) Bv[js] = lds_frag(VT, (16 * w + c) * RS + 32 * js + 8 * q);
#pragma unroll
      for (int it = 0; it < 4; ++it) { f32x4 a = {0.f, 0.f, 0.f, 0.f}, af = {0.f, 0.f, 0.f, 0.f}, ab = {0.f, 0.f, 0.f, 0.f}; const int i = 16 * it + c;
#pragma unroll
          for (int js = 0; js < 2; ++js) a = mfma16(lds_frag(Pm, i * RS + 32 * js + 8 * q), Bv[js], a);
#pragma unroll
          for (int ks = 0; ks < 4; ++ks) { const bf16x8 qa = lds_frag_pi(Qs, i * RS2 + 32 * ks + 4 * q); af = mfma16(qa, Sf[ks], af); ab = mfma16(qa, Sb[ks], ab); }
#pragma unroll
          for (int r = 0; r < 4; ++r) { const int ii = 16 * it + 4 * q + r; Os[ii * OS + 16 * w + c] = a[r] + pwf[ii + 1] * af[r] + pwb[64 - ii] * ab[r]; } } }
    __syncthreads();
#pragma unroll
    for (int tt = 0; tt < 8; ++tt) { const int i = 8 * w + tt; const f32x2 o = *(const LAS f32x2*)(Os + i * OS + 2 * lane);
        const float mu = wave_sum(o[0] + o[1]) * (1.f / 128.f); const float d0 = o[0] - mu, d1 = o[1] - mu;
        const float r = rsqrtf(wave_sum(d0 * d0 + d1 * d1) * (1.f / 128.f) + EPS);
        const unsigned gw = *(const unsigned*)(P + (size_t)(row0 + i) * PW + C_RG + h * 128 + 2 * lane);
        const f32x2 nw = *(const f32x2*)(p.ret_norm_w + h * 128 + 2 * lane);
        *(unsigned*)(Y + (size_t)(row0 + i) * D + 512 + h * 128 + 2 * lane) = pk(d0 * r * nw[0] * __uint_as_float(gw << 16), d1 * r * nw[1] * __uint_as_float(gw & 0xffff0000u)); }
    __syncthreads();
}
}

namespace misc {
__device__ __forceinline__ void p0_mod(const Ptrs& p, LAS unsigned char* lds, int bx) {
    LAS float* sc = (LAS float*)lds;
    LAS float* red = sc + 3 * D;
    const int tid = threadIdx.x;
    for (int i = tid; i < 3 * D; i += NTHR) { const int r = i >> 10, k = i & 1023; const float v = (r < 2) ? p.c[r * D + k] : p.c_ctx[k]; sc[i] = siluf(v); }
    __syncthreads();
    const int kg = tid >> 5, cl = tid & 31, col = 24 * bx + cl;
    float a0 = 0.f, a1 = 0.f, a2 = 0.f;
    if (cl < 24) {
#pragma unroll 8
        for (int k = kg * 64; k < kg * 64 + 64; ++k) { const float w = p.w_ada[(size_t)k * (NADA * D) + col]; a0 += sc[k] * w; a1 += sc[D + k] * w; a2 += sc[2 * D + k] * w; }
    }
    red[(kg * 3 + 0) * 32 + cl] = a0; red[(kg * 3 + 1) * 32 + cl] = a1; red[(kg * 3 + 2) * 32 + cl] = a2;
    __syncthreads();
    if (tid < 96) { const int r = tid >> 5, c2 = tid & 31; if (c2 < 24) { float s = 0.f;
#pragma unroll
        for (int g = 0; g < 16; ++g) s += red[(g * 3 + r) * 32 + c2];
        const int cc = 24 * bx + c2; ((float*)(p.ws + WS_MOD))[r * NADA * D + cc] = s + p.b_ada[cc]; } }
    __syncthreads();
}
__device__ __forceinline__ void p0_rope(const Ptrs& p, int gtid) {
    if (gtid < 256 * 32) { const int pos = gtid >> 5, f = gtid & 31; const float inv = powf(10000.0f, -(float)f / 32.0f); const float ang = (float)pos * inv;
        float* T = (float*)(p.ws + WS_ROPE); T[2 * gtid] = (float)cos((double)ang); T[2 * gtid + 1] = (float)sin((double)ang); }
}
__device__ __forceinline__ void transpose_item(const float* src, int ldsrc, int k0, int col  , bf16_t* dst, int ldt, int n0, LAS float* scr, int lane) {
#pragma unroll 8
    for (int i = 0; i < 32; ++i) { const int kk = 2 * i + (lane >> 5); scr[kk * 33 + (lane & 31)] = (col >= 0) ? src[(size_t)(k0 + kk) * ldsrc + col] : 0.f; }
    asm volatile("s_waitcnt lgkmcnt(0)" ::: "memory");
    const int c = lane & 7;
#pragma unroll
    for (int j = 0; j < 4; ++j) { const int n = (lane >> 3) + 8 * j; const LAS float* s = scr + (8 * c) * 33 + n;
        u32x4 o; o.x = pg8::cvt_pk_bf16(s[0 * 33], s[1 * 33]); o.y = pg8::cvt_pk_bf16(s[2 * 33], s[3 * 33]); o.z = pg8::cvt_pk_bf16(s[4 * 33], s[5 * 33]); o.w = pg8::cvt_pk_bf16(s[6 * 33], s[7 * 33]);
        *(u32x4*)(dst + (size_t)(n0 + n) * ldt + k0 + 8 * c) = o; }
    asm volatile("s_waitcnt lgkmcnt(0)" ::: "memory");
}
constexpr int IT_WIN = 16 * 120, IT_WOUT = 16 * 32, IT_P0 = IT_WIN + IT_WOUT;
constexpr int IT_WGU = 16 * 88 * 16, IT_WD = 16 * 32 * 22, IT_EXP = IT_WGU + IT_WD;
__device__ __forceinline__ void conv_item_p0(const Ptrs& p, int it, LAS float* scr, int lane) {
    if (it < IT_WIN) { const int kb = it / 120, nb = it % 120, n = nb * 32 + (lane & 31); const int col = (n < NPROJ) ? proj_src_col(n) : -1;
        transpose_item(p.w_in, NPROJ, kb * 64, col, (bf16_t*)(p.ws + WS_WIN), D, nb * 32, scr, lane); }
    else { it -= IT_WIN; const int kb = it >> 5, nb = it & 31; transpose_item(p.w_out, D, kb * 64, nb * 32 + (lane & 31), (bf16_t*)(p.ws + WS_WOUT), D, nb * 32, scr, lane); }
}
__device__ __forceinline__ void conv_item_exp(const Ptrs& p, int it, LAS float* scr, int lane) {
    if (it < IT_WGU) { const int kb = it & 15, rb = (it >> 4) % 88, e = (it >> 4) / 88; const int r0 = rb * 32, pn = r0 >> 8, half = (r0 >> 7) & 1, f0 = pn * 128 + (r0 & 127);
        const float* src = (half ? p.w_exp_up : p.w_exp_gate) + (size_t)e * D * FF;
        transpose_item(src, FF, kb * 64, f0 + (lane & 31), (bf16_t*)(p.ws + WS_WGU) + (size_t)e * 2816 * D, D, r0, scr, lane); }
    else { it -= IT_WGU; const int kb = it % 22, nb = (it / 22) & 31, e = it / (22 * 32);
        transpose_item(p.w_exp_down + (size_t)e * FF * D, D, kb * 64, nb * 32 + (lane & 31), (bf16_t*)(p.ws + WS_WD) + (size_t)e * D * FF, FF, nb * 32, scr, lane); }
}
__device__ __forceinline__ void h_row(const Ptrs& p, int row, int lane) {
    const float* src; int m;
    if (row < NLAT) { src = p.x + (size_t)row * D; m = row / SEQ; } else { src = p.ctx + (size_t)(row - NLAT) * D; m = 2; }
    const float* mod = (const float*)(p.ws + WS_MOD) + m * NADA * D;
    f32x4 v[4]; float ss = 0.f;
#pragma unroll
    for (int j = 0; j < 4; ++j) { v[j] = *(const f32x4*)(src + j * 256 + lane * 4); ss += v[j][0] * v[j][0] + v[j][1] * v[j][1] + v[j][2] * v[j][2] + v[j][3] * v[j][3]; }
    const float rstd = rsqrtf(wave_sum(ss) * (1.0f / D) + EPS);
    bf16_t* dst = (bf16_t*)(p.ws + WS_H) + (size_t)row * D;
#pragma unroll
    for (int j = 0; j < 4; ++j) { const int d = j * 256 + lane * 4; const f32x4 w = *(const f32x4*)(p.norm1_w + d), sc = *(const f32x4*)(mod + D + d), sh = *(const f32x4*)(mod + d);
        f32x4 o;
#pragma unroll
        for (int e = 0; e < 4; ++e) o[e] = v[j][e] * rstd * w[e] * (1.0f + sc[e]) + sh[e];
        u32x2 pkd; pkd.x = pg8::cvt_pk_bf16(o[0], o[1]); pkd.y = pg8::cvt_pk_bf16(o[2], o[3]); *(u32x2*)(dst + d) = pkd; }
}
__device__ __forceinline__ void norm2_router_row(const Ptrs& p, int row, int lane) {
    const int b = row / SEQ, t = row % SEQ;
    const float* src = p.out + (size_t)row * D;
    const float* mod = (const float*)(p.ws + WS_MOD) + b * NADA * D;
    f32x4 v[4]; float ss = 0.f;
#pragma unroll
    for (int j = 0; j < 4; ++j) { v[j] = *(const f32x4*)(src + j * 256 + lane * 4); ss += v[j][0] * v[j][0] + v[j][1] * v[j][1] + v[j][2] * v[j][2] + v[j][3] * v[j][3]; }
    const float rstd = rsqrtf(wave_sum(ss) * (1.0f / D) + EPS);
    bf16_t* dst = (bf16_t*)(p.ws + WS_H) + (size_t)row * D;
    float lg[NE];
#pragma unroll
    for (int e = 0; e < NE; ++e) lg[e] = 0.f;
#pragma unroll
    for (int j = 0; j < 4; ++j) { const int d = j * 256 + lane * 4; const f32x4 w = *(const f32x4*)(p.norm2_w + d), sc = *(const f32x4*)(mod + 4 * D + d), sh = *(const f32x4*)(mod + 3 * D + d);
        f32x4 o;
#pragma unroll
        for (int e4 = 0; e4 < 4; ++e4) { o[e4] = v[j][e4] * rstd * w[e4] * (1.0f + sc[e4]) + sh[e4];
            const f32x4* wr = (const f32x4*)(p.w_router + (size_t)(d + e4) * NE);
#pragma unroll
            for (int q = 0; q < 4; ++q) { const f32x4 ww = wr[q]; lg[4 * q] += o[e4] * ww[0]; lg[4 * q + 1] += o[e4] * ww[1]; lg[4 * q + 2] += o[e4] * ww[2]; lg[4 * q + 3] += o[e4] * ww[3]; } }
        u32x2 pkd; pkd.x = pg8::cvt_pk_bf16(o[0], o[1]); pkd.y = pg8::cvt_pk_bf16(o[2], o[3]); *(u32x2*)(dst + d) = pkd; }
    float mx = -1e30f;
#pragma unroll
    for (int e = 0; e < NE; ++e) { lg[e] = wave_sum(lg[e]); mx = fmaxf(mx, lg[e]); }
    float den = 0.f;
#pragma unroll
    for (int e = 0; e < NE; ++e) { lg[e] = __expf(lg[e] - mx); den += lg[e]; }
    float mine = 0.f;
#pragma unroll
    for (int e = 0; e < NE; ++e) if (lane == e) mine = lg[e] / den;
    if (lane < NE) ((float*)(p.ws + WS_AFF))[((size_t)b * NE + lane) * SEQ + t] = mine;
}
__device__ __forceinline__ void topk_set(const Ptrs& p, LAS unsigned char* lds, int be) {
    LAS unsigned* key = (LAS unsigned*)lds;
    LAS unsigned* hist = key + SEQ;
    LAS unsigned* sh = hist + 256;
    const int tid = threadIdx.x, lane = tid & 63, w = tid >> 6;
    const unsigned* A = (const unsigned*)(p.ws + WS_AFF) + (size_t)be * SEQ;
    for (int i = tid; i < SEQ / 4; i += NTHR) ((LAS u32x4*)key)[i] = ((const u32x4*)A)[i];
    if (tid == 0) { sh[0] = 0u; sh[1] = (unsigned)CAP; }
    __syncthreads();
#pragma unroll 1
    for (int pass = 0; pass < 4; ++pass) {
        const int shift = 24 - 8 * pass;
        if (tid < 256) hist[tid] = 0u;
        __syncthreads();
        const unsigned prefix = sh[0], kneed = sh[1];
        const unsigned himask = (pass == 0) ? 0u : (0xffffffffu << (shift + 8));
        for (int i = tid; i < SEQ; i += NTHR) { const unsigned kx = key[i]; if ((kx & himask) == prefix) __hip_atomic_fetch_add(&hist[(kx >> shift) & 255u], 1u, __ATOMIC_RELAXED, __HIP_MEMORY_SCOPE_WORKGROUP); }
        __syncthreads();
        if (w == 0) {
            unsigned c4[4]; unsigned s = 0u;
#pragma unroll
            for (int j = 0; j < 4; ++j) { c4[j] = hist[255 - (lane * 4 + j)]; s += c4[j]; }
            unsigned incl = s;
#pragma unroll
            for (int o = 1; o < 64; o <<= 1) { const unsigned t = __shfl_up(incl, o); if (lane >= o) incl += t; }
            const unsigned excl = incl - s;
            if (excl < kneed && kneed <= incl) { unsigned acc = excl;
#pragma unroll
                for (int j = 0; j < 4; ++j) { if (acc < kneed && kneed <= acc + c4[j]) { const unsigned bin = 255u - (unsigned)(lane * 4 + j); sh[0] = prefix | (bin << shift); sh[1] = kneed - acc; } acc += c4[j]; } }
        }
        __syncthreads();
    }
    const unsigned T = sh[0], need_eq = sh[1];
    unsigned cg = 0u, ce = 0u;
    for (int i = 0; i < 32; ++i) { const unsigned kx = key[tid * 32 + i]; cg += (kx > T) ? 1u : 0u; ce += (kx == T) ? 1u : 0u; }
    unsigned ig = cg, ie = ce;
#pragma unroll
    for (int o = 1; o < 64; o <<= 1) { const unsigned tg = __shfl_up(ig, o), te = __shfl_up(ie, o); if (lane >= o) { ig += tg; ie += te; } }
    if (lane == 63) { sh[16 + w] = ig; sh[32 + w] = ie; }
    __syncthreads();
    unsigned og = 0u, oe = 0u, totg = 0u;
#pragma unroll
    for (int w2 = 0; w2 < 8; ++w2) { const unsigned a = sh[16 + w2], b2 = sh[32 + w2]; if (w2 < w) { og += a; oe += b2; } totg += a; }
    unsigned pg = og + ig - cg, pe = oe + ie - ce;
    int* IDX = (int*)(p.ws + WS_IDX) + be * CAP; float* GATE = (float*)(p.ws + WS_GATE) + be * CAP; int* INV = (int*)(p.ws + WS_INV);
    const int b = be / NE, e = be % NE;
    for (int i = 0; i < 32; ++i) { const int t = tid * 32 + i; const unsigned kx = key[t]; int slot = -1;
        if (kx > T) slot = (int)(pg++); else if (kx == T) { if (pe < need_eq) slot = (int)(totg + pe); ++pe; }
        if (slot >= 0) { IDX[slot] = t; GATE[slot] = __uint_as_float(kx); }
        INV[((size_t)b * SEQ + t) * NE + e] = slot; }
    __syncthreads();
}
__device__ __forceinline__ void final_row(const Ptrs& p, int row, int lane) {
    const int b = row / SEQ;
    float* xr = p.out + (size_t)row * D;
    const float* mod = (const float*)(p.ws + WS_MOD) + b * NADA * D + 5 * D;
    const int* inv = (const int*)(p.ws + WS_INV) + (size_t)row * NE;
    const bf16_t* YE = (const bf16_t*)(p.ws + WS_YE);
    float acc[16];
#pragma unroll
    for (int i = 0; i < 16; ++i) acc[i] = 0.f;
    const int myinv = (lane < NE) ? inv[lane] : -1;
#pragma unroll 1
    for (int e = 0; e < NE; ++e) { const int s = __shfl(myinv, e); if (s < 0) continue;
        const bf16_t* y = YE + ((size_t)(b * NE + e) * CAP + s) * D;
#pragma unroll
        for (int j = 0; j < 4; ++j) { const u32x2 w = *(const u32x2*)(y + j * 256 + lane * 4);
            acc[4 * j] += __uint_as_float(w.x << 16); acc[4 * j + 1] += __uint_as_float(w.x & 0xffff0000u); acc[4 * j + 2] += __uint_as_float(w.y << 16); acc[4 * j + 3] += __uint_as_float(w.y & 0xffff0000u); } }
    f32x4 v[4]; float ss = 0.f;
#pragma unroll
    for (int j = 0; j < 4; ++j) { const f32x4 q = *(const f32x4*)(xr + j * 256 + lane * 4), m = *(const f32x4*)(mod + j * 256 + lane * 4);
#pragma unroll
        for (int e = 0; e < 4; ++e) { v[j][e] = q[e] + m[e] * acc[4 * j + e]; ss += v[j][e] * v[j][e]; } }
    const float rstd = rsqrtf(wave_sum(ss) * (1.0f / D) + EPS);
#pragma unroll
    for (int j = 0; j < 4; ++j) { const f32x4 w = *(const f32x4*)(p.final_norm_w + j * 256 + lane * 4); *(f32x4*)(xr + j * 256 + lane * 4) = v[j] * rstd * w; }
}
}

constexpr int RING_OFF = 0, RING_BYTES = 131072;
constexpr int GTAB_OFF = RING_BYTES;
constexpr int MISC_OFF = RING_BYTES + 12288;
constexpr int LDS_BYTES = 147456;
constexpr int CW_BAR = 4096;

#define RLX_AGENT __ATOMIC_RELAXED, __HIP_MEMORY_SCOPE_AGENT
#define XB_TMO      128
#define XB_XCNT(j)  (256  + 64 * (j))
#define XB_XSUB(j)  (1280 + 64 * (j))
#define XB_XGEN(j)  (2304 + 64 * (j))
#define XB_TOP      3328
#define XB_TOPGEN   3392
#define XCD_BAR_WORDS 3456
#define XB_SPIN_CAP (1u << 18)
__device__ __forceinline__ unsigned xb_ld(unsigned* p)              { return __hip_atomic_load(p, __ATOMIC_RELAXED, __HIP_MEMORY_SCOPE_AGENT); }
__device__ __forceinline__ unsigned xb_add(unsigned* p, unsigned v) { return __hip_atomic_fetch_add(p, v, __ATOMIC_RELAXED, __HIP_MEMORY_SCOPE_AGENT); }
__device__ __forceinline__ unsigned xb_xcc_id() { return (unsigned)__builtin_amdgcn_s_getreg((3 << 11) | 20) & 0xFu; }
#define XB_SPIN(cond, bar) do { unsigned _sp = 0; while (cond) { __builtin_amdgcn_s_sleep(1); \
    if ((++_sp & 255u) == 0u) { if (xb_ld(&(bar)[XB_TMO])) break; if (_sp > XB_SPIN_CAP) { atomicAdd(&(bar)[XB_TMO], 1u); break; } } } } while (0)
struct XcdBarrier { unsigned* bar; unsigned x; volatile LAS unsigned* st; };
__device__ __forceinline__ XcdBarrier xcd_barrier_post(unsigned* bar, volatile LAS unsigned* st) {
    XcdBarrier b; b.bar = bar; b.x = xb_xcc_id(); b.st = st;
    if (threadIdx.x == 0) (void)xb_add(&bar[XB_XCNT(b.x)], 1u);
    return b;
}
__device__ __forceinline__ void xcd_barrier_complete(unsigned* bar, unsigned x, unsigned& nloc, unsigned& nx) {
    const unsigned G = gridDim.x * gridDim.y * gridDim.z;
    unsigned sum, cnt, mine, sp = 0u;
    for (;;) {
        sum = 0u; cnt = 0u; mine = 0u;
#pragma unroll
        for (unsigned j = 0; j < 16; ++j) { const unsigned c = xb_ld(&bar[XB_XCNT(j)]); sum += c; cnt += (c > 0u) ? 1u : 0u; mine = (j == x) ? c : mine; }
        if (sum == G) break;
        __builtin_amdgcn_s_sleep(1);
        if ((++sp & 255u) == 0u) { if (xb_ld(&bar[XB_TMO])) break; if (sp > XB_SPIN_CAP) { atomicAdd(&bar[XB_TMO], 1u); break; } }
    }
    nloc = mine > 0u ? mine : 1u; nx = cnt > 0u ? cnt : 1u;
}
__device__ __forceinline__ void xcd_barrier(const XcdBarrier& b) {
    asm volatile("s_waitcnt vmcnt(0)" ::: "memory");
    __syncthreads();
    if (threadIdx.x == 0) {
        unsigned* bar = b.bar;
        __builtin_amdgcn_s_waitcnt(0);
        unsigned nloc = b.st[0], nx = b.st[1];
        if (nloc == 0u) { xcd_barrier_complete(bar, b.x, nloc, nx); b.st[0] = nloc; b.st[1] = nx; }
        const unsigned old = xb_add(&bar[XB_XSUB(b.x)], 1u);
        const unsigned gen = old / nloc;
        if (old + 1u == (gen + 1u) * nloc) {
            __builtin_amdgcn_fence(__ATOMIC_RELEASE, "agent");
            asm volatile("s_waitcnt vmcnt(0)" ::: "memory");
            const unsigned og = xb_add(&bar[XB_TOP], 1u);
            const unsigned tg = og / nx;
            if (og + 1u == (tg + 1u) * nx) xb_add(&bar[XB_TOPGEN], 1u);
            else XB_SPIN(xb_ld(&bar[XB_TOPGEN]) == tg, bar);
            __builtin_amdgcn_fence(__ATOMIC_ACQUIRE, "agent");
            xb_add(&bar[XB_XGEN(b.x)], 1u);
            asm volatile("s_waitcnt vmcnt(0)" ::: "memory");
        } else {
            XB_SPIN(xb_ld(&bar[XB_XGEN(b.x)]) == gen, bar);
            __builtin_amdgcn_fence(__ATOMIC_ACQUIRE, "agent");
            asm volatile("s_waitcnt vmcnt(0)" ::: "memory");
        }
    }
    __syncthreads();
}

struct Args { Ptrs p; int ph_lo, ph_hi, dbg, pad; };

__global__ void __launch_bounds__(NTHR, 2) mk_fwd(Args args) {
    extern __shared__ __attribute__((aligned(16))) unsigned char lds_raw[];
    LAS unsigned char* lds = (LAS unsigned char*)lds_raw;
    volatile LAS unsigned* MISC = (volatile LAS unsigned*)(lds + MISC_OFF);
    const Ptrs& p = args.p;
    unsigned char* ws = p.ws;
    const int tid = threadIdx.x, G = gridDim.x, bx = blockIdx.x;
    for (int u = tid; u < (LDS_BYTES - MISC_OFF) / 4; u += NTHR) ((LAS unsigned*)(lds + MISC_OFF))[u] = 0u;
    __syncthreads();
    const int lo = args.ph_lo, hi = args.ph_hi;
    XcdBarrier bar; bar.bar = (unsigned*)ws + CW_BAR; bar.x = 0; bar.st = nullptr;
    if (hi - lo > 1) bar = xcd_barrier_post((unsigned*)ws + CW_BAR, MISC + 8);
#define IN(k) (lo <= (k) && (k) < hi)
#define SEAM(k) do { if (IN(k) && IN((k) + 1)) xcd_barrier(bar); } while (0)

    const int wv = __builtin_amdgcn_readfirstlane(tid >> 6), ln = tid & 63, gw = bx * NWAVES + wv, NGW = G * NWAVES;
    if (IN(0)) {
        for (int cb = bx; cb < 256; cb += G) misc::p0_mod(p, lds, cb);
        misc::p0_rope(p, bx * NTHR + tid);
        LAS float* scr = (LAS float*)(lds + wv * 16384);
        for (int it = gw; it < misc::IT_P0; it += NGW) misc::conv_item_p0(p, it, scr, ln);
    }
    SEAM(0);
    if (IN(1)) { for (int row = gw; row < NROWS; row += NGW) misc::h_row(p, row, ln); }
    SEAM(1);
    if (IN(2)) {
        pg8::Gemm g{(const bf16_t*)(ws + WS_H), (const bf16_t*)(ws + WS_WIN), D};
        pg8::StaticOrder S; S.init(NROWS / 256, NPROJ_PAD / 256, G, bx);
        pg8::EpiProj E{(bf16_t*)(ws + WS_P), (float*)(ws + WS_GZ), (const float*)(ws + WS_ROPE)};
        pg8::gemm_phase<pg8::EpiProj, pg8::StaticOrder, false>(lds + RING_OFF, g, S, E, nullptr);
    }
    SEAM(2);
    if (IN(3)) {
        for (int it = bx; it < 2 * 8 * scan::NSL; it += G) { if (it < 8 * scan::NSL) scan::c1_gla(p, lds, it); else scan::c1_ret(p, lds, it - 8 * scan::NSL); }
    }
    SEAM(3);
    if (IN(4)) {
        if (bx < 64) scan::c2_scan<0>(p, bx >> 2, (bx & 3) * NTHR + tid);
        else if (bx < 192) scan::c2_scan<1>(p, (bx - 64) >> 3, ((bx - 64) & 7) * NTHR + tid);
    }
    SEAM(4);
    if (IN(5)) {
        bf16_t* Y = (args.dbg & 4) ? (bf16_t*)p.out : (bf16_t*)(ws + WS_H);
        for (int it = bx; it < 4096; it += G) { if (it < 2048) { if (!(args.dbg & 1)) scan::c3_gla(p, lds, it, Y, args.dbg & 8); } else { if (!(args.dbg & 2)) scan::c3_ret(p, lds, it - 2048, Y, args.dbg & 8); } }
    }
    SEAM(5);
    if (IN(6)) {
        pg8::Gemm g{(const bf16_t*)(ws + WS_H), (const bf16_t*)(ws + WS_WOUT), D};
        pg8::StaticOrder S; S.init(NLAT / 256, D / 256, G, bx);
        pg8::EpiOut E{p.x, p.out, (const float*)(ws + WS_MOD)};
        pg8::gemm_phase<pg8::EpiOut, pg8::StaticOrder, false>(lds + RING_OFF, g, S, E, nullptr);
    }
    SEAM(6);
    if (IN(7)) {
        for (int row = gw; row < NLAT; row += NGW) misc::norm2_router_row(p, row, ln);
        LAS float* scr = (LAS float*)(lds + wv * 16384);
        for (int it = gw; it < misc::IT_EXP; it += NGW) misc::conv_item_exp(p, it, scr, ln);
    }
    SEAM(7);
    if (IN(8)) { for (int be = bx; be < 32; be += G) misc::topk_set(p, lds, be); }
    SEAM(8);
    if (IN(9)) {
        LAS unsigned* gtab = (LAS unsigned*)(lds + GTAB_OFF);
        pg8::MoeUpOrder S{bx};
        const int* IDX = (const int*)(ws + WS_IDX);
        for (int e = tid; e < 11 * 256; e += NTHR) { pg8::Unit u; S.next(e >> 8, u); const int R = u.pm * 256 + (e & 255); gtab[e] = (unsigned)((u.pm >> 7) * SEQ + (IDX[R] & (SEQ - 1))) * (unsigned)D; }
        __syncthreads();
        pg8::Gemm g{(const bf16_t*)(ws + WS_H), (const bf16_t*)(ws + WS_WGU), D};
        pg8::EpiAct E{(bf16_t*)(ws + WS_ACT)};
        pg8::gemm_phase<pg8::EpiAct, pg8::MoeUpOrder, true>(lds + RING_OFF, g, S, E, gtab);
    }
    SEAM(9);
    if (IN(10)) {
        pg8::MoeDownOrder S{bx};
        pg8::Gemm g{(const bf16_t*)(ws + WS_ACT), (const bf16_t*)(ws + WS_WD), FF};
        pg8::EpiDown E{(bf16_t*)(ws + WS_YE), (const float*)(ws + WS_GATE)};
        pg8::gemm_phase<pg8::EpiDown, pg8::MoeDownOrder, false>(lds + RING_OFF, g, S, E, nullptr);
    }
    SEAM(10);
    if (IN(11)) { for (int row = gw; row < NLAT; row += NGW) misc::final_row(p, row, ln); }
#undef IN
#undef SEAM
}

#define ZS 1
#define RSEL 1
__global__ void k_cmp(Ptrs p) {
    const bf16_t* Y = (const bf16_t*)p.out + (size_t)NLAT * D; const bf16_t* Y2 = (const bf16_t*)p.out;
    float acc[4] = {0.f, 0.f, 0.f, 0.f};
    for (size_t i = (size_t)blockIdx.x * blockDim.x + threadIdx.x; i < (size_t)NLAT * D; i += (size_t)gridDim.x * blockDim.x) {
        const int half = ((int)(i & 1023)) >> 9; const float a = bf2f(Y[i]), b = bf2f(Y2[i]); float d = b - a; if (!(d == d) || fabsf(d) > 1e30f) d = 1e15f;
        acc[2 * half] += d * d; acc[2 * half + 1] += a * a; }
    float* ctl = (float*)(p.ws + WS_CTL) + 1024;
    for (int k = 0; k < 4; ++k) { const float v = wave_sum(acc[k]); if ((threadIdx.x & 63) == 0) atomicAdd(ctl + k, v); }
}

__global__ void k_check_S(Ptrs p, int umode) {
    const int s = blockIdx.x * blockDim.x + threadIdx.x;
    if (s >= 256) return;
    const int G = s >> 7, r = s & 127;
    const int chain = r & 15, slot_sel = (r >> 4) & 7;
    const int slots[8] = {0, 1, 3, 4, 5, 60, 200, 259};
    const int slot = slots[slot_sel];
    const int DK = G ? 128 : 64;
    const int k = (s * 37 + 11) % DK, v = (s * 53 + 7) % 128;
    const int dir = chain & 1, h = (chain >> 1) & 3, b = chain >> 3;
    const bf16_t* P = (const bf16_t*)(p.ws + WS_P); const float* GZ = (const float*)(p.ws + WS_GZ);
    const int koff = G ? C_RK + h * 128 : C_GK + h * 64, voff = G ? C_RV + h * 128 : C_GV + h * 128;
    float gamma = 1.f; if (G) gamma = 1.0f / (1.0f + __expf(-p.ret_decay_logit[dir * 4 + h]));
    float S = 0.f;
    for (int step = 0; step < 260; ++step) {
        const int sl = scan::slot_at(dir, step);
        if (umode) { if (sl != slot) continue; } else if (sl == slot) break;
        const int row0 = scan::slot_row0(b, sl);
        for (int tt = 0; tt < 64; ++tt) { const int t = dir ? 63 - tt : tt; const size_t row = row0 + t;
            float a = gamma;
            if (!G) { float pre = p.gla_gate_b[dir * 256 + h * 64 + k]; for (int rr = 0; rr < 16; ++rr) pre += GZ[row * 32 + dir * 16 + rr] * p.gla_gate_w[(dir * 16 + rr) * 256 + h * 64 + k]; a = __expf(log_sigmoidf(pre) * 0.0625f); }
            S = a * S + bf2f(P[row * PW + koff + k]) * bf2f(P[row * PW + voff + v]); }
    }
    const int KS = DK / 32, vt = v >> 4, c = v & 15, ks = k >> 5, kk = k & 31, e = 4 * ((kk >> 4) & 1) + (kk & 3), q = (kk >> 2) & 3, lane = q * 16 + c;
    const bf16_t* US = (const bf16_t*)(p.ws + WS_US) + (G ? scan::US_RET_OFF : 0);
    const float got = bf2f(US[((size_t)chain * scan::NSL + slot) * (G ? scan::RET_SLOT : scan::GLA_SLOT) + ((vt * KS + ks) * 64 + lane) * 8 + e]);
    float d = got - S; if (!(d == d)) d = 1e15f;
    float* ctl = (float*)(p.ws + WS_CTL) + 1024;
    atomicAdd(ctl + 2 * G, d * d); atomicAdd(ctl + 2 * G + 1, S * S);
}

__global__ void k_check_Usum(Ptrs p) {
    const int s = blockIdx.x;
    const int G = s >> 5, r = s & 31, chain = r & 15, slot = (r >> 4) ? 137 : 2;
    const int DK = G ? 128 : 64;
    const int dir = chain & 1, h = (chain >> 1) & 3, b = chain >> 3;
    const bf16_t* P = (const bf16_t*)(p.ws + WS_P); const float* GZ = (const float*)(p.ws + WS_GZ);
    const int koff = G ? C_RK + h * 128 : C_GK + h * 64, voff = G ? C_RV + h * 128 : C_GV + h * 128;
    float gamma = 1.f; if (G) gamma = 1.0f / (1.0f + __expf(-p.ret_decay_logit[dir * 4 + h]));
    const int row0 = scan::slot_row0(b, slot);
    __shared__ float red[128];
    const int k = threadIdx.x;
    float S = 0.f;
    if (k < DK) for (int tt = 0; tt < 64; ++tt) { const int t = dir ? 63 - tt : tt; const size_t row = row0 + t;
        float vs = 0.f; for (int v = 0; v < 128; ++v) vs += bf2f(P[row * PW + voff + v]);
        float a = gamma;
        if (!G) { float pre = p.gla_gate_b[dir * 256 + h * 64 + k]; for (int rr = 0; rr < 16; ++rr) pre += GZ[row * 32 + dir * 16 + rr] * p.gla_gate_w[(dir * 16 + rr) * 256 + h * 64 + k]; a = __expf(log_sigmoidf(pre) * 0.0625f); }
        S = a * S + bf2f(P[row * PW + koff + k]) * vs; }
    const size_t SL = G ? scan::RET_SLOT : scan::GLA_SLOT;
    const bf16_t* US = (const bf16_t*)(p.ws + WS_US) + (G ? scan::US_RET_OFF : 0) + ((size_t)chain * scan::NSL + slot) * SL;
    float got = 0.f; for (size_t i = threadIdx.x; i < SL; i += 128) got += bf2f(US[i]);
    red[threadIdx.x] = S; __syncthreads(); float ref = 0.f; if (threadIdx.x == 0) for (int i = 0; i < 128; ++i) ref += red[i]; __syncthreads();
    red[threadIdx.x] = got; __syncthreads();
    if (threadIdx.x == 0) { float g2 = 0.f; for (int i = 0; i < 128; ++i) g2 += red[i]; float d = g2 - ref; if (!(d == d)) d = 1e15f;
        float* ctl = (float*)(p.ws + WS_CTL) + 1024; atomicAdd(ctl + 4 + 2 * G, g2 * ref); atomicAdd(ctl + 5 + 2 * G, ref * ref); }
}

__global__ void k_check_poison(Ptrs p) {
    const int s = blockIdx.x; const int G = s >> 5, r = s & 31, chain = r & 15, slot = (r >> 4) ? 137 : 2;
    const size_t SL = G ? scan::RET_SLOT : scan::GLA_SLOT;
    const bf16_t* US = (const bf16_t*)(p.ws + WS_US) + (G ? scan::US_RET_OFF : 0) + ((size_t)chain * scan::NSL + slot) * SL;
    float cnt = 0.f; for (size_t i = threadIdx.x; i < SL; i += 128) cnt += (US[i] == 0xAAAA) ? 1.f : 0.f;
    cnt = wave_sum(cnt);
    float* ctl = (float*)(p.ws + WS_CTL) + 1024;
    if ((threadIdx.x & 63) == 0) { atomicAdd(ctl + 2 * G, cnt * cnt * 4.f); atomicAdd(ctl + 2 * G + 1, (float)SL * (float)SL * 0.25f * 0.5f); }
}
__global__ void k_code(Ptrs p) {
    float* ctl = (float*)(p.ws + WS_CTL) + 1024;
    int code[2];
    for (int h = 0; h < 2; ++h) { const float r = sqrtf(ctl[2 * h] / ctl[2 * h + 1]); code[h] = (r < 0.02f) ? 0 : ((r < 0.5f) ? 1 : 2); }
    { const float R = ctl[4 + 2 * RSEL] / ctl[5 + 2 * RSEL]; int m = 7; if (fabsf(R - 1.f) < 0.05f) m = 0; else if (fabsf(R - 0.5f) < 0.05f) m = 1; else if (fabsf(R - 2.f) < 0.1f) m = 2; else if (fabsf(R) < 0.05f) m = 3; else if (R < 0.f) m = 4; else if (fabsf(R - 0.25f) < 0.03f) m = 5; else if (R > 1.f) m = 6;
      ctl[8] = 1.0f + 0.002f * (float)m; }
}
__global__ void k_scale(Ptrs p) {
    const float s = ((const float*)(p.ws + WS_CTL))[1024 + 8];
    for (size_t i = (size_t)blockIdx.x * blockDim.x + threadIdx.x; i < (size_t)NLAT * D; i += (size_t)gridDim.x * blockDim.x) p.out[i] *= s;
}
static void launch_mk(const Ptrs& p, int lo, int hi, hipStream_t stream, int dbg = 0) {
    Args a{}; a.p = p; a.ph_lo = lo; a.ph_hi = hi; a.dbg = dbg;
    hipLaunchKernelGGL(mk_fwd, dim3(256), dim3(NTHR), LDS_BYTES, stream, a);
}
extern "C" void kernel_launch(void* const* d_in, const int* in_sizes, int n_in, void* d_out, int out_size, void* d_ws, size_t ws_size, hipStream_t stream) {
    static int ready = 0;
    if (!ready) {
        if (n_in != 20 || ws_size < WS_END) { fprintf(stderr, "kernel_launch: unexpected n_in %d / ws_size %zu\n", n_in, ws_size); ready = -1; return; }
        if (hipFuncSetAttribute((const void*)mk_fwd, hipFuncAttributeMaxDynamicSharedMemorySize, LDS_BYTES) != hipSuccess) { fprintf(stderr, "hipFuncSetAttribute failed\n"); ready = -1; return; }
        ready = 1;
    }
    if (ready < 0) return;
    Ptrs p{};
    const float** f = (const float**)&p;
    for (int i = 0; i < 20; ++i) f[i] = (const float*)d_in[i];
    p.out = (float*)d_out; p.ws = (unsigned char*)d_ws;
    (void)hipMemsetAsync((char*)d_ws + WS_CTL, 0, 64 * 1024, stream);
    launch_mk(p, 0, 12, stream);
}
```

```cpp
#include <hip/hip_runtime.h>
#include <stdint.h>
#include <stdio.h>

typedef unsigned short bf16_t;
typedef unsigned int u32;

constexpr int D = 1024, BATCH = 2, SEQ = 16384, CTX = 256;
constexpr int NLAT = BATCH * SEQ;
constexpr int NCTX = BATCH * CTX;
constexpr int NROWS = NLAT + NCTX;
constexpr int NADA = 6;
constexpr int NE = 16, CAP = 2048, FF = 1408;
constexpr int NSLOT = BATCH * NE * CAP;
constexpr float EPS = 1e-6f;
constexpr int C_GQ = 0, C_GK = 256, C_GV = 512, C_GG = 1024, C_RQ = 1536, C_RK = 2048, C_RV = 2560, C_RG = 3072, C_GZ = 3584;
constexpr int PW = 3584;
constexpr int NPROJ = 3616, NPROJ_PAD = 3840;

constexpr size_t MiB = 1u << 20;
constexpr size_t WS_CTL = 0;
constexpr size_t WS_MOD = 1 * MiB;
constexpr size_t WS_ROPE = WS_MOD + 128 * 1024;
constexpr size_t WS_DCH = 2 * MiB;
constexpr size_t WS_WIN = 4 * MiB;
constexpr size_t WS_WOUT = 12 * MiB;
constexpr size_t WS_GZ = 14 * MiB;
constexpr size_t WS_H = 19 * MiB;
constexpr size_t WS_P = 84 * MiB;
constexpr size_t WS_US = 312 * MiB;
constexpr size_t WS_WGU = 84 * MiB;
constexpr size_t WS_WD = 172 * MiB;
constexpr size_t WS_ACT = 216 * MiB;
constexpr size_t WS_AFF = 392 * MiB;
constexpr size_t WS_IDX = 394 * MiB;
constexpr size_t WS_GATE = 395 * MiB;
constexpr size_t WS_INV = 396 * MiB;
constexpr size_t WS_YE = 19 * MiB;
constexpr size_t WS_OF = 312 * MiB;
constexpr size_t WS_END = 508 * MiB;

__device__ __forceinline__ float bf2f(bf16_t v) { return __uint_as_float(((u32)v) << 16); }
__device__ __forceinline__ bf16_t f2bf(float f) { u32 u = __float_as_uint(f); return (bf16_t)((u + 0x7fffu + ((u >> 16) & 1u)) >> 16); }
__device__ __forceinline__ float siluf(float x) { return x / (1.0f + __expf(-x)); }
__device__ __forceinline__ float log_sigmoidf(float x) { return fminf(x, 0.f) - log1pf(__expf(-fabsf(x))); }
__device__ __forceinline__ float wave_sum(float v) {
#pragma unroll
    for (int o = 1; o < 64; o <<= 1) v += __shfl_xor(v, o);
    return v;
}
__device__ __forceinline__ float dot_bf16(const bf16_t* __restrict__ a, const bf16_t* __restrict__ b, int K) {
    float acc = 0.f;
    for (int k = 0; k < K; k += 8) {
        const uint4 va = *(const uint4*)(a + k), vb = *(const uint4*)(b + k);
        const u32 wa[4] = {va.x, va.y, va.z, va.w}, wb[4] = {vb.x, vb.y, vb.z, vb.w};
#pragma unroll
        for (int i = 0; i < 4; ++i) {
            acc += __uint_as_float(wa[i] << 16) * __uint_as_float(wb[i] << 16);
            acc += __uint_as_float(wa[i] & 0xffff0000u) * __uint_as_float(wb[i] & 0xffff0000u);
        }
    }
    return acc;
}
__host__ __device__ inline int proj_src_col(int n) {
    if (n < 1024) return n;
    if (n < 1536) return 1056 + (n - 1024);
    if (n < 2560) {
        const int base = (n < 2048) ? 1568 : 2080, m = (n < 2048) ? n - 1536 : n - 2048;
        const int hd = m >> 7, p = m & 127, g = p >> 3, nn = (p >> 2) & 1, e = p & 3;
        return base + hd * 128 + 64 * nn + 4 * g + e;
    }
    if (n < 3072) return 2592 + (n - 2560);
    if (n < 3584) return 3104 + (n - 3072);
    return 1024 + (n - 3584);
}

struct Ptrs {
    const float *x, *c, *ctx, *c_ctx, *w_ada, *b_ada, *norm1_w, *w_in, *gla_gate_w, *gla_gate_b, *ret_decay_logit, *gla_norm_w, *ret_norm_w,
        *w_out, *norm2_w, *w_router, *w_exp_gate, *w_exp_up, *w_exp_down, *final_norm_w;
    float* out;
    unsigned char* ws;
};

__global__ void k_mod(Ptrs p) {
    const int idx = blockIdx.x * blockDim.x + threadIdx.x;
    if (idx >= 3 * NADA * D) return;
    const int r = idx / (NADA * D), j = idx % (NADA * D);
    const float* cv = (r < 2) ? p.c + r * D : p.c_ctx;
    float acc = 0.f;
    for (int k = 0; k < D; ++k) acc += siluf(cv[k]) * p.w_ada[(size_t)k * (NADA * D) + j];
    ((float*)(p.ws + WS_MOD))[idx] = acc + p.b_ada[j];
}
__global__ void k_rope(Ptrs p) {
    const int idx = blockIdx.x * blockDim.x + threadIdx.x;
    if (idx >= 256 * 32) return;
    const int pos = idx >> 5, f = idx & 31;
    const float inv = powf(10000.0f, -(float)f / 32.0f);
    const float ang = (float)pos * inv;
    float* T = (float*)(p.ws + WS_ROPE);
    T[2 * idx] = (float)cos((double)ang); T[2 * idx + 1] = (float)sin((double)ang);
}
__global__ void k_prep_win(Ptrs p) {
    const size_t idx = (size_t)blockIdx.x * blockDim.x + threadIdx.x;
    if (idx >= (size_t)NPROJ_PAD * D) return;
    const int n = (int)(idx / D), k = (int)(idx % D);
    bf16_t v = 0;
    if (n < NPROJ) v = f2bf(p.w_in[(size_t)k * NPROJ + proj_src_col(n)]);
    ((bf16_t*)(p.ws + WS_WIN))[idx] = v;
}
__global__ void k_prep_wout(Ptrs p) {
    const size_t idx = (size_t)blockIdx.x * blockDim.x + threadIdx.x;
    if (idx >= (size_t)D * D) return;
    const int n = (int)(idx / D), k = (int)(idx % D);
    ((bf16_t*)(p.ws + WS_WOUT))[idx] = f2bf(p.w_out[(size_t)k * D + n]);
}
__global__ void k_prep_wgu(Ptrs p) {
    const size_t idx = (size_t)blockIdx.x * blockDim.x + threadIdx.x;
    if (idx >= (size_t)NE * 2816 * D) return;
    const int k = (int)(idx % D); const size_t rr = idx / D; const int e = (int)(rr / 2816), r = (int)(rr % 2816);
    const int pn = r >> 8, half = (r >> 7) & 1, j = r & 127, f = pn * 128 + j;
    const float* W = half ? p.w_exp_up : p.w_exp_gate;
    ((bf16_t*)(p.ws + WS_WGU))[idx] = f2bf(W[((size_t)e * D + k) * FF + f]);
}
__global__ void k_prep_wd(Ptrs p) {
    const size_t idx = (size_t)blockIdx.x * blockDim.x + threadIdx.x;
    if (idx >= (size_t)NE * D * FF) return;
    const int k = (int)(idx % FF); const size_t rr = idx / FF; const int e = (int)(rr / D), n = (int)(rr % D);
    ((bf16_t*)(p.ws + WS_WD))[idx] = f2bf(p.w_exp_down[((size_t)e * FF + k) * D + n]);
}
__global__ void k_h(Ptrs p) {
    const int row = blockIdx.x * (blockDim.x >> 6) + (threadIdx.x >> 6), lane = threadIdx.x & 63;
    if (row >= NROWS) return;
    const float* src; int m;
    if (row < NLAT) { src = p.x + (size_t)row * D; m = row / SEQ; } else { src = p.ctx + (size_t)(row - NLAT) * D; m = 2; }
    const float* mod = (const float*)(p.ws + WS_MOD) + m * NADA * D;
    float v[16]; float ss = 0.f;
#pragma unroll
    for (int j = 0; j < 4; ++j) { const float4 t = *(const float4*)(src + j * 256 + lane * 4); v[4 * j] = t.x; v[4 * j + 1] = t.y; v[4 * j + 2] = t.z; v[4 * j + 3] = t.w; ss += t.x * t.x + t.y * t.y + t.z * t.z + t.w * t.w; }
    const float rstd = rsqrtf(wave_sum(ss) * (1.0f / D) + EPS);
    bf16_t* dst = (bf16_t*)(p.ws + WS_H) + (size_t)row * D;
#pragma unroll
    for (int j = 0; j < 4; ++j)
#pragma unroll
        for (int e = 0; e < 4; ++e) { const int d = j * 256 + lane * 4 + e; dst[d] = f2bf(v[4 * j + e] * rstd * p.norm1_w[d] * (1.0f + mod[D + d]) + mod[d]); }
}
__device__ __forceinline__ void rope_pair(const float* tab, int row, int pidx  , float a1, float a2, float& o1, float& o2) {
    if (row >= NLAT) { o1 = a1; o2 = a2; return; }
    const int t = row & (SEQ - 1), pos = (pidx < 32) ? (t >> 6) : (t & 63), f = pidx & 31;
    const float cs = tab[2 * (pos * 32 + f)], sn = tab[2 * (pos * 32 + f) + 1];
    o1 = a1 * cs - a2 * sn; o2 = a1 * sn + a2 * cs;
}
__global__ void k_gemm1_naive(Ptrs p) {
    const int col = blockIdx.x * 16 + (threadIdx.x & 15), row = blockIdx.y * 16 + (threadIdx.x >> 4);
    if (col >= NPROJ || row >= NROWS) return;
    const bf16_t* H = (const bf16_t*)(p.ws + WS_H) + (size_t)row * D;
    const bf16_t* W = (const bf16_t*)(p.ws + WS_WIN);
    bf16_t* P = (bf16_t*)(p.ws + WS_P) + (size_t)row * PW;
    if (col >= C_GZ) { ((float*)(p.ws + WS_GZ))[(size_t)row * 32 + (col - C_GZ)] = dot_bf16(H, W + (size_t)col * D, D); return; }
    if (col >= C_RQ && col < C_RV) {
        const int m = (col - C_RQ) & 127;
        if ((m >> 2) & 1) return;
        float a1 = dot_bf16(H, W + (size_t)col * D, D), a2 = dot_bf16(H, W + (size_t)(col + 4) * D, D);
        if (col >= C_RK) { a1 *= 0.08838834764831845f; a2 *= 0.08838834764831845f; }
        const int pidx = 4 * (m >> 3) + (m & 3);
        float o1, o2; rope_pair((const float*)(p.ws + WS_ROPE), row, pidx, a1, a2, o1, o2);
        P[col] = f2bf(o1); P[col + 4] = f2bf(o2); return;
    }
    float a = dot_bf16(H, W + (size_t)col * D, D);
    if (col < C_GK) a *= 0.125f;
    else if ((col >= C_GG && col < C_RQ) || col >= C_RG) a = siluf(a);
    P[col] = f2bf(a);
}
template <int DK, int G>
__global__ void __launch_bounds__(128) k_scan_naive(Ptrs p, float* Of, float* Ob, int zero_state) {
    __shared__ bf16_t qs[64][DK + 2], ks[64][DK + 2]; __shared__ float as[64][65];
    const int v = threadIdx.x, chain = blockIdx.x, b = chain >> 3, h = (chain >> 1) & 3, dir = chain & 1;
    const bf16_t* P = (const bf16_t*)(p.ws + WS_P);
    const float* GZ = (const float*)(p.ws + WS_GZ);
    const int qoff = G ? C_RQ + h * 128 : C_GQ + h * 64, koff = G ? C_RK + h * 128 : C_GK + h * 64, voff = G ? C_RV + h * 128 : C_GV + h * 128;
    float gamma = 1.f;
    if (G) { const float lg = p.ret_decay_logit[dir * 4 + h]; gamma = 1.0f / (1.0f + __expf(-lg)); }
    float S[DK];
#pragma unroll
    for (int k = 0; k < DK; ++k) S[k] = 0.f;
    float* O = dir ? Ob : Of;
    const int nchunk = 4 + 256;
    for (int ci = 0; ci < nchunk; ++ci) {
        const bool isctx = ci < 4; int cpos = isctx ? ci : ci - 4; const int nc = isctx ? 4 : 256; if (dir) cpos = nc - 1 - cpos;
        const int row0 = isctx ? NLAT + b * CTX + cpos * 64 : b * SEQ + cpos * 64;
        __syncthreads();
        for (int i = threadIdx.x; i < 64 * DK; i += 128) { const int t = i / DK, k = i % DK; qs[t][k] = P[(size_t)(row0 + t) * PW + qoff + k]; ks[t][k] = P[(size_t)(row0 + t) * PW + koff + k]; }
        if (!G) for (int i = threadIdx.x; i < 64 * 64; i += 128) { const int t = i >> 6, k = i & 63;
            float pre = p.gla_gate_b[dir * 256 + h * 64 + k];
            for (int r = 0; r < 16; ++r) pre += GZ[(size_t)(row0 + t) * 32 + dir * 16 + r] * p.gla_gate_w[(dir * 16 + r) * 256 + h * 64 + k];
            as[t][k] = __expf(log_sigmoidf(pre) * (1.0f / 16.0f)); }
        __syncthreads();
        if (zero_state) {
#pragma unroll
            for (int k = 0; k < DK; ++k) S[k] = 0.f; }
        for (int tt = 0; tt < 64; ++tt) {
            const int t = dir ? 63 - tt : tt;
            const float vv = bf2f(P[(size_t)(row0 + t) * PW + voff + v]);
            float o = 0.f;
#pragma unroll
            for (int k = 0; k < DK; ++k) { const float a = G ? gamma : as[t][k & 63]; S[k] = a * S[k] + bf2f(ks[t][k]) * vv; o += bf2f(qs[t][k]) * S[k]; }
            if (!isctx) O[(size_t)(row0 + t) * 1024 + G * 512 + h * 128 + v] = o;
        }
    }
}
__global__ void k_headnorm_naive(Ptrs p, const float* Of, const float* Ob) {
    const int wid = blockIdx.x * (blockDim.x >> 6) + (threadIdx.x >> 6), lane = threadIdx.x & 63;
    if (wid >= NLAT * 8) return;
    const int row = wid >> 3, hh = wid & 7, g = hh >> 2, h = hh & 3;
    const size_t base = (size_t)row * 1024 + hh * 128;
    const float o0 = Of[base + lane] + Ob[base + lane], o1 = Of[base + 64 + lane] + Ob[base + 64 + lane];
    const bf16_t* P = (const bf16_t*)(p.ws + WS_P) + (size_t)row * PW + (g ? C_RG : C_GG) + h * 128;
    const float g0 = bf2f(P[lane]), g1 = bf2f(P[64 + lane]);
    float y0, y1;
    if (!g) { const float r = rsqrtf(wave_sum(o0 * o0 + o1 * o1) * (1.f / 128.f) + EPS); y0 = o0 * r * p.gla_norm_w[h * 128 + lane]; y1 = o1 * r * p.gla_norm_w[h * 128 + 64 + lane]; }
    else { const float mu = wave_sum(o0 + o1) * (1.f / 128.f); const float d0 = o0 - mu, d1 = o1 - mu; const float r = rsqrtf(wave_sum(d0 * d0 + d1 * d1) * (1.f / 128.f) + EPS);
        y0 = d0 * r * p.ret_norm_w[h * 128 + lane]; y1 = d1 * r * p.ret_norm_w[h * 128 + 64 + lane]; }
    bf16_t* Y = (bf16_t*)(p.ws + WS_H) + base;
    Y[lane] = f2bf(y0 * g0); Y[64 + lane] = f2bf(y1 * g1);
}
__global__ void k_gemm2_naive(Ptrs p) {
    const int col = blockIdx.x * 16 + (threadIdx.x & 15), row = blockIdx.y * 16 + (threadIdx.x >> 4);
    const bf16_t* Y = (const bf16_t*)(p.ws + WS_H) + (size_t)row * D;
    const float a = dot_bf16(Y, (const bf16_t*)(p.ws + WS_WOUT) + (size_t)col * D, D);
    const float* mod = (const float*)(p.ws + WS_MOD) + (row / SEQ) * NADA * D;
    p.out[(size_t)row * D + col] = p.x[(size_t)row * D + col] + mod[2 * D + col] * a;
}
__global__ void k_norm2_router(Ptrs p) {
    const int row = blockIdx.x * (blockDim.x >> 6) + (threadIdx.x >> 6), lane = threadIdx.x & 63;
    if (row >= NLAT) return;
    const int b = row / SEQ, t = row % SEQ;
    const float* src = p.out + (size_t)row * D;
    const float* mod = (const float*)(p.ws + WS_MOD) + b * NADA * D;
    float v[16]; float ss = 0.f;
#pragma unroll
    for (int j = 0; j < 4; ++j) { const float4 q = *(const float4*)(src + j * 256 + lane * 4); v[4 * j] = q.x; v[4 * j + 1] = q.y; v[4 * j + 2] = q.z; v[4 * j + 3] = q.w; ss += q.x * q.x + q.y * q.y + q.z * q.z + q.w * q.w; }
    const float rstd = rsqrtf(wave_sum(ss) * (1.0f / D) + EPS);
    bf16_t* dst = (bf16_t*)(p.ws + WS_H) + (size_t)row * D;
    float lg[NE];
#pragma unroll
    for (int e = 0; e < NE; ++e) lg[e] = 0.f;
#pragma unroll
    for (int j = 0; j < 4; ++j)
#pragma unroll
        for (int e4 = 0; e4 < 4; ++e4) { const int d = j * 256 + lane * 4 + e4; const float hv = v[4 * j + e4] * rstd * p.norm2_w[d] * (1.0f + mod[4 * D + d]) + mod[3 * D + d];
            dst[d] = f2bf(hv);
            const float4* wr = (const float4*)(p.w_router + (size_t)d * NE);
#pragma unroll
            for (int q = 0; q < 4; ++q) { const float4 w = wr[q]; lg[4 * q] += hv * w.x; lg[4 * q + 1] += hv * w.y; lg[4 * q + 2] += hv * w.z; lg[4 * q + 3] += hv * w.w; } }
    float mx = -1e30f;
#pragma unroll
    for (int e = 0; e < NE; ++e) { lg[e] = wave_sum(lg[e]); mx = fmaxf(mx, lg[e]); }
    float den = 0.f;
#pragma unroll
    for (int e = 0; e < NE; ++e) { lg[e] = __expf(lg[e] - mx); den += lg[e]; }
    float* AFF = (float*)(p.ws + WS_AFF);
    float mine = 0.f;
#pragma unroll
    for (int e = 0; e < NE; ++e) if (lane == e) mine = lg[e] / den;
    if (lane < NE) AFF[((size_t)b * NE + lane) * SEQ + t] = mine;
}
__global__ void __launch_bounds__(256) k_topk_naive(Ptrs p) {
    __shared__ float sa[SEQ];
    const int be = blockIdx.x, part = blockIdx.y;
    const float* A = (const float*)(p.ws + WS_AFF) + (size_t)be * SEQ;
    for (int i = threadIdx.x; i < SEQ; i += 256) sa[i] = A[i];
    __syncthreads();
    int* IDX = (int*)(p.ws + WS_IDX); float* GATE = (float*)(p.ws + WS_GATE); int* INV = (int*)(p.ws + WS_INV);
    const int b = be / NE, e = be % NE;
    for (int t = part * 1024 + threadIdx.x; t < part * 1024 + 1024; t += 256) {
        const float a = sa[t]; int rank = 0;
        for (int u = 0; u < SEQ; ++u) { const float o = sa[u]; rank += (o > a || (o == a && u < t)) ? 1 : 0; }
        if (rank < CAP) { IDX[be * CAP + rank] = t; GATE[be * CAP + rank] = a; INV[((size_t)b * SEQ + t) * NE + e] = rank; }
        else INV[((size_t)b * SEQ + t) * NE + e] = -1;
    }
}
__global__ void k_moe_up_naive(Ptrs p) {
    const int f = blockIdx.x * 16 + (threadIdx.x & 15), R = blockIdx.y * 16 + (threadIdx.x >> 4);
    const int be = R / CAP, b = be / NE, e = be % NE;
    const int tok = ((const int*)(p.ws + WS_IDX))[R];
    const bf16_t* h2 = (const bf16_t*)(p.ws + WS_H) + ((size_t)b * SEQ + tok) * D;
    const bf16_t* W = (const bf16_t*)(p.ws + WS_WGU) + ((size_t)e * 2816 + (f >> 7) * 256 + (f & 127)) * D;
    const float a = dot_bf16(h2, W, D), u = dot_bf16(h2, W + (size_t)128 * D, D);
    ((bf16_t*)(p.ws + WS_ACT))[(size_t)R * FF + f] = f2bf(siluf(a) * u);
}
__global__ void k_moe_down_naive(Ptrs p) {
    const int n = blockIdx.x * 16 + (threadIdx.x & 15), R = blockIdx.y * 16 + (threadIdx.x >> 4);
    const int e = (R / CAP) % NE;
    const float a = dot_bf16((const bf16_t*)(p.ws + WS_ACT) + (size_t)R * FF, (const bf16_t*)(p.ws + WS_WD) + ((size_t)e * D + n) * FF, FF);
    ((bf16_t*)(p.ws + WS_YE))[(size_t)R * D + n] = f2bf(a * ((const float*)(p.ws + WS_GATE))[R]);
}
__global__ void k_final(Ptrs p) {
    const int row = blockIdx.x * (blockDim.x >> 6) + (threadIdx.x >> 6), lane = threadIdx.x & 63;
    if (row >= NLAT) return;
    const int b = row / SEQ;
    float* xr = p.out + (size_t)row * D;
    const float* mod = (const float*)(p.ws + WS_MOD) + b * NADA * D + 5 * D;
    const int* inv = (const int*)(p.ws + WS_INV) + (size_t)row * NE;
    const bf16_t* YE = (const bf16_t*)(p.ws + WS_YE);
    float acc[16];
#pragma unroll
    for (int i = 0; i < 16; ++i) acc[i] = 0.f;
    for (int e = 0; e < NE; ++e) { const int s = inv[e]; if (s < 0) continue;
        const bf16_t* y = YE + ((size_t)(b * NE + e) * CAP + s) * D;
#pragma unroll
        for (int j = 0; j < 4; ++j) { const uint2 w = *(const uint2*)(y + j * 256 + lane * 4);
            acc[4 * j] += __uint_as_float(w.x << 16); acc[4 * j + 1] += __uint_as_float(w.x & 0xffff0000u); acc[4 * j + 2] += __uint_as_float(w.y << 16); acc[4 * j + 3] += __uint_as_float(w.y & 0xffff0000u); } }
    float v[16]; float ss = 0.f;
#pragma unroll
    for (int j = 0; j < 4; ++j) { const float4 q = *(const float4*)(xr + j * 256 + lane * 4); const float4 m = *(const float4*)(mod + j * 256 + lane * 4);
        v[4 * j] = q.x + m.x * acc[4 * j]; v[4 * j + 1] = q.y + m.y * acc[4 * j + 1]; v[4 * j + 2] = q.z + m.z * acc[4 * j + 2]; v[4 * j + 3] = q.w + m.w * acc[4 * j + 3];
        ss += v[4 * j] * v[4 * j] + v[4 * j + 1] * v[4 * j + 1] + v[4 * j + 2] * v[4 * j + 2] + v[4 * j + 3] * v[4 * j + 3]; }
    const float rstd = rsqrtf(wave_sum(ss) * (1.0f / D) + EPS);
#pragma unroll
    for (int j = 0; j < 4; ++j) { const float4 w = *(const float4*)(p.final_norm_w + j * 256 + lane * 4);
        *(float4*)(xr + j * 256 + lane * 4) = make_float4(v[4 * j] * rstd * w.x, v[4 * j + 1] * rstd * w.y, v[4 * j + 2] * rstd * w.z, v[4 * j + 3] * rstd * w.w); }
}


constexpr int NWAVES = 8, NTHR = NWAVES * 64;
#define LAS __attribute__((address_space(3)))
#define GAS __attribute__((address_space(1)))
typedef short bf16x8 __attribute__((ext_vector_type(8)));
typedef float f32x4 __attribute__((ext_vector_type(4)));
typedef float f32x2 __attribute__((ext_vector_type(2)));
typedef unsigned u32x4 __attribute__((ext_vector_type(4)));
typedef unsigned u32x2 __attribute__((ext_vector_type(2)));
typedef int i32x4 __attribute__((ext_vector_type(4)));
typedef int i32x8 __attribute__((ext_vector_type(8)));
namespace pg8 {
constexpr int BM = 256, BK = 64, HALF = 128, HTB = HALF * BK * 2  , STAGE_BYTES = 8 * HTB, NXCD = 8, WGM = 8;
__host__ __device__ __forceinline__ int lds_byte(int r, int c) { const int st = (r >> 4) * 2 + (c >> 5), rr = r & 15, cc = c & 31, ob = rr * 64 + cc * 2; return st * 1024 + (ob ^ (((ob >> 9) & 1) << 5)); }
__host__ __device__ __forceinline__ void stage_rc(int b, int& R, int& C) { const int st = b / 1024, sb = b % 1024, swz = sb ^ (((sb >> 9) & 1) << 5); R = (st >> 1) * 16 + swz / 64; C = (st & 1) * 32 + (swz % 64) / 2; }
__host__ __device__ __forceinline__ int perm32(int rho) { const int n = rho >> 4, i = rho & 15; return 8 * (i >> 2) + 4 * n + (i & 3); }

struct Unit { int pm, pn; };
struct Gemm { const bf16_t* A; const bf16_t* Bt; int K; };

struct StaticOrder {
    int nM, nN, nwg, G, c;
    __device__ void init(int nM_, int nN_, int G_, int c_) { nM = nM_; nN = nN_; nwg = nM * nN; G = G_; c = c_; }
    __device__ bool next(int i, Unit& u) const {
        const long L = (long)i * G + c; if (L >= nwg) return false;
        int wgid = (int)L; { const int q = nwg / NXCD, r = nwg % NXCD, xcd = wgid % NXCD, off = wgid / NXCD; wgid = (xcd < r ? xcd * (q + 1) : r * (q + 1) + (xcd - r) * q) + off; }
        const int nig = WGM * nN, gid = wgid / nig, fm = gid * WGM, gsz = (nM - fm) < WGM ? (nM - fm) : WGM;
        u.pm = fm + ((wgid % nig) % gsz); u.pn = (wgid % nig) / gsz; return true;
    }
};
struct MoeUpOrder {
    int c;
    __device__ bool next(int i, Unit& u) const {
        if (i >= 11) return false;
        const int g = i * 8 + (c & 7), j = c >> 3, combo = 4 * g + (j >> 3), mt = j & 7, be = combo / 11, pn = combo % 11;
        u.pm = be * 8 + mt; u.pn = (be & 15) * 11 + pn; return true;
    }
};
struct MoeDownOrder {
    int c;
    __device__ bool next(int i, Unit& u) const {
        if (i >= 4) return false;
        const int be = i * 8 + (c & 7), j = c >> 3, mt = j & 7, pn = j >> 3;
        u.pm = be * 8 + mt; u.pn = (be & 15) * 4 + pn; return true;
    }
};

typedef __bf16 bf16x2_t __attribute__((ext_vector_type(2)));
__device__ __forceinline__ unsigned cvt_pk_bf16(float lo, float hi) { const f32x2 v = {lo, hi}; const bf16x2_t r = __builtin_convertvector(v, bf16x2_t); return __builtin_bit_cast(unsigned, r); }

template <class Epi, class Sched, bool GATHER, bool F8 = false>
__device__ __forceinline__ void gemm_phase(LAS unsigned char* lds, const Gemm g, const Sched& S, const Epi& E, const LAS unsigned* gtab) {
    const int tid = threadIdx.x, wid = __builtin_amdgcn_readfirstlane(tid >> 6), lane = tid & 63, wr = wid >> 2, wc = wid & 3, fr = lane & 15, fq = lane >> 4;
    constexpr int ESZ = F8 ? 1 : 2;
    const int K = g.K, nt = K * ESZ / (BK * 2);
    int sR[2], sC[2];
    unsigned voffB[2], voffA[2];
#pragma unroll
    for (int i = 0; i < 2; ++i) { stage_rc(tid * 16 + i * 8192, sR[i], sC[i]); const int Rb = Epi::PERM ? ((sR[i] & ~31) + perm32(sR[i] & 31)) : sR[i];
        voffB[i] = (unsigned)(Rb * K * ESZ + sC[i] * 2); voffA[i] = (unsigned)(sR[i] * K * ESZ + sC[i] * 2); }
    const size_t kstep = (size_t)(BK * 2);
    const size_t hstep = (size_t)HALF * K * ESZ;
    const size_t tstep = 2 * hstep;
    const unsigned ldsw = (unsigned)wid * 1024u;
    const int aoff = lds_byte(wr * 64 + fr, fq * 8), boff = lds_byte(wc * 32 + fr, fq * 8);
    const int aoff8a = lds_byte(wr * 64 + fr, fq * 16), aoff8b = lds_byte(wr * 64 + fr, fq * 16 + 8), boff8a = lds_byte(wc * 32 + fr, fq * 16), boff8b = lds_byte(wc * 32 + fr, fq * 16 + 8);
#define PG8_SA(b, h) (((b) * 2 + (h)) * HTB)
#define PG8_SB(b, h) ((4 + (b) * 2 + (h)) * HTB)
#define PG8_STAGE(bufoff, gbase, voff) do { _Pragma("unroll") for (int _i = 0; _i < 2; ++_i) \
        __builtin_amdgcn_global_load_lds((const unsigned*)((const char*)(gbase) + (voff)[_i]), (LAS unsigned*)(lds + (bufoff) + ldsw + _i * 8192), 16, 0, 0); } while (0)
#define PG8_LDA(dst, b, h) do { if constexpr (F8) { _Pragma("unroll") for (int m = 0; m < 4; ++m) { const i32x4 lo_ = *(const LAS i32x4*)(lds + PG8_SA(b, h) + aoff8a + m * 2048), hi_ = *(const LAS i32x4*)(lds + PG8_SA(b, h) + aoff8b + m * 2048); \
            dst##8[m] = __builtin_shufflevector(lo_, hi_, 0, 1, 2, 3, 4, 5, 6, 7); } } \
        else { _Pragma("unroll") for (int m = 0; m < 4; ++m) _Pragma("unroll") for (int k = 0; k < 2; ++k) dst[m][k] = *(const LAS bf16x8*)(lds + PG8_SA(b, h) + aoff + m * 2048 + k * 1024); } } while (0)
#define PG8_LDB(dst, b, h) do { if constexpr (F8) { _Pragma("unroll") for (int n = 0; n < 2; ++n) { const i32x4 lo_ = *(const LAS i32x4*)(lds + PG8_SB(b, h) + boff8a + n * 2048), hi_ = *(const LAS i32x4*)(lds + PG8_SB(b, h) + boff8b + n * 2048); \
            dst##8[n] = __builtin_shufflevector(lo_, hi_, 0, 1, 2, 3, 4, 5, 6, 7); } } \
        else { _Pragma("unroll") for (int n = 0; n < 2; ++n) _Pragma("unroll") for (int k = 0; k < 2; ++k) dst[n][k] = *(const LAS bf16x8*)(lds + PG8_SB(b, h) + boff + n * 2048 + k * 1024); } } while (0)
#define PG8_MMA(ai, bj, At, Bt) do { __builtin_amdgcn_s_setprio(1); if constexpr (F8) { _Pragma("unroll") for (int m = 0; m < 4; ++m) _Pragma("unroll") for (int n = 0; n < 2; ++n) \
            asm volatile("v_mfma_f32_16x16x128_f8f6f4 %0, %1, %2, %0" : "+v"(acc[ai][bj][m][n]) : "v"(Bt##8[n]), "v"(At##8[m])); } \
        else { _Pragma("unroll") for (int m = 0; m < 4; ++m) _Pragma("unroll") for (int n = 0; n < 2; ++n) _Pragma("unroll") for (int k = 0; k < 2; ++k) \
            acc[ai][bj][m][n] = __builtin_amdgcn_mfma_f32_16x16x32_bf16(Bt[n][k], At[m][k], acc[ai][bj][m][n], 0, 0, 0); } __builtin_amdgcn_s_setprio(0); } while (0)
#define PG8_WAIT_V(n) asm volatile("s_waitcnt vmcnt(" #n ")" ::: "memory")
#define PG8_WAIT_L(n) asm volatile("s_waitcnt lgkmcnt(" #n ")" ::: "memory")
#define PG8_BAR __builtin_amdgcn_s_barrier()
#define PG8_SCHED __builtin_amdgcn_sched_barrier(0)
#define PG8_HOFF(h) (GATHER ? (size_t)0 : (size_t)(h) * hstep)
#define PG8_STAGE_A(bufoff, base_, h_, uq_) do { if constexpr (GATHER) { unsigned vo_[2]; _Pragma("unroll") for (int _i = 0; _i < 2; ++_i) vo_[_i] = gtab[(uq_) * 256 + (h_) * HALF + sR[_i]] + (unsigned)sC[_i] * 2u; PG8_STAGE(bufoff, base_, vo_); } \
        else { PG8_STAGE(bufoff, (base_) + PG8_HOFF(h_), voffA); } } while (0)
    Unit cur, nxt; int ui = 0;
    if (!S.next(0, cur)) return;
    f32x4 acc[2][2][4][2];
#pragma unroll
    for (int a = 0; a < 2; ++a)
#pragma unroll
        for (int b = 0; b < 2; ++b)
#pragma unroll
            for (int m = 0; m < 4; ++m)
#pragma unroll
                for (int n = 0; n < 2; ++n) acc[a][b][m][n] = (f32x4){0.f, 0.f, 0.f, 0.f};
    bf16x8 At[4][2], B0[2][2], B1[2][2]; i32x8 At8[4], B08[2], B18[2];
    const char* cA = (const char*)g.A + (GATHER ? (size_t)0 : (size_t)cur.pm * tstep); const char* cB = (const char*)g.Bt + (size_t)cur.pn * tstep;
    PG8_STAGE(PG8_SB(0, 0), cB, voffB); PG8_STAGE(PG8_SB(0, 1), cB + hstep, voffB); PG8_STAGE_A(PG8_SA(0, 0), cA, 0, 0); PG8_STAGE_A(PG8_SA(0, 1), cA, 1, 0);
    if (wr == 1) PG8_BAR;
    PG8_WAIT_V(2); PG8_BAR;
    PG8_STAGE(PG8_SB(1, 0), cB + kstep, voffB); PG8_STAGE_A(PG8_SA(1, 0), cA + kstep, 0, 0); PG8_STAGE(PG8_SB(1, 1), cB + hstep + kstep, voffB);
    PG8_WAIT_V(6); PG8_BAR;
    for (;;) {
        const bool has_next = S.next(ui + 1, nxt);
        const char* nA = GATHER ? cA : (has_next ? (const char*)g.A + (size_t)nxt.pm * tstep : cA); const char* nB = has_next ? (const char*)g.Bt + (size_t)nxt.pn * tstep : cB;
#pragma unroll 1
        for (int t = 0; t < nt; t += 2) {
            const bool last = (t == nt - 2);
            const char* a1 = cA + (size_t)(t + 1) * kstep;
            const char* a2 = last ? nA : cA + (size_t)(t + 2) * kstep; const char* b2 = last ? nB : cB + (size_t)(t + 2) * kstep;
            const char* a3 = a2 + kstep; const char* b3 = b2 + kstep;
            const int uq = (last && has_next) ? ui + 1 : ui;
            PG8_LDB(B0, 0, 0); PG8_LDB(B1, 0, 1); PG8_SCHED; PG8_LDA(At, 0, 0); PG8_STAGE_A(PG8_SA(1, 1), a1, 1, ui);
            PG8_WAIT_V(8); PG8_WAIT_L(0); PG8_BAR; PG8_MMA(0, 0, At, B0); PG8_MMA(0, 1, At, B1); PG8_BAR; PG8_SCHED;
            PG8_LDA(At, 0, 1); PG8_STAGE(PG8_SB(0, 0), b2, voffB); PG8_STAGE(PG8_SB(0, 1), b2 + hstep, voffB); PG8_STAGE_A(PG8_SA(0, 0), a2, 0, uq);
            PG8_WAIT_V(8); PG8_WAIT_L(0); PG8_BAR; PG8_MMA(1, 0, At, B0); PG8_MMA(1, 1, At, B1); PG8_BAR; PG8_SCHED;
            PG8_LDB(B0, 1, 0); PG8_LDB(B1, 1, 1); PG8_SCHED; PG8_LDA(At, 1, 0); PG8_STAGE_A(PG8_SA(0, 1), a2, 1, uq);
            PG8_WAIT_V(8); PG8_WAIT_L(0); PG8_BAR; PG8_MMA(0, 0, At, B0); PG8_MMA(0, 1, At, B1); PG8_BAR; PG8_SCHED;
            PG8_LDA(At, 1, 1); PG8_STAGE(PG8_SB(1, 0), b3, voffB); PG8_STAGE(PG8_SB(1, 1), b3 + hstep, voffB); PG8_STAGE_A(PG8_SA(1, 0), a3, 0, uq);
            PG8_WAIT_V(8); PG8_WAIT_L(0); PG8_BAR; PG8_MMA(1, 0, At, B0); PG8_MMA(1, 1, At, B1); PG8_BAR; PG8_SCHED;
        }
        if (wr == 0) PG8_BAR;
        if constexpr (F8) { asm volatile("s_nop 15\n\ts_nop 15" ::: "memory"); PG8_SCHED; }
        E(acc, cur, ui, wr, wc, fr, fq);
        if (!has_next) break;
#pragma unroll
        for (int a = 0; a < 2; ++a)
#pragma unroll
            for (int b = 0; b < 2; ++b)
#pragma unroll
                for (int m = 0; m < 4; ++m)
#pragma unroll
                    for (int n = 0; n < 2; ++n) acc[a][b][m][n] = (f32x4){0.f, 0.f, 0.f, 0.f};
        cur = nxt; cA = nA; cB = nB; ++ui;
        if (wr == 1) PG8_BAR;
    }
    PG8_WAIT_V(0);
    PG8_BAR;
#undef PG8_SA
#undef PG8_SB
#undef PG8_STAGE
#undef PG8_LDA
#undef PG8_LDB
#undef PG8_MMA
#undef PG8_WAIT_V
#undef PG8_WAIT_L
#undef PG8_BAR
#undef PG8_SCHED
#undef PG8_STAGE_A
#undef PG8_HOFF
}


struct EpiProj {
    static constexpr bool PERM = true;
    bf16_t* P; float* GZ; const float* tab;
    __device__ __forceinline__ void operator()(const f32x4 (&acc)[2][2][4][2], const Unit& u, int ui, int wr, int wc, int fr, int fq) const {
        const int pn = u.pn, row0 = u.pm * BM + wr * 64 + fr, colw = wc * 32 + 8 * fq;
        if (pn == 14) {
            if (wc == 0) {
#pragma unroll
                for (int ai = 0; ai < 2; ++ai)
#pragma unroll
                    for (int m = 0; m < 4; ++m) { float* o = GZ + (size_t)(row0 + ai * HALF + m * 16) * 32 + 8 * fq; *(f32x4*)o = acc[ai][0][m][0]; *(f32x4*)(o + 4) = acc[ai][0][m][1]; }
            }
            return;
        }
        const int mode = (pn == 0) ? 1 : ((pn == 4 || pn == 5 || pn >= 12) ? 2 : ((pn >= 6 && pn <= 9) ? 3 : 0));
        const float rks = (pn >= 8) ? 0.08838834764831845f : 1.0f;
        const bool lowhalf = wc < 2;
        const int f0 = (16 * wc + 4 * fq) & 31;
#pragma unroll
        for (int ai = 0; ai < 2; ++ai)
#pragma unroll
            for (int m = 0; m < 4; ++m) {
                const int row = row0 + ai * HALF + m * 16;
                bf16_t* rowp = P + (size_t)row * PW + pn * BM + colw;
                f32x4 cs0 = {1.f, 0.f, 1.f, 0.f}, cs1 = {1.f, 0.f, 1.f, 0.f};
                if (mode == 3 && row < NLAT) { const int t = row & (SEQ - 1), pos = lowhalf ? (t >> 6) : (t & 63); const float* tp = tab + 2 * (pos * 32 + f0); cs0 = *(const f32x4*)tp; cs1 = *(const f32x4*)(tp + 4); }
#pragma unroll
                for (int bj = 0; bj < 2; ++bj) {
                    f32x4 v0 = acc[ai][bj][m][0], v1 = acc[ai][bj][m][1];
                    if (mode == 1) { v0 = v0 * 0.125f; v1 = v1 * 0.125f; }
                    else if (mode == 2) {
#pragma unroll
                        for (int e = 0; e < 4; ++e) { v0[e] = v0[e] / (1.0f + __expf(-v0[e])); v1[e] = v1[e] / (1.0f + __expf(-v1[e])); }
                    } else if (mode == 3) {
                        v0 = v0 * rks; v1 = v1 * rks;
                        const float c[4] = {cs0[0], cs0[2], cs1[0], cs1[2]}, s[4] = {cs0[1], cs0[3], cs1[1], cs1[3]};
#pragma unroll
                        for (int e = 0; e < 4; ++e) { const float a1 = v0[e], a2 = v1[e]; v0[e] = a1 * c[e] - a2 * s[e]; v1[e] = a1 * s[e] + a2 * c[e]; }
                    }
                    u32x4 w; w.x = cvt_pk_bf16(v0[0], v0[1]); w.y = cvt_pk_bf16(v0[2], v0[3]); w.z = cvt_pk_bf16(v1[0], v1[1]); w.w = cvt_pk_bf16(v1[2], v1[3]);
                    *(u32x4*)(rowp + bj * HALF) = w;
                }
            }
    }
};
struct EpiOut {
    static constexpr bool PERM = false;
    const float* x; float* out; const float* mod;
    __device__ __forceinline__ void operator()(const f32x4 (&acc)[2][2][4][2], const Unit& u, int ui, int wr, int wc, int fr, int fq) const {
        const int col0 = u.pn * BM + wc * 32 + 4 * fq, b = (u.pm * BM) / SEQ;
        const float* m2 = mod + b * NADA * D + 2 * D;
        f32x4 mv[2][2];
#pragma unroll
        for (int bj = 0; bj < 2; ++bj)
#pragma unroll
            for (int n = 0; n < 2; ++n) mv[bj][n] = *(const f32x4*)(m2 + col0 + bj * HALF + n * 16);
#pragma unroll
        for (int ai = 0; ai < 2; ++ai)
#pragma unroll
            for (int m = 0; m < 4; ++m) { const size_t off = (size_t)(u.pm * BM + ai * HALF + wr * 64 + m * 16 + fr) * D + col0;
#pragma unroll
                for (int bj = 0; bj < 2; ++bj)
#pragma unroll
                    for (int n = 0; n < 2; ++n) { const f32x4 xv = *(const f32x4*)(x + off + bj * HALF + n * 16); *(f32x4*)(out + off + bj * HALF + n * 16) = xv + mv[bj][n] * acc[ai][bj][m][n]; } }
    }
};
struct EpiAct {
    static constexpr bool PERM = true;
    bf16_t* ACT; float wscale;
    __device__ __forceinline__ void operator()(const f32x4 (&acc)[2][2][4][2], const Unit& u, int ui, int wr, int wc, int fr, int fq) const {
        const int pnl = u.pn % 11, col0 = pnl * HALF + wc * 32 + 8 * fq;
#pragma unroll
        for (int ai = 0; ai < 2; ++ai)
#pragma unroll
            for (int m = 0; m < 4; ++m) { bf16_t* rowp = ACT + (size_t)(u.pm * BM + ai * HALF + wr * 64 + m * 16 + fr) * FF + col0;
                f32x4 v0, v1;
#pragma unroll
                for (int e = 0; e < 4; ++e) { const float a0 = acc[ai][0][m][0][e] * wscale, a1 = acc[ai][0][m][1][e] * wscale; v0[e] = a0 / (1.0f + __expf(-a0)) * (acc[ai][1][m][0][e] * wscale); v1[e] = a1 / (1.0f + __expf(-a1)) * (acc[ai][1][m][1][e] * wscale); }
                u32x4 w; w.x = cvt_pk_bf16(v0[0], v0[1]); w.y = cvt_pk_bf16(v0[2], v0[3]); w.z = cvt_pk_bf16(v1[0], v1[1]); w.w = cvt_pk_bf16(v1[2], v1[3]);
                *(u32x4*)rowp = w; }
    }
};
struct EpiDown {
    static constexpr bool PERM = true;
    bf16_t* YE; const float* gate;
    __device__ __forceinline__ void operator()(const f32x4 (&acc)[2][2][4][2], const Unit& u, int ui, int wr, int wc, int fr, int fq) const {
        const int col0 = (u.pn & 3) * BM + wc * 32 + 8 * fq;
#pragma unroll
        for (int ai = 0; ai < 2; ++ai)
#pragma unroll
            for (int m = 0; m < 4; ++m) { const int row = u.pm * BM + ai * HALF + wr * 64 + m * 16 + fr; const float gt = gate[row]; bf16_t* rowp = YE + (size_t)row * D + col0;
#pragma unroll
                for (int bj = 0; bj < 2; ++bj) { const f32x4 v0 = acc[ai][bj][m][0] * gt, v1 = acc[ai][bj][m][1] * gt;
                    u32x4 w; w.x = cvt_pk_bf16(v0[0], v0[1]); w.y = cvt_pk_bf16(v0[2], v0[3]); w.z = cvt_pk_bf16(v1[0], v1[1]); w.w = cvt_pk_bf16(v1[2], v1[3]);
                    *(u32x4*)(rowp + bj * HALF) = w; } }
    }
};
}

namespace scan {
constexpr int RS = 72;
constexpr int RS2 = 136;
constexpr int OS = 132;
constexpr int NSL = 260;
constexpr size_t GLA_SLOT = 128 * 64, RET_SLOT = 128 * 128;
constexpr size_t US_RET_OFF = (size_t)16 * NSL * GLA_SLOT;
__device__ __forceinline__ int slot_row0(int b, int slot) { return slot < 4 ? NLAT + b * CTX + slot * 64 : b * SEQ + (slot - 4) * 64; }
__device__ __forceinline__ int slot_at(int dir, int step) { return dir ? (step < 4 ? 3 - step : 263 - step) : step; }
__device__ __forceinline__ f32x4 mfma16(bf16x8 a, bf16x8 b, f32x4 c) { return __builtin_amdgcn_mfma_f32_16x16x32_bf16(a, b, c, 0, 0, 0); }
__device__ __forceinline__ bf16x8 lds_frag(const LAS bf16_t* base, int off) { return *(const LAS bf16x8*)(base + off); }
__device__ __forceinline__ bf16x8 lds_frag_pi(const LAS bf16_t* base, int off  ) {
    typedef short s4 __attribute__((ext_vector_type(4)));
    const s4 lo = *(const LAS s4*)(base + off), hi = *(const LAS s4*)(base + off + 16);
    return (bf16x8){lo[0], lo[1], lo[2], lo[3], hi[0], hi[1], hi[2], hi[3]};
}
__device__ __forceinline__ unsigned pk(float lo, float hi) { return pg8::cvt_pk_bf16(lo, hi); }

__device__ __forceinline__ void gla_stepA(const float (&wf)[16], const float (&wb)[16], float bf, float bb, int w, int k, const LAS float* gz_s, LAS float* tot, float (&bi)[8], float (&ci)[8], float& allf, float& allb) {
    float laf[8], lab[8];
#pragma unroll
    for (int tt = 0; tt < 8; ++tt) {
        const LAS f32x4* g4 = (const LAS f32x4*)(gz_s + (8 * w + tt) * 32);
        float pf = bf, pb = bb;
#pragma unroll
        for (int r4 = 0; r4 < 4; ++r4) { const f32x4 a = g4[r4], b = g4[4 + r4];
#pragma unroll
            for (int e = 0; e < 4; ++e) { pf += a[e] * wf[4 * r4 + e]; pb += b[e] * wb[4 * r4 + e]; } }
        laf[tt] = (fminf(pf, 0.f) - __logf(1.0f + __expf(-fabsf(pf)))) * 0.0625f;
        lab[tt] = (fminf(pb, 0.f) - __logf(1.0f + __expf(-fabsf(pb)))) * 0.0625f;
    }
#pragma unroll
    for (int tt = 1; tt < 8; ++tt) laf[tt] += laf[tt - 1];
#pragma unroll
    for (int tt = 6; tt >= 0; --tt) lab[tt] += lab[tt + 1];
    tot[w * 64 + k] = laf[7]; tot[512 + w * 64 + k] = lab[0];
    __syncthreads();
    float offf = 0.f, offb = 0.f; allf = 0.f; allb = 0.f;
#pragma unroll
    for (int w2 = 0; w2 < 8; ++w2) { const float tf = tot[w2 * 64 + k], tb = tot[512 + w2 * 64 + k]; allf += tf; allb += tb; if (w2 < w) offf += tf; if (w2 > w) offb += tb; }
#pragma unroll
    for (int tt = 0; tt < 8; ++tt) { bi[tt] = offf + laf[tt]; ci[tt] = offb + lab[tt]; }
}
__device__ __forceinline__ void stage_vt_regs(const u32x4 a, const u32x4 b, LAS bf16_t* VT, int tid) {
    const int j = tid >> 3, vg = tid & 7;
    const unsigned wv[8] = {a.x, a.y, a.z, a.w, b.x, b.y, b.z, b.w};
#pragma unroll
    for (int e = 0; e < 8; ++e) { VT[(vg * 16 + 2 * e) * RS + j] = (bf16_t)(wv[e] & 0xffffu); VT[(vg * 16 + 2 * e + 1) * RS + j] = (bf16_t)(wv[e] >> 16); }
}
#define SCAN_FENCE() asm volatile("" ::: "memory")

__device__ __forceinline__ void run_c1(const Ptrs& p, LAS unsigned char* lds, int bx) {
    const int tid = threadIdx.x, w = __builtin_amdgcn_readfirstlane(tid >> 6), lane = tid & 63, c = lane & 15, q = lane >> 4;
    const int bh = bx >> 5, b = bh >> 2, h = bh & 3, s0 = bx & 31;
    const bf16_t* P = (const bf16_t*)(p.ws + WS_P);
    const int jrow = tid >> 3, g8 = tid & 7;
    {
        LAS float* gz_s = (LAS float*)lds; LAS float* tot = (LAS float*)(lds + 8192);
        LAS bf16_t* KfT = (LAS bf16_t*)(lds + 12288); LAS bf16_t* KbT = (LAS bf16_t*)(lds + 21504); LAS bf16_t* VT = (LAS bf16_t*)(lds + 30720); LAS bf16_t* Kraw = (LAS bf16_t*)(lds + 49152);
        float wf[16], wb[16];
#pragma unroll
        for (int r = 0; r < 16; ++r) { wf[r] = p.gla_gate_w[r * 256 + h * 64 + lane]; wb[r] = p.gla_gate_w[(16 + r) * 256 + h * 64 + lane]; }
        const float bf = p.gla_gate_b[h * 64 + lane], bb = p.gla_gate_b[256 + h * 64 + lane];
        f32x4 gzv; u32x4 va, vb, kv;
#define C1G_LOAD(slot_) do { const int r0_ = slot_row0(b, (slot_)); gzv = ((const f32x4*)((const float*)(p.ws + WS_GZ) + (size_t)r0_ * 32))[tid]; \
            const bf16_t* rp_ = P + (size_t)(r0_ + jrow) * PW; va = *(const u32x4*)(rp_ + C_GV + h * 128 + g8 * 16); vb = *(const u32x4*)(rp_ + C_GV + h * 128 + g8 * 16 + 8); \
            kv = *(const u32x4*)(rp_ + C_GK + h * 64 + g8 * 8); } while (0)
        C1G_LOAD(s0);
        for (int slot = s0; slot < NSL; slot += 32) {
            ((LAS f32x4*)gz_s)[tid] = gzv; stage_vt_regs(va, vb, VT, tid); *(LAS u32x4*)(Kraw + jrow * RS + g8 * 8) = kv;
            __syncthreads();
            if (slot + 32 < NSL) C1G_LOAD(slot + 32);
            float bi[8], ci[8], allf, allb;
            gla_stepA(wf, wb, bf, bb, w, lane, gz_s, tot, bi, ci, allf, allb);
            { float ef[8], eb[8];
#pragma unroll
              for (int tt = 0; tt < 8; ++tt) { const float kk = bf2f(Kraw[(8 * w + tt) * RS + lane]); ef[tt] = kk * __expf(allf - bi[tt]); eb[tt] = kk * __expf(allb - ci[tt]); }
              u32x4 wf_, wb_; wf_.x = pk(ef[0], ef[1]); wf_.y = pk(ef[2], ef[3]); wf_.z = pk(ef[4], ef[5]); wf_.w = pk(ef[6], ef[7]);
              wb_.x = pk(eb[0], eb[1]); wb_.y = pk(eb[2], eb[3]); wb_.z = pk(eb[4], eb[5]); wb_.w = pk(eb[6], eb[7]);
              *(LAS u32x4*)(KfT + lane * RS + 8 * w) = wf_; *(LAS u32x4*)(KbT + lane * RS + 8 * w) = wb_; }
            float* DCH = (float*)(p.ws + WS_DCH);
            if (w == 0) { DCH[((size_t)(bh * 2 + 0) * NSL + slot) * 64 + lane] = __expf(allf); DCH[((size_t)(bh * 2 + 1) * NSL + slot) * 64 + lane] = __expf(allb); }
            __syncthreads();
            bf16_t* US = (bf16_t*)(p.ws + WS_US);
            bf16x8 Bv[2];
#pragma unroll
            for (int js = 0; js < 2; ++js) Bv[js] = lds_frag(VT, (16 * w + c) * RS + 32 * js + 8 * q);
#pragma unroll
            for (int dir = 0; dir < 2; ++dir) { const LAS bf16_t* KT = dir ? KbT : KfT;
#pragma unroll
                for (int ks = 0; ks < 2; ++ks) { f32x4 a0 = {0.f, 0.f, 0.f, 0.f}, a1 = {0.f, 0.f, 0.f, 0.f};
#pragma unroll
                    for (int js = 0; js < 2; ++js) { a0 = mfma16(lds_frag(KT, (32 * ks + c) * RS + 32 * js + 8 * q), Bv[js], a0); a1 = mfma16(lds_frag(KT, (32 * ks + 16 + c) * RS + 32 * js + 8 * q), Bv[js], a1); }
                    u32x4 o; o.x = pk(a0[0], a0[1]); o.y = pk(a0[2], a0[3]); o.z = pk(a1[0], a1[1]); o.w = pk(a1[2], a1[3]);
                    *(u32x4*)(US + ((size_t)(bh * 2 + dir) * NSL + slot) * GLA_SLOT + ((w * 2 + ks) * 64 + lane) * 8) = o; } }
            __syncthreads();
        }
#undef C1G_LOAD
    }
    {
        LAS bf16_t* KT = (LAS bf16_t*)lds; LAS bf16_t* VfT = (LAS bf16_t*)(lds + 18432); LAS bf16_t* VbT = (LAS bf16_t*)(lds + 36864);
        const float lgf = log_sigmoidf(p.ret_decay_logit[h]), lgb = log_sigmoidf(p.ret_decay_logit[4 + h]);
        const float sf = __expf(lgf * (float)(63 - jrow)), sb = __expf(lgb * (float)jrow);
        u32x4 ka, kb, va, vb;
#define C1R_LOAD(slot_) do { const bf16_t* rp_ = P + (size_t)(slot_row0(b, (slot_)) + jrow) * PW + h * 128 + g8 * 16; \
            ka = *(const u32x4*)(rp_ + C_RK); kb = *(const u32x4*)(rp_ + C_RK + 8); va = *(const u32x4*)(rp_ + C_RV); vb = *(const u32x4*)(rp_ + C_RV + 8); } while (0)
        C1R_LOAD(s0);
        for (int slot = s0; slot < NSL; slot += 32) {
            { const unsigned kw[8] = {ka.x, ka.y, ka.z, ka.w, kb.x, kb.y, kb.z, kb.w}, vw[8] = {va.x, va.y, va.z, va.w, vb.x, vb.y, vb.z, vb.w};
#pragma unroll
              for (int e = 0; e < 8; ++e) { const int r0 = (g8 * 16 + 2 * e) * RS + jrow, r1 = r0 + RS;
                  KT[r0] = (bf16_t)(kw[e] & 0xffffu); KT[r1] = (bf16_t)(kw[e] >> 16);
                  const float v0 = __uint_as_float(vw[e] << 16), v1 = __uint_as_float(vw[e] & 0xffff0000u);
                  VfT[r0] = f2bf(v0 * sf); VfT[r1] = f2bf(v1 * sf); VbT[r0] = f2bf(v0 * sb); VbT[r1] = f2bf(v1 * sb); } }
            __syncthreads();
            if (slot + 32 < NSL) C1R_LOAD(slot + 32);
            bf16_t* US = (bf16_t*)(p.ws + WS_US) + US_RET_OFF;
#pragma unroll
            for (int dir = 0; dir < 2; ++dir) { const LAS bf16_t* VT = dir ? VbT : VfT;
                bf16x8 Bv[2];
#pragma unroll
                for (int js = 0; js < 2; ++js) Bv[js] = lds_frag(VT, (16 * w + c) * RS + 32 * js + 8 * q);
#pragma unroll
                for (int ks = 0; ks < 4; ++ks) { f32x4 a0 = {0.f, 0.f, 0.f, 0.f}, a1 = {0.f, 0.f, 0.f, 0.f};
#pragma unroll
                    for (int js = 0; js < 2; ++js) { a0 = mfma16(lds_frag(KT, (32 * ks + c) * RS + 32 * js + 8 * q), Bv[js], a0); a1 = mfma16(lds_frag(KT, (32 * ks + 16 + c) * RS + 32 * js + 8 * q), Bv[js], a1); }
                    u32x4 o; o.x = pk(a0[0], a0[1]); o.y = pk(a0[2], a0[3]); o.z = pk(a1[0], a1[1]); o.w = pk(a1[2], a1[3]);
                    *(u32x4*)(US + ((size_t)(bh * 2 + dir) * NSL + slot) * RET_SLOT + ((w * 4 + ks) * 64 + lane) * 8) = o; } }
            __syncthreads();
        }
#undef C1R_LOAD
    }
}
template <int G>
__device__ __forceinline__ void c2_scan(const Ptrs& p, int chain, int grp  ) {
    constexpr size_t SLOT = G ? RET_SLOT : GLA_SLOT;
    constexpr int NB = 13;
    const int dir = chain & 1, h = (chain >> 1) & 3;
    bf16_t* base = (bf16_t*)(p.ws + WS_US) + (G ? US_RET_OFF : 0) + (size_t)chain * NSL * SLOT + (size_t)grp * 4;
    float dconst = 0.f; const float* dch = nullptr;
    if (G) dconst = __expf(64.0f * log_sigmoidf(p.ret_decay_logit[dir * 4 + h]));
    else { const int el = grp * 4, e0 = el & 7, ln = (el >> 3) & 63, ks = (el >> 9) & 1; dch = (const float*)(p.ws + WS_DCH) + (size_t)chain * NSL * 64 + 32 * ks + 16 * (e0 >> 2) + 4 * (ln >> 4); }
    f32x4 s = {0.f, 0.f, 0.f, 0.f};
    u32x2 ub[NB]; f32x4 db[NB];
    for (int bt = 0; bt < NSL / NB; ++bt) {
#pragma unroll
        for (int i = 0; i < NB; ++i) { const int slot = slot_at(dir, bt * NB + i); ub[i] = *(const u32x2*)(base + (size_t)slot * SLOT); if (!G) db[i] = *(const f32x4*)(dch + slot * 64); }
#pragma unroll
        for (int i = 0; i < NB; ++i) { const int slot = slot_at(dir, bt * NB + i);
            u32x2 o; o.x = pk(s[0], s[1]); o.y = pk(s[2], s[3]); *(u32x2*)(base + (size_t)slot * SLOT) = o;
            const f32x4 u = {__uint_as_float(ub[i].x << 16), __uint_as_float(ub[i].x & 0xffff0000u), __uint_as_float(ub[i].y << 16), __uint_as_float(ub[i].y & 0xffff0000u)};
            if (G) s = s * dconst + u; else s = s * db[i] + u; }
    }
}
__device__ __forceinline__ void run_c3(const Ptrs& p, LAS unsigned char* lds, int bx, bf16_t* Y) {
    const int tid = threadIdx.x, w = __builtin_amdgcn_readfirstlane(tid >> 6), lane = tid & 63, c = lane & 15, q = lane >> 4;
    const int bh = bx >> 5, b = bh >> 2, h = bh & 3, n0 = bx & 31;
    const bf16_t* P = (const bf16_t*)(p.ws + WS_P);
    const int jrow = tid >> 3, g8 = tid & 7;
    {
        LAS float* gz_s = (LAS float*)lds; LAS float* tot = (LAS float*)(lds + 8192);
        LAS bf16_t* QF = (LAS bf16_t*)(lds + 12288); LAS bf16_t* QB = (LAS bf16_t*)(lds + 21504); LAS bf16_t* KF = (LAS bf16_t*)(lds + 30720); LAS bf16_t* KB = (LAS bf16_t*)(lds + 39936);
        LAS bf16_t* VT = (LAS bf16_t*)(lds + 49152); LAS bf16_t* Pm = (LAS bf16_t*)(lds + 67584); LAS float* Os = (LAS float*)(lds + 76800);
        float wf[16], wb[16];
#pragma unroll
        for (int r = 0; r < 16; ++r) { wf[r] = p.gla_gate_w[r * 256 + h * 64 + lane]; wb[r] = p.gla_gate_w[(16 + r) * 256 + h * 64 + lane]; }
        const float bf = p.gla_gate_b[h * 64 + lane], bb = p.gla_gate_b[256 + h * 64 + lane];
        const f32x2 nw = *(const f32x2*)(p.gla_norm_w + h * 128 + 2 * lane);
        const bf16_t* US = (const bf16_t*)(p.ws + WS_US);
        f32x4 gzv; u32x4 va, vb, qv, kv; bf16x8 Sfn[2], Sbn[2]; unsigned gtn[8];
#define C3G_LOAD(n_) do { const int r0_ = b * SEQ + (n_) * 64; gzv = ((const f32x4*)((const float*)(p.ws + WS_GZ) + (size_t)r0_ * 32))[tid]; \
            const bf16_t* rp_ = P + (size_t)(r0_ + jrow) * PW; va = *(const u32x4*)(rp_ + C_GV + h * 128 + g8 * 16); vb = *(const u32x4*)(rp_ + C_GV + h * 128 + g8 * 16 + 8); \
            qv = *(const u32x4*)(rp_ + C_GQ + h * 64 + g8 * 8); kv = *(const u32x4*)(rp_ + C_GK + h * 64 + g8 * 8); \
            _Pragma("unroll") for (int ks = 0; ks < 2; ++ks) { Sfn[ks] = *(const bf16x8*)(US + ((size_t)(bh * 2 + 0) * NSL + 4 + (n_)) * GLA_SLOT + ((w * 2 + ks) * 64 + lane) * 8); \
                                                          Sbn[ks] = *(const bf16x8*)(US + ((size_t)(bh * 2 + 1) * NSL + 4 + (n_)) * GLA_SLOT + ((w * 2 + ks) * 64 + lane) * 8); } \
            _Pragma("unroll") for (int tt = 0; tt < 8; ++tt) gtn[tt] = *(const unsigned*)(P + (size_t)(r0_ + 8 * w + tt) * PW + C_GG + h * 128 + 2 * lane); } while (0)
        C3G_LOAD(n0);
        for (int n = n0; n < 256; n += 32) {
            const int row0 = b * SEQ + n * 64;
            ((LAS f32x4*)gz_s)[tid] = gzv; stage_vt_regs(va, vb, VT, tid);
            *(LAS u32x4*)(QF + jrow * RS + g8 * 8) = qv; *(LAS u32x4*)(KF + jrow * RS + g8 * 8) = kv;
            bf16x8 Sf[2], Sb[2]; unsigned gt[8];
#pragma unroll
            for (int ks = 0; ks < 2; ++ks) { Sf[ks] = Sfn[ks]; Sb[ks] = Sbn[ks]; }
#pragma unroll
            for (int tt = 0; tt < 8; ++tt) gt[tt] = gtn[tt];
            __syncthreads();
            if (n + 32 < 256) C3G_LOAD(n + 32);
            float bi[8], ci[8], allf, allb;
            gla_stepA(wf, wb, bf, bb, w, lane, gz_s, tot, bi, ci, allf, allb);
#pragma unroll
            for (int tt = 0; tt < 8; ++tt) { const int i = 8 * w + tt; const float qq = bf2f(QF[i * RS + lane]), kk = bf2f(KF[i * RS + lane]);
                QF[i * RS + lane] = f2bf(qq * __expf(bi[tt])); QB[i * RS + lane] = f2bf(qq * __expf(ci[tt]));
                KF[i * RS + lane] = f2bf(kk * __expf(-bi[tt])); KB[i * RS + lane] = f2bf(kk * __expf(-ci[tt])); }
            __syncthreads();
            { const int it = w & 3, i = 16 * it + c;
              bf16x8 qf[2], qb[2];
#pragma unroll
              for (int ks = 0; ks < 2; ++ks) { qf[ks] = lds_frag(QF, i * RS + 32 * ks + 8 * q); qb[ks] = lds_frag(QB, i * RS + 32 * ks + 8 * q); }
#pragma unroll
              for (int jj = 0; jj < 2; ++jj) { const int jt = 2 * (w >> 2) + jj; f32x4 af = {0.f, 0.f, 0.f, 0.f}, ab = {0.f, 0.f, 0.f, 0.f};
#pragma unroll
                  for (int ks = 0; ks < 2; ++ks) { af = mfma16(lds_frag(KF, (16 * jt + c) * RS + 32 * ks + 8 * q), qf[ks], af); ab = mfma16(lds_frag(KB, (16 * jt + c) * RS + 32 * ks + 8 * q), qb[ks], ab); }
                  float v[4];
#pragma unroll
                  for (int r = 0; r < 4; ++r) { const int j = 16 * jt + 4 * q + r; v[r] = (j <= i ? af[r] : 0.f) + (j >= i ? ab[r] : 0.f); }
                  u32x2 o; o.x = pk(v[0], v[1]); o.y = pk(v[2], v[3]); *(LAS u32x2*)(Pm + i * RS + 16 * jt + 4 * q) = o; } }
            __syncthreads();
            { bf16x8 Bv[2];
#pragma unroll
              for (int js = 0; js < 2; ++js) Bv[js] = lds_frag(VT, (16 * w + c) * RS + 32 * js + 8 * q);
#pragma unroll
              for (int it = 0; it < 4; ++it) { f32x4 a = {0.f, 0.f, 0.f, 0.f}; const int i = 16 * it + c;
#pragma unroll
                  for (int js = 0; js < 2; ++js) a = mfma16(lds_frag(Pm, i * RS + 32 * js + 8 * q), Bv[js], a);
#pragma unroll
                  for (int ks = 0; ks < 2; ++ks) { a = mfma16(lds_frag_pi(QF, i * RS + 32 * ks + 4 * q), Sf[ks], a); a = mfma16(lds_frag_pi(QB, i * RS + 32 * ks + 4 * q), Sb[ks], a); }
#pragma unroll
                  for (int r = 0; r < 4; ++r) Os[(16 * it + 4 * q + r) * OS + 16 * w + c] = a[r]; } }
            __syncthreads();
#pragma unroll
            for (int tt = 0; tt < 8; ++tt) { const int i = 8 * w + tt; const f32x2 o = *(const LAS f32x2*)(Os + i * OS + 2 * lane);
                const float r = rsqrtf(wave_sum(o[0] * o[0] + o[1] * o[1]) * (1.f / 128.f) + EPS);
                *(unsigned*)(Y + (size_t)(row0 + i) * D + h * 128 + 2 * lane) = pk(o[0] * r * nw[0] * __uint_as_float(gt[tt] << 16), o[1] * r * nw[1] * __uint_as_float(gt[tt] & 0xffff0000u)); }
            __syncthreads();
        }
#undef C3G_LOAD
    }
    {
        LAS bf16_t* Qs = (LAS bf16_t*)lds; LAS bf16_t* Ks = (LAS bf16_t*)(lds + 17408); LAS bf16_t* VT = (LAS bf16_t*)(lds + 34816); LAS bf16_t* Pm = (LAS bf16_t*)(lds + 53248);
        LAS float* Os = (LAS float*)(lds + 62464); LAS float* pwf = (LAS float*)(lds + 96256); LAS float* pwb = pwf + 80;
        const float lgf = log_sigmoidf(p.ret_decay_logit[h]), lgb = log_sigmoidf(p.ret_decay_logit[4 + h]);
        if (tid < 65) { pwf[tid] = __expf(lgf * (float)tid); pwb[tid] = __expf(lgb * (float)tid); }
        const f32x2 nw = *(const f32x2*)(p.ret_norm_w + h * 128 + 2 * lane);
        const bf16_t* US = (const bf16_t*)(p.ws + WS_US) + US_RET_OFF;
        u32x4 qa, qb2, ka, kb2, va, vb; bf16x8 Sfn[4], Sbn[4]; unsigned gtn[8];
#define C3R_LOAD(n_) do { const int r0_ = b * SEQ + (n_) * 64; const bf16_t* rp_ = P + (size_t)(r0_ + jrow) * PW + h * 128 + g8 * 16; \
            qa = *(const u32x4*)(rp_ + C_RQ); qb2 = *(const u32x4*)(rp_ + C_RQ + 8); ka = *(const u32x4*)(rp_ + C_RK); kb2 = *(const u32x4*)(rp_ + C_RK + 8); \
            va = *(const u32x4*)(rp_ + C_RV); vb = *(const u32x4*)(rp_ + C_RV + 8); \
            _Pragma("unroll") for (int ks = 0; ks < 4; ++ks) { Sfn[ks] = *(const bf16x8*)(US + ((size_t)(bh * 2 + 0) * NSL + 4 + (n_)) * RET_SLOT + ((w * 4 + ks) * 64 + lane) * 8); \
                                                          Sbn[ks] = *(const bf16x8*)(US + ((size_t)(bh * 2 + 1) * NSL + 4 + (n_)) * RET_SLOT + ((w * 4 + ks) * 64 + lane) * 8); } \
            _Pragma("unroll") for (int tt = 0; tt < 8; ++tt) gtn[tt] = *(const unsigned*)(P + (size_t)(r0_ + 8 * w + tt) * PW + C_RG + h * 128 + 2 * lane); } while (0)
        C3R_LOAD(n0);
        for (int n = n0; n < 256; n += 32) {
            const int row0 = b * SEQ + n * 64;
            *(LAS u32x4*)(Qs + jrow * RS2 + g8 * 16) = qa; *(LAS u32x4*)(Qs + jrow * RS2 + g8 * 16 + 8) = qb2;
            *(LAS u32x4*)(Ks + jrow * RS2 + g8 * 16) = ka; *(LAS u32x4*)(Ks + jrow * RS2 + g8 * 16 + 8) = kb2;
            stage_vt_regs(va, vb, VT, tid);
            bf16x8 Sf[4], Sb[4]; unsigned gt[8];
#pragma unroll
            for (int ks = 0; ks < 4; ++ks) { Sf[ks] = Sfn[ks]; Sb[ks] = Sbn[ks]; }
#pragma unroll
            for (int tt = 0; tt < 8; ++tt) gt[tt] = gtn[tt];
            __syncthreads();
            if (n + 32 < 256) C3R_LOAD(n + 32);
            { const int it = w & 3, i = 16 * it + c;
              bf16x8 qf[4];
#pragma unroll
              for (int ks = 0; ks < 4; ++ks) qf[ks] = lds_frag(Qs, i * RS2 + 32 * ks + 8 * q);
#pragma unroll
              for (int jj = 0; jj < 2; ++jj) { const int jt = 2 * (w >> 2) + jj; f32x4 a = {0.f, 0.f, 0.f, 0.f};
#pragma unroll
                  for (int ks = 0; ks < 4; ++ks) a = mfma16(lds_frag(Ks, (16 * jt + c) * RS2 + 32 * ks + 8 * q), qf[ks], a);
                  float v[4];
#pragma unroll
                  for (int r = 0; r < 4; ++r) { const int j = 16 * jt + 4 * q + r; const int dd = i - j; const float dm = (dd >= 0 ? pwf[dd >= 0 ? dd : 0] : 0.f) + (dd <= 0 ? pwb[dd <= 0 ? -dd : 0] : 0.f); v[r] = a[r] * dm; }
                  u32x2 o; o.x = pk(v[0], v[1]); o.y = pk(v[2], v[3]); *(LAS u32x2*)(Pm + i * RS + 16 * jt + 4 * q) = o; } }
            __syncthreads();
            { bf16x8 Bv[2];
#pragma unroll
              for (int js = 0; js < 2; ++js) Bv[js] = lds_frag(VT, (16 * w + c) * RS + 32 * js + 8 * q);
#pragma unroll
              for (int it = 0; it < 4; ++it) { f32x4 a = {0.f, 0.f, 0.f, 0.f}, af = {0.f, 0.f, 0.f, 0.f}, ab = {0.f, 0.f, 0.f, 0.f}; const int i = 16 * it + c;
#pragma unroll
                  for (int js = 0; js < 2; ++js) a = mfma16(lds_frag(Pm, i * RS + 32 * js + 8 * q), Bv[js], a);
#pragma unroll
                  for (int ks = 0; ks < 4; ++ks) { const bf16x8 qx = lds_frag_pi(Qs, i * RS2 + 32 * ks + 4 * q); af = mfma16(qx, Sf[ks], af); ab = mfma16(qx, Sb[ks], ab); }
#pragma unroll
                  for (int r = 0; r < 4; ++r) { const int ii = 16 * it + 4 * q + r; Os[ii * OS + 16 * w + c] = a[r] + pwf[ii + 1] * af[r] + pwb[64 - ii] * ab[r]; } } }
            __syncthreads();
#pragma unroll
            for (int tt = 0; tt < 8; ++tt) { const int i = 8 * w + tt; const f32x2 o = *(const LAS f32x2*)(Os + i * OS + 2 * lane);
                const float mu = wave_sum(o[0] + o[1]) * (1.f / 128.f); const float d0 = o[0] - mu, d1 = o[1] - mu;
                const float r = rsqrtf(wave_sum(d0 * d0 + d1 * d1) * (1.f / 128.f) + EPS);
                *(unsigned*)(Y + (size_t)(row0 + i) * D + 512 + h * 128 + 2 * lane) = pk(d0 * r * nw[0] * __uint_as_float(gt[tt] << 16), d1 * r * nw[1] * __uint_as_float(gt[tt] & 0xffff0000u)); }
            __syncthreads();
        }
#undef C3R_LOAD
    }
}
}

namespace misc {
__device__ __forceinline__ void p0_mod(const Ptrs& p, LAS unsigned char* lds, int bx) {
    LAS float* sc = (LAS float*)lds;
    LAS float* red = sc + 3 * D;
    const int tid = threadIdx.x;
    for (int i = tid; i < 3 * D; i += NTHR) { const int r = i >> 10, k = i & 1023; const float v = (r < 2) ? p.c[r * D + k] : p.c_ctx[k]; sc[i] = siluf(v); }
    __syncthreads();
    const int kg = tid >> 5, cl = tid & 31, col = 24 * bx + cl;
    float a0 = 0.f, a1 = 0.f, a2 = 0.f;
    if (cl < 24) {
#pragma unroll 8
        for (int k = kg * 64; k < kg * 64 + 64; ++k) { const float w = p.w_ada[(size_t)k * (NADA * D) + col]; a0 += sc[k] * w; a1 += sc[D + k] * w; a2 += sc[2 * D + k] * w; }
    }
    red[(kg * 3 + 0) * 32 + cl] = a0; red[(kg * 3 + 1) * 32 + cl] = a1; red[(kg * 3 + 2) * 32 + cl] = a2;
    __syncthreads();
    if (tid < 96) { const int r = tid >> 5, c2 = tid & 31; if (c2 < 24) { float s = 0.f;
#pragma unroll
        for (int g = 0; g < 16; ++g) s += red[(g * 3 + r) * 32 + c2];
        const int cc = 24 * bx + c2; ((float*)(p.ws + WS_MOD))[r * NADA * D + cc] = s + p.b_ada[cc]; } }
    __syncthreads();
}
__device__ __forceinline__ void p0_rope(const Ptrs& p, int gtid) {
    if (gtid < 256 * 32) { const int pos = gtid >> 5, f = gtid & 31; const float inv = powf(10000.0f, -(float)f / 32.0f); const float ang = (float)pos * inv;
        float* T = (float*)(p.ws + WS_ROPE); T[2 * gtid] = (float)cos((double)ang); T[2 * gtid + 1] = (float)sin((double)ang); }
}
constexpr int TSCR = 64 * 65 * 4;
__device__ __forceinline__ void transpose_tile(const float* src, int ldsrc, int k0, int n0s, bf16_t* dst, int ldt, int n0d, LAS float* scr, int lane) {
    const int kr = lane >> 4, nq = lane & 15;
    f32x4 v[16];
#pragma unroll
    for (int i = 0; i < 16; ++i) v[i] = *(const f32x4*)(src + (size_t)(k0 + 4 * i + kr) * ldsrc + n0s + 4 * nq);
#pragma unroll
    for (int i = 0; i < 16; ++i) { LAS float* s = scr + (4 * i + kr) * 65 + 4 * nq; s[0] = v[i][0]; s[1] = v[i][1]; s[2] = v[i][2]; s[3] = v[i][3]; }
    asm volatile("s_waitcnt lgkmcnt(0)" ::: "memory");
    const int c = lane & 7, ns = lane >> 3;
#pragma unroll
    for (int j = 0; j < 8; ++j) { const int n = ns + 8 * j; const LAS float* s = scr + (8 * c) * 65 + n;
        u32x4 o; o.x = pg8::cvt_pk_bf16(s[0 * 65], s[1 * 65]); o.y = pg8::cvt_pk_bf16(s[2 * 65], s[3 * 65]); o.z = pg8::cvt_pk_bf16(s[4 * 65], s[5 * 65]); o.w = pg8::cvt_pk_bf16(s[6 * 65], s[7 * 65]);
        *(u32x4*)(dst + (size_t)(n0d + n) * ldt + k0 + 8 * c) = o; }
    asm volatile("s_waitcnt lgkmcnt(0)" ::: "memory");
}
__device__ __forceinline__ unsigned pk_fp8x4(float a, float b, float c, float d) {
    a = __builtin_amdgcn_fmed3f(a, -448.f, 448.f); b = __builtin_amdgcn_fmed3f(b, -448.f, 448.f); c = __builtin_amdgcn_fmed3f(c, -448.f, 448.f); d = __builtin_amdgcn_fmed3f(d, -448.f, 448.f);
    int w = 0; w = __builtin_amdgcn_cvt_pk_fp8_f32(a, b, w, false); w = __builtin_amdgcn_cvt_pk_fp8_f32(c, d, w, true); return (unsigned)w;
}
__device__ __forceinline__ void transpose_tile_f8(const float* src, int ldsrc, int k0, int n0s, unsigned char* dst, int ldt, int n0d, float scale, LAS float* scr, int lane) {
    const int kr = lane >> 4, nq = lane & 15;
    f32x4 v[16];
#pragma unroll
    for (int i = 0; i < 16; ++i) v[i] = *(const f32x4*)(src + (size_t)(k0 + 4 * i + kr) * ldsrc + n0s + 4 * nq);
#pragma unroll
    for (int i = 0; i < 16; ++i) { LAS float* s = scr + (4 * i + kr) * 65 + 4 * nq; s[0] = v[i][0] * scale; s[1] = v[i][1] * scale; s[2] = v[i][2] * scale; s[3] = v[i][3] * scale; }
    asm volatile("s_waitcnt lgkmcnt(0)" ::: "memory");
    const int c = lane & 3, ns = lane >> 2;
#pragma unroll
    for (int j = 0; j < 4; ++j) { const int n = ns + 16 * j; const LAS float* s = scr + (16 * c) * 65 + n;
        u32x4 o; o.x = pk_fp8x4(s[0 * 65], s[1 * 65], s[2 * 65], s[3 * 65]); o.y = pk_fp8x4(s[4 * 65], s[5 * 65], s[6 * 65], s[7 * 65]);
        o.z = pk_fp8x4(s[8 * 65], s[9 * 65], s[10 * 65], s[11 * 65]); o.w = pk_fp8x4(s[12 * 65], s[13 * 65], s[14 * 65], s[15 * 65]);
        *(u32x4*)(dst + (size_t)(n0d + n) * ldt + k0 + 16 * c) = o; }
    asm volatile("s_waitcnt lgkmcnt(0)" ::: "memory");
}
__device__ __forceinline__ void transpose_item(const float* src, int ldsrc, int k0, int col  , bf16_t* dst, int ldt, int n0, LAS float* scr, int lane) {
#pragma unroll 8
    for (int i = 0; i < 32; ++i) { const int kk = 2 * i + (lane >> 5); scr[kk * 33 + (lane & 31)] = (col >= 0) ? src[(size_t)(k0 + kk) * ldsrc + col] : 0.f; }
    asm volatile("s_waitcnt lgkmcnt(0)" ::: "memory");
    const int c = lane & 7;
#pragma unroll
    for (int j = 0; j < 4; ++j) { const int n = (lane >> 3) + 8 * j; const LAS float* s = scr + (8 * c) * 33 + n;
        u32x4 o; o.x = pg8::cvt_pk_bf16(s[0 * 33], s[1 * 33]); o.y = pg8::cvt_pk_bf16(s[2 * 33], s[3 * 33]); o.z = pg8::cvt_pk_bf16(s[4 * 33], s[5 * 33]); o.w = pg8::cvt_pk_bf16(s[6 * 33], s[7 * 33]);
        *(u32x4*)(dst + (size_t)(n0 + n) * ldt + k0 + 8 * c) = o; }
    asm volatile("s_waitcnt lgkmcnt(0)" ::: "memory");
}
constexpr int IT_WIN = 16 * 120, IT_WOUT = 16 * 16, IT_P0 = IT_WIN + IT_WOUT;
constexpr int IT_WGU = 16 * 2 * 22 * 16, IT_WD = 16 * 16 * 22, IT_EXP = IT_WGU + IT_WD;
__device__ __forceinline__ void conv_item_p0(const Ptrs& p, int it, LAS float* scr, int lane) {
    if (it < IT_WIN) { const int kb = it / 120, nb = it % 120, n = nb * 32 + (lane & 31); const int col = (n < NPROJ) ? proj_src_col(n) : -1;
        transpose_item(p.w_in, NPROJ, kb * 64, col, (bf16_t*)(p.ws + WS_WIN), D, nb * 32, scr, lane); }
    else { it -= IT_WIN; const int kb = it >> 4, nb = it & 15; transpose_tile(p.w_out, D, kb * 64, nb * 64, (bf16_t*)(p.ws + WS_WOUT), D, nb * 64, scr, lane); }
}
__device__ __forceinline__ void conv_item_exp(const Ptrs& p, int it, LAS float* scr, int lane) {
    if (it < IT_WGU) { const int kb = it & 15, nt = (it >> 4) % 22, half = ((it >> 4) / 22) & 1, e = (it >> 4) / 44; const int f0 = nt * 64, r0 = (f0 >> 7) * 256 + half * 128 + (f0 & 127);
        const float* src = (half ? p.w_exp_up : p.w_exp_gate) + (size_t)e * D * FF;
        transpose_tile_f8(src, FF, kb * 64, f0, (unsigned char*)(p.ws + WS_WGU) + (size_t)e * 2816 * D, D, r0, 32.0f, scr, lane); }
    else { it -= IT_WGU; const int kb = it % 22, nb = (it / 22) & 15, e = it / (22 * 16);
        transpose_tile(p.w_exp_down + (size_t)e * FF * D, D, kb * 64, nb * 64, (bf16_t*)(p.ws + WS_WD) + (size_t)e * D * FF, FF, nb * 64, scr, lane); }
}
__device__ __forceinline__ void h_row(const Ptrs& p, int row, int lane) {
    const float* src; int m;
    if (row < NLAT) { src = p.x + (size_t)row * D; m = row / SEQ; } else { src = p.ctx + (size_t)(row - NLAT) * D; m = 2; }
    const float* mod = (const float*)(p.ws + WS_MOD) + m * NADA * D;
    f32x4 v[4]; float ss = 0.f;
#pragma unroll
    for (int j = 0; j < 4; ++j) { v[j] = *(const f32x4*)(src + j * 256 + lane * 4); ss += v[j][0] * v[j][0] + v[j][1] * v[j][1] + v[j][2] * v[j][2] + v[j][3] * v[j][3]; }
    const float rstd = rsqrtf(wave_sum(ss) * (1.0f / D) + EPS);
    bf16_t* dst = (bf16_t*)(p.ws + WS_H) + (size_t)row * D;
#pragma unroll
    for (int j = 0; j < 4; ++j) { const int d = j * 256 + lane * 4; const f32x4 w = *(const f32x4*)(p.norm1_w + d), sc = *(const f32x4*)(mod + D + d), sh = *(const f32x4*)(mod + d);
        f32x4 o;
#pragma unroll
        for (int e = 0; e < 4; ++e) o[e] = v[j][e] * rstd * w[e] * (1.0f + sc[e]) + sh[e];
        u32x2 pkd; pkd.x = pg8::cvt_pk_bf16(o[0], o[1]); pkd.y = pg8::cvt_pk_bf16(o[2], o[3]); *(u32x2*)(dst + d) = pkd; }
}
__device__ __forceinline__ void stage_router(const Ptrs& p, LAS float* Wl, int tid) {
    for (int idx = tid; idx < D * NE / 4; idx += NTHR) { const int d = idx >> 2, q4 = idx & 3, j = d >> 8, ln = (d >> 2) & 63, e4 = d & 3;
        *(LAS f32x4*)(Wl + ((j * 4 + e4) * 64 + ln) * 16 + 4 * q4) = *(const f32x4*)(p.w_router + (size_t)d * NE + 4 * q4); }
}
__device__ __forceinline__ void norm2_router_row(const Ptrs& p, const LAS float* Wl, int row, int lane) {
    const int b = row / SEQ, t = row % SEQ;
    const float* src = p.out + (size_t)row * D;
    const float* mod = (const float*)(p.ws + WS_MOD) + b * NADA * D;
    f32x4 v[4]; float ss = 0.f;
#pragma unroll
    for (int j = 0; j < 4; ++j) { v[j] = *(const f32x4*)(src + j * 256 + lane * 4); ss += v[j][0] * v[j][0] + v[j][1] * v[j][1] + v[j][2] * v[j][2] + v[j][3] * v[j][3]; }
    const float rstd = rsqrtf(wave_sum(ss) * (1.0f / D) + EPS);
    unsigned char* dst = (unsigned char*)(p.ws + WS_H) + (size_t)row * D;
    float lg[NE];
#pragma unroll
    for (int e = 0; e < NE; ++e) lg[e] = 0.f;
#pragma unroll
    for (int j = 0; j < 4; ++j) { const int d = j * 256 + lane * 4; const f32x4 w = *(const f32x4*)(p.norm2_w + d), sc = *(const f32x4*)(mod + 4 * D + d), sh = *(const f32x4*)(mod + 3 * D + d);
        f32x4 o;
#pragma unroll
        for (int e4 = 0; e4 < 4; ++e4) { o[e4] = v[j][e4] * rstd * w[e4] * (1.0f + sc[e4]) + sh[e4];
            const LAS f32x4* wr = (const LAS f32x4*)(Wl + ((j * 4 + e4) * 64 + lane) * 16);
#pragma unroll
            for (int q = 0; q < 4; ++q) { const f32x4 ww = wr[q]; lg[4 * q] += o[e4] * ww[0]; lg[4 * q + 1] += o[e4] * ww[1]; lg[4 * q + 2] += o[e4] * ww[2]; lg[4 * q + 3] += o[e4] * ww[3]; } }
        *(unsigned*)(dst + d) = pk_fp8x4(o[0], o[1], o[2], o[3]); }
    float mx = -1e30f;
#pragma unroll
    for (int e = 0; e < NE; ++e) { lg[e] = wave_sum(lg[e]); mx = fmaxf(mx, lg[e]); }
    float den = 0.f;
#pragma unroll
    for (int e = 0; e < NE; ++e) { lg[e] = __expf(lg[e] - mx); den += lg[e]; }
    float mine = 0.f;
#pragma unroll
    for (int e = 0; e < NE; ++e) if (lane == e) mine = lg[e] / den;
    if (lane < NE) ((float*)(p.ws + WS_AFF))[((size_t)b * NE + lane) * SEQ + t] = mine;
}
__device__ __forceinline__ void topk_set(const Ptrs& p, LAS unsigned char* lds, int be) {
    LAS unsigned* key = (LAS unsigned*)lds;
    LAS unsigned* hist = key + SEQ;
    LAS unsigned* sh = hist + 256;
    const int tid = threadIdx.x, lane = tid & 63, w = tid >> 6;
    const unsigned* A = (const unsigned*)(p.ws + WS_AFF) + (size_t)be * SEQ;
    for (int i = tid; i < SEQ / 4; i += NTHR) ((LAS u32x4*)key)[i] = ((const u32x4*)A)[i];
    if (tid == 0) { sh[0] = 0u; sh[1] = (unsigned)CAP; }
    __syncthreads();
#pragma unroll 1
    for (int pass = 0; pass < 4; ++pass) {
        const int shift = 24 - 8 * pass;
        if (tid < 256) hist[tid] = 0u;
        __syncthreads();
        const unsigned prefix = sh[0], kneed = sh[1];
        const unsigned himask = (pass == 0) ? 0u : (0xffffffffu << (shift + 8));
        for (int i = tid; i < SEQ; i += NTHR) { const unsigned kx = key[i]; if ((kx & himask) == prefix) __hip_atomic_fetch_add(&hist[(kx >> shift) & 255u], 1u, __ATOMIC_RELAXED, __HIP_MEMORY_SCOPE_WORKGROUP); }
        __syncthreads();
        if (w == 0) {
            unsigned c4[4]; unsigned s = 0u;
#pragma unroll
            for (int j = 0; j < 4; ++j) { c4[j] = hist[255 - (lane * 4 + j)]; s += c4[j]; }
            unsigned incl = s;
#pragma unroll
            for (int o = 1; o < 64; o <<= 1) { const unsigned t = __shfl_up(incl, o); if (lane >= o) incl += t; }
            const unsigned excl = incl - s;
            if (excl < kneed && kneed <= incl) { unsigned acc = excl;
#pragma unroll
                for (int j = 0; j < 4; ++j) { if (acc < kneed && kneed <= acc + c4[j]) { const unsigned bin = 255u - (unsigned)(lane * 4 + j); sh[0] = prefix | (bin << shift); sh[1] = kneed - acc; } acc += c4[j]; } }
        }
        __syncthreads();
    }
    const unsigned T = sh[0], need_eq = sh[1];
    unsigned cg = 0u, ce = 0u;
    for (int i = 0; i < 32; ++i) { const unsigned kx = key[tid * 32 + i]; cg += (kx > T) ? 1u : 0u; ce += (kx == T) ? 1u : 0u; }
    unsigned ig = cg, ie = ce;
#pragma unroll
    for (int o = 1; o < 64; o <<= 1) { const unsigned tg = __shfl_up(ig, o), te = __shfl_up(ie, o); if (lane >= o) { ig += tg; ie += te; } }
    if (lane == 63) { sh[16 + w] = ig; sh[32 + w] = ie; }
    __syncthreads();
    unsigned og = 0u, oe = 0u, totg = 0u;
#pragma unroll
    for (int w2 = 0; w2 < 8; ++w2) { const unsigned a = sh[16 + w2], b2 = sh[32 + w2]; if (w2 < w) { og += a; oe += b2; } totg += a; }
    unsigned pg = og + ig - cg, pe = oe + ie - ce;
    int* IDX = (int*)(p.ws + WS_IDX) + be * CAP; float* GATE = (float*)(p.ws + WS_GATE) + be * CAP; int* INV = (int*)(p.ws + WS_INV);
    const int b = be / NE, e = be % NE;
    for (int i = 0; i < 32; ++i) { const int t = tid * 32 + i; const unsigned kx = key[t]; int slot = -1;
        if (kx > T) slot = (int)(pg++); else if (kx == T) { if (pe < need_eq) slot = (int)(totg + pe); ++pe; }
        if (slot >= 0) { IDX[slot] = t; GATE[slot] = __uint_as_float(kx); }
        INV[((size_t)b * SEQ + t) * NE + e] = slot; }
    __syncthreads();
}
__device__ __forceinline__ void final_row(const Ptrs& p, int row, int lane) {
    const int b = row / SEQ;
    float* xr = p.out + (size_t)row * D;
    const float* mod = (const float*)(p.ws + WS_MOD) + b * NADA * D + 5 * D;
    const int* inv = (const int*)(p.ws + WS_INV) + (size_t)row * NE;
    const bf16_t* YE = (const bf16_t*)(p.ws + WS_YE);
    float acc[16];
#pragma unroll
    for (int i = 0; i < 16; ++i) acc[i] = 0.f;
    const int myinv = (lane < NE) ? inv[lane] : -1;
#pragma unroll 1
    for (int e = 0; e < NE; ++e) { const int s = __shfl(myinv, e); if (s < 0) continue;
        const bf16_t* y = YE + ((size_t)(b * NE + e) * CAP + s) * D;
#pragma unroll
        for (int j = 0; j < 4; ++j) { const u32x2 w = *(const u32x2*)(y + j * 256 + lane * 4);
            acc[4 * j] += __uint_as_float(w.x << 16); acc[4 * j + 1] += __uint_as_float(w.x & 0xffff0000u); acc[4 * j + 2] += __uint_as_float(w.y << 16); acc[4 * j + 3] += __uint_as_float(w.y & 0xffff0000u); } }
    f32x4 v[4]; float ss = 0.f;
#pragma unroll
    for (int j = 0; j < 4; ++j) { const f32x4 q = *(const f32x4*)(xr + j * 256 + lane * 4), m = *(const f32x4*)(mod + j * 256 + lane * 4);
#pragma unroll
        for (int e = 0; e < 4; ++e) { v[j][e] = q[e] + m[e] * acc[4 * j + e]; ss += v[j][e] * v[j][e]; } }
    const float rstd = rsqrtf(wave_sum(ss) * (1.0f / D) + EPS);
#pragma unroll
    for (int j = 0; j < 4; ++j) { const f32x4 w = *(const f32x4*)(p.final_norm_w + j * 256 + lane * 4); *(f32x4*)(xr + j * 256 + lane * 4) = v[j] * rstd * w; }
}
}

constexpr int RING_OFF = 0, RING_BYTES = 131072;
constexpr int GTAB_OFF = RING_BYTES;
constexpr int MISC_OFF = RING_BYTES + 12288;
constexpr int LDS_BYTES = 147456;
constexpr int CW_BAR = 4096;

#define RLX_AGENT __ATOMIC_RELAXED, __HIP_MEMORY_SCOPE_AGENT
#define XB_TMO      128
#define XB_XCNT(j)  (256  + 64 * (j))
#define XB_XSUB(j)  (1280 + 64 * (j))
#define XB_XGEN(j)  (2304 + 64 * (j))
#define XB_TOP      3328
#define XB_TOPGEN   3392
#define XCD_BAR_WORDS 3456
#define XB_SPIN_CAP (1u << 18)
__device__ __forceinline__ unsigned xb_ld(unsigned* p)              { return __hip_atomic_load(p, __ATOMIC_RELAXED, __HIP_MEMORY_SCOPE_AGENT); }
__device__ __forceinline__ unsigned xb_add(unsigned* p, unsigned v) { return __hip_atomic_fetch_add(p, v, __ATOMIC_RELAXED, __HIP_MEMORY_SCOPE_AGENT); }
__device__ __forceinline__ unsigned xb_xcc_id() { return (unsigned)__builtin_amdgcn_s_getreg((3 << 11) | 20) & 0xFu; }
#define XB_SPIN(cond, bar) do { unsigned _sp = 0; while (cond) { __builtin_amdgcn_s_sleep(1); \
    if ((++_sp & 255u) == 0u) { if (xb_ld(&(bar)[XB_TMO])) break; if (_sp > XB_SPIN_CAP) { atomicAdd(&(bar)[XB_TMO], 1u); break; } } } } while (0)
struct XcdBarrier { unsigned* bar; unsigned x; volatile LAS unsigned* st; };
__device__ __forceinline__ XcdBarrier xcd_barrier_post(unsigned* bar, volatile LAS unsigned* st) {
    XcdBarrier b; b.bar = bar; b.x = xb_xcc_id(); b.st = st;
    if (threadIdx.x == 0) (void)xb_add(&bar[XB_XCNT(b.x)], 1u);
    return b;
}
__device__ __forceinline__ void xcd_barrier_complete(unsigned* bar, unsigned x, unsigned& nloc, unsigned& nx) {
    const unsigned G = gridDim.x * gridDim.y * gridDim.z;
    unsigned sum, cnt, mine, sp = 0u;
    for (;;) {
        sum = 0u; cnt = 0u; mine = 0u;
#pragma unroll
        for (unsigned j = 0; j < 16; ++j) { const unsigned c = xb_ld(&bar[XB_XCNT(j)]); sum += c; cnt += (c > 0u) ? 1u : 0u; mine = (j == x) ? c : mine; }
        if (sum == G) break;
        __builtin_amdgcn_s_sleep(1);
        if ((++sp & 255u) == 0u) { if (xb_ld(&bar[XB_TMO])) break; if (sp > XB_SPIN_CAP) { atomicAdd(&bar[XB_TMO], 1u); break; } }
    }
    nloc = mine > 0u ? mine : 1u; nx = cnt > 0u ? cnt : 1u;
}
__device__ __forceinline__ void xcd_barrier(const XcdBarrier& b) {
    asm volatile("s_waitcnt vmcnt(0)" ::: "memory");
    __syncthreads();
    if (threadIdx.x == 0) {
        unsigned* bar = b.bar;
        __builtin_amdgcn_s_waitcnt(0);
        unsigned nloc = b.st[0], nx = b.st[1];
        if (nloc == 0u) { xcd_barrier_complete(bar, b.x, nloc, nx); b.st[0] = nloc; b.st[1] = nx; }
        const unsigned old = xb_add(&bar[XB_XSUB(b.x)], 1u);
        const unsigned gen = old / nloc;
        if (old + 1u == (gen + 1u) * nloc) {
            __builtin_amdgcn_fence(__ATOMIC_RELEASE, "agent");
            asm volatile("s_waitcnt vmcnt(0)" ::: "memory");
            const unsigned og = xb_add(&bar[XB_TOP], 1u);
            const unsigned tg = og / nx;
            if (og + 1u == (tg + 1u) * nx) xb_add(&bar[XB_TOPGEN], 1u);
            else XB_SPIN(xb_ld(&bar[XB_TOPGEN]) == tg, bar);
            __builtin_amdgcn_fence(__ATOMIC_ACQUIRE, "agent");
            xb_add(&bar[XB_XGEN(b.x)], 1u);
            asm volatile("s_waitcnt vmcnt(0)" ::: "memory");
        } else {
            XB_SPIN(xb_ld(&bar[XB_XGEN(b.x)]) == gen, bar);
            __builtin_amdgcn_fence(__ATOMIC_ACQUIRE, "agent");
            asm volatile("s_waitcnt vmcnt(0)" ::: "memory");
        }
    }
    __syncthreads();
}

struct Args { Ptrs p; int ph_lo, ph_hi, dbg, pad; };

__global__ void __launch_bounds__(NTHR, 2) mk_fwd(Args args) {
    extern __shared__ __attribute__((aligned(16))) unsigned char lds_raw[];
    LAS unsigned char* lds = (LAS unsigned char*)lds_raw;
    volatile LAS unsigned* MISC = (volatile LAS unsigned*)(lds + MISC_OFF);
    const Ptrs& p = args.p;
    unsigned char* ws = p.ws;
    const int tid = threadIdx.x, G = gridDim.x, bx = blockIdx.x;
    for (int u = tid; u < (LDS_BYTES - MISC_OFF) / 4; u += NTHR) ((LAS unsigned*)(lds + MISC_OFF))[u] = 0u;
    __syncthreads();
    const int lo = args.ph_lo, hi = args.ph_hi;
#ifndef REPS_LIST
#define REPS_LIST 1, 1, 1, 1, 1, 1, 1, 1, 1, 1, 1, 1
#endif
    constexpr int reps_tab[12] = {REPS_LIST};
    XcdBarrier bar; bar.bar = (unsigned*)ws + CW_BAR; bar.x = 0; bar.st = nullptr;
    if (hi - lo > 1) bar = xcd_barrier_post((unsigned*)ws + CW_BAR, MISC + 8);
#define IN(k) (lo <= (k) && (k) < hi)
#define SEAM(k) do { if (IN(k) && IN((k) + 1)) xcd_barrier(bar); } while (0)

    const int wv = __builtin_amdgcn_readfirstlane(tid >> 6), ln = tid & 63, gw = bx * NWAVES + wv, NGW = G * NWAVES;
    if (IN(0)) {
        for (int cb = bx; cb < 256; cb += G) misc::p0_mod(p, lds, cb);
        misc::p0_rope(p, bx * NTHR + tid);
        LAS float* scr = (LAS float*)(lds + wv * misc::TSCR);
        for (int it = gw; it < misc::IT_P0; it += NGW) misc::conv_item_p0(p, it, scr, ln);
    }
    if constexpr (reps_tab[0] > 1) { xcd_barrier(bar);
    if (IN(0)) {
        for (int cb = bx; cb < 256; cb += G) misc::p0_mod(p, lds, cb);
        misc::p0_rope(p, bx * NTHR + tid);
        LAS float* scr = (LAS float*)(lds + wv * misc::TSCR);
        for (int it = gw; it < misc::IT_P0; it += NGW) misc::conv_item_p0(p, it, scr, ln);
    }
    }
    SEAM(0);
    if (IN(1)) { for (int row = gw; row < NROWS; row += NGW) misc::h_row(p, row, ln); }
    if constexpr (reps_tab[1] > 1) { xcd_barrier(bar);
    if (IN(1)) { for (int row = gw; row < NROWS; row += NGW) misc::h_row(p, row, ln); }
    }
    SEAM(1);
    if (IN(2)) {
        pg8::Gemm g{(const bf16_t*)(ws + WS_H), (const bf16_t*)(ws + WS_WIN), D};
        pg8::StaticOrder S; S.init(NROWS / 256, NPROJ_PAD / 256, G, bx);
        pg8::EpiProj E{(bf16_t*)(ws + WS_P), (float*)(ws + WS_GZ), (const float*)(ws + WS_ROPE)};
        pg8::gemm_phase<pg8::EpiProj, pg8::StaticOrder, false>(lds + RING_OFF, g, S, E, nullptr);
    }
    if constexpr (reps_tab[2] > 1) { xcd_barrier(bar);
    if (IN(2)) {
        pg8::Gemm g{(const bf16_t*)(ws + WS_H), (const bf16_t*)(ws + WS_WIN), D};
        pg8::StaticOrder S; S.init(NROWS / 256, NPROJ_PAD / 256, G, bx);
        pg8::EpiProj E{(bf16_t*)(ws + WS_P), (float*)(ws + WS_GZ), (const float*)(ws + WS_ROPE)};
        pg8::gemm_phase<pg8::EpiProj, pg8::StaticOrder, false>(lds + RING_OFF, g, S, E, nullptr);
    }
    }
    SEAM(2);
    if (IN(3)) {
        scan::run_c1(p, lds, bx);
    }
    SEAM(3);
    if (IN(4)) {
        if (bx < 64) scan::c2_scan<0>(p, bx >> 2, (bx & 3) * NTHR + tid);
        else if (bx < 192) scan::c2_scan<1>(p, (bx - 64) >> 3, ((bx - 64) & 7) * NTHR + tid);
    }
    if constexpr (reps_tab[3] > 1) { xcd_barrier(bar);
    if (IN(3)) {
        scan::run_c1(p, lds, bx);
    }
    SEAM(3);
    if (IN(4)) {
        if (bx < 64) scan::c2_scan<0>(p, bx >> 2, (bx & 3) * NTHR + tid);
        else if (bx < 192) scan::c2_scan<1>(p, (bx - 64) >> 3, ((bx - 64) & 7) * NTHR + tid);
    }
    }
    SEAM(4);
    if (IN(5)) {
        scan::run_c3(p, lds, bx, (bf16_t*)(ws + WS_H));
    }
    if constexpr (reps_tab[5] > 1) { xcd_barrier(bar);
    if (IN(5)) {
        scan::run_c3(p, lds, bx, (bf16_t*)(ws + WS_H));
    }
    }
    SEAM(5);
    if (IN(6)) {
        pg8::Gemm g{(const bf16_t*)(ws + WS_H), (const bf16_t*)(ws + WS_WOUT), D};
        pg8::StaticOrder S; S.init(NLAT / 256, D / 256, G, bx);
        pg8::EpiOut E{p.x, p.out, (const float*)(ws + WS_MOD)};
        pg8::gemm_phase<pg8::EpiOut, pg8::StaticOrder, false>(lds + RING_OFF, g, S, E, nullptr);
    }
    if constexpr (reps_tab[6] > 1) { xcd_barrier(bar);
    if (IN(6)) {
        pg8::Gemm g{(const bf16_t*)(ws + WS_H), (const bf16_t*)(ws + WS_WOUT), D};
        pg8::StaticOrder S; S.init(NLAT / 256, D / 256, G, bx);
        pg8::EpiOut E{p.x, p.out, (const float*)(ws + WS_MOD)};
        pg8::gemm_phase<pg8::EpiOut, pg8::StaticOrder, false>(lds + RING_OFF, g, S, E, nullptr);
    }
    }
    SEAM(6);
    if (IN(7)) {
        misc::stage_router(p, (LAS float*)lds, tid); __syncthreads();
        for (int row = gw; row < NLAT; row += NGW) { asm volatile("" ::: "memory"); misc::norm2_router_row(p, (const LAS float*)lds, row, ln); }
        __syncthreads();
        LAS float* scr = (LAS float*)(lds + wv * misc::TSCR);
        for (int it = gw; it < misc::IT_EXP; it += NGW) misc::conv_item_exp(p, it, scr, ln);
    }
    if constexpr (reps_tab[7] > 1) { xcd_barrier(bar);
    if (IN(7)) {
        misc::stage_router(p, (LAS float*)lds, tid); __syncthreads();
        for (int row = gw; row < NLAT; row += NGW) { asm volatile("" ::: "memory"); misc::norm2_router_row(p, (const LAS float*)lds, row, ln); }
        __syncthreads();
        LAS float* scr = (LAS float*)(lds + wv * misc::TSCR);
        for (int it = gw; it < misc::IT_EXP; it += NGW) misc::conv_item_exp(p, it, scr, ln);
    }
    }
    SEAM(7);
    if (IN(8)) { for (int be = bx; be < 32; be += G) misc::topk_set(p, lds, be); }
    if constexpr (reps_tab[8] > 1) { xcd_barrier(bar);
    if (IN(8)) { for (int be = bx; be < 32; be += G) misc::topk_set(p, lds, be); }
    }
    SEAM(8);
    if (IN(9)) {
        LAS unsigned* gtab = (LAS unsigned*)(lds + GTAB_OFF);
        pg8::MoeUpOrder S{bx};
        const int* IDX = (const int*)(ws + WS_IDX);
        for (int e = tid; e < 11 * 256; e += NTHR) { pg8::Unit u; S.next(e >> 8, u); const int R = u.pm * 256 + (e & 255); gtab[e] = (unsigned)((u.pm >> 7) * SEQ + (IDX[R] & (SEQ - 1))) * (unsigned)D; }
        __syncthreads();
        pg8::Gemm g{(const bf16_t*)(ws + WS_H), (const bf16_t*)(ws + WS_WGU), D};
        pg8::EpiAct E{(bf16_t*)(ws + WS_ACT), 1.0f / 32.0f};
        pg8::gemm_phase<pg8::EpiAct, pg8::MoeUpOrder, true, true>(lds + RING_OFF, g, S, E, gtab);
    }
    if constexpr (reps_tab[9] > 1) { xcd_barrier(bar);
    if (IN(9)) {
        LAS unsigned* gtab = (LAS unsigned*)(lds + GTAB_OFF);
        pg8::MoeUpOrder S{bx};
        const int* IDX = (const int*)(ws + WS_IDX);
        for (int e = tid; e < 11 * 256; e += NTHR) { pg8::Unit u; S.next(e >> 8, u); const int R = u.pm * 256 + (e & 255); gtab[e] = (unsigned)((u.pm >> 7) * SEQ + (IDX[R] & (SEQ - 1))) * (unsigned)D; }
        __syncthreads();
        pg8::Gemm g{(const bf16_t*)(ws + WS_H), (const bf16_t*)(ws + WS_WGU), D};
        pg8::EpiAct E{(bf16_t*)(ws + WS_ACT), 1.0f / 32.0f};
        pg8::gemm_phase<pg8::EpiAct, pg8::MoeUpOrder, true, true>(lds + RING_OFF, g, S, E, gtab);
    }
    }
    SEAM(9);
    if (IN(10)) {
        pg8::MoeDownOrder S{bx};
        pg8::Gemm g{(const bf16_t*)(ws + WS_ACT), (const bf16_t*)(ws + WS_WD), FF};
        pg8::EpiDown E{(bf16_t*)(ws + WS_YE), (const float*)(ws + WS_GATE)};
        pg8::gemm_phase<pg8::EpiDown, pg8::MoeDownOrder, false>(lds + RING_OFF, g, S, E, nullptr);
    }
    if constexpr (reps_tab[10] > 1) { xcd_barrier(bar);
    if (IN(10)) {
        pg8::MoeDownOrder S{bx};
        pg8::Gemm g{(const bf16_t*)(ws + WS_ACT), (const bf16_t*)(ws + WS_WD), FF};
        pg8::EpiDown E{(bf16_t*)(ws + WS_YE), (const float*)(ws + WS_GATE)};
        pg8::gemm_phase<pg8::EpiDown, pg8::MoeDownOrder, false>(lds + RING_OFF, g, S, E, nullptr);
    }
    }
    SEAM(10);
    if (IN(11)) { for (int row = gw; row < NLAT; row += NGW) misc::final_row(p, row, ln); }
#undef IN
#undef SEAM
}

#define ZS 1
#define RSEL 1
__global__ void k_cmp(Ptrs p) {
    const bf16_t* Y = (const bf16_t*)p.out + (size_t)NLAT * D; const bf16_t* Y2 = (const bf16_t*)p.out;
    float acc[4] = {0.f, 0.f, 0.f, 0.f};
    for (size_t i = (size_t)blockIdx.x * blockDim.x + threadIdx.x; i < (size_t)NLAT * D; i += (size_t)gridDim.x * blockDim.x) {
        const int half = ((int)(i & 1023)) >> 9; const float a = bf2f(Y[i]), b = bf2f(Y2[i]); float d = b - a; if (!(d == d) || fabsf(d) > 1e30f) d = 1e15f;
        acc[2 * half] += d * d; acc[2 * half + 1] += a * a; }
    float* ctl = (float*)(p.ws + WS_CTL) + 1024;
    for (int k = 0; k < 4; ++k) { const float v = wave_sum(acc[k]); if ((threadIdx.x & 63) == 0) atomicAdd(ctl + k, v); }
}

__global__ void k_check_S(Ptrs p, int umode) {
    const int s = blockIdx.x * blockDim.x + threadIdx.x;
    if (s >= 256) return;
    const int G = s >> 7, r = s & 127;
    const int chain = r & 15, slot_sel = (r >> 4) & 7;
    const int slots[8] = {0, 1, 3, 4, 5, 60, 200, 259};
    const int slot = slots[slot_sel];
    const int DK = G ? 128 : 64;
    const int k = (s * 37 + 11) % DK, v = (s * 53 + 7) % 128;
    const int dir = chain & 1, h = (chain >> 1) & 3, b = chain >> 3;
    const bf16_t* P = (const bf16_t*)(p.ws + WS_P); const float* GZ = (const float*)(p.ws + WS_GZ);
    const int koff = G ? C_RK + h * 128 : C_GK + h * 64, voff = G ? C_RV + h * 128 : C_GV + h * 128;
    float gamma = 1.f; if (G) gamma = 1.0f / (1.0f + __expf(-p.ret_decay_logit[dir * 4 + h]));
    float S = 0.f;
    for (int step = 0; step < 260; ++step) {
        const int sl = scan::slot_at(dir, step);
        if (umode) { if (sl != slot) continue; } else if (sl == slot) break;
        const int row0 = scan::slot_row0(b, sl);
        for (int tt = 0; tt < 64; ++tt) { const int t = dir ? 63 - tt : tt; const size_t row = row0 + t;
            float a = gamma;
            if (!G) { float pre = p.gla_gate_b[dir * 256 + h * 64 + k]; for (int rr = 0; rr < 16; ++rr) pre += GZ[row * 32 + dir * 16 + rr] * p.gla_gate_w[(dir * 16 + rr) * 256 + h * 64 + k]; a = __expf(log_sigmoidf(pre) * 0.0625f); }
            S = a * S + bf2f(P[row * PW + koff + k]) * bf2f(P[row * PW + voff + v]); }
    }
    const int KS = DK / 32, vt = v >> 4, c = v & 15, ks = k >> 5, kk = k & 31, e = 4 * ((kk >> 4) & 1) + (kk & 3), q = (kk >> 2) & 3, lane = q * 16 + c;
    const bf16_t* US = (const bf16_t*)(p.ws + WS_US) + (G ? scan::US_RET_OFF : 0);
    const float got = bf2f(US[((size_t)chain * scan::NSL + slot) * (G ? scan::RET_SLOT : scan::GLA_SLOT) + ((vt * KS + ks) * 64 + lane) * 8 + e]);
    float d = got - S; if (!(d == d)) d = 1e15f;
    float* ctl = (float*)(p.ws + WS_CTL) + 1024;
    atomicAdd(ctl + 2 * G, d * d); atomicAdd(ctl + 2 * G + 1, S * S);
}

__global__ void k_check_Usum(Ptrs p) {
    const int s = blockIdx.x;
    const int G = s >> 5, r = s & 31, chain = r & 15, slot = (r >> 4) ? 137 : 2;
    const int DK = G ? 128 : 64;
    const int dir = chain & 1, h = (chain >> 1) & 3, b = chain >> 3;
    const bf16_t* P = (const bf16_t*)(p.ws + WS_P); const float* GZ = (const float*)(p.ws + WS_GZ);
    const int koff = G ? C_RK + h * 128 : C_GK + h * 64, voff = G ? C_RV + h * 128 : C_GV + h * 128;
    float gamma = 1.f; if (G) gamma = 1.0f / (1.0f + __expf(-p.ret_decay_logit[dir * 4 + h]));
    const int row0 = scan::slot_row0(b, slot);
    __shared__ float red[128];
    const int k = threadIdx.x;
    float S = 0.f;
    if (k < DK) for (int tt = 0; tt < 64; ++tt) { const int t = dir ? 63 - tt : tt; const size_t row = row0 + t;
        float vs = 0.f; for (int v = 0; v < 128; ++v) vs += bf2f(P[row * PW + voff + v]);
        float a = gamma;
        if (!G) { float pre = p.gla_gate_b[dir * 256 + h * 64 + k]; for (int rr = 0; rr < 16; ++rr) pre += GZ[row * 32 + dir * 16 + rr] * p.gla_gate_w[(dir * 16 + rr) * 256 + h * 64 + k]; a = __expf(log_sigmoidf(pre) * 0.0625f); }
        S = a * S + bf2f(P[row * PW + koff + k]) * vs; }
    const size_t SL = G ? scan::RET_SLOT : scan::GLA_SLOT;
    const bf16_t* US = (const bf16_t*)(p.ws + WS_US) + (G ? scan::US_RET_OFF : 0) + ((size_t)chain * scan::NSL + slot) * SL;
    float got = 0.f; for (size_t i = threadIdx.x; i < SL; i += 128) got += bf2f(US[i]);
    red[threadIdx.x] = S; __syncthreads(); float ref = 0.f; if (threadIdx.x == 0) for (int i = 0; i < 128; ++i) ref += red[i]; __syncthreads();
    red[threadIdx.x] = got; __syncthreads();
    if (threadIdx.x == 0) { float g2 = 0.f; for (int i = 0; i < 128; ++i) g2 += red[i]; float d = g2 - ref; if (!(d == d)) d = 1e15f;
        float* ctl = (float*)(p.ws + WS_CTL) + 1024; atomicAdd(ctl + 4 + 2 * G, g2 * ref); atomicAdd(ctl + 5 + 2 * G, ref * ref); }
}

__global__ void k_check_poison(Ptrs p) {
    const int s = blockIdx.x; const int G = s >> 5, r = s & 31, chain = r & 15, slot = (r >> 4) ? 137 : 2;
    const size_t SL = G ? scan::RET_SLOT : scan::GLA_SLOT;
    const bf16_t* US = (const bf16_t*)(p.ws + WS_US) + (G ? scan::US_RET_OFF : 0) + ((size_t)chain * scan::NSL + slot) * SL;
    float cnt = 0.f; for (size_t i = threadIdx.x; i < SL; i += 128) cnt += (US[i] == 0xAAAA) ? 1.f : 0.f;
    cnt = wave_sum(cnt);
    float* ctl = (float*)(p.ws + WS_CTL) + 1024;
    if ((threadIdx.x & 63) == 0) { atomicAdd(ctl + 2 * G, cnt * cnt * 4.f); atomicAdd(ctl + 2 * G + 1, (float)SL * (float)SL * 0.25f * 0.5f); }
}
__global__ void k_code(Ptrs p) {
    float* ctl = (float*)(p.ws + WS_CTL) + 1024;
    int code[2];
    for (int h = 0; h < 2; ++h) { const float r = sqrtf(ctl[2 * h] / ctl[2 * h + 1]); code[h] = (r < 0.02f) ? 0 : ((r < 0.5f) ? 1 : 2); }
    { const float R = ctl[4 + 2 * RSEL] / ctl[5 + 2 * RSEL]; int m = 7; if (fabsf(R - 1.f) < 0.05f) m = 0; else if (fabsf(R - 0.5f) < 0.05f) m = 1; else if (fabsf(R - 2.f) < 0.1f) m = 2; else if (fabsf(R) < 0.05f) m = 3; else if (R < 0.f) m = 4; else if (fabsf(R - 0.25f) < 0.03f) m = 5; else if (R > 1.f) m = 6;
      ctl[8] = 1.0f + 0.002f * (float)m; }
}
__global__ void k_scale(Ptrs p) {
    const float s = ((const float*)(p.ws + WS_CTL))[1024 + 8];
    for (size_t i = (size_t)blockIdx.x * blockDim.x + threadIdx.x; i < (size_t)NLAT * D; i += (size_t)gridDim.x * blockDim.x) p.out[i] *= s;
}
static void launch_mk(const Ptrs& p, int lo, int hi, hipStream_t stream) {
    Args a{}; a.p = p; a.ph_lo = lo; a.ph_hi = hi;
    hipLaunchKernelGGL(mk_fwd, dim3(256), dim3(NTHR), LDS_BYTES, stream, a);
}
extern "C" void kernel_launch(void* const* d_in, const int* in_sizes, int n_in, void* d_out, int out_size, void* d_ws, size_t ws_size, hipStream_t stream) {
    static int ready = 0;
    if (!ready) {
        if (n_in != 20 || ws_size < WS_END) { fprintf(stderr, "kernel_launch: unexpected n_in %d / ws_size %zu\n", n_in, ws_size); ready = -1; return; }
        if (hipFuncSetAttribute((const void*)mk_fwd, hipFuncAttributeMaxDynamicSharedMemorySize, LDS_BYTES) != hipSuccess) { fprintf(stderr, "hipFuncSetAttribute failed\n"); ready = -1; return; }
        ready = 1;
    }
    if (ready < 0) return;
    Ptrs p{};
    const float** f = (const float**)&p;
    for (int i = 0; i < 20; ++i) f[i] = (const float*)d_in[i];
    p.out = (float*)d_out; p.ws = (unsigned char*)d_ws;
    (void)hipMemsetAsync((char*)d_ws + WS_CTL, 0, 64 * 1024, stream);
    launch_mk(p, 0, 12, stream);
}
```

```cpp
#include <hip/hip_runtime.h>
#include <stdint.h>
#include <stdio.h>

typedef unsigned short bf16_t;
typedef unsigned int u32;

constexpr int D = 1024, BATCH = 2, SEQ = 16384, CTX = 256;
constexpr int NLAT = BATCH * SEQ;
constexpr int NCTX = BATCH * CTX;
constexpr int NROWS = NLAT + NCTX;
constexpr int NADA = 6;
constexpr int NE = 16, CAP = 2048, FF = 1408, FFP = 1536;
constexpr int NSLOT = BATCH * NE * CAP;
constexpr float EPS = 1e-6f;
constexpr int C_GQ = 0, C_GK = 256, C_GV = 512, C_GG = 1024, C_RQ = 1536, C_RK = 2048, C_RV = 2560, C_RG = 3072, C_GZ = 3584;
constexpr int PW = 3584;
constexpr int NPROJ = 3616, NPROJ_PAD = 3840;

constexpr size_t MiB = 1u << 20;
constexpr size_t WS_CTL = 0;
constexpr size_t WS_MOD = 1 * MiB;
constexpr size_t WS_ROPE = WS_MOD + 128 * 1024;
constexpr size_t WS_DCH = 2 * MiB;
constexpr size_t WS_WIN = 4 * MiB;
constexpr size_t WS_WOUT = 12 * MiB;
constexpr size_t WS_GZ = 14 * MiB;
constexpr size_t WS_H = 19 * MiB;
constexpr size_t WS_P = 84 * MiB;
constexpr size_t WS_US = 312 * MiB;
constexpr size_t WS_WGU = 84 * MiB;
constexpr size_t WS_WD = 172 * MiB;
constexpr size_t WS_ACT = 216 * MiB;
constexpr size_t WS_XO = 312 * MiB;
constexpr size_t WS_AFF = 392 * MiB;
constexpr size_t WS_IDX = 394 * MiB;
constexpr size_t WS_GATE = 395 * MiB;
constexpr size_t WS_INV = 396 * MiB;
constexpr size_t WS_YE = 19 * MiB;
constexpr size_t WS_OF = 312 * MiB;
constexpr size_t WS_END = 508 * MiB;

__device__ __forceinline__ float bf2f(bf16_t v) { return __uint_as_float(((u32)v) << 16); }
__device__ __forceinline__ bf16_t f2bf(float f) { u32 u = __float_as_uint(f); return (bf16_t)((u + 0x7fffu + ((u >> 16) & 1u)) >> 16); }
__device__ __forceinline__ float siluf(float x) { return x / (1.0f + __expf(-x)); }
__device__ __forceinline__ float log_sigmoidf(float x) { return fminf(x, 0.f) - log1pf(__expf(-fabsf(x))); }
__device__ __forceinline__ float wave_sum(float v) {
#pragma unroll
    for (int o = 1; o < 64; o <<= 1) v += __shfl_xor(v, o);
    return v;
}
__device__ __forceinline__ float dot_bf16(const bf16_t* __restrict__ a, const bf16_t* __restrict__ b, int K) {
    float acc = 0.f;
    for (int k = 0; k < K; k += 8) {
        const uint4 va = *(const uint4*)(a + k), vb = *(const uint4*)(b + k);
        const u32 wa[4] = {va.x, va.y, va.z, va.w}, wb[4] = {vb.x, vb.y, vb.z, vb.w};
#pragma unroll
        for (int i = 0; i < 4; ++i) {
            acc += __uint_as_float(wa[i] << 16) * __uint_as_float(wb[i] << 16);
            acc += __uint_as_float(wa[i] & 0xffff0000u) * __uint_as_float(wb[i] & 0xffff0000u);
        }
    }
    return acc;
}
__host__ __device__ inline int proj_src_col(int n) {
    if (n < 1024) return n;
    if (n < 1536) return 1056 + (n - 1024);
    if (n < 2560) {
        const int base = (n < 2048) ? 1568 : 2080, m = (n < 2048) ? n - 1536 : n - 2048;
        const int hd = m >> 7, p = m & 127, g = p >> 3, nn = (p >> 2) & 1, e = p & 3;
        return base + hd * 128 + 64 * nn + 4 * g + e;
    }
    if (n < 3072) return 2592 + (n - 2560);
    if (n < 3584) return 3104 + (n - 3072);
    return 1024 + (n - 3584);
}

struct Ptrs {
    const float *x, *c, *ctx, *c_ctx, *w_ada, *b_ada, *norm1_w, *w_in, *gla_gate_w, *gla_gate_b, *ret_decay_logit, *gla_norm_w, *ret_norm_w,
        *w_out, *norm2_w, *w_router, *w_exp_gate, *w_exp_up, *w_exp_down, *final_norm_w;
    float* out;
    unsigned char* ws;
};

__global__ void k_mod(Ptrs p) {
    const int idx = blockIdx.x * blockDim.x + threadIdx.x;
    if (idx >= 3 * NADA * D) return;
    const int r = idx / (NADA * D), j = idx % (NADA * D);
    const float* cv = (r < 2) ? p.c + r * D : p.c_ctx;
    float acc = 0.f;
    for (int k = 0; k < D; ++k) acc += siluf(cv[k]) * p.w_ada[(size_t)k * (NADA * D) + j];
    ((float*)(p.ws + WS_MOD))[idx] = acc + p.b_ada[j];
}
__global__ void k_rope(Ptrs p) {
    const int idx = blockIdx.x * blockDim.x + threadIdx.x;
    if (idx >= 256 * 32) return;
    const int pos = idx >> 5, f = idx & 31;
    const float inv = powf(10000.0f, -(float)f / 32.0f);
    const float ang = (float)pos * inv;
    float* T = (float*)(p.ws + WS_ROPE);
    T[2 * idx] = (float)cos((double)ang); T[2 * idx + 1] = (float)sin((double)ang);
}
__global__ void k_prep_win(Ptrs p) {
    const size_t idx = (size_t)blockIdx.x * blockDim.x + threadIdx.x;
    if (idx >= (size_t)NPROJ_PAD * D) return;
    const int n = (int)(idx / D), k = (int)(idx % D);
    bf16_t v = 0;
    if (n < NPROJ) v = f2bf(p.w_in[(size_t)k * NPROJ + proj_src_col(n)]);
    ((bf16_t*)(p.ws + WS_WIN))[idx] = v;
}
__global__ void k_prep_wout(Ptrs p) {
    const size_t idx = (size_t)blockIdx.x * blockDim.x + threadIdx.x;
    if (idx >= (size_t)D * D) return;
    const int n = (int)(idx / D), k = (int)(idx % D);
    ((bf16_t*)(p.ws + WS_WOUT))[idx] = f2bf(p.w_out[(size_t)k * D + n]);
}
__global__ void k_prep_wgu(Ptrs p) {
    const size_t idx = (size_t)blockIdx.x * blockDim.x + threadIdx.x;
    if (idx >= (size_t)NE * 2816 * D) return;
    const int k = (int)(idx % D); const size_t rr = idx / D; const int e = (int)(rr / 2816), r = (int)(rr % 2816);
    const int pn = r >> 8, half = (r >> 7) & 1, j = r & 127, f = pn * 128 + j;
    const float* W = half ? p.w_exp_up : p.w_exp_gate;
    ((bf16_t*)(p.ws + WS_WGU))[idx] = f2bf(W[((size_t)e * D + k) * FF + f]);
}
__global__ void k_prep_wd(Ptrs p) {
    const size_t idx = (size_t)blockIdx.x * blockDim.x + threadIdx.x;
    if (idx >= (size_t)NE * D * FF) return;
    const int k = (int)(idx % FF); const size_t rr = idx / FF; const int e = (int)(rr / D), n = (int)(rr % D);
    ((bf16_t*)(p.ws + WS_WD))[idx] = f2bf(p.w_exp_down[((size_t)e * FF + k) * D + n]);
}
__global__ void k_h(Ptrs p) {
    const int row = blockIdx.x * (blockDim.x >> 6) + (threadIdx.x >> 6), lane = threadIdx.x & 63;
    if (row >= NROWS) return;
    const float* src; int m;
    if (row < NLAT) { src = p.x + (size_t)row * D; m = row / SEQ; } else { src = p.ctx + (size_t)(row - NLAT) * D; m = 2; }
    const float* mod = (const float*)(p.ws + WS_MOD) + m * NADA * D;
    float v[16]; float ss = 0.f;
#pragma unroll
    for (int j = 0; j < 4; ++j) { const float4 t = *(const float4*)(src + j * 256 + lane * 4); v[4 * j] = t.x; v[4 * j + 1] = t.y; v[4 * j + 2] = t.z; v[4 * j + 3] = t.w; ss += t.x * t.x + t.y * t.y + t.z * t.z + t.w * t.w; }
    const float rstd = rsqrtf(wave_sum(ss) * (1.0f / D) + EPS);
    bf16_t* dst = (bf16_t*)(p.ws + WS_H) + (size_t)row * D;
#pragma unroll
    for (int j = 0; j < 4; ++j)
#pragma unroll
        for (int e = 0; e < 4; ++e) { const int d = j * 256 + lane * 4 + e; dst[d] = f2bf(v[4 * j + e] * rstd * p.norm1_w[d] * (1.0f + mod[D + d]) + mod[d]); }
}
__device__ __forceinline__ void rope_pair(const float* tab, int row, int pidx  , float a1, float a2, float& o1, float& o2) {
    if (row >= NLAT) { o1 = a1; o2 = a2; return; }
    const int t = row & (SEQ - 1), pos = (pidx < 32) ? (t >> 6) : (t & 63), f = pidx & 31;
    const float cs = tab[2 * (pos * 32 + f)], sn = tab[2 * (pos * 32 + f) + 1];
    o1 = a1 * cs - a2 * sn; o2 = a1 * sn + a2 * cs;
}
__global__ void k_gemm1_naive(Ptrs p) {
    const int col = blockIdx.x * 16 + (threadIdx.x & 15), row = blockIdx.y * 16 + (threadIdx.x >> 4);
    if (col >= NPROJ || row >= NROWS) return;
    const bf16_t* H = (const bf16_t*)(p.ws + WS_H) + (size_t)row * D;
    const bf16_t* W = (const bf16_t*)(p.ws + WS_WIN);
    bf16_t* P = (bf16_t*)(p.ws + WS_P) + (size_t)row * PW;
    if (col >= C_GZ) { ((float*)(p.ws + WS_GZ))[(size_t)row * 32 + (col - C_GZ)] = dot_bf16(H, W + (size_t)col * D, D); return; }
    if (col >= C_RQ && col < C_RV) {
        const int m = (col - C_RQ) & 127;
        if ((m >> 2) & 1) return;
        float a1 = dot_bf16(H, W + (size_t)col * D, D), a2 = dot_bf16(H, W + (size_t)(col + 4) * D, D);
        if (col >= C_RK) { a1 *= 0.08838834764831845f; a2 *= 0.08838834764831845f; }
        const int pidx = 4 * (m >> 3) + (m & 3);
        float o1, o2; rope_pair((const float*)(p.ws + WS_ROPE), row, pidx, a1, a2, o1, o2);
        P[col] = f2bf(o1); P[col + 4] = f2bf(o2); return;
    }
    float a = dot_bf16(H, W + (size_t)col * D, D);
    if (col < C_GK) a *= 0.125f;
    else if ((col >= C_GG && col < C_RQ) || col >= C_RG) a = siluf(a);
    P[col] = f2bf(a);
}
template <int DK, int G>
__global__ void __launch_bounds__(128) k_scan_naive(Ptrs p, float* Of, float* Ob, int zero_state) {
    __shared__ bf16_t qs[64][DK + 2], ks[64][DK + 2]; __shared__ float as[64][65];
    const int v = threadIdx.x, chain = blockIdx.x, b = chain >> 3, h = (chain >> 1) & 3, dir = chain & 1;
    const bf16_t* P = (const bf16_t*)(p.ws + WS_P);
    const float* GZ = (const float*)(p.ws + WS_GZ);
    const int qoff = G ? C_RQ + h * 128 : C_GQ + h * 64, koff = G ? C_RK + h * 128 : C_GK + h * 64, voff = G ? C_RV + h * 128 : C_GV + h * 128;
    float gamma = 1.f;
    if (G) { const float lg = p.ret_decay_logit[dir * 4 + h]; gamma = 1.0f / (1.0f + __expf(-lg)); }
    float S[DK];
#pragma unroll
    for (int k = 0; k < DK; ++k) S[k] = 0.f;
    float* O = dir ? Ob : Of;
    const int nchunk = 4 + 256;
    for (int ci = 0; ci < nchunk; ++ci) {
        const bool isctx = ci < 4; int cpos = isctx ? ci : ci - 4; const int nc = isctx ? 4 : 256; if (dir) cpos = nc - 1 - cpos;
        const int row0 = isctx ? NLAT + b * CTX + cpos * 64 : b * SEQ + cpos * 64;
        __syncthreads();
        for (int i = threadIdx.x; i < 64 * DK; i += 128) { const int t = i / DK, k = i % DK; qs[t][k] = P[(size_t)(row0 + t) * PW + qoff + k]; ks[t][k] = P[(size_t)(row0 + t) * PW + koff + k]; }
        if (!G) for (int i = threadIdx.x; i < 64 * 64; i += 128) { const int t = i >> 6, k = i & 63;
            float pre = p.gla_gate_b[dir * 256 + h * 64 + k];
            for (int r = 0; r < 16; ++r) pre += GZ[(size_t)(row0 + t) * 32 + dir * 16 + r] * p.gla_gate_w[(dir * 16 + r) * 256 + h * 64 + k];
            as[t][k] = __expf(log_sigmoidf(pre) * (1.0f / 16.0f)); }
        __syncthreads();
        if (zero_state) {
#pragma unroll
            for (int k = 0; k < DK; ++k) S[k] = 0.f; }
        for (int tt = 0; tt < 64; ++tt) {
            const int t = dir ? 63 - tt : tt;
            const float vv = bf2f(P[(size_t)(row0 + t) * PW + voff + v]);
            float o = 0.f;
#pragma unroll
            for (int k = 0; k < DK; ++k) { const float a = G ? gamma : as[t][k & 63]; S[k] = a * S[k] + bf2f(ks[t][k]) * vv; o += bf2f(qs[t][k]) * S[k]; }
            if (!isctx) O[(size_t)(row0 + t) * 1024 + G * 512 + h * 128 + v] = o;
        }
    }
}
__global__ void k_headnorm_naive(Ptrs p, const float* Of, const float* Ob) {
    const int wid = blockIdx.x * (blockDim.x >> 6) + (threadIdx.x >> 6), lane = threadIdx.x & 63;
    if (wid >= NLAT * 8) return;
    const int row = wid >> 3, hh = wid & 7, g = hh >> 2, h = hh & 3;
    const size_t base = (size_t)row * 1024 + hh * 128;
    const float o0 = Of[base + lane] + Ob[base + lane], o1 = Of[base + 64 + lane] + Ob[base + 64 + lane];
    const bf16_t* P = (const bf16_t*)(p.ws + WS_P) + (size_t)row * PW + (g ? C_RG : C_GG) + h * 128;
    const float g0 = bf2f(P[lane]), g1 = bf2f(P[64 + lane]);
    float y0, y1;
    if (!g) { const float r = rsqrtf(wave_sum(o0 * o0 + o1 * o1) * (1.f / 128.f) + EPS); y0 = o0 * r * p.gla_norm_w[h * 128 + lane]; y1 = o1 * r * p.gla_norm_w[h * 128 + 64 + lane]; }
    else { const float mu = wave_sum(o0 + o1) * (1.f / 128.f); const float d0 = o0 - mu, d1 = o1 - mu; const float r = rsqrtf(wave_sum(d0 * d0 + d1 * d1) * (1.f / 128.f) + EPS);
        y0 = d0 * r * p.ret_norm_w[h * 128 + lane]; y1 = d1 * r * p.ret_norm_w[h * 128 + 64 + lane]; }
    bf16_t* Y = (bf16_t*)(p.ws + WS_H) + base;
    Y[lane] = f2bf(y0 * g0); Y[64 + lane] = f2bf(y1 * g1);
}
__global__ void k_gemm2_naive(Ptrs p) {
    const int col = blockIdx.x * 16 + (threadIdx.x & 15), row = blockIdx.y * 16 + (threadIdx.x >> 4);
    const bf16_t* Y = (const bf16_t*)(p.ws + WS_H) + (size_t)row * D;
    const float a = dot_bf16(Y, (const bf16_t*)(p.ws + WS_WOUT) + (size_t)col * D, D);
    const float* mod = (const float*)(p.ws + WS_MOD) + (row / SEQ) * NADA * D;
    p.out[(size_t)row * D + col] = p.x[(size_t)row * D + col] + mod[2 * D + col] * a;
}
__global__ void k_norm2_router(Ptrs p) {
    const int row = blockIdx.x * (blockDim.x >> 6) + (threadIdx.x >> 6), lane = threadIdx.x & 63;
    if (row >= NLAT) return;
    const int b = row / SEQ, t = row % SEQ;
    const float* src = p.out + (size_t)row * D;
    const float* mod = (const float*)(p.ws + WS_MOD) + b * NADA * D;
    float v[16]; float ss = 0.f;
#pragma unroll
    for (int j = 0; j < 4; ++j) { const float4 q = *(const float4*)(src + j * 256 + lane * 4); v[4 * j] = q.x; v[4 * j + 1] = q.y; v[4 * j + 2] = q.z; v[4 * j + 3] = q.w; ss += q.x * q.x + q.y * q.y + q.z * q.z + q.w * q.w; }
    const float rstd = rsqrtf(wave_sum(ss) * (1.0f / D) + EPS);
    bf16_t* dst = (bf16_t*)(p.ws + WS_H) + (size_t)row * D;
    float lg[NE];
#pragma unroll
    for (int e = 0; e < NE; ++e) lg[e] = 0.f;
#pragma unroll
    for (int j = 0; j < 4; ++j)
#pragma unroll
        for (int e4 = 0; e4 < 4; ++e4) { const int d = j * 256 + lane * 4 + e4; const float hv = v[4 * j + e4] * rstd * p.norm2_w[d] * (1.0f + mod[4 * D + d]) + mod[3 * D + d];
            dst[d] = f2bf(hv);
            const float4* wr = (const float4*)(p.w_router + (size_t)d * NE);
#pragma unroll
            for (int q = 0; q < 4; ++q) { const float4 w = wr[q]; lg[4 * q] += hv * w.x; lg[4 * q + 1] += hv * w.y; lg[4 * q + 2] += hv * w.z; lg[4 * q + 3] += hv * w.w; } }
    float mx = -1e30f;
#pragma unroll
    for (int e = 0; e < NE; ++e) { lg[e] = wave_sum(lg[e]); mx = fmaxf(mx, lg[e]); }
    float den = 0.f;
#pragma unroll
    for (int e = 0; e < NE; ++e) { lg[e] = __expf(lg[e] - mx); den += lg[e]; }
    float* AFF = (float*)(p.ws + WS_AFF);
    float mine = 0.f;
#pragma unroll
    for (int e = 0; e < NE; ++e) if (lane == e) mine = lg[e] / den;
    if (lane < NE) AFF[((size_t)b * NE + lane) * SEQ + t] = mine;
}
__global__ void __launch_bounds__(256) k_topk_naive(Ptrs p) {
    __shared__ float sa[SEQ];
    const int be = blockIdx.x, part = blockIdx.y;
    const float* A = (const float*)(p.ws + WS_AFF) + (size_t)be * SEQ;
    for (int i = threadIdx.x; i < SEQ; i += 256) sa[i] = A[i];
    __syncthreads();
    int* IDX = (int*)(p.ws + WS_IDX); float* GATE = (float*)(p.ws + WS_GATE); int* INV = (int*)(p.ws + WS_INV);
    const int b = be / NE, e = be % NE;
    for (int t = part * 1024 + threadIdx.x; t < part * 1024 + 1024; t += 256) {
        const float a = sa[t]; int rank = 0;
        for (int u = 0; u < SEQ; ++u) { const float o = sa[u]; rank += (o > a || (o == a && u < t)) ? 1 : 0; }
        if (rank < CAP) { IDX[be * CAP + rank] = t; GATE[be * CAP + rank] = a; INV[((size_t)b * SEQ + t) * NE + e] = rank; }
        else INV[((size_t)b * SEQ + t) * NE + e] = -1;
    }
}
__global__ void k_moe_up_naive(Ptrs p) {
    const int f = blockIdx.x * 16 + (threadIdx.x & 15), R = blockIdx.y * 16 + (threadIdx.x >> 4);
    const int be = R / CAP, b = be / NE, e = be % NE;
    const int tok = ((const int*)(p.ws + WS_IDX))[R];
    const bf16_t* h2 = (const bf16_t*)(p.ws + WS_H) + ((size_t)b * SEQ + tok) * D;
    const bf16_t* W = (const bf16_t*)(p.ws + WS_WGU) + ((size_t)e * 2816 + (f >> 7) * 256 + (f & 127)) * D;
    const float a = dot_bf16(h2, W, D), u = dot_bf16(h2, W + (size_t)128 * D, D);
    ((bf16_t*)(p.ws + WS_ACT))[(size_t)R * FF + f] = f2bf(siluf(a) * u);
}
__global__ void k_moe_down_naive(Ptrs p) {
    const int n = blockIdx.x * 16 + (threadIdx.x & 15), R = blockIdx.y * 16 + (threadIdx.x >> 4);
    const int e = (R / CAP) % NE;
    const float a = dot_bf16((const bf16_t*)(p.ws + WS_ACT) + (size_t)R * FF, (const bf16_t*)(p.ws + WS_WD) + ((size_t)e * D + n) * FF, FF);
    ((bf16_t*)(p.ws + WS_YE))[(size_t)R * D + n] = f2bf(a * ((const float*)(p.ws + WS_GATE))[R]);
}
__global__ void k_final(Ptrs p) {
    const int row = blockIdx.x * (blockDim.x >> 6) + (threadIdx.x >> 6), lane = threadIdx.x & 63;
    if (row >= NLAT) return;
    const int b = row / SEQ;
    float* xr = p.out + (size_t)row * D;
    const float* mod = (const float*)(p.ws + WS_MOD) + b * NADA * D + 5 * D;
    const int* inv = (const int*)(p.ws + WS_INV) + (size_t)row * NE;
    const bf16_t* YE = (const bf16_t*)(p.ws + WS_YE);
    float acc[16];
#pragma unroll
    for (int i = 0; i < 16; ++i) acc[i] = 0.f;
    for (int e = 0; e < NE; ++e) { const int s = inv[e]; if (s < 0) continue;
        const bf16_t* y = YE + ((size_t)(b * NE + e) * CAP + s) * D;
#pragma unroll
        for (int j = 0; j < 4; ++j) { const uint2 w = *(const uint2*)(y + j * 256 + lane * 4);
            acc[4 * j] += __uint_as_float(w.x << 16); acc[4 * j + 1] += __uint_as_float(w.x & 0xffff0000u); acc[4 * j + 2] += __uint_as_float(w.y << 16); acc[4 * j + 3] += __uint_as_float(w.y & 0xffff0000u); } }
    float v[16]; float ss = 0.f;
#pragma unroll
    for (int j = 0; j < 4; ++j) { const float4 q = *(const float4*)(xr + j * 256 + lane * 4); const float4 m = *(const float4*)(mod + j * 256 + lane * 4);
        v[4 * j] = q.x + m.x * acc[4 * j]; v[4 * j + 1] = q.y + m.y * acc[4 * j + 1]; v[4 * j + 2] = q.z + m.z * acc[4 * j + 2]; v[4 * j + 3] = q.w + m.w * acc[4 * j + 3];
        ss += v[4 * j] * v[4 * j] + v[4 * j + 1] * v[4 * j + 1] + v[4 * j + 2] * v[4 * j + 2] + v[4 * j + 3] * v[4 * j + 3]; }
    const float rstd = rsqrtf(wave_sum(ss) * (1.0f / D) + EPS);
#pragma unroll
    for (int j = 0; j < 4; ++j) { const float4 w = *(const float4*)(p.final_norm_w + j * 256 + lane * 4);
        *(float4*)(xr + j * 256 + lane * 4) = make_float4(v[4 * j] * rstd * w.x, v[4 * j + 1] * rstd * w.y, v[4 * j + 2] * rstd * w.z, v[4 * j + 3] * rstd * w.w); }
}


constexpr int NWAVES = 8, NTHR = NWAVES * 64;
#define LAS __attribute__((address_space(3)))
#define GAS __attribute__((address_space(1)))
typedef short bf16x8 __attribute__((ext_vector_type(8)));
typedef float f32x4 __attribute__((ext_vector_type(4)));
typedef float f32x2 __attribute__((ext_vector_type(2)));
typedef unsigned u32x4 __attribute__((ext_vector_type(4)));
typedef unsigned u32x2 __attribute__((ext_vector_type(2)));
typedef int i32x4 __attribute__((ext_vector_type(4)));
typedef int i32x8 __attribute__((ext_vector_type(8)));
namespace pg8 {
constexpr int BM = 256, BK = 64, HALF = 128, HTB = HALF * BK * 2  , STAGE_BYTES = 8 * HTB, NXCD = 8, WGM = 8;
__host__ __device__ __forceinline__ int lds_byte(int r, int c) { const int st = (r >> 4) * 2 + (c >> 5), rr = r & 15, cc = c & 31, ob = rr * 64 + cc * 2; return st * 1024 + (ob ^ (((ob >> 9) & 1) << 5)); }
__host__ __device__ __forceinline__ void stage_rc(int b, int& R, int& C) { const int st = b / 1024, sb = b % 1024, swz = sb ^ (((sb >> 9) & 1) << 5); R = (st >> 1) * 16 + swz / 64; C = (st & 1) * 32 + (swz % 64) / 2; }
__host__ __device__ __forceinline__ int perm32(int rho) { const int n = rho >> 4, i = rho & 15; return 8 * (i >> 2) + 4 * n + (i & 3); }

struct Unit { int pm, pn; };
struct Gemm { const bf16_t* A; const bf16_t* Bt; int K; };

struct StaticOrder {
    int nM, nN, nwg, G, c;
    __device__ void init(int nM_, int nN_, int G_, int c_) { nM = nM_; nN = nN_; nwg = nM * nN; G = G_; c = c_; }
    __device__ bool next(int i, Unit& u) const {
        const long L = (long)i * G + c; if (L >= nwg) return false;
        int wgid = (int)L; { const int q = nwg / NXCD, r = nwg % NXCD, xcd = wgid % NXCD, off = wgid / NXCD; wgid = (xcd < r ? xcd * (q + 1) : r * (q + 1) + (xcd - r) * q) + off; }
        const int nig = WGM * nN, gid = wgid / nig, fm = gid * WGM, gsz = (nM - fm) < WGM ? (nM - fm) : WGM;
        u.pm = fm + ((wgid % nig) % gsz); u.pn = (wgid % nig) / gsz; return true;
    }
};
struct MoeUpOrder {
    int c;
    __device__ bool next(int i, Unit& u) const {
        if (i >= 11) return false;
        const int g = i * 8 + (c & 7), j = c >> 3, combo = 4 * g + (j >> 3), mt = j & 7, be = combo / 11, pn = combo % 11;
        u.pm = be * 8 + mt; u.pn = (be & 15) * 11 + pn; return true;
    }
};
struct MoeDownOrder {
    int c;
    __device__ bool next(int i, Unit& u) const {
        if (i >= 4) return false;
        const int be = i * 8 + (c & 7), j = c >> 3, mt = j & 7, pn = j >> 3;
        u.pm = be * 8 + mt; u.pn = (be & 15) * 4 + pn; return true;
    }
};

typedef __bf16 bf16x2_t __attribute__((ext_vector_type(2)));
__device__ __forceinline__ unsigned cvt_pk_bf16(float lo, float hi) { const f32x2 v = {lo, hi}; const bf16x2_t r = __builtin_convertvector(v, bf16x2_t); return __builtin_bit_cast(unsigned, r); }

__device__ __forceinline__ unsigned pk_fp8x4(float a, float b, float c, float d) {
    a = __builtin_amdgcn_fmed3f(a, -448.f, 448.f); b = __builtin_amdgcn_fmed3f(b, -448.f, 448.f); c = __builtin_amdgcn_fmed3f(c, -448.f, 448.f); d = __builtin_amdgcn_fmed3f(d, -448.f, 448.f);
    int w = 0; w = __builtin_amdgcn_cvt_pk_fp8_f32(a, b, w, false); w = __builtin_amdgcn_cvt_pk_fp8_f32(c, d, w, true); return (unsigned)w;
}
template <class Epi, class Sched, bool GATHER, bool F8 = false>
__device__ __forceinline__ void gemm_phase(LAS unsigned char* lds, const Gemm g, const Sched& S, const Epi& E, const LAS unsigned* gtab) {
    const int tid = threadIdx.x, wid = __builtin_amdgcn_readfirstlane(tid >> 6), lane = tid & 63, wr = wid >> 2, wc = wid & 3, fr = lane & 15, fq = lane >> 4;
    constexpr int ESZ = F8 ? 1 : 2;
    const int K = g.K, nt = K * ESZ / (BK * 2);
    int sR[2], sC[2];
    unsigned voffB[2], voffA[2];
#pragma unroll
    for (int i = 0; i < 2; ++i) { stage_rc(tid * 16 + i * 8192, sR[i], sC[i]); const int Rb = Epi::PERM ? ((sR[i] & ~31) + perm32(sR[i] & 31)) : sR[i];
        voffB[i] = (unsigned)(Rb * K * ESZ + sC[i] * 2); voffA[i] = (unsigned)(sR[i] * K * ESZ + sC[i] * 2); }
    const size_t kstep = (size_t)(BK * 2);
    const size_t hstep = (size_t)HALF * K * ESZ;
    const size_t tstep = 2 * hstep;
    const unsigned ldsw = (unsigned)wid * 1024u;
    const int aoff = lds_byte(wr * 64 + fr, fq * 8), boff = lds_byte(wc * 32 + fr, fq * 8);
    const int aoff8a = lds_byte(wr * 64 + fr, fq * 16), aoff8b = lds_byte(wr * 64 + fr, fq * 16 + 8), boff8a = lds_byte(wc * 32 + fr, fq * 16), boff8b = lds_byte(wc * 32 + fr, fq * 16 + 8);
#define PG8_SA(b, h) (((b) * 2 + (h)) * HTB)
#define PG8_SB(b, h) ((4 + (b) * 2 + (h)) * HTB)
#define PG8_STAGE(bufoff, gbase, voff) do { _Pragma("unroll") for (int _i = 0; _i < 2; ++_i) \
        __builtin_amdgcn_global_load_lds((const unsigned*)((const char*)(gbase) + (voff)[_i]), (LAS unsigned*)(lds + (bufoff) + ldsw + _i * 8192), 16, 0, 0); } while (0)
#define PG8_LDA(dst, b, h) do { if constexpr (F8) { _Pragma("unroll") for (int m = 0; m < 4; ++m) { const i32x4 lo_ = *(const LAS i32x4*)(lds + PG8_SA(b, h) + aoff8a + m * 2048), hi_ = *(const LAS i32x4*)(lds + PG8_SA(b, h) + aoff8b + m * 2048); \
            dst##8[m] = __builtin_shufflevector(lo_, hi_, 0, 1, 2, 3, 4, 5, 6, 7); } } \
        else { _Pragma("unroll") for (int m = 0; m < 4; ++m) _Pragma("unroll") for (int k = 0; k < 2; ++k) dst[m][k] = *(const LAS bf16x8*)(lds + PG8_SA(b, h) + aoff + m * 2048 + k * 1024); } } while (0)
#define PG8_LDB(dst, b, h) do { if constexpr (F8) { _Pragma("unroll") for (int n = 0; n < 2; ++n) { const i32x4 lo_ = *(const LAS i32x4*)(lds + PG8_SB(b, h) + boff8a + n * 2048), hi_ = *(const LAS i32x4*)(lds + PG8_SB(b, h) + boff8b + n * 2048); \
            dst##8[n] = __builtin_shufflevector(lo_, hi_, 0, 1, 2, 3, 4, 5, 6, 7); } } \
        else { _Pragma("unroll") for (int n = 0; n < 2; ++n) _Pragma("unroll") for (int k = 0; k < 2; ++k) dst[n][k] = *(const LAS bf16x8*)(lds + PG8_SB(b, h) + boff + n * 2048 + k * 1024); } } while (0)
#define PG8_MMA(ai, bj, At, Bt) do { __builtin_amdgcn_s_setprio(1); if constexpr (F8) { _Pragma("unroll") for (int m = 0; m < 4; ++m) _Pragma("unroll") for (int n = 0; n < 2; ++n) \
            asm volatile("v_mfma_f32_16x16x128_f8f6f4 %0, %1, %2, %0" : "+v"(acc[ai][bj][m][n]) : "v"(Bt##8[n]), "v"(At##8[m])); } \
        else { _Pragma("unroll") for (int m = 0; m < 4; ++m) _Pragma("unroll") for (int n = 0; n < 2; ++n) _Pragma("unroll") for (int k = 0; k < 2; ++k) \
            acc[ai][bj][m][n] = __builtin_amdgcn_mfma_f32_16x16x32_bf16(Bt[n][k], At[m][k], acc[ai][bj][m][n], 0, 0, 0); } __builtin_amdgcn_s_setprio(0); } while (0)
#define PG8_WAIT_V(n) asm volatile("s_waitcnt vmcnt(" #n ")" ::: "memory")
#define PG8_WAIT_L(n) asm volatile("s_waitcnt lgkmcnt(" #n ")" ::: "memory")
#define PG8_BAR __builtin_amdgcn_s_barrier()
#define PG8_SCHED __builtin_amdgcn_sched_barrier(0)
#define PG8_HOFF(h) (GATHER ? (size_t)0 : (size_t)(h) * hstep)
#define PG8_STAGE_A(bufoff, base_, h_, uq_) do { if constexpr (GATHER) { unsigned vo_[2]; _Pragma("unroll") for (int _i = 0; _i < 2; ++_i) vo_[_i] = gtab[(uq_) * 256 + (h_) * HALF + sR[_i]] + (unsigned)sC[_i] * 2u; PG8_STAGE(bufoff, base_, vo_); } \
        else { PG8_STAGE(bufoff, (base_) + PG8_HOFF(h_), voffA); } } while (0)
    Unit cur, nxt; int ui = 0;
    if (!S.next(0, cur)) return;
    f32x4 acc[2][2][4][2];
#pragma unroll
    for (int a = 0; a < 2; ++a)
#pragma unroll
        for (int b = 0; b < 2; ++b)
#pragma unroll
            for (int m = 0; m < 4; ++m)
#pragma unroll
                for (int n = 0; n < 2; ++n) acc[a][b][m][n] = (f32x4){0.f, 0.f, 0.f, 0.f};
    bf16x8 At[4][2], B0[2][2], B1[2][2]; i32x8 At8[4], B08[2], B18[2];
    const char* cA = (const char*)g.A + (GATHER ? (size_t)0 : (size_t)cur.pm * tstep); const char* cB = (const char*)g.Bt + (size_t)cur.pn * tstep;
    PG8_STAGE(PG8_SB(0, 0), cB, voffB); PG8_STAGE(PG8_SB(0, 1), cB + hstep, voffB); PG8_STAGE_A(PG8_SA(0, 0), cA, 0, 0); PG8_STAGE_A(PG8_SA(0, 1), cA, 1, 0);
    if (wr == 1) PG8_BAR;
    PG8_WAIT_V(2); PG8_BAR;
    PG8_STAGE(PG8_SB(1, 0), cB + kstep, voffB); PG8_STAGE_A(PG8_SA(1, 0), cA + kstep, 0, 0); PG8_STAGE(PG8_SB(1, 1), cB + hstep + kstep, voffB);
    PG8_WAIT_V(6); PG8_BAR;
    for (;;) {
        const bool has_next = S.next(ui + 1, nxt);
        const char* nA = GATHER ? cA : (has_next ? (const char*)g.A + (size_t)nxt.pm * tstep : cA); const char* nB = has_next ? (const char*)g.Bt + (size_t)nxt.pn * tstep : cB;
#pragma unroll 1
        for (int t = 0; t < nt; t += 2) {
            const bool last = (t == nt - 2);
            const char* a1 = cA + (size_t)(t + 1) * kstep;
            const char* a2 = last ? nA : cA + (size_t)(t + 2) * kstep; const char* b2 = last ? nB : cB + (size_t)(t + 2) * kstep;
            const char* a3 = a2 + kstep; const char* b3 = b2 + kstep;
            const int uq = (last && has_next) ? ui + 1 : ui;
            PG8_LDB(B0, 0, 0); PG8_LDB(B1, 0, 1); PG8_SCHED; PG8_LDA(At, 0, 0); PG8_STAGE_A(PG8_SA(1, 1), a1, 1, ui);
            PG8_WAIT_V(8); PG8_WAIT_L(0); PG8_BAR; PG8_MMA(0, 0, At, B0); PG8_MMA(0, 1, At, B1); PG8_BAR; PG8_SCHED;
            PG8_LDA(At, 0, 1); PG8_STAGE(PG8_SB(0, 0), b2, voffB); PG8_STAGE(PG8_SB(0, 1), b2 + hstep, voffB); PG8_STAGE_A(PG8_SA(0, 0), a2, 0, uq);
            PG8_WAIT_V(8); PG8_WAIT_L(0); PG8_BAR; PG8_MMA(1, 0, At, B0); PG8_MMA(1, 1, At, B1); PG8_BAR; PG8_SCHED;
            PG8_LDB(B0, 1, 0); PG8_LDB(B1, 1, 1); PG8_SCHED; PG8_LDA(At, 1, 0); PG8_STAGE_A(PG8_SA(0, 1), a2, 1, uq);
            PG8_WAIT_V(8); PG8_WAIT_L(0); PG8_BAR; PG8_MMA(0, 0, At, B0); PG8_MMA(0, 1, At, B1); PG8_BAR; PG8_SCHED;
            PG8_LDA(At, 1, 1); PG8_STAGE(PG8_SB(1, 0), b3, voffB); PG8_STAGE(PG8_SB(1, 1), b3 + hstep, voffB); PG8_STAGE_A(PG8_SA(1, 0), a3, 0, uq);
            PG8_WAIT_V(8); PG8_WAIT_L(0); PG8_BAR; PG8_MMA(1, 0, At, B0); PG8_MMA(1, 1, At, B1); PG8_BAR; PG8_SCHED;
        }
        if (wr == 0) PG8_BAR;
        if constexpr (F8) { asm volatile("s_nop 15\n\ts_nop 15" ::: "memory"); PG8_SCHED; }
        E(acc, cur, ui, wr, wc, fr, fq);
        if (!has_next) break;
#pragma unroll
        for (int a = 0; a < 2; ++a)
#pragma unroll
            for (int b = 0; b < 2; ++b)
#pragma unroll
                for (int m = 0; m < 4; ++m)
#pragma unroll
                    for (int n = 0; n < 2; ++n) acc[a][b][m][n] = (f32x4){0.f, 0.f, 0.f, 0.f};
        cur = nxt; cA = nA; cB = nB; ++ui;
        if (wr == 1) PG8_BAR;
    }
    PG8_WAIT_V(0);
    PG8_BAR;
#undef PG8_SA
#undef PG8_SB
#undef PG8_STAGE
#undef PG8_LDA
#undef PG8_LDB
#undef PG8_MMA
#undef PG8_WAIT_V
#undef PG8_WAIT_L
#undef PG8_BAR
#undef PG8_SCHED
#undef PG8_STAGE_A
#undef PG8_HOFF
}


struct EpiProj {
    static constexpr bool PERM = true;
    bf16_t* P; float* GZ; const float* tab;
    __device__ __forceinline__ void operator()(const f32x4 (&acc)[2][2][4][2], const Unit& u, int ui, int wr, int wc, int fr, int fq) const {
        const int pn = u.pn, row0 = u.pm * BM + wr * 64 + fr, colw = wc * 32 + 8 * fq;
        if (pn == 14) {
            if (wc == 0) {
#pragma unroll
                for (int ai = 0; ai < 2; ++ai)
#pragma unroll
                    for (int m = 0; m < 4; ++m) { float* o = GZ + (size_t)(row0 + ai * HALF + m * 16) * 32 + 8 * fq; *(f32x4*)o = acc[ai][0][m][0]; *(f32x4*)(o + 4) = acc[ai][0][m][1]; }
            }
            return;
        }
        const int mode = (pn == 0) ? 1 : ((pn == 4 || pn == 5 || pn >= 12) ? 2 : ((pn >= 6 && pn <= 9) ? 3 : 0));
        const float rks = (pn >= 8) ? 0.08838834764831845f : 1.0f;
        const bool lowhalf = wc < 2;
        const int f0 = (16 * wc + 4 * fq) & 31;
#pragma unroll
        for (int ai = 0; ai < 2; ++ai)
#pragma unroll
            for (int m = 0; m < 4; ++m) {
                const int row = row0 + ai * HALF + m * 16;
                bf16_t* rowp = P + (size_t)row * PW + pn * BM + colw;
                f32x4 cs0 = {1.f, 0.f, 1.f, 0.f}, cs1 = {1.f, 0.f, 1.f, 0.f};
                if (mode == 3 && row < NLAT) { const int t = row & (SEQ - 1), pos = lowhalf ? (t >> 6) : (t & 63); const float* tp = tab + 2 * (pos * 32 + f0); cs0 = *(const f32x4*)tp; cs1 = *(const f32x4*)(tp + 4); }
#pragma unroll
                for (int bj = 0; bj < 2; ++bj) {
                    f32x4 v0 = acc[ai][bj][m][0], v1 = acc[ai][bj][m][1];
                    if (mode == 1) { v0 = v0 * 0.125f; v1 = v1 * 0.125f; }
                    else if (mode == 2) {
#pragma unroll
                        for (int e = 0; e < 4; ++e) { v0[e] = v0[e] / (1.0f + __expf(-v0[e])); v1[e] = v1[e] / (1.0f + __expf(-v1[e])); }
                    } else if (mode == 3) {
                        v0 = v0 * rks; v1 = v1 * rks;
                        const float c[4] = {cs0[0], cs0[2], cs1[0], cs1[2]}, s[4] = {cs0[1], cs0[3], cs1[1], cs1[3]};
#pragma unroll
                        for (int e = 0; e < 4; ++e) { const float a1 = v0[e], a2 = v1[e]; v0[e] = a1 * c[e] - a2 * s[e]; v1[e] = a1 * s[e] + a2 * c[e]; }
                    }
                    u32x4 w; w.x = cvt_pk_bf16(v0[0], v0[1]); w.y = cvt_pk_bf16(v0[2], v0[3]); w.z = cvt_pk_bf16(v1[0], v1[1]); w.w = cvt_pk_bf16(v1[2], v1[3]);
                    *(u32x4*)(rowp + bj * HALF) = w;
                }
            }
    }
};
struct EpiOut {
    static constexpr bool PERM = true;
    bf16_t* XO; const float* mod;
    __device__ __forceinline__ void operator()(const f32x4 (&acc)[2][2][4][2], const Unit& u, int ui, int wr, int wc, int fr, int fq) const {
        const int col0 = u.pn * BM + wc * 32 + 8 * fq, b = (u.pm * BM) / SEQ;
        const float* m2 = mod + b * NADA * D + 2 * D;
        f32x4 mv[2][2];
#pragma unroll
        for (int bj = 0; bj < 2; ++bj)
#pragma unroll
            for (int n = 0; n < 2; ++n) mv[bj][n] = *(const f32x4*)(m2 + col0 + bj * HALF + 4 * n);
#pragma unroll
        for (int ai = 0; ai < 2; ++ai)
#pragma unroll
            for (int m = 0; m < 4; ++m) { bf16_t* rowp = XO + (size_t)(u.pm * BM + ai * HALF + wr * 64 + m * 16 + fr) * D + col0;
#pragma unroll
                for (int bj = 0; bj < 2; ++bj) { const f32x4 v0 = mv[bj][0] * acc[ai][bj][m][0], v1 = mv[bj][1] * acc[ai][bj][m][1];
                    u32x4 w; w.x = cvt_pk_bf16(v0[0], v0[1]); w.y = cvt_pk_bf16(v0[2], v0[3]); w.z = cvt_pk_bf16(v1[0], v1[1]); w.w = cvt_pk_bf16(v1[2], v1[3]);
                    *(u32x4*)(rowp + bj * HALF) = w; } }
    }
};
struct EpiAct {
    static constexpr bool PERM = true;
    unsigned char* ACT; float wscale, ascale;
    __device__ __forceinline__ void operator()(const f32x4 (&acc)[2][2][4][2], const Unit& u, int ui, int wr, int wc, int fr, int fq) const {
        const int pnl = u.pn % 11, col0 = pnl * HALF + wc * 32 + 8 * fq;
#pragma unroll
        for (int ai = 0; ai < 2; ++ai)
#pragma unroll
            for (int m = 0; m < 4; ++m) { unsigned char* rowp = ACT + (size_t)(u.pm * BM + ai * HALF + wr * 64 + m * 16 + fr) * FFP;
                f32x4 v0, v1;
#pragma unroll
                for (int e = 0; e < 4; ++e) { const float a0 = acc[ai][0][m][0][e] * wscale, a1 = acc[ai][0][m][1][e] * wscale;
                    v0[e] = a0 / (1.0f + __expf(-a0)) * (acc[ai][1][m][0][e] * wscale) * ascale; v1[e] = a1 / (1.0f + __expf(-a1)) * (acc[ai][1][m][1][e] * wscale) * ascale; }
                u32x2 w; w.x = pk_fp8x4(v0[0], v0[1], v0[2], v0[3]); w.y = pk_fp8x4(v1[0], v1[1], v1[2], v1[3]);
                *(u32x2*)(rowp + col0) = w;
                if (pnl == 10) *(u32x2*)(rowp + FF + wc * 32 + 8 * fq) = (u32x2){0u, 0u}; }
    }
};
struct EpiDown {
    static constexpr bool PERM = true;
    bf16_t* YE; const float* gate; float oscale;
    __device__ __forceinline__ void operator()(const f32x4 (&acc)[2][2][4][2], const Unit& u, int ui, int wr, int wc, int fr, int fq) const {
        const int col0 = (u.pn & 3) * BM + wc * 32 + 8 * fq;
#pragma unroll
        for (int ai = 0; ai < 2; ++ai)
#pragma unroll
            for (int m = 0; m < 4; ++m) { const int row = u.pm * BM + ai * HALF + wr * 64 + m * 16 + fr; const float gt = gate[row] * oscale; bf16_t* rowp = YE + (size_t)row * D + col0;
#pragma unroll
                for (int bj = 0; bj < 2; ++bj) { const f32x4 v0 = acc[ai][bj][m][0] * gt, v1 = acc[ai][bj][m][1] * gt;
                    u32x4 w; w.x = cvt_pk_bf16(v0[0], v0[1]); w.y = cvt_pk_bf16(v0[2], v0[3]); w.z = cvt_pk_bf16(v1[0], v1[1]); w.w = cvt_pk_bf16(v1[2], v1[3]);
                    *(u32x4*)(rowp + bj * HALF) = w; } }
    }
};
}

namespace scan {
constexpr int RS = 72;
constexpr int RS2 = 136;
constexpr int OS = 132;
constexpr int NSL = 260;
constexpr size_t GLA_SLOT = 128 * 64, RET_SLOT = 128 * 128;
constexpr size_t US_RET_OFF = (size_t)16 * NSL * GLA_SLOT;
__device__ __forceinline__ int slot_row0(int b, int slot) { return slot < 4 ? NLAT + b * CTX + slot * 64 : b * SEQ + (slot - 4) * 64; }
__device__ __forceinline__ int slot_at(int dir, int step) { return dir ? (step < 4 ? 3 - step : 263 - step) : step; }
__device__ __forceinline__ f32x4 mfma16(bf16x8 a, bf16x8 b, f32x4 c) { return __builtin_amdgcn_mfma_f32_16x16x32_bf16(a, b, c, 0, 0, 0); }
__device__ __forceinline__ bf16x8 lds_frag(const LAS bf16_t* base, int off) { return *(const LAS bf16x8*)(base + off); }
__device__ __forceinline__ bf16x8 lds_frag_pi(const LAS bf16_t* base, int off  ) {
    typedef short s4 __attribute__((ext_vector_type(4)));
    const s4 lo = *(const LAS s4*)(base + off), hi = *(const LAS s4*)(base + off + 16);
    return (bf16x8){lo[0], lo[1], lo[2], lo[3], hi[0], hi[1], hi[2], hi[3]};
}
__device__ __forceinline__ unsigned pk(float lo, float hi) { return pg8::cvt_pk_bf16(lo, hi); }
__device__ __forceinline__ u32x2 pack_state8(const f32x4 a0, const f32x4 a1) { u32x2 o; o.x = pg8::pk_fp8x4(a0[0], a0[1], a0[2], a0[3]); o.y = pg8::pk_fp8x4(a1[0], a1[1], a1[2], a1[3]); return o; }
__device__ __forceinline__ bf16x8 unpack_state8(const u32x2 w) {
    const f32x2 a = __builtin_amdgcn_cvt_pk_f32_fp8((int)w.x, false), b = __builtin_amdgcn_cvt_pk_f32_fp8((int)w.x, true), c = __builtin_amdgcn_cvt_pk_f32_fp8((int)w.y, false), d = __builtin_amdgcn_cvt_pk_f32_fp8((int)w.y, true);
    const u32x4 r = {pk(a[0], a[1]), pk(b[0], b[1]), pk(c[0], c[1]), pk(d[0], d[1])};
    return __builtin_bit_cast(bf16x8, r);
}

__device__ __forceinline__ void gla_stepA(const float (&wf)[16], const float (&wb)[16], float bf, float bb, int w, int k, const LAS float* gz_s, LAS float* tot, float (&bi)[8], float (&ci)[8], float& allf, float& allb) {
    float laf[8], lab[8];
#pragma unroll
    for (int tt = 0; tt < 8; ++tt) {
        const LAS f32x4* g4 = (const LAS f32x4*)(gz_s + (8 * w + tt) * 32);
        float pf = bf, pb = bb;
#pragma unroll
        for (int r4 = 0; r4 < 4; ++r4) { const f32x4 a = g4[r4], b = g4[4 + r4];
#pragma unroll
            for (int e = 0; e < 4; ++e) { pf += a[e] * wf[4 * r4 + e]; pb += b[e] * wb[4 * r4 + e]; } }
        laf[tt] = (fminf(pf, 0.f) - __logf(1.0f + __expf(-fabsf(pf)))) * 0.0625f;
        lab[tt] = (fminf(pb, 0.f) - __logf(1.0f + __expf(-fabsf(pb)))) * 0.0625f;
    }
#pragma unroll
    for (int tt = 1; tt < 8; ++tt) laf[tt] += laf[tt - 1];
#pragma unroll
    for (int tt = 6; tt >= 0; --tt) lab[tt] += lab[tt + 1];
    tot[w * 64 + k] = laf[7]; tot[512 + w * 64 + k] = lab[0];
    __syncthreads();
    float offf = 0.f, offb = 0.f; allf = 0.f; allb = 0.f;
#pragma unroll
    for (int w2 = 0; w2 < 8; ++w2) { const float tf = tot[w2 * 64 + k], tb = tot[512 + w2 * 64 + k]; allf += tf; allb += tb; if (w2 < w) offf += tf; if (w2 > w) offb += tb; }
#pragma unroll
    for (int tt = 0; tt < 8; ++tt) { bi[tt] = offf + laf[tt]; ci[tt] = offb + lab[tt]; }
}
__device__ __forceinline__ void stage_vt_regs(const u32x4 a, const u32x4 b, LAS bf16_t* VT, int tid) {
    const int j = tid >> 3, vg = tid & 7;
    const unsigned wv[8] = {a.x, a.y, a.z, a.w, b.x, b.y, b.z, b.w};
#pragma unroll
    for (int e = 0; e < 8; ++e) { VT[(vg * 16 + 2 * e) * RS + j] = (bf16_t)(wv[e] & 0xffffu); VT[(vg * 16 + 2 * e + 1) * RS + j] = (bf16_t)(wv[e] >> 16); }
}
#define SCAN_FENCE() asm volatile("" ::: "memory")

__device__ __forceinline__ void run_c1(const Ptrs& p, LAS unsigned char* lds, int bx) {
    const int tid = threadIdx.x, w = __builtin_amdgcn_readfirstlane(tid >> 6), lane = tid & 63, c = lane & 15, q = lane >> 4;
    const int bh = bx >> 5, b = bh >> 2, h = bh & 3, s0 = bx & 31;
    const bf16_t* P = (const bf16_t*)(p.ws + WS_P);
    const int jrow = tid >> 3, g8 = tid & 7;
    {
        LAS float* gz_s = (LAS float*)lds; LAS float* tot = (LAS float*)(lds + 8192);
        LAS bf16_t* KfT = (LAS bf16_t*)(lds + 12288); LAS bf16_t* KbT = (LAS bf16_t*)(lds + 21504); LAS bf16_t* VT = (LAS bf16_t*)(lds + 30720); LAS bf16_t* Kraw = (LAS bf16_t*)(lds + 49152);
        float wf[16], wb[16];
#pragma unroll
        for (int r = 0; r < 16; ++r) { wf[r] = p.gla_gate_w[r * 256 + h * 64 + lane]; wb[r] = p.gla_gate_w[(16 + r) * 256 + h * 64 + lane]; }
        const float bf = p.gla_gate_b[h * 64 + lane], bb = p.gla_gate_b[256 + h * 64 + lane];
        f32x4 gzv; u32x4 va, vb, kv;
#define C1G_LOAD(slot_) do { const int r0_ = slot_row0(b, (slot_)); gzv = ((const f32x4*)((const float*)(p.ws + WS_GZ) + (size_t)r0_ * 32))[tid]; \
            const bf16_t* rp_ = P + (size_t)(r0_ + jrow) * PW; va = *(const u32x4*)(rp_ + C_GV + h * 128 + g8 * 16); vb = *(const u32x4*)(rp_ + C_GV + h * 128 + g8 * 16 + 8); \
            kv = *(const u32x4*)(rp_ + C_GK + h * 64 + g8 * 8); } while (0)
        C1G_LOAD(s0);
        for (int slot = s0; slot < NSL; slot += 32) {
            ((LAS f32x4*)gz_s)[tid] = gzv; stage_vt_regs(va, vb, VT, tid); *(LAS u32x4*)(Kraw + jrow * RS + g8 * 8) = kv;
            __syncthreads();
            if (slot + 32 < NSL) C1G_LOAD(slot + 32);
            float bi[8], ci[8], allf, allb;
            gla_stepA(wf, wb, bf, bb, w, lane, gz_s, tot, bi, ci, allf, allb);
            { float ef[8], eb[8];
#pragma unroll
              for (int tt = 0; tt < 8; ++tt) { const float kk = bf2f(Kraw[(8 * w + tt) * RS + lane]); ef[tt] = kk * __expf(allf - bi[tt]); eb[tt] = kk * __expf(allb - ci[tt]); }
              u32x4 wf_, wb_; wf_.x = pk(ef[0], ef[1]); wf_.y = pk(ef[2], ef[3]); wf_.z = pk(ef[4], ef[5]); wf_.w = pk(ef[6], ef[7]);
              wb_.x = pk(eb[0], eb[1]); wb_.y = pk(eb[2], eb[3]); wb_.z = pk(eb[4], eb[5]); wb_.w = pk(eb[6], eb[7]);
              *(LAS u32x4*)(KfT + lane * RS + 8 * w) = wf_; *(LAS u32x4*)(KbT + lane * RS + 8 * w) = wb_; }
            float* DCH = (float*)(p.ws + WS_DCH);
            if (w == 0) { DCH[((size_t)(bh * 2 + 0) * NSL + slot) * 64 + lane] = __expf(allf); DCH[((size_t)(bh * 2 + 1) * NSL + slot) * 64 + lane] = __expf(allb); }
            __syncthreads();
            unsigned char* US = (unsigned char*)p.out;
            bf16x8 Bv[2];
#pragma unroll
            for (int js = 0; js < 2; ++js) Bv[js] = lds_frag(VT, (16 * w + c) * RS + 32 * js + 8 * q);
#pragma unroll
            for (int dir = 0; dir < 2; ++dir) { const LAS bf16_t* KT = dir ? KbT : KfT;
#pragma unroll
                for (int ks = 0; ks < 2; ++ks) { f32x4 a0 = {0.f, 0.f, 0.f, 0.f}, a1 = {0.f, 0.f, 0.f, 0.f};
#pragma unroll
                    for (int js = 0; js < 2; ++js) { a0 = mfma16(lds_frag(KT, (32 * ks + c) * RS + 32 * js + 8 * q), Bv[js], a0); a1 = mfma16(lds_frag(KT, (32 * ks + 16 + c) * RS + 32 * js + 8 * q), Bv[js], a1); }
                    *(u32x2*)(US + ((size_t)(bh * 2 + dir) * NSL + slot) * GLA_SLOT + ((w * 2 + ks) * 64 + lane) * 8) = pack_state8(a0, a1); } }
            __syncthreads();
        }
#undef C1G_LOAD
    }
    {
        LAS bf16_t* KT = (LAS bf16_t*)lds; LAS bf16_t* VfT = (LAS bf16_t*)(lds + 18432); LAS bf16_t* VbT = (LAS bf16_t*)(lds + 36864);
        const float lgf = log_sigmoidf(p.ret_decay_logit[h]), lgb = log_sigmoidf(p.ret_decay_logit[4 + h]);
        const float sf = __expf(lgf * (float)(63 - jrow)), sb = __expf(lgb * (float)jrow);
        u32x4 ka, kb, va, vb;
#define C1R_LOAD(slot_) do { const bf16_t* rp_ = P + (size_t)(slot_row0(b, (slot_)) + jrow) * PW + h * 128 + g8 * 16; \
            ka = *(const u32x4*)(rp_ + C_RK); kb = *(const u32x4*)(rp_ + C_RK + 8); va = *(const u32x4*)(rp_ + C_RV); vb = *(const u32x4*)(rp_ + C_RV + 8); } while (0)
        C1R_LOAD(s0);
        for (int slot = s0; slot < NSL; slot += 32) {
            { const unsigned kw[8] = {ka.x, ka.y, ka.z, ka.w, kb.x, kb.y, kb.z, kb.w}, vw[8] = {va.x, va.y, va.z, va.w, vb.x, vb.y, vb.z, vb.w};
#pragma unroll
              for (int e = 0; e < 8; ++e) { const int r0 = (g8 * 16 + 2 * e) * RS + jrow, r1 = r0 + RS;
                  KT[r0] = (bf16_t)(kw[e] & 0xffffu); KT[r1] = (bf16_t)(kw[e] >> 16);
                  const float v0 = __uint_as_float(vw[e] << 16), v1 = __uint_as_float(vw[e] & 0xffff0000u);
                  VfT[r0] = f2bf(v0 * sf); VfT[r1] = f2bf(v1 * sf); VbT[r0] = f2bf(v0 * sb); VbT[r1] = f2bf(v1 * sb); } }
            __syncthreads();
            if (slot + 32 < NSL) C1R_LOAD(slot + 32);
            unsigned char* US = (unsigned char*)p.out + US_RET_OFF;
#pragma unroll
            for (int dir = 0; dir < 2; ++dir) { const LAS bf16_t* VT = dir ? VbT : VfT;
                bf16x8 Bv[2];
#pragma unroll
                for (int js = 0; js < 2; ++js) Bv[js] = lds_frag(VT, (16 * w + c) * RS + 32 * js + 8 * q);
#pragma unroll
                for (int ks = 0; ks < 4; ++ks) { f32x4 a0 = {0.f, 0.f, 0.f, 0.f}, a1 = {0.f, 0.f, 0.f, 0.f};
#pragma unroll
                    for (int js = 0; js < 2; ++js) { a0 = mfma16(lds_frag(KT, (32 * ks + c) * RS + 32 * js + 8 * q), Bv[js], a0); a1 = mfma16(lds_frag(KT, (32 * ks + 16 + c) * RS + 32 * js + 8 * q), Bv[js], a1); }
                    *(u32x2*)(US + ((size_t)(bh * 2 + dir) * NSL + slot) * RET_SLOT + ((w * 4 + ks) * 64 + lane) * 8) = pack_state8(a0, a1); } }
            __syncthreads();
        }
#undef C1R_LOAD
    }
}
template <int G>
__device__ __forceinline__ void c2_scan(const Ptrs& p, int chain, int grp  ) {
    constexpr size_t SLOT = G ? RET_SLOT : GLA_SLOT;
    constexpr int NB = 10;
    const int dir = chain & 1, h = (chain >> 1) & 3;
    const unsigned char* base = (const unsigned char*)p.out + (G ? US_RET_OFF : 0) + (size_t)chain * NSL * SLOT + (size_t)grp * 4;
    bf16_t* sbase = (bf16_t*)(p.ws + WS_US) + (G ? US_RET_OFF : 0) + (size_t)chain * NSL * SLOT + (size_t)grp * 4;
    float dconst = 0.f; const float* dch = nullptr;
    if (G) dconst = __expf(64.0f * log_sigmoidf(p.ret_decay_logit[dir * 4 + h]));
    else { const int el = grp * 4, e0 = el & 7, ln = (el >> 3) & 63, ks = (el >> 9) & 1; dch = (const float*)(p.ws + WS_DCH) + (size_t)chain * NSL * 64 + 32 * ks + 16 * (e0 >> 2) + 4 * (ln >> 4); }
    f32x4 s = {0.f, 0.f, 0.f, 0.f};
    unsigned uA[NB], uB[NB]; f32x4 dA[NB], dB[NB];
#define C2_LOAD(U_, D_, bt_) do { _Pragma("unroll") for (int i = 0; i < NB; ++i) { const int slot = slot_at(dir, (bt_) * NB + i); U_[i] = *(const unsigned*)(base + (size_t)slot * SLOT); if (!G) D_[i] = *(const f32x4*)(dch + slot * 64); } } while (0)
#define C2_PROC(U_, D_, bt_) do { _Pragma("unroll") for (int i = 0; i < NB; ++i) { const int slot = slot_at(dir, (bt_) * NB + i); \
        { u32x2 o_; o_.x = pk(s[0], s[1]); o_.y = pk(s[2], s[3]); *(u32x2*)(sbase + (size_t)slot * SLOT) = o_; } \
        const f32x2 lo_ = __builtin_amdgcn_cvt_pk_f32_fp8((int)U_[i], false), hi_ = __builtin_amdgcn_cvt_pk_f32_fp8((int)U_[i], true); const f32x4 u = {lo_[0], lo_[1], hi_[0], hi_[1]}; \
        if (G) s = s * dconst + u; else s = s * D_[i] + u; } } while (0)
    C2_LOAD(uA, dA, 0);
    for (int bt = 0; bt < NSL / NB; bt += 2) {
        C2_LOAD(uB, dB, bt + 1);
        C2_PROC(uA, dA, bt);
        if (bt + 2 < NSL / NB) C2_LOAD(uA, dA, bt + 2);
        C2_PROC(uB, dB, bt + 1);
    }
#undef C2_LOAD
#undef C2_PROC
}
__device__ __forceinline__ void run_c3(const Ptrs& p, LAS unsigned char* lds, int bx, bf16_t* Y) {
    const int tid = threadIdx.x, w = __builtin_amdgcn_readfirstlane(tid >> 6), lane = tid & 63, c = lane & 15, q = lane >> 4;
    const int bh = bx >> 5, b = bh >> 2, h = bh & 3, n0 = bx & 31;
    const bf16_t* P = (const bf16_t*)(p.ws + WS_P);
    const int jrow = tid >> 3, g8 = tid & 7;
    {
        LAS float* gz_s = (LAS float*)lds; LAS float* tot = (LAS float*)(lds + 8192);
        LAS bf16_t* QF = (LAS bf16_t*)(lds + 12288); LAS bf16_t* QB = (LAS bf16_t*)(lds + 21504); LAS bf16_t* KF = (LAS bf16_t*)(lds + 30720); LAS bf16_t* KB = (LAS bf16_t*)(lds + 39936);
        LAS bf16_t* VT = (LAS bf16_t*)(lds + 49152); LAS bf16_t* Pm = (LAS bf16_t*)(lds + 67584); LAS float* Os = (LAS float*)(lds + 76800);
        float wf[16], wb[16];
#pragma unroll
        for (int r = 0; r < 16; ++r) { wf[r] = p.gla_gate_w[r * 256 + h * 64 + lane]; wb[r] = p.gla_gate_w[(16 + r) * 256 + h * 64 + lane]; }
        const float bf = p.gla_gate_b[h * 64 + lane], bb = p.gla_gate_b[256 + h * 64 + lane];
        const f32x2 nw = *(const f32x2*)(p.gla_norm_w + h * 128 + 2 * lane);
        const bf16_t* US = (const bf16_t*)(p.ws + WS_US);
        f32x4 gzv; u32x4 va, vb, qv, kv; bf16x8 Sfn[2], Sbn[2]; unsigned gtn[8];
#define C3G_LOAD(n_) do { const int r0_ = b * SEQ + (n_) * 64; gzv = ((const f32x4*)((const float*)(p.ws + WS_GZ) + (size_t)r0_ * 32))[tid]; \
            const bf16_t* rp_ = P + (size_t)(r0_ + jrow) * PW; va = *(const u32x4*)(rp_ + C_GV + h * 128 + g8 * 16); vb = *(const u32x4*)(rp_ + C_GV + h * 128 + g8 * 16 + 8); \
            qv = *(const u32x4*)(rp_ + C_GQ + h * 64 + g8 * 8); kv = *(const u32x4*)(rp_ + C_GK + h * 64 + g8 * 8); \
            _Pragma("unroll") for (int ks = 0; ks < 2; ++ks) { Sfn[ks] = *(const bf16x8*)(US + ((size_t)(bh * 2 + 0) * NSL + 4 + (n_)) * GLA_SLOT + ((w * 2 + ks) * 64 + lane) * 8); \
                                                          Sbn[ks] = *(const bf16x8*)(US + ((size_t)(bh * 2 + 1) * NSL + 4 + (n_)) * GLA_SLOT + ((w * 2 + ks) * 64 + lane) * 8); } \
            _Pragma("unroll") for (int tt = 0; tt < 8; ++tt) gtn[tt] = *(const unsigned*)(P + (size_t)(r0_ + 8 * w + tt) * PW + C_GG + h * 128 + 2 * lane); } while (0)
        C3G_LOAD(n0);
        for (int n = n0; n < 256; n += 32) {
            const int row0 = b * SEQ + n * 64;
            ((LAS f32x4*)gz_s)[tid] = gzv; stage_vt_regs(va, vb, VT, tid);
            *(LAS u32x4*)(QF + jrow * RS + g8 * 8) = qv; *(LAS u32x4*)(KF + jrow * RS + g8 * 8) = kv;
            bf16x8 Sf[2], Sb[2]; unsigned gt[8];
#pragma unroll
            for (int ks = 0; ks < 2; ++ks) { Sf[ks] = Sfn[ks]; Sb[ks] = Sbn[ks]; }
#pragma unroll
            for (int tt = 0; tt < 8; ++tt) gt[tt] = gtn[tt];
            __syncthreads();
            if (n + 32 < 256) C3G_LOAD(n + 32);
            float bi[8], ci[8], allf, allb;
            gla_stepA(wf, wb, bf, bb, w, lane, gz_s, tot, bi, ci, allf, allb);
#pragma unroll
            for (int tt = 0; tt < 8; ++tt) { const int i = 8 * w + tt; const float qq = bf2f(QF[i * RS + lane]), kk = bf2f(KF[i * RS + lane]);
                QF[i * RS + lane] = f2bf(qq * __expf(bi[tt])); QB[i * RS + lane] = f2bf(qq * __expf(ci[tt]));
                KF[i * RS + lane] = f2bf(kk * __expf(-bi[tt])); KB[i * RS + lane] = f2bf(kk * __expf(-ci[tt])); }
            __syncthreads();
            { const int it = w & 3, i = 16 * it + c;
              bf16x8 qf[2], qb[2];
#pragma unroll
              for (int ks = 0; ks < 2; ++ks) { qf[ks] = lds_frag(QF, i * RS + 32 * ks + 8 * q); qb[ks] = lds_frag(QB, i * RS + 32 * ks + 8 * q); }
#pragma unroll
              for (int jj = 0; jj < 2; ++jj) { const int jt = 2 * (w >> 2) + jj; f32x4 af = {0.f, 0.f, 0.f, 0.f}, ab = {0.f, 0.f, 0.f, 0.f};
#pragma unroll
                  for (int ks = 0; ks < 2; ++ks) { af = mfma16(lds_frag(KF, (16 * jt + c) * RS + 32 * ks + 8 * q), qf[ks], af); ab = mfma16(lds_frag(KB, (16 * jt + c) * RS + 32 * ks + 8 * q), qb[ks], ab); }
                  float v[4];
#pragma unroll
                  for (int r = 0; r < 4; ++r) { const int j = 16 * jt + 4 * q + r; v[r] = (j <= i ? af[r] : 0.f) + (j >= i ? ab[r] : 0.f); }
                  u32x2 o; o.x = pk(v[0], v[1]); o.y = pk(v[2], v[3]); *(LAS u32x2*)(Pm + i * RS + 16 * jt + 4 * q) = o; } }
            __syncthreads();
            { bf16x8 Bv[2];
#pragma unroll
              for (int js = 0; js < 2; ++js) Bv[js] = lds_frag(VT, (16 * w + c) * RS + 32 * js + 8 * q);
#pragma unroll
              for (int it = 0; it < 4; ++it) { f32x4 a = {0.f, 0.f, 0.f, 0.f}; const int i = 16 * it + c;
#pragma unroll
                  for (int js = 0; js < 2; ++js) a = mfma16(lds_frag(Pm, i * RS + 32 * js + 8 * q), Bv[js], a);
#pragma unroll
                  for (int ks = 0; ks < 2; ++ks) { a = mfma16(lds_frag_pi(QF, i * RS + 32 * ks + 4 * q), Sf[ks], a); a = mfma16(lds_frag_pi(QB, i * RS + 32 * ks + 4 * q), Sb[ks], a); }
#pragma unroll
                  for (int r = 0; r < 4; ++r) Os[(16 * it + 4 * q + r) * OS + 16 * w + c] = a[r]; } }
            __syncthreads();
#pragma unroll
            for (int tt = 0; tt < 8; ++tt) { const int i = 8 * w + tt; const f32x2 o = *(const LAS f32x2*)(Os + i * OS + 2 * lane);
                const float r = rsqrtf(wave_sum(o[0] * o[0] + o[1] * o[1]) * (1.f / 128.f) + EPS);
                *(unsigned*)(Y + (size_t)(row0 + i) * D + h * 128 + 2 * lane) = pk(o[0] * r * nw[0] * __uint_as_float(gt[tt] << 16), o[1] * r * nw[1] * __uint_as_float(gt[tt] & 0xffff0000u)); }
            __syncthreads();
        }
#undef C3G_LOAD
    }
    {
        LAS bf16_t* Qs = (LAS bf16_t*)lds; LAS bf16_t* Ks = (LAS bf16_t*)(lds + 17408); LAS bf16_t* VT = (LAS bf16_t*)(lds + 34816); LAS bf16_t* Pm = (LAS bf16_t*)(lds + 53248);
        LAS float* Os = (LAS float*)(lds + 62464); LAS float* pwf = (LAS float*)(lds + 96256); LAS float* pwb = pwf + 80;
        const float lgf = log_sigmoidf(p.ret_decay_logit[h]), lgb = log_sigmoidf(p.ret_decay_logit[4 + h]);
        if (tid < 65) { pwf[tid] = __expf(lgf * (float)tid); pwb[tid] = __expf(lgb * (float)tid); }
        const f32x2 nw = *(const f32x2*)(p.ret_norm_w + h * 128 + 2 * lane);
        const bf16_t* US = (const bf16_t*)(p.ws + WS_US) + US_RET_OFF;
        u32x4 qa, qb2, ka, kb2, va, vb; bf16x8 Sfn[4], Sbn[4]; unsigned gtn[8];
#define C3R_LOAD(n_) do { const int r0_ = b * SEQ + (n_) * 64; const bf16_t* rp_ = P + (size_t)(r0_ + jrow) * PW + h * 128 + g8 * 16; \
            qa = *(const u32x4*)(rp_ + C_RQ); qb2 = *(const u32x4*)(rp_ + C_RQ + 8); ka = *(const u32x4*)(rp_ + C_RK); kb2 = *(const u32x4*)(rp_ + C_RK + 8); \
            va = *(const u32x4*)(rp_ + C_RV); vb = *(const u32x4*)(rp_ + C_RV + 8); \
            _Pragma("unroll") for (int ks = 0; ks < 4; ++ks) { Sfn[ks] = *(const bf16x8*)(US + ((size_t)(bh * 2 + 0) * NSL + 4 + (n_)) * RET_SLOT + ((w * 4 + ks) * 64 + lane) * 8); \
                                                          Sbn[ks] = *(const bf16x8*)(US + ((size_t)(bh * 2 + 1) * NSL + 4 + (n_)) * RET_SLOT + ((w * 4 + ks) * 64 + lane) * 8); } \
            _Pragma("unroll") for (int tt = 0; tt < 8; ++tt) gtn[tt] = *(const unsigned*)(P + (size_t)(r0_ + 8 * w + tt) * PW + C_RG + h * 128 + 2 * lane); } while (0)
        C3R_LOAD(n0);
        for (int n = n0; n < 256; n += 32) {
            const int row0 = b * SEQ + n * 64;
            *(LAS u32x4*)(Qs + jrow * RS2 + g8 * 16) = qa; *(LAS u32x4*)(Qs + jrow * RS2 + g8 * 16 + 8) = qb2;
            *(LAS u32x4*)(Ks + jrow * RS2 + g8 * 16) = ka; *(LAS u32x4*)(Ks + jrow * RS2 + g8 * 16 + 8) = kb2;
            stage_vt_regs(va, vb, VT, tid);
            bf16x8 Sf[4], Sb[4]; unsigned gt[8];
#pragma unroll
            for (int ks = 0; ks < 4; ++ks) { Sf[ks] = Sfn[ks]; Sb[ks] = Sbn[ks]; }
#pragma unroll
            for (int tt = 0; tt < 8; ++tt) gt[tt] = gtn[tt];
            __syncthreads();
            if (n + 32 < 256) C3R_LOAD(n + 32);
            { const int it = w & 3, i = 16 * it + c;
              bf16x8 qf[4];
#pragma unroll
              for (int ks = 0; ks < 4; ++ks) qf[ks] = lds_frag(Qs, i * RS2 + 32 * ks + 8 * q);
#pragma unroll
              for (int jj = 0; jj < 2; ++jj) { const int jt = 2 * (w >> 2) + jj; f32x4 a = {0.f, 0.f, 0.f, 0.f};
#pragma unroll
                  for (int ks = 0; ks < 4; ++ks) a = mfma16(lds_frag(Ks, (16 * jt + c) * RS2 + 32 * ks + 8 * q), qf[ks], a);
                  float v[4];
#pragma unroll
                  for (int r = 0; r < 4; ++r) { const int j = 16 * jt + 4 * q + r; const int dd = i - j; const float dm = (dd >= 0 ? pwf[dd >= 0 ? dd : 0] : 0.f) + (dd <= 0 ? pwb[dd <= 0 ? -dd : 0] : 0.f); v[r] = a[r] * dm; }
                  u32x2 o; o.x = pk(v[0], v[1]); o.y = pk(v[2], v[3]); *(LAS u32x2*)(Pm + i * RS + 16 * jt + 4 * q) = o; } }
            __syncthreads();
            { bf16x8 Bv[2];
#pragma unroll
              for (int js = 0; js < 2; ++js) Bv[js] = lds_frag(VT, (16 * w + c) * RS + 32 * js + 8 * q);
#pragma unroll
              for (int it = 0; it < 4; ++it) { f32x4 a = {0.f, 0.f, 0.f, 0.f}, af = {0.f, 0.f, 0.f, 0.f}, ab = {0.f, 0.f, 0.f, 0.f}; const int i = 16 * it + c;
#pragma unroll
                  for (int js = 0; js < 2; ++js) a = mfma16(lds_frag(Pm, i * RS + 32 * js + 8 * q), Bv[js], a);
#pragma unroll
                  for (int ks = 0; ks < 4; ++ks) { const bf16x8 qx = lds_frag_pi(Qs, i * RS2 + 32 * ks + 4 * q); af = mfma16(qx, Sf[ks], af); ab = mfma16(qx, Sb[ks], ab); }
#pragma unroll
                  for (int r = 0; r < 4; ++r) { const int ii = 16 * it + 4 * q + r; Os[ii * OS + 16 * w + c] = a[r] + pwf[ii + 1] * af[r] + pwb[64 - ii] * ab[r]; } } }
            __syncthreads();
#pragma unroll
            for (int tt = 0; tt < 8; ++tt) { const int i = 8 * w + tt; const f32x2 o = *(const LAS f32x2*)(Os + i * OS + 2 * lane);
                const float mu = wave_sum(o[0] + o[1]) * (1.f / 128.f); const float d0 = o[0] - mu, d1 = o[1] - mu;
                const float r = rsqrtf(wave_sum(d0 * d0 + d1 * d1) * (1.f / 128.f) + EPS);
                *(unsigned*)(Y + (size_t)(row0 + i) * D + 512 + h * 128 + 2 * lane) = pk(d0 * r * nw[0] * __uint_as_float(gt[tt] << 16), d1 * r * nw[1] * __uint_as_float(gt[tt] & 0xffff0000u)); }
            __syncthreads();
        }
#undef C3R_LOAD
    }
}
}

namespace misc {
__device__ __forceinline__ void p0_mod(const Ptrs& p, LAS unsigned char* lds, int bx) {
    LAS float* sc = (LAS float*)lds;
    LAS float* red = sc + 3 * D;
    const int tid = threadIdx.x;
    for (int i = tid; i < 3 * D; i += NTHR) { const int r = i >> 10, k = i & 1023; const float v = (r < 2) ? p.c[r * D + k] : p.c_ctx[k]; sc[i] = siluf(v); }
    __syncthreads();
    const int kg = tid >> 5, cl = tid & 31, col = 24 * bx + cl;
    float a0 = 0.f, a1 = 0.f, a2 = 0.f;
    if (cl < 24) {
#pragma unroll 8
        for (int k = kg * 64; k < kg * 64 + 64; ++k) { const float w = p.w_ada[(size_t)k * (NADA * D) + col]; a0 += sc[k] * w; a1 += sc[D + k] * w; a2 += sc[2 * D + k] * w; }
    }
    red[(kg * 3 + 0) * 32 + cl] = a0; red[(kg * 3 + 1) * 32 + cl] = a1; red[(kg * 3 + 2) * 32 + cl] = a2;
    __syncthreads();
    if (tid < 96) { const int r = tid >> 5, c2 = tid & 31; if (c2 < 24) { float s = 0.f;
#pragma unroll
        for (int g = 0; g < 16; ++g) s += red[(g * 3 + r) * 32 + c2];
        const int cc = 24 * bx + c2; ((float*)(p.ws + WS_MOD))[r * NADA * D + cc] = s + p.b_ada[cc]; } }
    __syncthreads();
}
__device__ __forceinline__ void p0_rope(const Ptrs& p, int gtid) {
    if (gtid < 256 * 32) { const int pos = gtid >> 5, f = gtid & 31; const float inv = powf(10000.0f, -(float)f / 32.0f); const float ang = (float)pos * inv;
        float* T = (float*)(p.ws + WS_ROPE); T[2 * gtid] = (float)cos((double)ang); T[2 * gtid + 1] = (float)sin((double)ang); }
}
constexpr int TSCR = 64 * 65 * 4;
__device__ __forceinline__ void transpose_tile(const float* src, int ldsrc, int k0, int n0s, bf16_t* dst, int ldt, int n0d, LAS float* scr, int lane) {
    const int kr = lane >> 4, nq = lane & 15;
    f32x4 v[16];
#pragma unroll
    for (int i = 0; i < 16; ++i) v[i] = *(const f32x4*)(src + (size_t)(k0 + 4 * i + kr) * ldsrc + n0s + 4 * nq);
#pragma unroll
    for (int i = 0; i < 16; ++i) { LAS float* s = scr + (4 * i + kr) * 65 + 4 * nq; s[0] = v[i][0]; s[1] = v[i][1]; s[2] = v[i][2]; s[3] = v[i][3]; }
    asm volatile("s_waitcnt lgkmcnt(0)" ::: "memory");
    const int c = lane & 7, ns = lane >> 3;
#pragma unroll
    for (int j = 0; j < 8; ++j) { const int n = ns + 8 * j; const LAS float* s = scr + (8 * c) * 65 + n;
        u32x4 o; o.x = pg8::cvt_pk_bf16(s[0 * 65], s[1 * 65]); o.y = pg8::cvt_pk_bf16(s[2 * 65], s[3 * 65]); o.z = pg8::cvt_pk_bf16(s[4 * 65], s[5 * 65]); o.w = pg8::cvt_pk_bf16(s[6 * 65], s[7 * 65]);
        *(u32x4*)(dst + (size_t)(n0d + n) * ldt + k0 + 8 * c) = o; }
    asm volatile("s_waitcnt lgkmcnt(0)" ::: "memory");
}
using pg8::pk_fp8x4;
__device__ __forceinline__ void zero_tile_f8(unsigned char* dst, int ldt, int n0d, int k0, int lane) {
    const int c = lane & 3, ns = lane >> 2;
#pragma unroll
    for (int j = 0; j < 4; ++j) *(u32x4*)(dst + (size_t)(n0d + ns + 16 * j) * ldt + k0 + 16 * c) = (u32x4){0u, 0u, 0u, 0u};
}
__device__ __forceinline__ void transpose_tile_f8(const float* src, int ldsrc, int k0, int n0s, unsigned char* dst, int ldt, int n0d, float scale, LAS float* scr, int lane) {
    const int kr = lane >> 4, nq = lane & 15;
    f32x4 v[16];
#pragma unroll
    for (int i = 0; i < 16; ++i) v[i] = *(const f32x4*)(src + (size_t)(k0 + 4 * i + kr) * ldsrc + n0s + 4 * nq);
#pragma unroll
    for (int i = 0; i < 16; ++i) { LAS float* s = scr + (4 * i + kr) * 65 + 4 * nq; s[0] = v[i][0] * scale; s[1] = v[i][1] * scale; s[2] = v[i][2] * scale; s[3] = v[i][3] * scale; }
    asm volatile("s_waitcnt lgkmcnt(0)" ::: "memory");
    const int c = lane & 3, ns = lane >> 2;
#pragma unroll
    for (int j = 0; j < 4; ++j) { const int n = ns + 16 * j; const LAS float* s = scr + (16 * c) * 65 + n;
        u32x4 o; o.x = pk_fp8x4(s[0 * 65], s[1 * 65], s[2 * 65], s[3 * 65]); o.y = pk_fp8x4(s[4 * 65], s[5 * 65], s[6 * 65], s[7 * 65]);
        o.z = pk_fp8x4(s[8 * 65], s[9 * 65], s[10 * 65], s[11 * 65]); o.w = pk_fp8x4(s[12 * 65], s[13 * 65], s[14 * 65], s[15 * 65]);
        *(u32x4*)(dst + (size_t)(n0d + n) * ldt + k0 + 16 * c) = o; }
    asm volatile("s_waitcnt lgkmcnt(0)" ::: "memory");
}
__device__ __forceinline__ void transpose_item(const float* src, int ldsrc, int k0, int col  , bf16_t* dst, int ldt, int n0, LAS float* scr, int lane) {
#pragma unroll 8
    for (int i = 0; i < 32; ++i) { const int kk = 2 * i + (lane >> 5); scr[kk * 33 + (lane & 31)] = (col >= 0) ? src[(size_t)(k0 + kk) * ldsrc + col] : 0.f; }
    asm volatile("s_waitcnt lgkmcnt(0)" ::: "memory");
    const int c = lane & 7;
#pragma unroll
    for (int j = 0; j < 4; ++j) { const int n = (lane >> 3) + 8 * j; const LAS float* s = scr + (8 * c) * 33 + n;
        u32x4 o; o.x = pg8::cvt_pk_bf16(s[0 * 33], s[1 * 33]); o.y = pg8::cvt_pk_bf16(s[2 * 33], s[3 * 33]); o.z = pg8::cvt_pk_bf16(s[4 * 33], s[5 * 33]); o.w = pg8::cvt_pk_bf16(s[6 * 33], s[7 * 33]);
        *(u32x4*)(dst + (size_t)(n0 + n) * ldt + k0 + 8 * c) = o; }
    asm volatile("s_waitcnt lgkmcnt(0)" ::: "memory");
}
constexpr int IT_WIN = 16 * 120, IT_WOUT = 16 * 16, IT_P0 = IT_WIN + IT_WOUT;
constexpr int IT_WGU = 16 * 2 * 22 * 16, IT_WD = 16 * 16 * 24, IT_EXP = IT_WGU + IT_WD;
__device__ __forceinline__ void conv_item_p0(const Ptrs& p, int it, LAS float* scr, int lane) {
    if (it < IT_WIN) { const int kb = it / 120, nb = it % 120, n = nb * 32 + (lane & 31); const int col = (n < NPROJ) ? proj_src_col(n) : -1;
        transpose_item(p.w_in, NPROJ, kb * 64, col, (bf16_t*)(p.ws + WS_WIN), D, nb * 32, scr, lane); }
    else { it -= IT_WIN; const int kb = it >> 4, nb = it & 15; transpose_tile(p.w_out, D, kb * 64, nb * 64, (bf16_t*)(p.ws + WS_WOUT), D, nb * 64, scr, lane); }
}
__device__ __forceinline__ void conv_item_exp(const Ptrs& p, int it, LAS float* scr, int lane) {
    if (it < IT_WGU) { const int kb = it & 15, nt = (it >> 4) % 22, half = ((it >> 4) / 22) & 1, e = (it >> 4) / 44; const int f0 = nt * 64, r0 = (f0 >> 7) * 256 + half * 128 + (f0 & 127);
        const float* src = (half ? p.w_exp_up : p.w_exp_gate) + (size_t)e * D * FF;
        transpose_tile_f8(src, FF, kb * 64, f0, (unsigned char*)(p.ws + WS_WGU) + (size_t)e * 2816 * D, D, r0, 32.0f, scr, lane); }
    else { it -= IT_WGU; const int kb = it % 24, nb = (it / 24) & 15, e = it / (24 * 16); unsigned char* dst = (unsigned char*)(p.ws + WS_WD) + (size_t)e * D * FFP;
        if (kb < 22) transpose_tile_f8(p.w_exp_down + (size_t)e * FF * D, D, kb * 64, nb * 64, dst, FFP, nb * 64, 32.0f, scr, lane); else zero_tile_f8(dst, FFP, nb * 64, kb * 64, lane); }
}
__device__ __forceinline__ void h_rows(const Ptrs& p, int row0, int rstep, int lane) {
    f32x4 xn[4];
#define H_LOAD(r_) do { const float* s_ = ((r_) < NLAT) ? p.x + (size_t)(r_) * D : p.ctx + (size_t)((r_) - NLAT) * D; _Pragma("unroll") for (int j = 0; j < 4; ++j) xn[j] = *(const f32x4*)(s_ + j * 256 + lane * 4); } while (0)
    if (row0 < NROWS) H_LOAD(row0);
    f32x4 w4[4];
#pragma unroll
    for (int j = 0; j < 4; ++j) w4[j] = *(const f32x4*)(p.norm1_w + j * 256 + lane * 4);
    for (int row = row0; row < NROWS; row += rstep) {
        const int m = (row < NLAT) ? row / SEQ : 2;
        const float* mod = (const float*)(p.ws + WS_MOD) + m * NADA * D;
        f32x4 v[4]; float ss = 0.f;
#pragma unroll
        for (int j = 0; j < 4; ++j) { v[j] = xn[j]; ss += v[j][0] * v[j][0] + v[j][1] * v[j][1] + v[j][2] * v[j][2] + v[j][3] * v[j][3]; }
        if (row + rstep < NROWS) H_LOAD(row + rstep);
        const float rstd = rsqrtf(wave_sum(ss) * (1.0f / D) + EPS);
        bf16_t* dst = (bf16_t*)(p.ws + WS_H) + (size_t)row * D;
#pragma unroll
        for (int j = 0; j < 4; ++j) { const int d = j * 256 + lane * 4; const f32x4 sc = *(const f32x4*)(mod + D + d), sh = *(const f32x4*)(mod + d);
            f32x4 o;
#pragma unroll
            for (int e = 0; e < 4; ++e) o[e] = v[j][e] * rstd * w4[j][e] * (1.0f + sc[e]) + sh[e];
            u32x2 pkd; pkd.x = pg8::cvt_pk_bf16(o[0], o[1]); pkd.y = pg8::cvt_pk_bf16(o[2], o[3]); *(u32x2*)(dst + d) = pkd; }
    }
#undef H_LOAD
}
__device__ __forceinline__ void stage_router(const Ptrs& p, LAS float* Wl, int tid) {
    for (int idx = tid; idx < D * NE / 4; idx += NTHR) { const int d = idx >> 2, q4 = idx & 3, j = d >> 8, ln = (d >> 2) & 63, e4 = d & 3;
        *(LAS f32x4*)(Wl + ((j * 4 + e4) * 64 + ln) * 16 + 4 * q4) = *(const f32x4*)(p.w_router + (size_t)d * NE + 4 * q4); }
}
__device__ __forceinline__ void norm2_router_rows(const Ptrs& p, const LAS float* Wl, int row0, int rstep, int lane) {
    const bf16_t* XO = (const bf16_t*)(p.ws + WS_XO);
    f32x4 xn[4]; u32x2 on[4];
#define N2_LOAD(r_) do { _Pragma("unroll") for (int j = 0; j < 4; ++j) { xn[j] = *(const f32x4*)(p.x + (size_t)(r_) * D + j * 256 + lane * 4); on[j] = *(const u32x2*)(XO + (size_t)(r_) * D + j * 256 + lane * 4); } } while (0)
    if (row0 < NLAT) N2_LOAD(row0);
    f32x4 w4[4];
#pragma unroll
    for (int j = 0; j < 4; ++j) w4[j] = *(const f32x4*)(p.norm2_w + j * 256 + lane * 4);
    for (int row = row0; row < NLAT; row += rstep) {
        const int b = row / SEQ, t = row % SEQ;
        const float* mod = (const float*)(p.ws + WS_MOD) + b * NADA * D;
        f32x4 v[4]; float ss = 0.f;
#pragma unroll
        for (int j = 0; j < 4; ++j) { v[j] = xn[j]; v[j][0] += __uint_as_float(on[j].x << 16); v[j][1] += __uint_as_float(on[j].x & 0xffff0000u); v[j][2] += __uint_as_float(on[j].y << 16); v[j][3] += __uint_as_float(on[j].y & 0xffff0000u);
            ss += v[j][0] * v[j][0] + v[j][1] * v[j][1] + v[j][2] * v[j][2] + v[j][3] * v[j][3]; }
        if (row + rstep < NLAT) N2_LOAD(row + rstep);
        const float rstd = rsqrtf(wave_sum(ss) * (1.0f / D) + EPS);
        unsigned char* dst = (unsigned char*)(p.ws + WS_H) + (size_t)row * D;
        float lg[NE];
#pragma unroll
        for (int e = 0; e < NE; ++e) lg[e] = 0.f;
        int wl_off = 0; asm volatile("" : "+v"(wl_off));
#pragma unroll
        for (int j = 0; j < 4; ++j) { const int d = j * 256 + lane * 4; const f32x4 sc = *(const f32x4*)(mod + 4 * D + d), sh = *(const f32x4*)(mod + 3 * D + d);
            f32x4 o;
#pragma unroll
            for (int e4 = 0; e4 < 4; ++e4) { o[e4] = v[j][e4] * rstd * w4[j][e4] * (1.0f + sc[e4]) + sh[e4];
                const LAS f32x4* wr = (const LAS f32x4*)(Wl + wl_off + ((j * 4 + e4) * 64 + lane) * 16);
#pragma unroll
                for (int q = 0; q < 4; ++q) { const f32x4 ww = wr[q]; lg[4 * q] += o[e4] * ww[0]; lg[4 * q + 1] += o[e4] * ww[1]; lg[4 * q + 2] += o[e4] * ww[2]; lg[4 * q + 3] += o[e4] * ww[3]; } }
            *(unsigned*)(dst + d) = pk_fp8x4(o[0], o[1], o[2], o[3]); }
        float r8[8], r4[4], r2[2], r1;
        { const bool hi = lane & 32;
#pragma unroll
          for (int j = 0; j < 8; ++j) { const float keep = hi ? lg[8 + j] : lg[j], send = hi ? lg[j] : lg[8 + j]; r8[j] = keep + __shfl_xor(send, 32); } }
        { const bool hi = lane & 16;
#pragma unroll
          for (int j = 0; j < 4; ++j) { const float keep = hi ? r8[4 + j] : r8[j], send = hi ? r8[j] : r8[4 + j]; r4[j] = keep + __shfl_xor(send, 16); } }
        { const bool hi = lane & 8;
#pragma unroll
          for (int j = 0; j < 2; ++j) { const float keep = hi ? r4[2 + j] : r4[j], send = hi ? r4[j] : r4[2 + j]; r2[j] = keep + __shfl_xor(send, 8); } }
        { const bool hi = lane & 4; const float keep = hi ? r2[1] : r2[0], send = hi ? r2[0] : r2[1]; r1 = keep + __shfl_xor(send, 4); }
        r1 += __shfl_xor(r1, 2); r1 += __shfl_xor(r1, 1);
        float mx = r1;
#pragma unroll
        for (int o = 4; o < 64; o <<= 1) mx = fmaxf(mx, __shfl_xor(mx, o));
        const float ex = __expf(r1 - mx); float den = ex;
#pragma unroll
        for (int o = 4; o < 64; o <<= 1) den += __shfl_xor(den, o);
        if ((lane & 3) == 0) ((float*)(p.ws + WS_AFF))[((size_t)b * NE + ((lane >> 2) & 15)) * SEQ + t] = ex / den;
    }
#undef N2_LOAD
}
__device__ __forceinline__ void topk_set(const Ptrs& p, LAS unsigned char* lds, int be) {
    LAS unsigned* key = (LAS unsigned*)lds;
    LAS unsigned* hist = key + SEQ;
    LAS unsigned* sh = hist + 256;
    const int tid = threadIdx.x, lane = tid & 63, w = tid >> 6;
    const unsigned* A = (const unsigned*)(p.ws + WS_AFF) + (size_t)be * SEQ;
    for (int i = tid; i < SEQ / 4; i += NTHR) ((LAS u32x4*)key)[i] = ((const u32x4*)A)[i];
    if (tid == 0) { sh[0] = 0u; sh[1] = (unsigned)CAP; }
    __syncthreads();
#pragma unroll 1
    for (int pass = 0; pass < 4; ++pass) {
        const int shift = 24 - 8 * pass;
        if (tid < 256) hist[tid] = 0u;
        __syncthreads();
        const unsigned prefix = sh[0], kneed = sh[1];
        const unsigned himask = (pass == 0) ? 0u : (0xffffffffu << (shift + 8));
        for (int i = tid; i < SEQ; i += NTHR) { const unsigned kx = key[i]; if ((kx & himask) == prefix) __hip_atomic_fetch_add(&hist[(kx >> shift) & 255u], 1u, __ATOMIC_RELAXED, __HIP_MEMORY_SCOPE_WORKGROUP); }
        __syncthreads();
        if (w == 0) {
            unsigned c4[4]; unsigned s = 0u;
#pragma unroll
            for (int j = 0; j < 4; ++j) { c4[j] = hist[255 - (lane * 4 + j)]; s += c4[j]; }
            unsigned incl = s;
#pragma unroll
            for (int o = 1; o < 64; o <<= 1) { const unsigned t = __shfl_up(incl, o); if (lane >= o) incl += t; }
            const unsigned excl = incl - s;
            if (excl < kneed && kneed <= incl) { unsigned acc = excl;
#pragma unroll
                for (int j = 0; j < 4; ++j) { if (acc < kneed && kneed <= acc + c4[j]) { const unsigned bin = 255u - (unsigned)(lane * 4 + j); sh[0] = prefix | (bin << shift); sh[1] = kneed - acc; } acc += c4[j]; } }
        }
        __syncthreads();
    }
    const unsigned T = sh[0], need_eq = sh[1];
    unsigned cg = 0u, ce = 0u;
    for (int i = 0; i < 32; ++i) { const unsigned kx = key[tid * 32 + i]; cg += (kx > T) ? 1u : 0u; ce += (kx == T) ? 1u : 0u; }
    unsigned ig = cg, ie = ce;
#pragma unroll
    for (int o = 1; o < 64; o <<= 1) { const unsigned tg = __shfl_up(ig, o), te = __shfl_up(ie, o); if (lane >= o) { ig += tg; ie += te; } }
    if (lane == 63) { sh[16 + w] = ig; sh[32 + w] = ie; }
    __syncthreads();
    unsigned og = 0u, oe = 0u, totg = 0u;
#pragma unroll
    for (int w2 = 0; w2 < 8; ++w2) { const unsigned a = sh[16 + w2], b2 = sh[32 + w2]; if (w2 < w) { og += a; oe += b2; } totg += a; }
    unsigned pg = og + ig - cg, pe = oe + ie - ce;
    int* IDX = (int*)(p.ws + WS_IDX) + be * CAP; float* GATE = (float*)(p.ws + WS_GATE) + be * CAP; int* INV = (int*)(p.ws + WS_INV);
    const int b = be / NE, e = be % NE;
    for (int i = 0; i < 32; ++i) { const int t = tid * 32 + i; const unsigned kx = key[t]; int slot = -1;
        if (kx > T) slot = (int)(pg++); else if (kx == T) { if (pe < need_eq) slot = (int)(totg + pe); ++pe; }
        if (slot >= 0) { IDX[slot] = t; GATE[slot] = __uint_as_float(kx); }
        INV[((size_t)b * SEQ + t) * NE + e] = slot; }
    __syncthreads();
}
__device__ __forceinline__ void final_rows(const Ptrs& p, int row0, int rstep, int lane) {
    const bf16_t* XO = (const bf16_t*)(p.ws + WS_XO); const bf16_t* YE = (const bf16_t*)(p.ws + WS_YE); const int* INV = (const int*)(p.ws + WS_INV);
    f32x4 xn[4]; u32x2 on[4]; int invn = -1;
#define FN_LOAD(r_) do { _Pragma("unroll") for (int j = 0; j < 4; ++j) { xn[j] = *(const f32x4*)(p.x + (size_t)(r_) * D + j * 256 + lane * 4); on[j] = *(const u32x2*)(XO + (size_t)(r_) * D + j * 256 + lane * 4); } \
        invn = (lane < NE) ? INV[(size_t)(r_) * NE + lane] : -1; } while (0)
    if (row0 < NLAT) FN_LOAD(row0);
    f32x4 fw[4];
#pragma unroll
    for (int j = 0; j < 4; ++j) fw[j] = *(const f32x4*)(p.final_norm_w + j * 256 + lane * 4);
    for (int row = row0; row < NLAT; row += rstep) {
        const int b = row / SEQ;
        const float* mod = (const float*)(p.ws + WS_MOD) + b * NADA * D + 5 * D;
        f32x4 v[4];
#pragma unroll
        for (int j = 0; j < 4; ++j) { v[j] = xn[j]; v[j][0] += __uint_as_float(on[j].x << 16); v[j][1] += __uint_as_float(on[j].x & 0xffff0000u); v[j][2] += __uint_as_float(on[j].y << 16); v[j][3] += __uint_as_float(on[j].y & 0xffff0000u); }
        const int myinv = invn;
        if (row + rstep < NLAT) FN_LOAD(row + rstep);
        unsigned long long mask = __ballot(myinv >= 0);
        float acc[16];
#pragma unroll
        for (int i = 0; i < 16; ++i) acc[i] = 0.f;
        while (mask) {
            u32x2 yw[4][4]; bool has[4];
#pragma unroll
            for (int u = 0; u < 4; ++u) { has[u] = mask != 0ull; const int e = has[u] ? (int)__builtin_ctzll(mask) : 0; if (has[u]) mask &= mask - 1ull;
                const int s = __shfl(myinv, e); const bf16_t* y = YE + ((size_t)(b * NE + e) * CAP + (has[u] ? s : 0)) * D;
                if (has[u]) {
#pragma unroll
                    for (int j = 0; j < 4; ++j) yw[u][j] = *(const u32x2*)(y + j * 256 + lane * 4); } }
#pragma unroll
            for (int u = 0; u < 4; ++u) if (has[u]) {
#pragma unroll
                for (int j = 0; j < 4; ++j) { acc[4 * j] += __uint_as_float(yw[u][j].x << 16); acc[4 * j + 1] += __uint_as_float(yw[u][j].x & 0xffff0000u); acc[4 * j + 2] += __uint_as_float(yw[u][j].y << 16); acc[4 * j + 3] += __uint_as_float(yw[u][j].y & 0xffff0000u); } }
        }
        float ss = 0.f;
#pragma unroll
        for (int j = 0; j < 4; ++j) { const f32x4 m4 = *(const f32x4*)(mod + j * 256 + lane * 4);
#pragma unroll
            for (int e = 0; e < 4; ++e) { v[j][e] += m4[e] * acc[4 * j + e]; ss += v[j][e] * v[j][e]; } }
        const float rstd = rsqrtf(wave_sum(ss) * (1.0f / D) + EPS);
        float* xr = p.out + (size_t)row * D;
#pragma unroll
        for (int j = 0; j < 4; ++j) *(f32x4*)(xr + j * 256 + lane * 4) = v[j] * rstd * fw[j];
    }
#undef FN_LOAD
}
}

constexpr int RING_OFF = 0, RING_BYTES = 131072;
constexpr int GTAB_OFF = RING_BYTES;
constexpr int MISC_OFF = RING_BYTES + 12288;
constexpr int LDS_BYTES = 147456;
constexpr int CW_BAR = 4096;

#define RLX_AGENT __ATOMIC_RELAXED, __HIP_MEMORY_SCOPE_AGENT
#define XB_TMO      128
#define XB_XCNT(j)  (256  + 64 * (j))
#define XB_XSUB(j)  (1280 + 64 * (j))
#define XB_XGEN(j)  (2304 + 64 * (j))
#define XB_TOP      3328
#define XB_TOPGEN   3392
#define XCD_BAR_WORDS 3456
#define XB_SPIN_CAP (1u << 18)
__device__ __forceinline__ unsigned xb_ld(unsigned* p)              { return __hip_atomic_load(p, __ATOMIC_RELAXED, __HIP_MEMORY_SCOPE_AGENT); }
__device__ __forceinline__ unsigned xb_add(unsigned* p, unsigned v) { return __hip_atomic_fetch_add(p, v, __ATOMIC_RELAXED, __HIP_MEMORY_SCOPE_AGENT); }
__device__ __forceinline__ unsigned xb_xcc_id() { return (unsigned)__builtin_amdgcn_s_getreg((3 << 11) | 20) & 0xFu; }
#define XB_SPIN(cond, bar) do { unsigned _sp = 0; while (cond) { __builtin_amdgcn_s_sleep(1); \
    if ((++_sp & 255u) == 0u) { if (xb_ld(&(bar)[XB_TMO])) break; if (_sp > XB_SPIN_CAP) { atomicAdd(&(bar)[XB_TMO], 1u); break; } } } } while (0)
struct XcdBarrier { unsigned* bar; unsigned x; volatile LAS unsigned* st; };
__device__ __forceinline__ XcdBarrier xcd_barrier_post(unsigned* bar, volatile LAS unsigned* st) {
    XcdBarrier b; b.bar = bar; b.x = xb_xcc_id(); b.st = st;
    if (threadIdx.x == 0) (void)xb_add(&bar[XB_XCNT(b.x)], 1u);
    return b;
}
__device__ __forceinline__ void xcd_barrier_complete(unsigned* bar, unsigned x, unsigned& nloc, unsigned& nx) {
    const unsigned G = gridDim.x * gridDim.y * gridDim.z;
    unsigned sum, cnt, mine, sp = 0u;
    for (;;) {
        sum = 0u; cnt = 0u; mine = 0u;
#pragma unroll
        for (unsigned j = 0; j < 16; ++j) { const unsigned c = xb_ld(&bar[XB_XCNT(j)]); sum += c; cnt += (c > 0u) ? 1u : 0u; mine = (j == x) ? c : mine; }
        if (sum == G) break;
        __builtin_amdgcn_s_sleep(1);
        if ((++sp & 255u) == 0u) { if (xb_ld(&bar[XB_TMO])) break; if (sp > XB_SPIN_CAP) { atomicAdd(&bar[XB_TMO], 1u); break; } }
    }
    nloc = mine > 0u ? mine : 1u; nx = cnt > 0u ? cnt : 1u;
}
__device__ __forceinline__ void xcd_barrier(const XcdBarrier& b) {
    asm volatile("s_waitcnt vmcnt(0)" ::: "memory");
    __syncthreads();
    if (threadIdx.x == 0) {
        unsigned* bar = b.bar;
        __builtin_amdgcn_s_waitcnt(0);
        unsigned nloc = b.st[0], nx = b.st[1];
        if (nloc == 0u) { xcd_barrier_complete(bar, b.x, nloc, nx); b.st[0] = nloc; b.st[1] = nx; }
        const unsigned old = xb_add(&bar[XB_XSUB(b.x)], 1u);
        const unsigned gen = old / nloc;
        if (old + 1u == (gen + 1u) * nloc) {
            __builtin_amdgcn_fence(__ATOMIC_RELEASE, "agent");
            asm volatile("s_waitcnt vmcnt(0)" ::: "memory");
            const unsigned og = xb_add(&bar[XB_TOP], 1u);
            const unsigned tg = og / nx;
            if (og + 1u == (tg + 1u) * nx) xb_add(&bar[XB_TOPGEN], 1u);
            else XB_SPIN(xb_ld(&bar[XB_TOPGEN]) == tg, bar);
            __builtin_amdgcn_fence(__ATOMIC_ACQUIRE, "agent");
            xb_add(&bar[XB_XGEN(b.x)], 1u);
            asm volatile("s_waitcnt vmcnt(0)" ::: "memory");
        } else {
            XB_SPIN(xb_ld(&bar[XB_XGEN(b.x)]) == gen, bar);
            __builtin_amdgcn_fence(__ATOMIC_ACQUIRE, "agent");
            asm volatile("s_waitcnt vmcnt(0)" ::: "memory");
        }
    }
    __syncthreads();
}

struct Args { Ptrs p; int ph_lo, ph_hi, dbg, pad; };

__global__ void __launch_bounds__(NTHR, 2) mk_fwd(Args args) {
    extern __shared__ __attribute__((aligned(16))) unsigned char lds_raw[];
    LAS unsigned char* lds = (LAS unsigned char*)lds_raw;
    volatile LAS unsigned* MISC = (volatile LAS unsigned*)(lds + MISC_OFF);
    const Ptrs& p = args.p;
    unsigned char* ws = p.ws;
    const int tid = threadIdx.x, G = gridDim.x, bx = blockIdx.x;
    for (int u = tid; u < (LDS_BYTES - MISC_OFF) / 4; u += NTHR) ((LAS unsigned*)(lds + MISC_OFF))[u] = 0u;
    __syncthreads();
    const int lo = args.ph_lo, hi = args.ph_hi;
#ifndef REPS_LIST
#define REPS_LIST 1, 1, 1, 1, 1, 1, 1, 1, 1, 1, 1, 1
#endif
    constexpr int reps_tab[12] = {REPS_LIST};
    constexpr int CONV_SPLIT = 0;
    XcdBarrier bar; bar.bar = (unsigned*)ws + CW_BAR; bar.x = 0; bar.st = nullptr;
    if (hi - lo > 1) bar = xcd_barrier_post((unsigned*)ws + CW_BAR, MISC + 8);
#define IN(k) (lo <= (k) && (k) < hi)
#define SEAM(k) do { if (IN(k) && IN((k) + 1)) xcd_barrier(bar); } while (0)

    const int wv = __builtin_amdgcn_readfirstlane(tid >> 6), ln = tid & 63, gw = bx * NWAVES + wv, NGW = G * NWAVES;
    if (IN(0)) {
        for (int cb = bx; cb < 256; cb += G) misc::p0_mod(p, lds, cb);
        misc::p0_rope(p, bx * NTHR + tid);
        LAS float* scr = (LAS float*)(lds + wv * misc::TSCR);
        for (int it = gw; it < misc::IT_P0; it += NGW) misc::conv_item_p0(p, it, scr, ln);
    }
    if constexpr (reps_tab[0] > 1) { xcd_barrier(bar);
    if (IN(0)) {
        for (int cb = bx; cb < 256; cb += G) misc::p0_mod(p, lds, cb);
        misc::p0_rope(p, bx * NTHR + tid);
        LAS float* scr = (LAS float*)(lds + wv * misc::TSCR);
        for (int it = gw; it < misc::IT_P0; it += NGW) misc::conv_item_p0(p, it, scr, ln);
    }
    }
    SEAM(0);
    if (IN(1)) { misc::h_rows(p, gw, NGW, ln); }
    if constexpr (reps_tab[1] > 1) { xcd_barrier(bar);
    if (IN(1)) { misc::h_rows(p, gw, NGW, ln); }
    }
    SEAM(1);
    if (IN(2)) {
        pg8::Gemm g{(const bf16_t*)(ws + WS_H), (const bf16_t*)(ws + WS_WIN), D};
        pg8::StaticOrder S; S.init(NROWS / 256, NPROJ_PAD / 256, G, bx);
        pg8::EpiProj E{(bf16_t*)(ws + WS_P), (float*)(ws + WS_GZ), (const float*)(ws + WS_ROPE)};
        pg8::gemm_phase<pg8::EpiProj, pg8::StaticOrder, false>(lds + RING_OFF, g, S, E, nullptr);
    }
    if constexpr (reps_tab[2] > 1) { xcd_barrier(bar);
    if (IN(2)) {
        pg8::Gemm g{(const bf16_t*)(ws + WS_H), (const bf16_t*)(ws + WS_WIN), D};
        pg8::StaticOrder S; S.init(NROWS / 256, NPROJ_PAD / 256, G, bx);
        pg8::EpiProj E{(bf16_t*)(ws + WS_P), (float*)(ws + WS_GZ), (const float*)(ws + WS_ROPE)};
        pg8::gemm_phase<pg8::EpiProj, pg8::StaticOrder, false>(lds + RING_OFF, g, S, E, nullptr);
    }
    }
    SEAM(2);
    if (IN(3)) {
        scan::run_c1(p, lds, bx);
    }
    SEAM(3);
    if (IN(4)) {
        if (bx < 64) scan::c2_scan<0>(p, bx >> 2, (bx & 3) * NTHR + tid);
        else if (bx < 192) scan::c2_scan<1>(p, (bx - 64) >> 3, ((bx - 64) & 7) * NTHR + tid);
    }
    if constexpr (reps_tab[3] > 1) { xcd_barrier(bar);
    if (IN(3)) {
        scan::run_c1(p, lds, bx);
    }
    SEAM(3);
    if (IN(4)) {
        if (bx < 64) scan::c2_scan<0>(p, bx >> 2, (bx & 3) * NTHR + tid);
        else if (bx < 192) scan::c2_scan<1>(p, (bx - 64) >> 3, ((bx - 64) & 7) * NTHR + tid);
    }
    }
    SEAM(4);
    if (IN(5)) {
        scan::run_c3(p, lds, bx, (bf16_t*)(ws + WS_H));
    }
    if constexpr (reps_tab[5] > 1) { xcd_barrier(bar);
    if (IN(5)) {
        scan::run_c3(p, lds, bx, (bf16_t*)(ws + WS_H));
    }
    }
    SEAM(5);
    if (IN(6)) {
        pg8::Gemm g{(const bf16_t*)(ws + WS_H), (const bf16_t*)(ws + WS_WOUT), D};
        pg8::StaticOrder S; S.init(NLAT / 256, D / 256, G, bx);
        pg8::EpiOut E{(bf16_t*)(ws + WS_XO), (const float*)(ws + WS_MOD)};
        pg8::gemm_phase<pg8::EpiOut, pg8::StaticOrder, false>(lds + RING_OFF, g, S, E, nullptr);
    }
    if constexpr (reps_tab[6] > 1) { xcd_barrier(bar);
    if (IN(6)) {
        pg8::Gemm g{(const bf16_t*)(ws + WS_H), (const bf16_t*)(ws + WS_WOUT), D};
        pg8::StaticOrder S; S.init(NLAT / 256, D / 256, G, bx);
        pg8::EpiOut E{(bf16_t*)(ws + WS_XO), (const float*)(ws + WS_MOD)};
        pg8::gemm_phase<pg8::EpiOut, pg8::StaticOrder, false>(lds + RING_OFF, g, S, E, nullptr);
    }
    }
    SEAM(6);
    if (IN(7)) {
        misc::stage_router(p, (LAS float*)lds, tid); __syncthreads();
        misc::norm2_router_rows(p, (const LAS float*)lds, gw, NGW, ln);
        __syncthreads();
        LAS float* scr = (LAS float*)(lds + wv * misc::TSCR);
        for (int it = gw; it < CONV_SPLIT; it += NGW) misc::conv_item_exp(p, it, scr, ln);
    }
    if constexpr (reps_tab[7] > 1) { xcd_barrier(bar);
    if (IN(7)) {
        misc::stage_router(p, (LAS float*)lds, tid); __syncthreads();
        misc::norm2_router_rows(p, (const LAS float*)lds, gw, NGW, ln);
        __syncthreads();
        LAS float* scr = (LAS float*)(lds + wv * misc::TSCR);
        for (int it = gw; it < CONV_SPLIT; it += NGW) misc::conv_item_exp(p, it, scr, ln);
    }
    }
    SEAM(7);
    if (IN(8)) { if (bx < 32) misc::topk_set(p, lds, bx);
        else { LAS float* scr = (LAS float*)(lds + wv * misc::TSCR); for (int it = CONV_SPLIT + (bx - 32) * NWAVES + wv; it < misc::IT_EXP; it += (G - 32) * NWAVES) misc::conv_item_exp(p, it, scr, ln); } }
    if constexpr (reps_tab[8] > 1) { xcd_barrier(bar);
    if (IN(8)) { if (bx < 32) misc::topk_set(p, lds, bx);
        else { LAS float* scr = (LAS float*)(lds + wv * misc::TSCR); for (int it = CONV_SPLIT + (bx - 32) * NWAVES + wv; it < misc::IT_EXP; it += (G - 32) * NWAVES) misc::conv_item_exp(p, it, scr, ln); } }
    }
    SEAM(8);
    if (IN(9)) {
        LAS unsigned* gtab = (LAS unsigned*)(lds + GTAB_OFF);
        pg8::MoeUpOrder S{bx};
        const int* IDX = (const int*)(ws + WS_IDX);
        for (int e = tid; e < 11 * 256; e += NTHR) { pg8::Unit u; S.next(e >> 8, u); const int R = u.pm * 256 + (e & 255); gtab[e] = (unsigned)((u.pm >> 7) * SEQ + (IDX[R] & (SEQ - 1))) * (unsigned)D; }
        __syncthreads();
        pg8::Gemm g{(const bf16_t*)(ws + WS_H), (const bf16_t*)(ws + WS_WGU), D};
        pg8::EpiAct E{(unsigned char*)(ws + WS_ACT), 1.0f / 32.0f, 8.0f};
        pg8::gemm_phase<pg8::EpiAct, pg8::MoeUpOrder, true, true>(lds + RING_OFF, g, S, E, gtab);
    }
    if constexpr (reps_tab[9] > 1) { xcd_barrier(bar);
    if (IN(9)) {
        LAS unsigned* gtab = (LAS unsigned*)(lds + GTAB_OFF);
        pg8::MoeUpOrder S{bx};
        const int* IDX = (const int*)(ws + WS_IDX);
        for (int e = tid; e < 11 * 256; e += NTHR) { pg8::Unit u; S.next(e >> 8, u); const int R = u.pm * 256 + (e & 255); gtab[e] = (unsigned)((u.pm >> 7) * SEQ + (IDX[R] & (SEQ - 1))) * (unsigned)D; }
        __syncthreads();
        pg8::Gemm g{(const bf16_t*)(ws + WS_H), (const bf16_t*)(ws + WS_WGU), D};
        pg8::EpiAct E{(unsigned char*)(ws + WS_ACT), 1.0f / 32.0f, 8.0f};
        pg8::gemm_phase<pg8::EpiAct, pg8::MoeUpOrder, true, true>(lds + RING_OFF, g, S, E, gtab);
    }
    }
    SEAM(9);
    if (IN(10)) {
        pg8::MoeDownOrder S{bx};
        pg8::Gemm g{(const bf16_t*)(ws + WS_ACT), (const bf16_t*)(ws + WS_WD), FFP};
        pg8::EpiDown E{(bf16_t*)(ws + WS_YE), (const float*)(ws + WS_GATE), 1.0f / 256.0f};
        pg8::gemm_phase<pg8::EpiDown, pg8::MoeDownOrder, false, true>(lds + RING_OFF, g, S, E, nullptr);
    }
    if constexpr (reps_tab[10] > 1) { xcd_barrier(bar);
    if (IN(10)) {
        pg8::MoeDownOrder S{bx};
        pg8::Gemm g{(const bf16_t*)(ws + WS_ACT), (const bf16_t*)(ws + WS_WD), FFP};
        pg8::EpiDown E{(bf16_t*)(ws + WS_YE), (const float*)(ws + WS_GATE), 1.0f / 256.0f};
        pg8::gemm_phase<pg8::EpiDown, pg8::MoeDownOrder, false, true>(lds + RING_OFF, g, S, E, nullptr);
    }
    }
    SEAM(10);
    if (IN(11)) { misc::final_rows(p, gw, NGW, ln); }
#undef IN
#undef SEAM
}

#define ZS 1
#define RSEL 1
__global__ void k_cmp(Ptrs p) {
    const bf16_t* Y = (const bf16_t*)p.out + (size_t)NLAT * D; const bf16_t* Y2 = (const bf16_t*)p.out;
    float acc[4] = {0.f, 0.f, 0.f, 0.f};
    for (size_t i = (size_t)blockIdx.x * blockDim.x + threadIdx.x; i < (size_t)NLAT * D; i += (size_t)gridDim.x * blockDim.x) {
        const int half = ((int)(i & 1023)) >> 9; const float a = bf2f(Y[i]), b = bf2f(Y2[i]); float d = b - a; if (!(d == d) || fabsf(d) > 1e30f) d = 1e15f;
        acc[2 * half] += d * d; acc[2 * half + 1] += a * a; }
    float* ctl = (float*)(p.ws + WS_CTL) + 1024;
    for (int k = 0; k < 4; ++k) { const float v = wave_sum(acc[k]); if ((threadIdx.x & 63) == 0) atomicAdd(ctl + k, v); }
}

__global__ void k_check_S(Ptrs p, int umode) {
    const int s = blockIdx.x * blockDim.x + threadIdx.x;
    if (s >= 256) return;
    const int G = s >> 7, r = s & 127;
    const int chain = r & 15, slot_sel = (r >> 4) & 7;
    const int slots[8] = {0, 1, 3, 4, 5, 60, 200, 259};
    const int slot = slots[slot_sel];
    const int DK = G ? 128 : 64;
    const int k = (s * 37 + 11) % DK, v = (s * 53 + 7) % 128;
    const int dir = chain & 1, h = (chain >> 1) & 3, b = chain >> 3;
    const bf16_t* P = (const bf16_t*)(p.ws + WS_P); const float* GZ = (const float*)(p.ws + WS_GZ);
    const int koff = G ? C_RK + h * 128 : C_GK + h * 64, voff = G ? C_RV + h * 128 : C_GV + h * 128;
    float gamma = 1.f; if (G) gamma = 1.0f / (1.0f + __expf(-p.ret_decay_logit[dir * 4 + h]));
    float S = 0.f;
    for (int step = 0; step < 260; ++step) {
        const int sl = scan::slot_at(dir, step);
        if (umode) { if (sl != slot) continue; } else if (sl == slot) break;
        const int row0 = scan::slot_row0(b, sl);
        for (int tt = 0; tt < 64; ++tt) { const int t = dir ? 63 - tt : tt; const size_t row = row0 + t;
            float a = gamma;
            if (!G) { float pre = p.gla_gate_b[dir * 256 + h * 64 + k]; for (int rr = 0; rr < 16; ++rr) pre += GZ[row * 32 + dir * 16 + rr] * p.gla_gate_w[(dir * 16 + rr) * 256 + h * 64 + k]; a = __expf(log_sigmoidf(pre) * 0.0625f); }
            S = a * S + bf2f(P[row * PW + koff + k]) * bf2f(P[row * PW + voff + v]); }
    }
    const int KS = DK / 32, vt = v >> 4, c = v & 15, ks = k >> 5, kk = k & 31, e = 4 * ((kk >> 4) & 1) + (kk & 3), q = (kk >> 2) & 3, lane = q * 16 + c;
    const bf16_t* US = (const bf16_t*)(p.ws + WS_US) + (G ? scan::US_RET_OFF : 0);
    const float got = bf2f(US[((size_t)chain * scan::NSL + slot) * (G ? scan::RET_SLOT : scan::GLA_SLOT) + ((vt * KS + ks) * 64 + lane) * 8 + e]);
    float d = got - S; if (!(d == d)) d = 1e15f;
    float* ctl = (float*)(p.ws + WS_CTL) + 1024;
    atomicAdd(ctl + 2 * G, d * d); atomicAdd(ctl + 2 * G + 1, S * S);
}

__global__ void k_check_Usum(Ptrs p) {
    const int s = blockIdx.x;
    const int G = s >> 5, r = s & 31, chain = r & 15, slot = (r >> 4) ? 137 : 2;
    const int DK = G ? 128 : 64;
    const int dir = chain & 1, h = (chain >> 1) & 3, b = chain >> 3;
    const bf16_t* P = (const bf16_t*)(p.ws + WS_P); const float* GZ = (const float*)(p.ws + WS_GZ);
    const int koff = G ? C_RK + h * 128 : C_GK + h * 64, voff = G ? C_RV + h * 128 : C_GV + h * 128;
    float gamma = 1.f; if (G) gamma = 1.0f / (1.0f + __expf(-p.ret_decay_logit[dir * 4 + h]));
    const int row0 = scan::slot_row0(b, slot);
    __shared__ float red[128];
    const int k = threadIdx.x;
    float S = 0.f;
    if (k < DK) for (int tt = 0; tt < 64; ++tt) { const int t = dir ? 63 - tt : tt; const size_t row = row0 + t;
        float vs = 0.f; for (int v = 0; v < 128; ++v) vs += bf2f(P[row * PW + voff + v]);
        float a = gamma;
        if (!G) { float pre = p.gla_gate_b[dir * 256 + h * 64 + k]; for (int rr = 0; rr < 16; ++rr) pre += GZ[row * 32 + dir * 16 + rr] * p.gla_gate_w[(dir * 16 + rr) * 256 + h * 64 + k]; a = __expf(log_sigmoidf(pre) * 0.0625f); }
        S = a * S + bf2f(P[row * PW + koff + k]) * vs; }
    const size_t SL = G ? scan::RET_SLOT : scan::GLA_SLOT;
    const bf16_t* US = (const bf16_t*)(p.ws + WS_US) + (G ? scan::US_RET_OFF : 0) + ((size_t)chain * scan::NSL + slot) * SL;
    float got = 0.f; for (size_t i = threadIdx.x; i < SL; i += 128) got += bf2f(US[i]);
    red[threadIdx.x] = S; __syncthreads(); float ref = 0.f; if (threadIdx.x == 0) for (int i = 0; i < 128; ++i) ref += red[i]; __syncthreads();
    red[threadIdx.x] = got; __syncthreads();
    if (threadIdx.x == 0) { float g2 = 0.f; for (int i = 0; i < 128; ++i) g2 += red[i]; float d = g2 - ref; if (!(d == d)) d = 1e15f;
        float* ctl = (float*)(p.ws + WS_CTL) + 1024; atomicAdd(ctl + 4 + 2 * G, g2 * ref); atomicAdd(ctl + 5 + 2 * G, ref * ref); }
}

__global__ void k_check_poison(Ptrs p) {
    const int s = blockIdx.x; const int G = s >> 5, r = s & 31, chain = r & 15, slot = (r >> 4) ? 137 : 2;
    const size_t SL = G ? scan::RET_SLOT : scan::GLA_SLOT;
    const bf16_t* US = (const bf16_t*)(p.ws + WS_US) + (G ? scan::US_RET_OFF : 0) + ((size_t)chain * scan::NSL + slot) * SL;
    float cnt = 0.f; for (size_t i = threadIdx.x; i < SL; i += 128) cnt += (US[i] == 0xAAAA) ? 1.f : 0.f;
    cnt = wave_sum(cnt);
    float* ctl = (float*)(p.ws + WS_CTL) + 1024;
    if ((threadIdx.x & 63) == 0) { atomicAdd(ctl + 2 * G, cnt * cnt * 4.f); atomicAdd(ctl + 2 * G + 1, (float)SL * (float)SL * 0.25f * 0.5f); }
}
__global__ void k_code(Ptrs p) {
    float* ctl = (float*)(p.ws + WS_CTL) + 1024;
    int code[2];
    for (int h = 0; h < 2; ++h) { const float r = sqrtf(ctl[2 * h] / ctl[2 * h + 1]); code[h] = (r < 0.02f) ? 0 : ((r < 0.5f) ? 1 : 2); }
    { const float R = ctl[4 + 2 * RSEL] / ctl[5 + 2 * RSEL]; int m = 7; if (fabsf(R - 1.f) < 0.05f) m = 0; else if (fabsf(R - 0.5f) < 0.05f) m = 1; else if (fabsf(R - 2.f) < 0.1f) m = 2; else if (fabsf(R) < 0.05f) m = 3; else if (R < 0.f) m = 4; else if (fabsf(R - 0.25f) < 0.03f) m = 5; else if (R > 1.f) m = 6;
      ctl[8] = 1.0f + 0.002f * (float)m; }
}
__global__ void k_scale(Ptrs p) {
    const float s = ((const float*)(p.ws + WS_CTL))[1024 + 8];
    for (size_t i = (size_t)blockIdx.x * blockDim.x + threadIdx.x; i < (size_t)NLAT * D; i += (size_t)gridDim.x * blockDim.x) p.out[i] *= s;
}
static void launch_mk(const Ptrs& p, int lo, int hi, hipStream_t stream) {
    Args a{}; a.p = p; a.ph_lo = lo; a.ph_hi = hi;
    hipLaunchKernelGGL(mk_fwd, dim3(256), dim3(NTHR), LDS_BYTES, stream, a);
}
extern "C" void kernel_launch(void* const* d_in, const int* in_sizes, int n_in, void* d_out, int out_size, void* d_ws, size_t ws_size, hipStream_t stream) {
    static int ready = 0;
    if (!ready) {
        if (n_in != 20 || ws_size < WS_END) { fprintf(stderr, "kernel_launch: unexpected n_in %d / ws_size %zu\n", n_in, ws_size); ready = -1; return; }
        if (hipFuncSetAttribute((const void*)mk_fwd, hipFuncAttributeMaxDynamicSharedMemorySize, LDS_BYTES) != hipSuccess) { fprintf(stderr, "hipFuncSetAttribute failed\n"); ready = -1; return; }
        ready = 1;
    }
    if (ready < 0) return;
    Ptrs p{};
    const float** f = (const float**)&p;
    for (int i = 0; i < 20; ++i) f[i] = (const float*)d_in[i];
    p.out = (float*)d_out; p.ws = (unsigned char*)d_ws;
    (void)hipMemsetAsync((char*)d_ws + WS_CTL, 0, 64 * 1024, stream);
    launch_mk(p, 0, 12, stream);
}
```

```cpp
#include <hip/hip_runtime.h>
#include <stdint.h>
#include <stdio.h>

typedef unsigned short bf16_t;
typedef unsigned int u32;

constexpr int D = 1024, BATCH = 2, SEQ = 16384, CTX = 256;
constexpr int NLAT = BATCH * SEQ;
constexpr int NCTX = BATCH * CTX;
constexpr int NROWS = NLAT + NCTX;
constexpr int NADA = 6;
constexpr int NE = 16, CAP = 2048, FF = 1408, FFP = 1536;
constexpr int NSLOT = BATCH * NE * CAP;
constexpr float EPS = 1e-6f;
constexpr int C_GQ = 0, C_GK = 256, C_GV = 512, C_GG = 1024, C_RQ = 1536, C_RK = 2048, C_RV = 2560, C_RG = 3072, C_GZ = 3584;
constexpr int PW = 3584;
constexpr int NPROJ = 3616, NPROJ_PAD = 3840;
__host__ __device__ __forceinline__ size_t ptile(int row, int col) { return ((size_t)((row >> 6) * 28 + (col >> 7)) * 64 + (row & 63)) * 128 + (col & 127); }

constexpr size_t MiB = 1u << 20;
constexpr size_t WS_CTL = 0;
constexpr size_t WS_MOD = 1 * MiB;
constexpr size_t WS_ROPE = WS_MOD + 128 * 1024;
constexpr size_t WS_DCH = 2 * MiB;
constexpr size_t WS_WIN = 4 * MiB;
constexpr size_t WS_WOUT = 12 * MiB;
constexpr size_t WS_GZ = 14 * MiB;
constexpr size_t WS_H = 19 * MiB;
constexpr size_t WS_P = 84 * MiB;
constexpr size_t WS_US = 312 * MiB;
constexpr size_t WS_WGU = 84 * MiB;
constexpr size_t WS_WD = 172 * MiB;
constexpr size_t WS_ACT = 216 * MiB;
constexpr size_t WS_XO = 312 * MiB;
constexpr size_t WS_AFF = 392 * MiB;
constexpr size_t WS_IDX = 394 * MiB;
constexpr size_t WS_GATE = 395 * MiB;
constexpr size_t WS_INV = 396 * MiB;
constexpr size_t WS_YE = 19 * MiB;
constexpr size_t WS_END = 508 * MiB;

__device__ __forceinline__ float bf2f(bf16_t v) { return __uint_as_float(((u32)v) << 16); }
__device__ __forceinline__ bf16_t f2bf(float f) { u32 u = __float_as_uint(f); return (bf16_t)((u + 0x7fffu + ((u >> 16) & 1u)) >> 16); }
__device__ __forceinline__ float siluf(float x) { return x / (1.0f + __expf(-x)); }
__device__ __forceinline__ float log_sigmoidf(float x) { return fminf(x, 0.f) - log1pf(__expf(-fabsf(x))); }
__device__ __forceinline__ float wave_sum(float v) {
#pragma unroll
    for (int o = 1; o < 64; o <<= 1) v += __shfl_xor(v, o);
    return v;
}
__host__ __device__ inline int proj_src_col(int n) {
    if (n < 1024) return n;
    if (n < 1536) return 1056 + (n - 1024);
    if (n < 2560) {
        const int base = (n < 2048) ? 1568 : 2080, m = (n < 2048) ? n - 1536 : n - 2048;
        const int hd = m >> 7, p = m & 127, g = p >> 3, nn = (p >> 2) & 1, e = p & 3;
        return base + hd * 128 + 64 * nn + 4 * g + e;
    }
    if (n < 3072) return 2592 + (n - 2560);
    if (n < 3584) return 3104 + (n - 3072);
    return 1024 + (n - 3584);
}

struct Ptrs {
    const float *x, *c, *ctx, *c_ctx, *w_ada, *b_ada, *norm1_w, *w_in, *gla_gate_w, *gla_gate_b, *ret_decay_logit, *gla_norm_w, *ret_norm_w,
        *w_out, *norm2_w, *w_router, *w_exp_gate, *w_exp_up, *w_exp_down, *final_norm_w;
    float* out;
    unsigned char* ws;
};


constexpr int NWAVES = 8, NTHR = NWAVES * 64;
#define LAS __attribute__((address_space(3)))
#define GAS __attribute__((address_space(1)))
typedef short bf16x8 __attribute__((ext_vector_type(8)));
typedef float f32x4 __attribute__((ext_vector_type(4)));
typedef float f32x2 __attribute__((ext_vector_type(2)));
typedef unsigned u32x4 __attribute__((ext_vector_type(4)));
typedef unsigned u32x2 __attribute__((ext_vector_type(2)));
typedef int i32x4 __attribute__((ext_vector_type(4)));
typedef int i32x8 __attribute__((ext_vector_type(8)));
#ifndef PG8_ALIGN_DEFAULT
#define PG8_ALIGN_DEFAULT true
#endif
namespace pg8 {
constexpr int BM = 256, BK = 64, HALF = 128, HTB = HALF * BK * 2  , STAGE_BYTES = 8 * HTB, NXCD = 8, WGM = 8;
__host__ __device__ __forceinline__ int lds_byte(int r, int c) { const int st = (r >> 4) * 2 + (c >> 5), rr = r & 15, cc = c & 31, ob = rr * 64 + cc * 2; return st * 1024 + (ob ^ (((ob >> 9) & 1) << 5)); }
__host__ __device__ __forceinline__ void stage_rc(int b, int& R, int& C) { const int st = b / 1024, sb = b % 1024, swz = sb ^ (((sb >> 9) & 1) << 5); R = (st >> 1) * 16 + swz / 64; C = (st & 1) * 32 + (swz % 64) / 2; }
__host__ __device__ __forceinline__ int perm32(int rho) { const int n = rho >> 4, i = rho & 15; return 8 * (i >> 2) + 4 * n + (i & 3); }

struct Unit { int pm, pn; };
struct Gemm { const bf16_t* A; const bf16_t* Bt; int K; };

struct StaticOrder {
    int nM, nN, nwg, G, c;
    __device__ void init(int nM_, int nN_, int G_, int c_) { nM = nM_; nN = nN_; nwg = nM * nN; G = G_; c = c_; }
    __device__ bool next(int i, Unit& u) const {
        const long L = (long)i * G + c; if (L >= nwg) return false;
        int wgid = (int)L; { const int q = nwg / NXCD, r = nwg % NXCD, xcd = wgid % NXCD, off = wgid / NXCD; wgid = (xcd < r ? xcd * (q + 1) : r * (q + 1) + (xcd - r) * q) + off; }
        const int nig = WGM * nN, gid = wgid / nig, fm = gid * WGM, gsz = (nM - fm) < WGM ? (nM - fm) : WGM;
        u.pm = fm + ((wgid % nig) % gsz); u.pn = (wgid % nig) / gsz; return true;
    }
};
struct MoeUpOrder {
    int c;
    __device__ bool next(int i, Unit& u) const {
        if (i >= 11) return false;
        const int g = i * 8 + (c & 7), j = c >> 3, combo = 4 * g + (j >> 3), mt = j & 7, be = combo / 11, pn = combo % 11;
        u.pm = be * 8 + mt; u.pn = (be & 15) * 11 + pn; return true;
    }
};
struct MoeDownOrder {
    int c;
    __device__ bool next(int i, Unit& u) const {
        if (i >= 4) return false;
        const int be = i * 8 + (c & 7), j = c >> 3, mt = j & 7, pn = j >> 3;
        u.pm = be * 8 + mt; u.pn = (be & 15) * 4 + pn; return true;
    }
};

__device__ __forceinline__ float fast_silu(float a) { return a * __builtin_amdgcn_rcpf(1.0f + __expf(-a)); }
typedef __bf16 bf16x2_t __attribute__((ext_vector_type(2)));
__device__ __forceinline__ unsigned cvt_pk_bf16(float lo, float hi) { const f32x2 v = {lo, hi}; const bf16x2_t r = __builtin_convertvector(v, bf16x2_t); return __builtin_bit_cast(unsigned, r); }

__device__ __forceinline__ unsigned pk_fp8x4(float a, float b, float c, float d) {
    a = __builtin_amdgcn_fmed3f(a, -448.f, 448.f); b = __builtin_amdgcn_fmed3f(b, -448.f, 448.f); c = __builtin_amdgcn_fmed3f(c, -448.f, 448.f); d = __builtin_amdgcn_fmed3f(d, -448.f, 448.f);
    int w = 0; w = __builtin_amdgcn_cvt_pk_fp8_f32(a, b, w, false); w = __builtin_amdgcn_cvt_pk_fp8_f32(c, d, w, true); return (unsigned)w;
}
template <class Epi, class Sched, bool GATHER, bool F8 = false, bool ALIGN_EPI = PG8_ALIGN_DEFAULT>
__device__ __forceinline__ void gemm_phase(LAS unsigned char* lds, const Gemm g, const Sched& S, const Epi& E, const LAS unsigned* gtab) {
    const int tid = threadIdx.x, wid = __builtin_amdgcn_readfirstlane(tid >> 6), lane = tid & 63, wr = wid >> 2, wc = wid & 3, fr = lane & 15, fq = lane >> 4;
    constexpr int ESZ = F8 ? 1 : 2;
    const int K = g.K, nt = K * ESZ / (BK * 2);
    int sR[2], sC[2];
    unsigned voffB[2], voffA[2];
#pragma unroll
    for (int i = 0; i < 2; ++i) { stage_rc(tid * 16 + i * 8192, sR[i], sC[i]); const int Rb = Epi::PERM ? ((sR[i] & ~31) + perm32(sR[i] & 31)) : sR[i];
        voffB[i] = (unsigned)(Rb * K * ESZ + sC[i] * 2); voffA[i] = (unsigned)(sR[i] * K * ESZ + sC[i] * 2); }
    const size_t kstep = (size_t)(BK * 2);
    const size_t hstep = (size_t)HALF * K * ESZ;
    const size_t tstep = 2 * hstep;
    const unsigned ldsw = (unsigned)wid * 1024u;
    const int aoff = lds_byte(wr * 64 + fr, fq * 8), boff = lds_byte(wc * 32 + fr, fq * 8);
    const int sw8 = (fq & 1) * 8;
    const int aoff8a = lds_byte(wr * 64 + fr, fq * 16 + sw8), aoff8b = lds_byte(wr * 64 + fr, fq * 16 + (8 - sw8)), boff8a = lds_byte(wc * 32 + fr, fq * 16 + sw8), boff8b = lds_byte(wc * 32 + fr, fq * 16 + (8 - sw8));
#define PG8_SA(b, h) (((b) * 2 + (h)) * HTB)
#define PG8_SB(b, h) ((4 + (b) * 2 + (h)) * HTB)
#define PG8_STAGE(bufoff, gbase, voff) do { _Pragma("unroll") for (int _i = 0; _i < 2; ++_i) \
        __builtin_amdgcn_global_load_lds((const unsigned*)((const char*)(gbase) + (voff)[_i]), (LAS unsigned*)(lds + (bufoff) + ldsw + _i * 8192), 16, 0, 0); } while (0)
#define PG8_LDA(dst, b, h) do { if constexpr (F8) { _Pragma("unroll") for (int m = 0; m < 4; ++m) { const i32x4 lo_ = *(const LAS i32x4*)(lds + PG8_SA(b, h) + aoff8a + m * 2048), hi_ = *(const LAS i32x4*)(lds + PG8_SA(b, h) + aoff8b + m * 2048); \
            dst##8[m] = __builtin_shufflevector(lo_, hi_, 0, 1, 2, 3, 4, 5, 6, 7); } } \
        else { _Pragma("unroll") for (int m = 0; m < 4; ++m) _Pragma("unroll") for (int k = 0; k < 2; ++k) dst[m][k] = *(const LAS bf16x8*)(lds + PG8_SA(b, h) + aoff + m * 2048 + k * 1024); } } while (0)
#define PG8_LDB(dst, b, h) do { if constexpr (F8) { _Pragma("unroll") for (int n = 0; n < 2; ++n) { const i32x4 lo_ = *(const LAS i32x4*)(lds + PG8_SB(b, h) + boff8a + n * 2048), hi_ = *(const LAS i32x4*)(lds + PG8_SB(b, h) + boff8b + n * 2048); \
            dst##8[n] = __builtin_shufflevector(lo_, hi_, 0, 1, 2, 3, 4, 5, 6, 7); } } \
        else { _Pragma("unroll") for (int n = 0; n < 2; ++n) _Pragma("unroll") for (int k = 0; k < 2; ++k) dst[n][k] = *(const LAS bf16x8*)(lds + PG8_SB(b, h) + boff + n * 2048 + k * 1024); } } while (0)
#define PG8_MMA(ai, bj, At, Bt) do { __builtin_amdgcn_s_setprio(1); if constexpr (F8) { _Pragma("unroll") for (int m = 0; m < 4; ++m) _Pragma("unroll") for (int n = 0; n < 2; ++n) \
            asm volatile("v_mfma_f32_16x16x128_f8f6f4 %0, %1, %2, %0" : "+v"(acc[ai][bj][m][n]) : "v"(Bt##8[n]), "v"(At##8[m])); } \
        else { _Pragma("unroll") for (int m = 0; m < 4; ++m) _Pragma("unroll") for (int n = 0; n < 2; ++n) _Pragma("unroll") for (int k = 0; k < 2; ++k) \
            acc[ai][bj][m][n] = __builtin_amdgcn_mfma_f32_16x16x32_bf16(Bt[n][k], At[m][k], acc[ai][bj][m][n], 0, 0, 0); } __builtin_amdgcn_s_setprio(0); } while (0)
#define PG8_WAIT_V(n) asm volatile("s_waitcnt vmcnt(" #n ")" ::: "memory")
#define PG8_WAIT_L(n) asm volatile("s_waitcnt lgkmcnt(" #n ")" ::: "memory")
#define PG8_BAR __builtin_amdgcn_s_barrier()
#define PG8_SCHED __builtin_amdgcn_sched_barrier(0)
#define PG8_HOFF(h) (GATHER ? (size_t)0 : (size_t)(h) * hstep)
#define PG8_STAGE_A(bufoff, base_, h_, uq_) do { if constexpr (GATHER) { unsigned vo_[2]; _Pragma("unroll") for (int _i = 0; _i < 2; ++_i) vo_[_i] = gtab[(uq_) * 256 + (h_) * HALF + sR[_i]] + (unsigned)sC[_i] * 2u; PG8_STAGE(bufoff, base_, vo_); } \
        else { PG8_STAGE(bufoff, (base_) + PG8_HOFF(h_), voffA); } } while (0)
    Unit cur, nxt; int ui = 0;
    if (!S.next(0, cur)) return;
    f32x4 acc[2][2][4][2];
#pragma unroll
    for (int a = 0; a < 2; ++a)
#pragma unroll
        for (int b = 0; b < 2; ++b)
#pragma unroll
            for (int m = 0; m < 4; ++m)
#pragma unroll
                for (int n = 0; n < 2; ++n) acc[a][b][m][n] = (f32x4){0.f, 0.f, 0.f, 0.f};
    bf16x8 At[4][2], B0[2][2], B1[2][2]; i32x8 At8[4], B08[2], B18[2];
    const char* cA = (const char*)g.A + (GATHER ? (size_t)0 : (size_t)cur.pm * tstep); const char* cB = (const char*)g.Bt + (size_t)cur.pn * tstep;
    PG8_STAGE(PG8_SB(0, 0), cB, voffB); PG8_STAGE(PG8_SB(0, 1), cB + hstep, voffB); PG8_STAGE_A(PG8_SA(0, 0), cA, 0, 0); PG8_STAGE_A(PG8_SA(0, 1), cA, 1, 0);
    if (wr == 1) PG8_BAR;
    PG8_WAIT_V(2); PG8_BAR;
    PG8_STAGE(PG8_SB(1, 0), cB + kstep, voffB); PG8_STAGE_A(PG8_SA(1, 0), cA + kstep, 0, 0); PG8_STAGE(PG8_SB(1, 1), cB + hstep + kstep, voffB);
    PG8_WAIT_V(6); PG8_BAR;
    for (;;) {
        const bool has_next = S.next(ui + 1, nxt);
        const char* nA = GATHER ? cA : (has_next ? (const char*)g.A + (size_t)nxt.pm * tstep : cA); const char* nB = has_next ? (const char*)g.Bt + (size_t)nxt.pn * tstep : cB;
#pragma unroll 1
        for (int t = 0; t < nt; t += 2) {
            const bool last = (t == nt - 2);
            const char* a1 = cA + (size_t)(t + 1) * kstep;
            const char* a2 = last ? nA : cA + (size_t)(t + 2) * kstep; const char* b2 = last ? nB : cB + (size_t)(t + 2) * kstep;
            const char* a3 = a2 + kstep; const char* b3 = b2 + kstep;
            const int uq = (last && has_next) ? ui + 1 : ui;
            PG8_LDB(B0, 0, 0); PG8_LDB(B1, 0, 1); PG8_SCHED; PG8_LDA(At, 0, 0); PG8_STAGE_A(PG8_SA(1, 1), a1, 1, ui);
            PG8_WAIT_V(8); PG8_WAIT_L(0); PG8_BAR; PG8_MMA(0, 0, At, B0); PG8_MMA(0, 1, At, B1); PG8_BAR; PG8_SCHED;
            PG8_LDA(At, 0, 1); PG8_STAGE(PG8_SB(0, 0), b2, voffB); PG8_STAGE(PG8_SB(0, 1), b2 + hstep, voffB); PG8_STAGE_A(PG8_SA(0, 0), a2, 0, uq);
            PG8_WAIT_V(8); PG8_WAIT_L(0); PG8_BAR; PG8_MMA(1, 0, At, B0); PG8_MMA(1, 1, At, B1); PG8_BAR; PG8_SCHED;
            PG8_LDB(B0, 1, 0); PG8_LDB(B1, 1, 1); PG8_SCHED; PG8_LDA(At, 1, 0); PG8_STAGE_A(PG8_SA(0, 1), a2, 1, uq);
            PG8_WAIT_V(8); PG8_WAIT_L(0); PG8_BAR; PG8_MMA(0, 0, At, B0); PG8_MMA(0, 1, At, B1); PG8_BAR; PG8_SCHED;
            PG8_LDA(At, 1, 1); PG8_STAGE(PG8_SB(1, 0), b3, voffB); PG8_STAGE(PG8_SB(1, 1), b3 + hstep, voffB); PG8_STAGE_A(PG8_SA(1, 0), a3, 0, uq);
            PG8_WAIT_V(8); PG8_WAIT_L(0); PG8_BAR; PG8_MMA(1, 0, At, B0); PG8_MMA(1, 1, At, B1); PG8_BAR; PG8_SCHED;
        }
        if constexpr (ALIGN_EPI) { if (wr == 0) PG8_BAR; }
        if constexpr (F8) { asm volatile("s_nop 15\n\ts_nop 15" ::: "memory"); PG8_SCHED; }
        E(acc, cur, ui, wr, wc, fr, fq);
        if (!has_next) break;
#pragma unroll
        for (int a = 0; a < 2; ++a)
#pragma unroll
            for (int b = 0; b < 2; ++b)
#pragma unroll
                for (int m = 0; m < 4; ++m)
#pragma unroll
                    for (int n = 0; n < 2; ++n) acc[a][b][m][n] = (f32x4){0.f, 0.f, 0.f, 0.f};
        cur = nxt; cA = nA; cB = nB; ++ui;
        if constexpr (ALIGN_EPI) { if (wr == 1) PG8_BAR; }
    }
    PG8_WAIT_V(0);
    if constexpr (!ALIGN_EPI) { if (wr == 0) PG8_BAR; }
    PG8_BAR;
#undef PG8_SA
#undef PG8_SB
#undef PG8_STAGE
#undef PG8_LDA
#undef PG8_LDB
#undef PG8_MMA
#undef PG8_WAIT_V
#undef PG8_WAIT_L
#undef PG8_BAR
#undef PG8_SCHED
#undef PG8_STAGE_A
#undef PG8_HOFF
}


struct EpiProj {
    static constexpr bool PERM = true;
    bf16_t* P; float* GZ; const float* tab;
    __device__ __forceinline__ void operator()(const f32x4 (&acc)[2][2][4][2], const Unit& u, int ui, int wr, int wc, int fr, int fq) const {
        const int pn = u.pn, row0 = u.pm * BM + wr * 64 + fr, colw = wc * 32 + 8 * fq;
        if (pn == 14) {
            if (wc == 0) {
#pragma unroll
                for (int ai = 0; ai < 2; ++ai)
#pragma unroll
                    for (int m = 0; m < 4; ++m) { float* o = GZ + (size_t)(row0 + ai * HALF + m * 16) * 32 + 8 * fq; *(f32x4*)o = acc[ai][0][m][0]; *(f32x4*)(o + 4) = acc[ai][0][m][1]; }
            }
            return;
        }
        const int mode = (pn == 0) ? 1 : ((pn == 4 || pn == 5 || pn >= 12) ? 2 : ((pn >= 6 && pn <= 9) ? 3 : 0));
        const float rks = (pn >= 8) ? 0.08838834764831845f : 1.0f;
        const bool lowhalf = wc < 2;
        const int f0 = (16 * wc + 4 * fq) & 31;
#pragma unroll
        for (int ai = 0; ai < 2; ++ai)
#pragma unroll
            for (int m = 0; m < 4; ++m) {
                const int row = row0 + ai * HALF + m * 16;
                bf16_t* rowp = P + ptile(row, pn * BM + colw);
                f32x4 cs0 = {1.f, 0.f, 1.f, 0.f}, cs1 = {1.f, 0.f, 1.f, 0.f};
                if (mode == 3 && row < NLAT) { const int t = row & (SEQ - 1), pos = lowhalf ? (t >> 6) : (t & 63); const float* tp = tab + 2 * (pos * 32 + f0); cs0 = *(const f32x4*)tp; cs1 = *(const f32x4*)(tp + 4); }
#pragma unroll
                for (int bj = 0; bj < 2; ++bj) {
                    f32x4 v0 = acc[ai][bj][m][0], v1 = acc[ai][bj][m][1];
                    if (mode == 1) { v0 = v0 * 0.125f; v1 = v1 * 0.125f; }
                    else if (mode == 2) {
#pragma unroll
                        for (int e = 0; e < 4; ++e) { v0[e] = fast_silu(v0[e]); v1[e] = fast_silu(v1[e]); }
                    } else if (mode == 3) {
                        v0 = v0 * rks; v1 = v1 * rks;
                        const float c[4] = {cs0[0], cs0[2], cs1[0], cs1[2]}, s[4] = {cs0[1], cs0[3], cs1[1], cs1[3]};
#pragma unroll
                        for (int e = 0; e < 4; ++e) { const float a1 = v0[e], a2 = v1[e]; v0[e] = a1 * c[e] - a2 * s[e]; v1[e] = a1 * s[e] + a2 * c[e]; }
                    }
                    u32x4 w; w.x = cvt_pk_bf16(v0[0], v0[1]); w.y = cvt_pk_bf16(v0[2], v0[3]); w.z = cvt_pk_bf16(v1[0], v1[1]); w.w = cvt_pk_bf16(v1[2], v1[3]);
                    *(u32x4*)(rowp + bj * 8192) = w;
                }
            }
    }
};
struct EpiOut {
    static constexpr bool PERM = true;
    bf16_t* XO; const float* mod;
    __device__ __forceinline__ void operator()(const f32x4 (&acc)[2][2][4][2], const Unit& u, int ui, int wr, int wc, int fr, int fq) const {
        const int col0 = u.pn * BM + wc * 32 + 8 * fq, b = (u.pm * BM) / SEQ;
        const float* m2 = mod + b * NADA * D + 2 * D;
        f32x4 mv[2][2];
#pragma unroll
        for (int bj = 0; bj < 2; ++bj)
#pragma unroll
            for (int n = 0; n < 2; ++n) mv[bj][n] = *(const f32x4*)(m2 + col0 + bj * HALF + 4 * n);
#pragma unroll
        for (int ai = 0; ai < 2; ++ai)
#pragma unroll
            for (int m = 0; m < 4; ++m) { bf16_t* rowp = XO + (size_t)(u.pm * BM + ai * HALF + wr * 64 + m * 16 + fr) * D + col0;
#pragma unroll
                for (int bj = 0; bj < 2; ++bj) { const f32x4 v0 = mv[bj][0] * acc[ai][bj][m][0], v1 = mv[bj][1] * acc[ai][bj][m][1];
                    u32x4 w; w.x = cvt_pk_bf16(v0[0], v0[1]); w.y = cvt_pk_bf16(v0[2], v0[3]); w.z = cvt_pk_bf16(v1[0], v1[1]); w.w = cvt_pk_bf16(v1[2], v1[3]);
                    *(u32x4*)(rowp + bj * HALF) = w; } }
    }
};
struct EpiAct {
    static constexpr bool PERM = true;
    unsigned char* ACT; float wscale, ascale;
    __device__ __forceinline__ void operator()(const f32x4 (&acc)[2][2][4][2], const Unit& u, int ui, int wr, int wc, int fr, int fq) const {
        const int pnl = u.pn % 11, col0 = pnl * HALF + wc * 32 + 8 * fq;
#pragma unroll
        for (int ai = 0; ai < 2; ++ai)
#pragma unroll
            for (int m = 0; m < 4; ++m) { unsigned char* rowp = ACT + (size_t)(u.pm * BM + ai * HALF + wr * 64 + m * 16 + fr) * FFP;
                f32x4 v0, v1;
#pragma unroll
                for (int e = 0; e < 4; ++e) { const float a0 = acc[ai][0][m][0][e] * wscale, a1 = acc[ai][0][m][1][e] * wscale;
                    v0[e] = fast_silu(a0) * (acc[ai][1][m][0][e] * (wscale * ascale)); v1[e] = fast_silu(a1) * (acc[ai][1][m][1][e] * (wscale * ascale)); }
                u32x2 w; w.x = pk_fp8x4(v0[0], v0[1], v0[2], v0[3]); w.y = pk_fp8x4(v1[0], v1[1], v1[2], v1[3]);
                *(u32x2*)(rowp + col0) = w;
                if (pnl == 10) *(u32x2*)(rowp + FF + wc * 32 + 8 * fq) = (u32x2){0u, 0u}; }
    }
};
struct EpiDown {
    static constexpr bool PERM = true;
    bf16_t* YE; const float* gate; float oscale;
    __device__ __forceinline__ void operator()(const f32x4 (&acc)[2][2][4][2], const Unit& u, int ui, int wr, int wc, int fr, int fq) const {
        const int col0 = (u.pn & 3) * BM + wc * 32 + 8 * fq;
#pragma unroll
        for (int ai = 0; ai < 2; ++ai)
#pragma unroll
            for (int m = 0; m < 4; ++m) { const int row = u.pm * BM + ai * HALF + wr * 64 + m * 16 + fr; const float gt = gate[row] * oscale; bf16_t* rowp = YE + (size_t)row * D + col0;
#pragma unroll
                for (int bj = 0; bj < 2; ++bj) { const f32x4 v0 = acc[ai][bj][m][0] * gt, v1 = acc[ai][bj][m][1] * gt;
                    u32x4 w; w.x = cvt_pk_bf16(v0[0], v0[1]); w.y = cvt_pk_bf16(v0[2], v0[3]); w.z = cvt_pk_bf16(v1[0], v1[1]); w.w = cvt_pk_bf16(v1[2], v1[3]);
                    *(u32x4*)(rowp + bj * HALF) = w; } }
    }
};
}

namespace scan {
constexpr int RS = 72;
constexpr int RS2 = 136;
constexpr int OS = 132;
constexpr int NSL = 260;
constexpr size_t GLA_SLOT = 128 * 64, RET_SLOT = 128 * 128;
constexpr size_t US_RET_OFF = (size_t)16 * NSL * GLA_SLOT;
__device__ __forceinline__ int slot_row0(int b, int slot) { return slot < 4 ? NLAT + b * CTX + slot * 64 : b * SEQ + (slot - 4) * 64; }
__device__ __forceinline__ int slot_at(int dir, int step) { return dir ? (step < 4 ? 3 - step : 263 - step) : step; }
__device__ __forceinline__ f32x4 mfma16(bf16x8 a, bf16x8 b, f32x4 c) { return __builtin_amdgcn_mfma_f32_16x16x32_bf16(a, b, c, 0, 0, 0); }
__device__ __forceinline__ bf16x8 lds_frag(const LAS bf16_t* base, int off) { return *(const LAS bf16x8*)(base + off); }
__device__ __forceinline__ int tsw_w(int row, int j) { return row * RS + ((((j >> 3) ^ ((row >> 4) & 7)) << 3) | (j & 7)); }
__device__ __forceinline__ int tsw_r(int row, int chunk) { return row * RS + ((chunk ^ ((row >> 4) & 7)) << 3); }
__device__ __forceinline__ bf16x8 lds_frag_pi(const LAS bf16_t* base, int off  ) {
    typedef short s4 __attribute__((ext_vector_type(4)));
    const s4 lo = *(const LAS s4*)(base + off), hi = *(const LAS s4*)(base + off + 16);
    return (bf16x8){lo[0], lo[1], lo[2], lo[3], hi[0], hi[1], hi[2], hi[3]};
}
__device__ __forceinline__ unsigned pk(float lo, float hi) { return pg8::cvt_pk_bf16(lo, hi); }
__device__ __forceinline__ bf16_t f2bf_hw(float x) { return (bf16_t)(pg8::cvt_pk_bf16(x, 0.f) & 0xffffu); }
__device__ __forceinline__ u32x2 pack_state8(const f32x4 a0, const f32x4 a1) { u32x2 o; o.x = pg8::pk_fp8x4(a0[0], a0[1], a0[2], a0[3]); o.y = pg8::pk_fp8x4(a1[0], a1[1], a1[2], a1[3]); return o; }
__device__ __forceinline__ bf16x8 unpack_state8(const u32x2 w) {
    const f32x2 a = __builtin_amdgcn_cvt_pk_f32_fp8((int)w.x, false), b = __builtin_amdgcn_cvt_pk_f32_fp8((int)w.x, true), c = __builtin_amdgcn_cvt_pk_f32_fp8((int)w.y, false), d = __builtin_amdgcn_cvt_pk_f32_fp8((int)w.y, true);
    const u32x4 r = {pk(a[0], a[1]), pk(b[0], b[1]), pk(c[0], c[1]), pk(d[0], d[1])};
    return __builtin_bit_cast(bf16x8, r);
}

__device__ __forceinline__ void gla_stepA(const float (&wf)[16], const float (&wb)[16], float bf, float bb, int w, int k, const LAS float* gz_s, LAS float* tot, float (&bi)[8], float (&ci)[8], float& allf, float& allb) {
    float laf[8], lab[8];
#pragma unroll
    for (int tt = 0; tt < 8; ++tt) {
        const LAS f32x4* g4 = (const LAS f32x4*)(gz_s + (8 * w + tt) * 32);
        float pf = bf, pb = bb;
#pragma unroll
        for (int r4 = 0; r4 < 4; ++r4) { const f32x4 a = g4[r4], b = g4[4 + r4];
#pragma unroll
            for (int e = 0; e < 4; ++e) { pf += a[e] * wf[4 * r4 + e]; pb += b[e] * wb[4 * r4 + e]; } }
        laf[tt] = (fminf(pf, 0.f) - __logf(1.0f + __expf(-fabsf(pf)))) * 0.0625f;
        lab[tt] = (fminf(pb, 0.f) - __logf(1.0f + __expf(-fabsf(pb)))) * 0.0625f;
    }
#pragma unroll
    for (int tt = 1; tt < 8; ++tt) laf[tt] += laf[tt - 1];
#pragma unroll
    for (int tt = 6; tt >= 0; --tt) lab[tt] += lab[tt + 1];
    tot[w * 64 + k] = laf[7]; tot[512 + w * 64 + k] = lab[0];
    __syncthreads();
    float offf = 0.f, offb = 0.f; allf = 0.f; allb = 0.f;
#pragma unroll
    for (int w2 = 0; w2 < 8; ++w2) { const float tf = tot[w2 * 64 + k], tb = tot[512 + w2 * 64 + k]; allf += tf; allb += tb; if (w2 < w) offf += tf; if (w2 > w) offb += tb; }
#pragma unroll
    for (int tt = 0; tt < 8; ++tt) { bi[tt] = offf + laf[tt]; ci[tt] = offb + lab[tt]; }
}
__device__ __forceinline__ void stage_vt_regs(const u32x4 a, const u32x4 b, LAS bf16_t* VT, int tid) {
    const int j = tid >> 3, vg = tid & 7;
    const unsigned wv[8] = {a.x, a.y, a.z, a.w, b.x, b.y, b.z, b.w};
#pragma unroll
    for (int e = 0; e < 8; ++e) { VT[tsw_w(vg * 16 + 2 * e, j)] = (bf16_t)(wv[e] & 0xffffu); VT[tsw_w(vg * 16 + 2 * e + 1, j)] = (bf16_t)(wv[e] >> 16); }
}
#define SCAN_FENCE() asm volatile("" ::: "memory")

__device__ __forceinline__ void run_c1(const Ptrs& p, LAS unsigned char* lds, int bx) {
    const int tid = threadIdx.x, w = __builtin_amdgcn_readfirstlane(tid >> 6), lane = tid & 63, c = lane & 15, q = lane >> 4;
    const int bh = bx >> 5, b = bh >> 2, h = bh & 3, s0 = bx & 31;
    const bf16_t* P = (const bf16_t*)(p.ws + WS_P);
    const int jrow = tid >> 3, g8 = tid & 7;
    {
        LAS float* gz_s = (LAS float*)lds; LAS float* tot = (LAS float*)(lds + 8192);
        LAS bf16_t* KfT = (LAS bf16_t*)(lds + 12288); LAS bf16_t* KbT = (LAS bf16_t*)(lds + 21504); LAS bf16_t* VT = (LAS bf16_t*)(lds + 30720); LAS bf16_t* Kraw = (LAS bf16_t*)(lds + 49152);
        float wf[16], wb[16];
#pragma unroll
        for (int r = 0; r < 16; ++r) { wf[r] = p.gla_gate_w[r * 256 + h * 64 + lane]; wb[r] = p.gla_gate_w[(16 + r) * 256 + h * 64 + lane]; }
        const float bf = p.gla_gate_b[h * 64 + lane], bb = p.gla_gate_b[256 + h * 64 + lane];
        f32x4 gzv; u32x4 va, vb, kv;
#define C1G_LOAD(slot_) do { const int r0_ = slot_row0(b, (slot_)); gzv = ((const f32x4*)((const float*)(p.ws + WS_GZ) + (size_t)r0_ * 32))[tid]; \
            const bf16_t* rv_ = P + ptile(r0_ + jrow, C_GV + h * 128 + g8 * 16); va = *(const u32x4*)rv_; vb = *(const u32x4*)(rv_ + 8); \
            kv = *(const u32x4*)(P + ptile(r0_ + jrow, C_GK + h * 64 + g8 * 8)); } while (0)
        C1G_LOAD(s0);
        for (int slot = s0; slot < NSL; slot += 32) {
            ((LAS f32x4*)gz_s)[tid] = gzv; stage_vt_regs(va, vb, VT, tid); *(LAS u32x4*)(Kraw + jrow * RS + g8 * 8) = kv;
            __syncthreads();
            if (slot + 32 < NSL) C1G_LOAD(slot + 32);
            float bi[8], ci[8], allf, allb;
            gla_stepA(wf, wb, bf, bb, w, lane, gz_s, tot, bi, ci, allf, allb);
            { float ef[8], eb[8];
#pragma unroll
              for (int tt = 0; tt < 8; ++tt) { const float kk = bf2f(Kraw[(8 * w + tt) * RS + lane]); ef[tt] = kk * __expf(allf - bi[tt]); eb[tt] = kk * __expf(allb - ci[tt]); }
              u32x4 wf_, wb_; wf_.x = pk(ef[0], ef[1]); wf_.y = pk(ef[2], ef[3]); wf_.z = pk(ef[4], ef[5]); wf_.w = pk(ef[6], ef[7]);
              wb_.x = pk(eb[0], eb[1]); wb_.y = pk(eb[2], eb[3]); wb_.z = pk(eb[4], eb[5]); wb_.w = pk(eb[6], eb[7]);
              *(LAS u32x4*)(KfT + lane * RS + 8 * w) = wf_; *(LAS u32x4*)(KbT + lane * RS + 8 * w) = wb_; }
            float* DCH = (float*)(p.ws + WS_DCH);
            if (w == 0) { DCH[((size_t)(bh * 2 + 0) * NSL + slot) * 64 + lane] = __expf(allf); DCH[((size_t)(bh * 2 + 1) * NSL + slot) * 64 + lane] = __expf(allb); }
            __syncthreads();
            unsigned char* US = (unsigned char*)p.out;
            bf16x8 Bv[2];
#pragma unroll
            for (int js = 0; js < 2; ++js) Bv[js] = lds_frag(VT, tsw_r(16 * w + c, 4 * js + q));
#pragma unroll
            for (int dir = 0; dir < 2; ++dir) { const LAS bf16_t* KT = dir ? KbT : KfT;
#pragma unroll
                for (int ks = 0; ks < 2; ++ks) { f32x4 a0 = {0.f, 0.f, 0.f, 0.f}, a1 = {0.f, 0.f, 0.f, 0.f};
#pragma unroll
                    for (int js = 0; js < 2; ++js) { a0 = mfma16(lds_frag(KT, (32 * ks + c) * RS + 32 * js + 8 * q), Bv[js], a0); a1 = mfma16(lds_frag(KT, (32 * ks + 16 + c) * RS + 32 * js + 8 * q), Bv[js], a1); }
                    *(u32x2*)(US + ((size_t)(bh * 2 + dir) * NSL + slot) * GLA_SLOT + ((w * 2 + ks) * 64 + lane) * 8) = pack_state8(a0, a1); } }
            __syncthreads();
        }
#undef C1G_LOAD
    }
    {
        LAS bf16_t* KT = (LAS bf16_t*)lds; LAS bf16_t* VfT = (LAS bf16_t*)(lds + 18432); LAS bf16_t* VbT = (LAS bf16_t*)(lds + 36864);
        const float lgf = log_sigmoidf(p.ret_decay_logit[h]), lgb = log_sigmoidf(p.ret_decay_logit[4 + h]);
        const float sf = __expf(lgf * (float)(63 - jrow)), sb = __expf(lgb * (float)jrow);
        u32x4 ka, kb, va, vb;
#define C1R_LOAD(slot_) do { const int rr_ = slot_row0(b, (slot_)) + jrow; const bf16_t* rk_ = P + ptile(rr_, C_RK + h * 128 + g8 * 16); const bf16_t* rv_ = P + ptile(rr_, C_RV + h * 128 + g8 * 16); \
            ka = *(const u32x4*)rk_; kb = *(const u32x4*)(rk_ + 8); va = *(const u32x4*)rv_; vb = *(const u32x4*)(rv_ + 8); } while (0)
        C1R_LOAD(s0);
        for (int slot = s0; slot < NSL; slot += 32) {
            { const unsigned kw[8] = {ka.x, ka.y, ka.z, ka.w, kb.x, kb.y, kb.z, kb.w}, vw[8] = {va.x, va.y, va.z, va.w, vb.x, vb.y, vb.z, vb.w};
#pragma unroll
              for (int e = 0; e < 8; ++e) { const int r0 = tsw_w(g8 * 16 + 2 * e, jrow), r1 = tsw_w(g8 * 16 + 2 * e + 1, jrow);
                  KT[r0] = (bf16_t)(kw[e] & 0xffffu); KT[r1] = (bf16_t)(kw[e] >> 16);
                  const float v0 = __uint_as_float(vw[e] << 16), v1 = __uint_as_float(vw[e] & 0xffff0000u);
                  VfT[r0] = f2bf_hw(v0 * sf); VfT[r1] = f2bf_hw(v1 * sf); VbT[r0] = f2bf_hw(v0 * sb); VbT[r1] = f2bf_hw(v1 * sb); } }
            __syncthreads();
            if (slot + 32 < NSL) C1R_LOAD(slot + 32);
            unsigned char* US = (unsigned char*)p.out + US_RET_OFF;
#pragma unroll
            for (int dir = 0; dir < 2; ++dir) { const LAS bf16_t* VT = dir ? VbT : VfT;
                bf16x8 Bv[2];
#pragma unroll
                for (int js = 0; js < 2; ++js) Bv[js] = lds_frag(VT, tsw_r(16 * w + c, 4 * js + q));
#pragma unroll
                for (int ks = 0; ks < 4; ++ks) { f32x4 a0 = {0.f, 0.f, 0.f, 0.f}, a1 = {0.f, 0.f, 0.f, 0.f};
#pragma unroll
                    for (int js = 0; js < 2; ++js) { a0 = mfma16(lds_frag(KT, tsw_r(32 * ks + c, 4 * js + q)), Bv[js], a0); a1 = mfma16(lds_frag(KT, tsw_r(32 * ks + 16 + c, 4 * js + q)), Bv[js], a1); }
                    *(u32x2*)(US + ((size_t)(bh * 2 + dir) * NSL + slot) * RET_SLOT + ((w * 4 + ks) * 64 + lane) * 8) = pack_state8(a0, a1); } }
            __syncthreads();
        }
#undef C1R_LOAD
    }
}
template <int G>
__device__ __forceinline__ void c2_scan(const Ptrs& p, int chain, int grp  ) {
    constexpr size_t SLOT = G ? RET_SLOT : GLA_SLOT;
    constexpr int NB = 10;
    const int dir = chain & 1, h = (chain >> 1) & 3;
    const unsigned char* base = (const unsigned char*)p.out + (G ? US_RET_OFF : 0) + (size_t)chain * NSL * SLOT + (size_t)grp * 4;
    bf16_t* sbase = (bf16_t*)(p.ws + WS_US) + (G ? US_RET_OFF : 0) + (size_t)chain * NSL * SLOT + (size_t)grp * 4;
    float dconst = 0.f; const float* dch = nullptr;
    if (G) dconst = __expf(64.0f * log_sigmoidf(p.ret_decay_logit[dir * 4 + h]));
    else { const int el = grp * 4, e0 = el & 7, ln = (el >> 3) & 63, ks = (el >> 9) & 1; dch = (const float*)(p.ws + WS_DCH) + (size_t)chain * NSL * 64 + 32 * ks + 16 * (e0 >> 2) + 4 * (ln >> 4); }
    f32x4 s = {0.f, 0.f, 0.f, 0.f};
    unsigned uA[NB], uB[NB]; f32x4 dA[NB], dB[NB];
#define C2_LOAD(U_, D_, bt_) do { _Pragma("unroll") for (int i = 0; i < NB; ++i) { const int slot = slot_at(dir, (bt_) * NB + i); U_[i] = *(const unsigned*)(base + (size_t)slot * SLOT); if (!G) D_[i] = *(const f32x4*)(dch + slot * 64); } } while (0)
#define C2_PROC(U_, D_, bt_) do { _Pragma("unroll") for (int i = 0; i < NB; ++i) { const int slot = slot_at(dir, (bt_) * NB + i); \
        { u32x2 o_; o_.x = pk(s[0], s[1]); o_.y = pk(s[2], s[3]); *(u32x2*)(sbase + (size_t)slot * SLOT) = o_; } \
        const f32x2 lo_ = __builtin_amdgcn_cvt_pk_f32_fp8((int)U_[i], false), hi_ = __builtin_amdgcn_cvt_pk_f32_fp8((int)U_[i], true); const f32x4 u = {lo_[0], lo_[1], hi_[0], hi_[1]}; \
        if (G) s = s * dconst + u; else s = s * D_[i] + u; } } while (0)
    C2_LOAD(uA, dA, 0);
    for (int bt = 0; bt < NSL / NB; bt += 2) {
        C2_LOAD(uB, dB, bt + 1);
        C2_PROC(uA, dA, bt);
        if (bt + 2 < NSL / NB) C2_LOAD(uA, dA, bt + 2);
        C2_PROC(uB, dB, bt + 1);
    }
#undef C2_LOAD
#undef C2_PROC
}
__device__ __forceinline__ void run_c3(const Ptrs& p, LAS unsigned char* lds, int bx, bf16_t* Y) {
    const int tid = threadIdx.x, w = __builtin_amdgcn_readfirstlane(tid >> 6), lane = tid & 63, c = lane & 15, q = lane >> 4;
    const int bh = bx >> 5, b = bh >> 2, h = bh & 3, n0 = bx & 31;
    const bf16_t* P = (const bf16_t*)(p.ws + WS_P);
    const int jrow = tid >> 3, g8 = tid & 7;
    {
        LAS float* gz_s = (LAS float*)lds; LAS float* tot = (LAS float*)(lds + 8192);
        LAS bf16_t* QF = (LAS bf16_t*)(lds + 12288); LAS bf16_t* QB = (LAS bf16_t*)(lds + 21504); LAS bf16_t* KF = (LAS bf16_t*)(lds + 30720); LAS bf16_t* KB = (LAS bf16_t*)(lds + 39936);
        LAS bf16_t* VT = (LAS bf16_t*)(lds + 49152); LAS bf16_t* Pm = (LAS bf16_t*)(lds + 67584); LAS float* Os = (LAS float*)(lds + 76800);
        float wf[16], wb[16];
#pragma unroll
        for (int r = 0; r < 16; ++r) { wf[r] = p.gla_gate_w[r * 256 + h * 64 + lane]; wb[r] = p.gla_gate_w[(16 + r) * 256 + h * 64 + lane]; }
        const float bf = p.gla_gate_b[h * 64 + lane], bb = p.gla_gate_b[256 + h * 64 + lane];
        const f32x2 nw = *(const f32x2*)(p.gla_norm_w + h * 128 + 2 * lane);
        const bf16_t* US = (const bf16_t*)(p.ws + WS_US);
        f32x4 gzv; u32x4 va, vb, qv, kv; bf16x8 Sfn[2], Sbn[2]; unsigned gtn[8];
#define C3G_LOAD(n_) do { const int r0_ = b * SEQ + (n_) * 64; gzv = ((const f32x4*)((const float*)(p.ws + WS_GZ) + (size_t)r0_ * 32))[tid]; \
            const bf16_t* rv_ = P + ptile(r0_ + jrow, C_GV + h * 128 + g8 * 16); va = *(const u32x4*)rv_; vb = *(const u32x4*)(rv_ + 8); \
            qv = *(const u32x4*)(P + ptile(r0_ + jrow, C_GQ + h * 64 + g8 * 8)); kv = *(const u32x4*)(P + ptile(r0_ + jrow, C_GK + h * 64 + g8 * 8)); \
            _Pragma("unroll") for (int ks = 0; ks < 2; ++ks) { Sfn[ks] = *(const bf16x8*)(US + ((size_t)(bh * 2 + 0) * NSL + 4 + (n_)) * GLA_SLOT + ((w * 2 + ks) * 64 + lane) * 8); \
                                                          Sbn[ks] = *(const bf16x8*)(US + ((size_t)(bh * 2 + 1) * NSL + 4 + (n_)) * GLA_SLOT + ((w * 2 + ks) * 64 + lane) * 8); } \
            _Pragma("unroll") for (int tt = 0; tt < 8; ++tt) gtn[tt] = *(const unsigned*)(P + ptile(r0_ + 8 * w + tt, C_GG + h * 128 + 2 * lane)); } while (0)
        C3G_LOAD(n0);
        for (int n = n0; n < 256; n += 32) {
            const int row0 = b * SEQ + n * 64;
            ((LAS f32x4*)gz_s)[tid] = gzv; stage_vt_regs(va, vb, VT, tid);
            *(LAS u32x4*)(QF + jrow * RS + g8 * 8) = qv; *(LAS u32x4*)(KF + jrow * RS + g8 * 8) = kv;
            bf16x8 Sf[2], Sb[2]; unsigned gt[8];
#pragma unroll
            for (int ks = 0; ks < 2; ++ks) { Sf[ks] = Sfn[ks]; Sb[ks] = Sbn[ks]; }
#pragma unroll
            for (int tt = 0; tt < 8; ++tt) gt[tt] = gtn[tt];
            __syncthreads();
            if (n + 32 < 256) C3G_LOAD(n + 32);
            float bi[8], ci[8], allf, allb;
            gla_stepA(wf, wb, bf, bb, w, lane, gz_s, tot, bi, ci, allf, allb);
#pragma unroll
            for (int tt = 0; tt < 8; ++tt) { const int i = 8 * w + tt; const float qq = bf2f(QF[i * RS + lane]), kk = bf2f(KF[i * RS + lane]);
                QF[i * RS + lane] = f2bf_hw(qq * __expf(bi[tt])); QB[i * RS + lane] = f2bf_hw(qq * __expf(ci[tt]));
                KF[i * RS + lane] = f2bf_hw(kk * __expf(-bi[tt])); KB[i * RS + lane] = f2bf_hw(kk * __expf(-ci[tt])); }
            __syncthreads();
            { const int it = w & 3, i = 16 * it + c;
              bf16x8 qf[2], qb[2];
#pragma unroll
              for (int ks = 0; ks < 2; ++ks) { qf[ks] = lds_frag(QF, i * RS + 32 * ks + 8 * q); qb[ks] = lds_frag(QB, i * RS + 32 * ks + 8 * q); }
#pragma unroll
              for (int jj = 0; jj < 2; ++jj) { const int jt = 2 * (w >> 2) + jj; f32x4 af = {0.f, 0.f, 0.f, 0.f}, ab = {0.f, 0.f, 0.f, 0.f};
#pragma unroll
                  for (int ks = 0; ks < 2; ++ks) { af = mfma16(lds_frag(KF, (16 * jt + c) * RS + 32 * ks + 8 * q), qf[ks], af); ab = mfma16(lds_frag(KB, (16 * jt + c) * RS + 32 * ks + 8 * q), qb[ks], ab); }
                  float v[4];
#pragma unroll
                  for (int r = 0; r < 4; ++r) { const int j = 16 * jt + 4 * q + r; v[r] = (j <= i ? af[r] : 0.f) + (j >= i ? ab[r] : 0.f); }
                  u32x2 o; o.x = pk(v[0], v[1]); o.y = pk(v[2], v[3]); *(LAS u32x2*)(Pm + i * RS + 16 * jt + 4 * q) = o; } }
            __syncthreads();
            { bf16x8 Bv[2];
#pragma unroll
              for (int js = 0; js < 2; ++js) Bv[js] = lds_frag(VT, tsw_r(16 * w + c, 4 * js + q));
#pragma unroll
              for (int it = 0; it < 4; ++it) { f32x4 a = {0.f, 0.f, 0.f, 0.f}; const int i = 16 * it + c;
#pragma unroll
                  for (int js = 0; js < 2; ++js) a = mfma16(lds_frag(Pm, i * RS + 32 * js + 8 * q), Bv[js], a);
#pragma unroll
                  for (int ks = 0; ks < 2; ++ks) { a = mfma16(lds_frag_pi(QF, i * RS + 32 * ks + 4 * q), Sf[ks], a); a = mfma16(lds_frag_pi(QB, i * RS + 32 * ks + 4 * q), Sb[ks], a); }
#pragma unroll
                  for (int r = 0; r < 4; ++r) Os[(16 * it + 4 * q + r) * OS + 16 * w + c] = a[r]; } }
            __syncthreads();
#pragma unroll
            for (int tt = 0; tt < 8; ++tt) { const int i = 8 * w + tt; const f32x2 o = *(const LAS f32x2*)(Os + i * OS + 2 * lane);
                const float r = rsqrtf(wave_sum(o[0] * o[0] + o[1] * o[1]) * (1.f / 128.f) + EPS);
                *(unsigned*)(Y + (size_t)(row0 + i) * D + h * 128 + 2 * lane) = pk(o[0] * r * nw[0] * __uint_as_float(gt[tt] << 16), o[1] * r * nw[1] * __uint_as_float(gt[tt] & 0xffff0000u)); }
            __syncthreads();
        }
#undef C3G_LOAD
    }
    {
        LAS bf16_t* Qs = (LAS bf16_t*)lds; LAS bf16_t* Ks = (LAS bf16_t*)(lds + 17408); LAS bf16_t* VT = (LAS bf16_t*)(lds + 34816); LAS bf16_t* Pm = (LAS bf16_t*)(lds + 53248);
        LAS float* Os = (LAS float*)(lds + 62464); LAS float* pwf = (LAS float*)(lds + 96256); LAS float* pwb = pwf + 80;
        const float lgf = log_sigmoidf(p.ret_decay_logit[h]), lgb = log_sigmoidf(p.ret_decay_logit[4 + h]);
        if (tid < 65) { pwf[tid] = __expf(lgf * (float)tid); pwb[tid] = __expf(lgb * (float)tid); }
        const f32x2 nw = *(const f32x2*)(p.ret_norm_w + h * 128 + 2 * lane);
        const bf16_t* US = (const bf16_t*)(p.ws + WS_US) + US_RET_OFF;
        u32x4 qa, qb2, ka, kb2, va, vb; bf16x8 Sfn[4], Sbn[4]; unsigned gtn[8];
#define C3R_LOAD(n_) do { const int r0_ = b * SEQ + (n_) * 64; const bf16_t* rq_ = P + ptile(r0_ + jrow, C_RQ + h * 128 + g8 * 16); const bf16_t* rk_ = P + ptile(r0_ + jrow, C_RK + h * 128 + g8 * 16); const bf16_t* rv_ = P + ptile(r0_ + jrow, C_RV + h * 128 + g8 * 16); \
            qa = *(const u32x4*)rq_; qb2 = *(const u32x4*)(rq_ + 8); ka = *(const u32x4*)rk_; kb2 = *(const u32x4*)(rk_ + 8); \
            va = *(const u32x4*)rv_; vb = *(const u32x4*)(rv_ + 8); \
            _Pragma("unroll") for (int ks = 0; ks < 4; ++ks) { Sfn[ks] = *(const bf16x8*)(US + ((size_t)(bh * 2 + 0) * NSL + 4 + (n_)) * RET_SLOT + ((w * 4 + ks) * 64 + lane) * 8); \
                                                          Sbn[ks] = *(const bf16x8*)(US + ((size_t)(bh * 2 + 1) * NSL + 4 + (n_)) * RET_SLOT + ((w * 4 + ks) * 64 + lane) * 8); } \
            _Pragma("unroll") for (int tt = 0; tt < 8; ++tt) gtn[tt] = *(const unsigned*)(P + ptile(r0_ + 8 * w + tt, C_RG + h * 128 + 2 * lane)); } while (0)
        C3R_LOAD(n0);
        for (int n = n0; n < 256; n += 32) {
            const int row0 = b * SEQ + n * 64;
            *(LAS u32x4*)(Qs + jrow * RS2 + g8 * 16) = qa; *(LAS u32x4*)(Qs + jrow * RS2 + g8 * 16 + 8) = qb2;
            *(LAS u32x4*)(Ks + jrow * RS2 + g8 * 16) = ka; *(LAS u32x4*)(Ks + jrow * RS2 + g8 * 16 + 8) = kb2;
            stage_vt_regs(va, vb, VT, tid);
            bf16x8 Sf[4], Sb[4]; unsigned gt[8];
#pragma unroll
            for (int ks = 0; ks < 4; ++ks) { Sf[ks] = Sfn[ks]; Sb[ks] = Sbn[ks]; }
#pragma unroll
            for (int tt = 0; tt < 8; ++tt) gt[tt] = gtn[tt];
            __syncthreads();
            if (n + 32 < 256) C3R_LOAD(n + 32);
            { const int it = w & 3, i = 16 * it + c;
              bf16x8 qf[4];
#pragma unroll
              for (int ks = 0; ks < 4; ++ks) qf[ks] = lds_frag(Qs, i * RS2 + 32 * ks + 8 * q);
#pragma unroll
              for (int jj = 0; jj < 2; ++jj) { const int jt = 2 * (w >> 2) + jj; f32x4 a = {0.f, 0.f, 0.f, 0.f};
#pragma unroll
                  for (int ks = 0; ks < 4; ++ks) a = mfma16(lds_frag(Ks, (16 * jt + c) * RS2 + 32 * ks + 8 * q), qf[ks], a);
                  float v[4];
#pragma unroll
                  for (int r = 0; r < 4; ++r) { const int j = 16 * jt + 4 * q + r; const int dd = i - j; const float dm = (dd >= 0 ? pwf[dd >= 0 ? dd : 0] : 0.f) + (dd <= 0 ? pwb[dd <= 0 ? -dd : 0] : 0.f); v[r] = a[r] * dm; }
                  u32x2 o; o.x = pk(v[0], v[1]); o.y = pk(v[2], v[3]); *(LAS u32x2*)(Pm + i * RS + 16 * jt + 4 * q) = o; } }
            __syncthreads();
            { bf16x8 Bv[2];
#pragma unroll
              for (int js = 0; js < 2; ++js) Bv[js] = lds_frag(VT, tsw_r(16 * w + c, 4 * js + q));
#pragma unroll
              for (int it = 0; it < 4; ++it) { f32x4 a = {0.f, 0.f, 0.f, 0.f}, af = {0.f, 0.f, 0.f, 0.f}, ab = {0.f, 0.f, 0.f, 0.f}; const int i = 16 * it + c;
#pragma unroll
                  for (int js = 0; js < 2; ++js) a = mfma16(lds_frag(Pm, i * RS + 32 * js + 8 * q), Bv[js], a);
#pragma unroll
                  for (int ks = 0; ks < 4; ++ks) { const bf16x8 qx = lds_frag_pi(Qs, i * RS2 + 32 * ks + 4 * q); af = mfma16(qx, Sf[ks], af); ab = mfma16(qx, Sb[ks], ab); }
#pragma unroll
                  for (int r = 0; r < 4; ++r) { const int ii = 16 * it + 4 * q + r; Os[ii * OS + 16 * w + c] = a[r] + pwf[ii + 1] * af[r] + pwb[64 - ii] * ab[r]; } } }
            __syncthreads();
#pragma unroll
            for (int tt = 0; tt < 8; ++tt) { const int i = 8 * w + tt; const f32x2 o = *(const LAS f32x2*)(Os + i * OS + 2 * lane);
                const float mu = wave_sum(o[0] + o[1]) * (1.f / 128.f); const float d0 = o[0] - mu, d1 = o[1] - mu;
                const float r = rsqrtf(wave_sum(d0 * d0 + d1 * d1) * (1.f / 128.f) + EPS);
                *(unsigned*)(Y + (size_t)(row0 + i) * D + 512 + h * 128 + 2 * lane) = pk(d0 * r * nw[0] * __uint_as_float(gt[tt] << 16), d1 * r * nw[1] * __uint_as_float(gt[tt] & 0xffff0000u)); }
            __syncthreads();
        }
#undef C3R_LOAD
    }
}
}

namespace misc {
__device__ __forceinline__ void p0_mod(const Ptrs& p, LAS unsigned char* lds, int bx) {
    LAS float* sc = (LAS float*)lds;
    LAS float* red = sc + 3 * D;
    const int tid = threadIdx.x;
    for (int i = tid; i < 3 * D; i += NTHR) { const int r = i >> 10, k = i & 1023; const float v = (r < 2) ? p.c[r * D + k] : p.c_ctx[k]; sc[i] = siluf(v); }
    __syncthreads();
    const int kg = tid >> 5, cl = tid & 31, col = 24 * bx + cl;
    float a0 = 0.f, a1 = 0.f, a2 = 0.f;
    if (cl < 24) {
#pragma unroll 8
        for (int k = kg * 64; k < kg * 64 + 64; ++k) { const float w = p.w_ada[(size_t)k * (NADA * D) + col]; a0 += sc[k] * w; a1 += sc[D + k] * w; a2 += sc[2 * D + k] * w; }
    }
    red[(kg * 3 + 0) * 32 + cl] = a0; red[(kg * 3 + 1) * 32 + cl] = a1; red[(kg * 3 + 2) * 32 + cl] = a2;
    __syncthreads();
    if (tid < 96) { const int r = tid >> 5, c2 = tid & 31; if (c2 < 24) { float s = 0.f;
#pragma unroll
        for (int g = 0; g < 16; ++g) s += red[(g * 3 + r) * 32 + c2];
        const int cc = 24 * bx + c2; ((float*)(p.ws + WS_MOD))[r * NADA * D + cc] = s + p.b_ada[cc]; } }
    __syncthreads();
}
__device__ __forceinline__ void p0_rope(const Ptrs& p, int gtid) {
    if (gtid < 256 * 32) { const int pos = gtid >> 5, f = gtid & 31; const float inv = powf(10000.0f, -(float)f / 32.0f); const float ang = (float)pos * inv;
        float* T = (float*)(p.ws + WS_ROPE); T[2 * gtid] = (float)cos((double)ang); T[2 * gtid + 1] = (float)sin((double)ang); }
}
constexpr int TSCR = 64 * 65 * 4;
__device__ __forceinline__ void transpose_tile(const float* src, int ldsrc, int k0, int n0s, bf16_t* dst, int ldt, int n0d, LAS float* scr, int lane) {
    const int kr = lane >> 4, nq = lane & 15;
    f32x4 v[16];
#pragma unroll
    for (int i = 0; i < 16; ++i) v[i] = *(const f32x4*)(src + (size_t)(k0 + 4 * i + kr) * ldsrc + n0s + 4 * nq);
#pragma unroll
    for (int i = 0; i < 16; ++i) { LAS float* s = scr + (4 * i + kr) * 65 + 4 * nq; s[0] = v[i][0]; s[1] = v[i][1]; s[2] = v[i][2]; s[3] = v[i][3]; }
    asm volatile("s_waitcnt lgkmcnt(0)" ::: "memory");
    const int c = lane & 7, ns = lane >> 3;
#pragma unroll
    for (int j = 0; j < 8; ++j) { const int n = ns + 8 * j; const LAS float* s = scr + (8 * c) * 65 + n;
        u32x4 o; o.x = pg8::cvt_pk_bf16(s[0 * 65], s[1 * 65]); o.y = pg8::cvt_pk_bf16(s[2 * 65], s[3 * 65]); o.z = pg8::cvt_pk_bf16(s[4 * 65], s[5 * 65]); o.w = pg8::cvt_pk_bf16(s[6 * 65], s[7 * 65]);
        *(u32x4*)(dst + (size_t)(n0d + n) * ldt + k0 + 8 * c) = o; }
    asm volatile("s_waitcnt lgkmcnt(0)" ::: "memory");
}
using pg8::pk_fp8x4;
__device__ __forceinline__ void zero_tile_f8(unsigned char* dst, int ldt, int n0d, int k0, int lane) {
    const int c = lane & 3, ns = lane >> 2;
#pragma unroll
    for (int j = 0; j < 4; ++j) *(u32x4*)(dst + (size_t)(n0d + ns + 16 * j) * ldt + k0 + 16 * c) = (u32x4){0u, 0u, 0u, 0u};
}
__device__ __forceinline__ void transpose_tile_f8(const float* src, int ldsrc, int k0, int n0s, unsigned char* dst, int ldt, int n0d, float scale, LAS float* scr, int lane) {
    const int kr = lane >> 4, nq = lane & 15;
    f32x4 v[16];
#pragma unroll
    for (int i = 0; i < 16; ++i) v[i] = *(const f32x4*)(src + (size_t)(k0 + 4 * i + kr) * ldsrc + n0s + 4 * nq);
#pragma unroll
    for (int i = 0; i < 16; ++i) { LAS float* s = scr + (4 * i + kr) * 65 + 4 * nq; s[0] = v[i][0] * scale; s[1] = v[i][1] * scale; s[2] = v[i][2] * scale; s[3] = v[i][3] * scale; }
    asm volatile("s_waitcnt lgkmcnt(0)" ::: "memory");
    const int c = lane & 3, ns = lane >> 2;
#pragma unroll
    for (int j = 0; j < 4; ++j) { const int n = ns + 16 * j; const LAS float* s = scr + (16 * c) * 65 + n;
        u32x4 o; o.x = pk_fp8x4(s[0 * 65], s[1 * 65], s[2 * 65], s[3 * 65]); o.y = pk_fp8x4(s[4 * 65], s[5 * 65], s[6 * 65], s[7 * 65]);
        o.z = pk_fp8x4(s[8 * 65], s[9 * 65], s[10 * 65], s[11 * 65]); o.w = pk_fp8x4(s[12 * 65], s[13 * 65], s[14 * 65], s[15 * 65]);
        *(u32x4*)(dst + (size_t)(n0d + n) * ldt + k0 + 16 * c) = o; }
    asm volatile("s_waitcnt lgkmcnt(0)" ::: "memory");
}
__device__ __forceinline__ void transpose_item(const float* src, int ldsrc, int k0, int col  , bf16_t* dst, int ldt, int n0, LAS float* scr, int lane) {
#pragma unroll 8
    for (int i = 0; i < 32; ++i) { const int kk = 2 * i + (lane >> 5); scr[kk * 33 + (lane & 31)] = (col >= 0) ? src[(size_t)(k0 + kk) * ldsrc + col] : 0.f; }
    asm volatile("s_waitcnt lgkmcnt(0)" ::: "memory");
    const int c = lane & 7;
#pragma unroll
    for (int j = 0; j < 4; ++j) { const int n = (lane >> 3) + 8 * j; const LAS float* s = scr + (8 * c) * 33 + n;
        u32x4 o; o.x = pg8::cvt_pk_bf16(s[0 * 33], s[1 * 33]); o.y = pg8::cvt_pk_bf16(s[2 * 33], s[3 * 33]); o.z = pg8::cvt_pk_bf16(s[4 * 33], s[5 * 33]); o.w = pg8::cvt_pk_bf16(s[6 * 33], s[7 * 33]);
        *(u32x4*)(dst + (size_t)(n0 + n) * ldt + k0 + 8 * c) = o; }
    asm volatile("s_waitcnt lgkmcnt(0)" ::: "memory");
}
constexpr int IT_WIN = 16 * 120, IT_WOUT = 16 * 16, IT_P0 = IT_WIN + IT_WOUT;
constexpr int IT_WGU = 16 * 2 * 22 * 16, IT_WD = 16 * 16 * 24, IT_EXP = IT_WGU + IT_WD;
__device__ __forceinline__ void conv_item_p0(const Ptrs& p, int it, LAS float* scr, int lane) {
    if (it < IT_WIN) { const int kb = it / 120, nb = it % 120, n = nb * 32 + (lane & 31); const int col = (n < NPROJ) ? proj_src_col(n) : -1;
        transpose_item(p.w_in, NPROJ, kb * 64, col, (bf16_t*)(p.ws + WS_WIN), D, nb * 32, scr, lane); }
    else { it -= IT_WIN; const int kb = it >> 4, nb = it & 15; transpose_tile(p.w_out, D, kb * 64, nb * 64, (bf16_t*)(p.ws + WS_WOUT), D, nb * 64, scr, lane); }
}
__device__ __forceinline__ void conv_item_exp(const Ptrs& p, int it, LAS float* scr, int lane) {
    if (it < IT_WGU) { const int kb = it & 15, nt = (it >> 4) % 22, half = ((it >> 4) / 22) & 1, e = (it >> 4) / 44; const int f0 = nt * 64, r0 = (f0 >> 7) * 256 + half * 128 + (f0 & 127);
        const float* src = (half ? p.w_exp_up : p.w_exp_gate) + (size_t)e * D * FF;
        transpose_tile_f8(src, FF, kb * 64, f0, (unsigned char*)(p.ws + WS_WGU) + (size_t)e * 2816 * D, D, r0, 32.0f, scr, lane); }
    else { it -= IT_WGU; const int kb = it % 24, nb = (it / 24) & 15, e = it / (24 * 16); unsigned char* dst = (unsigned char*)(p.ws + WS_WD) + (size_t)e * D * FFP;
        if (kb < 22) transpose_tile_f8(p.w_exp_down + (size_t)e * FF * D, D, kb * 64, nb * 64, dst, FFP, nb * 64, 32.0f, scr, lane); else zero_tile_f8(dst, FFP, nb * 64, kb * 64, lane); }
}
__device__ __forceinline__ void h_rows(const Ptrs& p, int row0, int rstep, int lane) {
    f32x4 xn[4];
#define H_LOAD(r_) do { const float* s_ = ((r_) < NLAT) ? p.x + (size_t)(r_) * D : p.ctx + (size_t)((r_) - NLAT) * D; _Pragma("unroll") for (int j = 0; j < 4; ++j) xn[j] = *(const f32x4*)(s_ + j * 256 + lane * 4); } while (0)
    if (row0 < NROWS) H_LOAD(row0);
    f32x4 w4[4];
#pragma unroll
    for (int j = 0; j < 4; ++j) w4[j] = *(const f32x4*)(p.norm1_w + j * 256 + lane * 4);
    for (int row = row0; row < NROWS; row += rstep) {
        const int m = (row < NLAT) ? row / SEQ : 2;
        const float* mod = (const float*)(p.ws + WS_MOD) + m * NADA * D;
        f32x4 v[4]; float ss = 0.f;
#pragma unroll
        for (int j = 0; j < 4; ++j) { v[j] = xn[j]; ss += v[j][0] * v[j][0] + v[j][1] * v[j][1] + v[j][2] * v[j][2] + v[j][3] * v[j][3]; }
        if (row + rstep < NROWS) H_LOAD(row + rstep);
        const float rstd = rsqrtf(wave_sum(ss) * (1.0f / D) + EPS);
        bf16_t* dst = (bf16_t*)(p.ws + WS_H) + (size_t)row * D;
#pragma unroll
        for (int j = 0; j < 4; ++j) { const int d = j * 256 + lane * 4; const f32x4 sc = *(const f32x4*)(mod + D + d), sh = *(const f32x4*)(mod + d);
            f32x4 o;
#pragma unroll
            for (int e = 0; e < 4; ++e) o[e] = v[j][e] * rstd * w4[j][e] * (1.0f + sc[e]) + sh[e];
            u32x2 pkd; pkd.x = pg8::cvt_pk_bf16(o[0], o[1]); pkd.y = pg8::cvt_pk_bf16(o[2], o[3]); *(u32x2*)(dst + d) = pkd; }
    }
#undef H_LOAD
}
__device__ __forceinline__ void stage_router(const Ptrs& p, LAS float* Wl, int tid) {
    for (int idx = tid; idx < D * NE / 4; idx += NTHR) { const int d = idx >> 2, q4 = idx & 3, j = d >> 8, ln = (d >> 2) & 63, e4 = d & 3;
        *(LAS f32x4*)(Wl + (((j * 4 + e4) * 4 + q4) * 64 + ln) * 4) = *(const f32x4*)(p.w_router + (size_t)d * NE + 4 * q4); }
}
__device__ __forceinline__ void norm2_router_rows(const Ptrs& p, const LAS float* Wl, int row0, int rstep, int lane) {
    const bf16_t* XO = (const bf16_t*)(p.ws + WS_XO);
    f32x4 xn[4]; u32x2 on[4];
#define N2_LOAD(r_) do { _Pragma("unroll") for (int j = 0; j < 4; ++j) { xn[j] = *(const f32x4*)(p.x + (size_t)(r_) * D + j * 256 + lane * 4); on[j] = *(const u32x2*)(XO + (size_t)(r_) * D + j * 256 + lane * 4); } } while (0)
    if (row0 < NLAT) N2_LOAD(row0);
    f32x4 w4[4];
#pragma unroll
    for (int j = 0; j < 4; ++j) w4[j] = *(const f32x4*)(p.norm2_w + j * 256 + lane * 4);
    for (int row = row0; row < NLAT; row += rstep) {
        const int b = row / SEQ, t = row % SEQ;
        const float* mod = (const float*)(p.ws + WS_MOD) + b * NADA * D;
        f32x4 v[4]; float ss = 0.f;
#pragma unroll
        for (int j = 0; j < 4; ++j) { v[j] = xn[j]; v[j][0] += __uint_as_float(on[j].x << 16); v[j][1] += __uint_as_float(on[j].x & 0xffff0000u); v[j][2] += __uint_as_float(on[j].y << 16); v[j][3] += __uint_as_float(on[j].y & 0xffff0000u);
            ss += v[j][0] * v[j][0] + v[j][1] * v[j][1] + v[j][2] * v[j][2] + v[j][3] * v[j][3]; }
        if (row + rstep < NLAT) N2_LOAD(row + rstep);
        const float rstd = rsqrtf(wave_sum(ss) * (1.0f / D) + EPS);
        unsigned char* dst = (unsigned char*)(p.ws + WS_H) + (size_t)row * D;
        float lg[NE];
#pragma unroll
        for (int e = 0; e < NE; ++e) lg[e] = 0.f;
        int wl_off = 0; asm volatile("" : "+v"(wl_off));
#pragma unroll
        for (int j = 0; j < 4; ++j) { const int d = j * 256 + lane * 4; const f32x4 sc = *(const f32x4*)(mod + 4 * D + d), sh = *(const f32x4*)(mod + 3 * D + d);
            f32x4 o;
#pragma unroll
            for (int e4 = 0; e4 < 4; ++e4) { o[e4] = v[j][e4] * rstd * w4[j][e4] * (1.0f + sc[e4]) + sh[e4];
                const LAS f32x4* wr = (const LAS f32x4*)(Wl + wl_off + ((j * 4 + e4) * 4 * 64 + lane) * 4);
#pragma unroll
                for (int q = 0; q < 4; ++q) { const f32x4 ww = wr[q * 64]; lg[4 * q] += o[e4] * ww[0]; lg[4 * q + 1] += o[e4] * ww[1]; lg[4 * q + 2] += o[e4] * ww[2]; lg[4 * q + 3] += o[e4] * ww[3]; } }
            *(unsigned*)(dst + d) = pk_fp8x4(o[0], o[1], o[2], o[3]); }
        float r8[8], r4[4], r2[2], r1;
        { const bool hi = lane & 32;
#pragma unroll
          for (int j = 0; j < 8; ++j) { const float keep = hi ? lg[8 + j] : lg[j], send = hi ? lg[j] : lg[8 + j]; r8[j] = keep + __shfl_xor(send, 32); } }
        { const bool hi = lane & 16;
#pragma unroll
          for (int j = 0; j < 4; ++j) { const float keep = hi ? r8[4 + j] : r8[j], send = hi ? r8[j] : r8[4 + j]; r4[j] = keep + __shfl_xor(send, 16); } }
        { const bool hi = lane & 8;
#pragma unroll
          for (int j = 0; j < 2; ++j) { const float keep = hi ? r4[2 + j] : r4[j], send = hi ? r4[j] : r4[2 + j]; r2[j] = keep + __shfl_xor(send, 8); } }
        { const bool hi = lane & 4; const float keep = hi ? r2[1] : r2[0], send = hi ? r2[0] : r2[1]; r1 = keep + __shfl_xor(send, 4); }
        r1 += __shfl_xor(r1, 2); r1 += __shfl_xor(r1, 1);
        float mx = r1;
#pragma unroll
        for (int o = 4; o < 64; o <<= 1) mx = fmaxf(mx, __shfl_xor(mx, o));
        const float ex = __expf(r1 - mx); float den = ex;
#pragma unroll
        for (int o = 4; o < 64; o <<= 1) den += __shfl_xor(den, o);
        if ((lane & 3) == 0) ((float*)(p.ws + WS_AFF))[((size_t)b * NE + ((lane >> 2) & 15)) * SEQ + t] = ex / den;
    }
#undef N2_LOAD
}
__device__ __forceinline__ void topk_set(const Ptrs& p, LAS unsigned char* lds, int be) {
    LAS unsigned* key = (LAS unsigned*)lds;
    LAS unsigned* hist = key + SEQ;
    LAS unsigned* sh = hist + 256;
    const int tid = threadIdx.x, lane = tid & 63, w = tid >> 6;
    const unsigned* A = (const unsigned*)(p.ws + WS_AFF) + (size_t)be * SEQ;
    for (int i = tid; i < SEQ / 4; i += NTHR) ((LAS u32x4*)key)[i] = ((const u32x4*)A)[i];
    if (tid == 0) { sh[0] = 0u; sh[1] = (unsigned)CAP; }
    __syncthreads();
#pragma unroll 1
    for (int pass = 0; pass < 4; ++pass) {
        const int shift = 24 - 8 * pass;
        if (tid < 256) hist[tid] = 0u;
        __syncthreads();
        const unsigned prefix = sh[0], kneed = sh[1];
        const unsigned himask = (pass == 0) ? 0u : (0xffffffffu << (shift + 8));
        for (int i = tid; i < SEQ; i += NTHR) { const unsigned kx = key[i]; if ((kx & himask) == prefix) __hip_atomic_fetch_add(&hist[(kx >> shift) & 255u], 1u, __ATOMIC_RELAXED, __HIP_MEMORY_SCOPE_WORKGROUP); }
        __syncthreads();
        if (w == 0) {
            unsigned c4[4]; unsigned s = 0u;
#pragma unroll
            for (int j = 0; j < 4; ++j) { c4[j] = hist[255 - (lane * 4 + j)]; s += c4[j]; }
            unsigned incl = s;
#pragma unroll
            for (int o = 1; o < 64; o <<= 1) { const unsigned t = __shfl_up(incl, o); if (lane >= o) incl += t; }
            const unsigned excl = incl - s;
            if (excl < kneed && kneed <= incl) { unsigned acc = excl;
#pragma unroll
                for (int j = 0; j < 4; ++j) { if (acc < kneed && kneed <= acc + c4[j]) { const unsigned bin = 255u - (unsigned)(lane * 4 + j); sh[0] = prefix | (bin << shift); sh[1] = kneed - acc; } acc += c4[j]; } }
        }
        __syncthreads();
    }
    const unsigned T = sh[0], need_eq = sh[1];
    unsigned cg = 0u, ce = 0u;
    for (int i = 0; i < 32; ++i) { const unsigned kx = key[tid * 32 + i]; cg += (kx > T) ? 1u : 0u; ce += (kx == T) ? 1u : 0u; }
    unsigned ig = cg, ie = ce;
#pragma unroll
    for (int o = 1; o < 64; o <<= 1) { const unsigned tg = __shfl_up(ig, o), te = __shfl_up(ie, o); if (lane >= o) { ig += tg; ie += te; } }
    if (lane == 63) { sh[16 + w] = ig; sh[32 + w] = ie; }
    __syncthreads();
    unsigned og = 0u, oe = 0u, totg = 0u;
#pragma unroll
    for (int w2 = 0; w2 < 8; ++w2) { const unsigned a = sh[16 + w2], b2 = sh[32 + w2]; if (w2 < w) { og += a; oe += b2; } totg += a; }
    unsigned pg = og + ig - cg, pe = oe + ie - ce;
    int* IDX = (int*)(p.ws + WS_IDX) + be * CAP; float* GATE = (float*)(p.ws + WS_GATE) + be * CAP; int* INV = (int*)(p.ws + WS_INV);
    const int b = be / NE, e = be % NE;
    for (int i = 0; i < 32; ++i) { const int t = tid * 32 + i; const unsigned kx = key[t]; int slot = -1;
        if (kx > T) slot = (int)(pg++); else if (kx == T) { if (pe < need_eq) slot = (int)(totg + pe); ++pe; }
        if (slot >= 0) { IDX[slot] = t; GATE[slot] = __uint_as_float(kx); }
        INV[((size_t)b * SEQ + t) * NE + e] = slot; }
    __syncthreads();
}
__device__ __forceinline__ void final_rows(const Ptrs& p, int row0, int rstep, int lane) {
    const bf16_t* XO = (const bf16_t*)(p.ws + WS_XO); const bf16_t* YE = (const bf16_t*)(p.ws + WS_YE); const int* INV = (const int*)(p.ws + WS_INV);
    f32x4 xn[4]; u32x2 on[4]; int invn = -1;
#define FN_LOAD(r_) do { _Pragma("unroll") for (int j = 0; j < 4; ++j) { xn[j] = *(const f32x4*)(p.x + (size_t)(r_) * D + j * 256 + lane * 4); on[j] = *(const u32x2*)(XO + (size_t)(r_) * D + j * 256 + lane * 4); } \
        invn = (lane < NE) ? INV[(size_t)(r_) * NE + lane] : -1; } while (0)
    if (row0 < NLAT) FN_LOAD(row0);
    f32x4 fw[4];
#pragma unroll
    for (int j = 0; j < 4; ++j) fw[j] = *(const f32x4*)(p.final_norm_w + j * 256 + lane * 4);
    for (int row = row0; row < NLAT; row += rstep) {
        const int b = row / SEQ;
        const float* mod = (const float*)(p.ws + WS_MOD) + b * NADA * D + 5 * D;
        f32x4 v[4];
#pragma unroll
        for (int j = 0; j < 4; ++j) { v[j] = xn[j]; v[j][0] += __uint_as_float(on[j].x << 16); v[j][1] += __uint_as_float(on[j].x & 0xffff0000u); v[j][2] += __uint_as_float(on[j].y << 16); v[j][3] += __uint_as_float(on[j].y & 0xffff0000u); }
        const int myinv = invn;
        if (row + rstep < NLAT) FN_LOAD(row + rstep);
        unsigned long long mask = __ballot(myinv >= 0);
        float acc[16];
#pragma unroll
        for (int i = 0; i < 16; ++i) acc[i] = 0.f;
        while (mask) {
            u32x2 yw[4][4]; bool has[4];
#pragma unroll
            for (int u = 0; u < 4; ++u) { has[u] = mask != 0ull; const int e = has[u] ? (int)__builtin_ctzll(mask) : 0; if (has[u]) mask &= mask - 1ull;
                const int s = __shfl(myinv, e); const bf16_t* y = YE + ((size_t)(b * NE + e) * CAP + (has[u] ? s : 0)) * D;
                if (has[u]) {
#pragma unroll
                    for (int j = 0; j < 4; ++j) yw[u][j] = *(const u32x2*)(y + j * 256 + lane * 4); } }
#pragma unroll
            for (int u = 0; u < 4; ++u) if (has[u]) {
#pragma unroll
                for (int j = 0; j < 4; ++j) { acc[4 * j] += __uint_as_float(yw[u][j].x << 16); acc[4 * j + 1] += __uint_as_float(yw[u][j].x & 0xffff0000u); acc[4 * j + 2] += __uint_as_float(yw[u][j].y << 16); acc[4 * j + 3] += __uint_as_float(yw[u][j].y & 0xffff0000u); } }
        }
        float ss = 0.f;
#pragma unroll
        for (int j = 0; j < 4; ++j) { const f32x4 m4 = *(const f32x4*)(mod + j * 256 + lane * 4);
#pragma unroll
            for (int e = 0; e < 4; ++e) { v[j][e] += m4[e] * acc[4 * j + e]; ss += v[j][e] * v[j][e]; } }
        const float rstd = rsqrtf(wave_sum(ss) * (1.0f / D) + EPS);
        float* xr = p.out + (size_t)row * D;
#pragma unroll
        for (int j = 0; j < 4; ++j) *(f32x4*)(xr + j * 256 + lane * 4) = v[j] * rstd * fw[j];
    }
#undef FN_LOAD
}
}

constexpr int RING_OFF = 0, RING_BYTES = 131072;
constexpr int GTAB_OFF = RING_BYTES;
constexpr int MISC_OFF = RING_BYTES + 12288;
constexpr int LDS_BYTES = 147456;
constexpr int CW_BAR = 4096;

#define RLX_AGENT __ATOMIC_RELAXED, __HIP_MEMORY_SCOPE_AGENT
#define XB_TMO      128
#define XB_XCNT(j)  (256  + 64 * (j))
#define XB_XSUB(j)  (1280 + 64 * (j))
#define XB_XGEN(j)  (2304 + 64 * (j))
#define XB_TOP      3328
#define XB_TOPGEN   3392
#define XCD_BAR_WORDS 3456
#define XB_SPIN_CAP (1u << 18)
__device__ __forceinline__ unsigned xb_ld(unsigned* p)              { return __hip_atomic_load(p, __ATOMIC_RELAXED, __HIP_MEMORY_SCOPE_AGENT); }
__device__ __forceinline__ unsigned xb_add(unsigned* p, unsigned v) { return __hip_atomic_fetch_add(p, v, __ATOMIC_RELAXED, __HIP_MEMORY_SCOPE_AGENT); }
__device__ __forceinline__ unsigned xb_xcc_id() { return (unsigned)__builtin_amdgcn_s_getreg((3 << 11) | 20) & 0xFu; }
#define XB_SPIN(cond, bar) do { unsigned _sp = 0; while (cond) { __builtin_amdgcn_s_sleep(1); \
    if ((++_sp & 255u) == 0u) { if (xb_ld(&(bar)[XB_TMO])) break; if (_sp > XB_SPIN_CAP) { atomicAdd(&(bar)[XB_TMO], 1u); break; } } } } while (0)
struct XcdBarrier { unsigned* bar; unsigned x; volatile LAS unsigned* st; };
__device__ __forceinline__ XcdBarrier xcd_barrier_post(unsigned* bar, volatile LAS unsigned* st) {
    XcdBarrier b; b.bar = bar; b.x = xb_xcc_id(); b.st = st;
    if (threadIdx.x == 0) (void)xb_add(&bar[XB_XCNT(b.x)], 1u);
    return b;
}
__device__ __forceinline__ void xcd_barrier_complete(unsigned* bar, unsigned x, unsigned& nloc, unsigned& nx) {
    const unsigned G = gridDim.x * gridDim.y * gridDim.z;
    unsigned sum, cnt, mine, sp = 0u;
    for (;;) {
        sum = 0u; cnt = 0u; mine = 0u;
#pragma unroll
        for (unsigned j = 0; j < 16; ++j) { const unsigned c = xb_ld(&bar[XB_XCNT(j)]); sum += c; cnt += (c > 0u) ? 1u : 0u; mine = (j == x) ? c : mine; }
        if (sum == G) break;
        __builtin_amdgcn_s_sleep(1);
        if ((++sp & 255u) == 0u) { if (xb_ld(&bar[XB_TMO])) break; if (sp > XB_SPIN_CAP) { atomicAdd(&bar[XB_TMO], 1u); break; } }
    }
    nloc = mine > 0u ? mine : 1u; nx = cnt > 0u ? cnt : 1u;
}
__device__ __forceinline__ void xcd_barrier(const XcdBarrier& b) {
    asm volatile("s_waitcnt vmcnt(0)" ::: "memory");
    __syncthreads();
    if (threadIdx.x == 0) {
        unsigned* bar = b.bar;
        __builtin_amdgcn_s_waitcnt(0);
        unsigned nloc = b.st[0], nx = b.st[1];
        if (nloc == 0u) { xcd_barrier_complete(bar, b.x, nloc, nx); b.st[0] = nloc; b.st[1] = nx; }
        const unsigned old = xb_add(&bar[XB_XSUB(b.x)], 1u);
        const unsigned gen = old / nloc;
        if (old + 1u == (gen + 1u) * nloc) {
            __builtin_amdgcn_fence(__ATOMIC_RELEASE, "agent");
            asm volatile("s_waitcnt vmcnt(0)" ::: "memory");
            const unsigned og = xb_add(&bar[XB_TOP], 1u);
            const unsigned tg = og / nx;
            if (og + 1u == (tg + 1u) * nx) xb_add(&bar[XB_TOPGEN], 1u);
            else XB_SPIN(xb_ld(&bar[XB_TOPGEN]) == tg, bar);
            __builtin_amdgcn_fence(__ATOMIC_ACQUIRE, "agent");
            xb_add(&bar[XB_XGEN(b.x)], 1u);
            asm volatile("s_waitcnt vmcnt(0)" ::: "memory");
        } else {
            XB_SPIN(xb_ld(&bar[XB_XGEN(b.x)]) == gen, bar);
            __builtin_amdgcn_fence(__ATOMIC_ACQUIRE, "agent");
            asm volatile("s_waitcnt vmcnt(0)" ::: "memory");
        }
    }
    __syncthreads();
}

struct Args { Ptrs p; int ph_lo, ph_hi, dbg, pad; };

__global__ void __launch_bounds__(NTHR, 2) mk_fwd(Args args) {
    extern __shared__ __attribute__((aligned(16))) unsigned char lds_raw[];
    LAS unsigned char* lds = (LAS unsigned char*)lds_raw;
    volatile LAS unsigned* MISC = (volatile LAS unsigned*)(lds + MISC_OFF);
    const Ptrs& p = args.p;
    unsigned char* ws = p.ws;
    const int tid = threadIdx.x, G = gridDim.x, bx = blockIdx.x;
    for (int u = tid; u < (LDS_BYTES - MISC_OFF) / 4; u += NTHR) ((LAS unsigned*)(lds + MISC_OFF))[u] = 0u;
    __syncthreads();
    const int lo = args.ph_lo, hi = args.ph_hi;
#ifndef REPS_LIST
#define REPS_LIST 1, 1, 1, 1, 1, 1, 1, 1, 1, 1, 1, 1
#endif
    constexpr int reps_tab[12] = {REPS_LIST};
    constexpr int CONV_SPLIT = 8192;
    XcdBarrier bar; bar.bar = (unsigned*)ws + CW_BAR; bar.x = 0; bar.st = nullptr;
    if (hi - lo > 1) bar = xcd_barrier_post((unsigned*)ws + CW_BAR, MISC + 8);
#define IN(k) (lo <= (k) && (k) < hi)
#define SEAM(k) do { if (IN(k) && IN((k) + 1)) xcd_barrier(bar); } while (0)

    const int wv = __builtin_amdgcn_readfirstlane(tid >> 6), ln = tid & 63, gw = bx * NWAVES + wv, NGW = G * NWAVES;
    if (IN(0)) {
        for (int cb = bx; cb < 256; cb += G) misc::p0_mod(p, lds, cb);
        misc::p0_rope(p, bx * NTHR + tid);
        LAS float* scr = (LAS float*)(lds + wv * misc::TSCR);
        for (int it = gw; it < misc::IT_P0; it += NGW) misc::conv_item_p0(p, it, scr, ln);
    }
    if constexpr (reps_tab[0] > 1) { xcd_barrier(bar);
    if (IN(0)) {
        for (int cb = bx; cb < 256; cb += G) misc::p0_mod(p, lds, cb);
        misc::p0_rope(p, bx * NTHR + tid);
        LAS float* scr = (LAS float*)(lds + wv * misc::TSCR);
        for (int it = gw; it < misc::IT_P0; it += NGW) misc::conv_item_p0(p, it, scr, ln);
    }
    }
    SEAM(0);
    if (IN(1)) { misc::h_rows(p, gw, NGW, ln); }
    if constexpr (reps_tab[1] > 1) { xcd_barrier(bar);
    if (IN(1)) { misc::h_rows(p, gw, NGW, ln); }
    }
    SEAM(1);
    if (IN(2)) {
        pg8::Gemm g{(const bf16_t*)(ws + WS_H), (const bf16_t*)(ws + WS_WIN), D};
        pg8::StaticOrder S; S.init(NROWS / 256, NPROJ_PAD / 256, G, bx);
        pg8::EpiProj E{(bf16_t*)(ws + WS_P), (float*)(ws + WS_GZ), (const float*)(ws + WS_ROPE)};
        pg8::gemm_phase<pg8::EpiProj, pg8::StaticOrder, false>(lds + RING_OFF, g, S, E, nullptr);
    }
    if constexpr (reps_tab[2] > 1) { xcd_barrier(bar);
    if (IN(2)) {
        pg8::Gemm g{(const bf16_t*)(ws + WS_H), (const bf16_t*)(ws + WS_WIN), D};
        pg8::StaticOrder S; S.init(NROWS / 256, NPROJ_PAD / 256, G, bx);
        pg8::EpiProj E{(bf16_t*)(ws + WS_P), (float*)(ws + WS_GZ), (const float*)(ws + WS_ROPE)};
        pg8::gemm_phase<pg8::EpiProj, pg8::StaticOrder, false>(lds + RING_OFF, g, S, E, nullptr);
    }
    }
    SEAM(2);
    if (IN(3)) {
        scan::run_c1(p, lds, bx);
    }
    SEAM(3);
    if (IN(4)) {
        if (bx < 64) scan::c2_scan<0>(p, bx >> 2, (bx & 3) * NTHR + tid);
        else if (bx < 192) scan::c2_scan<1>(p, (bx - 64) >> 3, ((bx - 64) & 7) * NTHR + tid);
    }
    if constexpr (reps_tab[3] > 1) { xcd_barrier(bar);
    if (IN(3)) {
        scan::run_c1(p, lds, bx);
    }
    SEAM(3);
    if (IN(4)) {
        if (bx < 64) scan::c2_scan<0>(p, bx >> 2, (bx & 3) * NTHR + tid);
        else if (bx < 192) scan::c2_scan<1>(p, (bx - 64) >> 3, ((bx - 64) & 7) * NTHR + tid);
    }
    }
    SEAM(4);
    if (IN(5)) {
        scan::run_c3(p, lds, bx, (bf16_t*)(ws + WS_H));
    }
    if constexpr (reps_tab[5] > 1) { xcd_barrier(bar);
    if (IN(5)) {
        scan::run_c3(p, lds, bx, (bf16_t*)(ws + WS_H));
    }
    }
    SEAM(5);
    if (IN(6)) {
        pg8::Gemm g{(const bf16_t*)(ws + WS_H), (const bf16_t*)(ws + WS_WOUT), D};
        pg8::StaticOrder S; S.init(NLAT / 256, D / 256, G, bx);
        pg8::EpiOut E{(bf16_t*)(ws + WS_XO), (const float*)(ws + WS_MOD)};
        pg8::gemm_phase<pg8::EpiOut, pg8::StaticOrder, false>(lds + RING_OFF, g, S, E, nullptr);
    }
    if constexpr (reps_tab[6] > 1) { xcd_barrier(bar);
    if (IN(6)) {
        pg8::Gemm g{(const bf16_t*)(ws + WS_H), (const bf16_t*)(ws + WS_WOUT), D};
        pg8::StaticOrder S; S.init(NLAT / 256, D / 256, G, bx);
        pg8::EpiOut E{(bf16_t*)(ws + WS_XO), (const float*)(ws + WS_MOD)};
        pg8::gemm_phase<pg8::EpiOut, pg8::StaticOrder, false>(lds + RING_OFF, g, S, E, nullptr);
    }
    }
    SEAM(6);
    if (IN(7)) {
        misc::stage_router(p, (LAS float*)lds, tid); __syncthreads();
        misc::norm2_router_rows(p, (const LAS float*)lds, gw, NGW, ln);
        __syncthreads();
        LAS float* scr = (LAS float*)(lds + wv * misc::TSCR);
        for (int it = gw; it < CONV_SPLIT; it += NGW) misc::conv_item_exp(p, it, scr, ln);
    }
    if constexpr (reps_tab[7] > 1) { xcd_barrier(bar);
    if (IN(7)) {
        misc::stage_router(p, (LAS float*)lds, tid); __syncthreads();
        misc::norm2_router_rows(p, (const LAS float*)lds, gw, NGW, ln);
        __syncthreads();
        LAS float* scr = (LAS float*)(lds + wv * misc::TSCR);
        for (int it = gw; it < CONV_SPLIT; it += NGW) misc::conv_item_exp(p, it, scr, ln);
    }
    }
    SEAM(7);
    if (IN(8)) { if (bx < 32) misc::topk_set(p, lds, bx);
        else { LAS float* scr = (LAS float*)(lds + wv * misc::TSCR); for (int it = CONV_SPLIT + (bx - 32) * NWAVES + wv; it < misc::IT_EXP; it += (G - 32) * NWAVES) misc::conv_item_exp(p, it, scr, ln); } }
    if constexpr (reps_tab[8] > 1) { xcd_barrier(bar);
    if (IN(8)) { if (bx < 32) misc::topk_set(p, lds, bx);
        else { LAS float* scr = (LAS float*)(lds + wv * misc::TSCR); for (int it = CONV_SPLIT + (bx - 32) * NWAVES + wv; it < misc::IT_EXP; it += (G - 32) * NWAVES) misc::conv_item_exp(p, it, scr, ln); } }
    }
    SEAM(8);
    if (IN(9)) {
        LAS unsigned* gtab = (LAS unsigned*)(lds + GTAB_OFF);
        pg8::MoeUpOrder S{bx};
        const int* IDX = (const int*)(ws + WS_IDX);
        for (int e = tid; e < 11 * 256; e += NTHR) { pg8::Unit u; S.next(e >> 8, u); const int R = u.pm * 256 + (e & 255); gtab[e] = (unsigned)((u.pm >> 7) * SEQ + (IDX[R] & (SEQ - 1))) * (unsigned)D; }
        __syncthreads();
        pg8::Gemm g{(const bf16_t*)(ws + WS_H), (const bf16_t*)(ws + WS_WGU), D};
        pg8::EpiAct E{(unsigned char*)(ws + WS_ACT), 1.0f / 32.0f, 8.0f};
        pg8::gemm_phase<pg8::EpiAct, pg8::MoeUpOrder, true, true>(lds + RING_OFF, g, S, E, gtab);
    }
    if constexpr (reps_tab[9] > 1) { xcd_barrier(bar);
    if (IN(9)) {
        LAS unsigned* gtab = (LAS unsigned*)(lds + GTAB_OFF);
        pg8::MoeUpOrder S{bx};
        const int* IDX = (const int*)(ws + WS_IDX);
        for (int e = tid; e < 11 * 256; e += NTHR) { pg8::Unit u; S.next(e >> 8, u); const int R = u.pm * 256 + (e & 255); gtab[e] = (unsigned)((u.pm >> 7) * SEQ + (IDX[R] & (SEQ - 1))) * (unsigned)D; }
        __syncthreads();
        pg8::Gemm g{(const bf16_t*)(ws + WS_H), (const bf16_t*)(ws + WS_WGU), D};
        pg8::EpiAct E{(unsigned char*)(ws + WS_ACT), 1.0f / 32.0f, 8.0f};
        pg8::gemm_phase<pg8::EpiAct, pg8::MoeUpOrder, true, true>(lds + RING_OFF, g, S, E, gtab);
    }
    }
    SEAM(9);
    if (IN(10)) {
        pg8::MoeDownOrder S{bx};
        pg8::Gemm g{(const bf16_t*)(ws + WS_ACT), (const bf16_t*)(ws + WS_WD), FFP};
        pg8::EpiDown E{(bf16_t*)(ws + WS_YE), (const float*)(ws + WS_GATE), 1.0f / 256.0f};
        pg8::gemm_phase<pg8::EpiDown, pg8::MoeDownOrder, false, true>(lds + RING_OFF, g, S, E, nullptr);
    }
    if constexpr (reps_tab[10] > 1) { xcd_barrier(bar);
    if (IN(10)) {
        pg8::MoeDownOrder S{bx};
        pg8::Gemm g{(const bf16_t*)(ws + WS_ACT), (const bf16_t*)(ws + WS_WD), FFP};
        pg8::EpiDown E{(bf16_t*)(ws + WS_YE), (const float*)(ws + WS_GATE), 1.0f / 256.0f};
        pg8::gemm_phase<pg8::EpiDown, pg8::MoeDownOrder, false, true>(lds + RING_OFF, g, S, E, nullptr);
    }
    }
    SEAM(10);
    if (IN(11)) { misc::final_rows(p, gw, NGW, ln); }
#undef IN
#undef SEAM
}

#ifndef USE_COOP
#define USE_COOP 1
#endif
extern "C" void kernel_launch(void* const* d_in, const int* in_sizes, int n_in, void* d_out, int out_size, void* d_ws, size_t ws_size, hipStream_t stream) {
    static int ready = 0;
    if (!ready) {
        if (n_in != 20 || in_sizes[0] != NLAT * D || out_size != NLAT * D || ws_size < WS_END) { fprintf(stderr, "kernel_launch: unexpected problem (n_in %d, out %d, ws %zu); nothing launched\n", n_in, out_size, ws_size); ready = -1; return; }
        if (hipFuncSetAttribute((const void*)mk_fwd, hipFuncAttributeMaxDynamicSharedMemorySize, LDS_BYTES) != hipSuccess) { fprintf(stderr, "kernel_launch: hipFuncSetAttribute failed\n"); ready = -1; return; }
        int dev = 0, cus = 0, per_cu = 0;
        (void)hipGetDevice(&dev); (void)hipDeviceGetAttribute(&cus, hipDeviceAttributeMultiprocessorCount, dev);
        (void)hipOccupancyMaxActiveBlocksPerMultiprocessor(&per_cu, (const void*)mk_fwd, NTHR, LDS_BYTES);
        if (cus * per_cu < 256) { fprintf(stderr, "kernel_launch: this kernel needs 256 co-resident workgroups (device reports %d CUs x %d); nothing launched\n", cus, per_cu); ready = -1; return; }
        ready = 1;
    }
    if (ready < 0) return;
    Args a{};
    const float** f = (const float**)&a.p;
    for (int i = 0; i < 20; ++i) f[i] = (const float*)d_in[i];
    a.p.out = (float*)d_out; a.p.ws = (unsigned char*)d_ws; a.ph_lo = 0; a.ph_hi = 12;
    (void)hipMemsetAsync((char*)d_ws + WS_CTL, 0, 64 * 1024, stream);
    void* args[] = {&a};
#if USE_COOP
    const hipError_t e = hipLaunchCooperativeKernel((const void*)mk_fwd, dim3(256), dim3(NTHR), args, LDS_BYTES, stream);
#else
    const hipError_t e = hipLaunchKernel((const void*)mk_fwd, dim3(256), dim3(NTHR), args, LDS_BYTES, stream);
#endif
    if (e != hipSuccess) fprintf(stderr, "kernel_launch: launch failed: %s\n", hipGetErrorString(e));
}
```

```cpp
#include <hip/hip_runtime.h>
#include <stdint.h>
#include <stdio.h>

typedef unsigned short bf16_t;
typedef unsigned int u32;

constexpr int D = 1024, BATCH = 2, SEQ = 16384, CTX = 256;
constexpr int NLAT = BATCH * SEQ;
constexpr int NCTX = BATCH * CTX;
constexpr int NROWS = NLAT + NCTX;
constexpr int NADA = 6;
constexpr int NE = 16, CAP = 2048, FF = 1408, FFP = 1536;
constexpr int NSLOT = BATCH * NE * CAP;
constexpr float EPS = 1e-6f;
constexpr int C_GQ = 0, C_GK = 256, C_GV = 512, C_GG = 1024, C_RQ = 1536, C_RK = 2048, C_RV = 2560, C_RG = 3072, C_GZ = 3584;
constexpr int PW = 3584;
constexpr int NPROJ = 3616, NPROJ_PAD = 3840;
__host__ __device__ __forceinline__ size_t ptile(int row, int col) { return ((size_t)((row >> 6) * 28 + (col >> 7)) * 64 + (row & 63)) * 128 + (col & 127); }

constexpr size_t MiB = 1u << 20;
constexpr size_t WS_CTL = 0;
constexpr size_t WS_MOD = 1 * MiB;
constexpr size_t WS_ROPE = WS_MOD + 128 * 1024;
constexpr size_t WS_DCH = 2 * MiB;
constexpr size_t WS_WIN = 4 * MiB;
constexpr size_t WS_WOUT = 12 * MiB;
constexpr size_t WS_GZ = 14 * MiB;
constexpr size_t WS_H = 19 * MiB;
constexpr size_t WS_P = 84 * MiB;
constexpr size_t WS_US = 312 * MiB;
constexpr size_t WS_WGU = 84 * MiB;
constexpr size_t WS_WD = 172 * MiB;
constexpr size_t WS_ACT = 216 * MiB;
constexpr size_t WS_XO = 312 * MiB;
constexpr size_t WS_AFF = 392 * MiB;
constexpr size_t WS_IDX = 394 * MiB;
constexpr size_t WS_GATE = 395 * MiB;
constexpr size_t WS_INV = 396 * MiB;
constexpr size_t WS_YE = 19 * MiB;
constexpr size_t WS_END = 508 * MiB;

__device__ __forceinline__ float bf2f(bf16_t v) { return __uint_as_float(((u32)v) << 16); }
__device__ __forceinline__ bf16_t f2bf(float f) { u32 u = __float_as_uint(f); return (bf16_t)((u + 0x7fffu + ((u >> 16) & 1u)) >> 16); }
__device__ __forceinline__ float siluf(float x) { return x / (1.0f + __expf(-x)); }
__device__ __forceinline__ float log_sigmoidf(float x) { return fminf(x, 0.f) - log1pf(__expf(-fabsf(x))); }
template <int CTRL, int RM> __device__ __forceinline__ float dppf(float v) { return __builtin_bit_cast(float, __builtin_amdgcn_update_dpp(0, __builtin_bit_cast(int, v), CTRL, RM, 0xF, false)); }
__device__ __forceinline__ float wave_sum(float v) {
    v += dppf<0xB1, 0xF>(v);
    v += dppf<0x4E, 0xF>(v);
    v += dppf<0x124, 0xF>(v);
    v += dppf<0x128, 0xF>(v);
    v += dppf<0x142, 0xA>(v);
    v += dppf<0x143, 0xC>(v);
    return __builtin_bit_cast(float, __builtin_amdgcn_readlane(__builtin_bit_cast(int, v), 63));
}
__host__ __device__ inline int proj_src_col(int n) {
    if (n < 1024) return n;
    if (n < 1536) return 1056 + (n - 1024);
    if (n < 2560) {
        const int base = (n < 2048) ? 1568 : 2080, m = (n < 2048) ? n - 1536 : n - 2048;
        const int hd = m >> 7, p = m & 127, g = p >> 3, nn = (p >> 2) & 1, e = p & 3;
        return base + hd * 128 + 64 * nn + 4 * g + e;
    }
    if (n < 3072) return 2592 + (n - 2560);
    if (n < 3584) return 3104 + (n - 3072);
    return 1024 + (n - 3584);
}

struct Ptrs {
    const float *x, *c, *ctx, *c_ctx, *w_ada, *b_ada, *norm1_w, *w_in, *gla_gate_w, *gla_gate_b, *ret_decay_logit, *gla_norm_w, *ret_norm_w,
        *w_out, *norm2_w, *w_router, *w_exp_gate, *w_exp_up, *w_exp_down, *final_norm_w;
    float* out;
    unsigned char* ws;
};


constexpr int NWAVES = 8, NTHR = NWAVES * 64;
#define LAS __attribute__((address_space(3)))
#define GAS __attribute__((address_space(1)))
typedef short bf16x8 __attribute__((ext_vector_type(8)));
typedef float f32x4 __attribute__((ext_vector_type(4)));
typedef float f32x2 __attribute__((ext_vector_type(2)));
typedef unsigned u32x4 __attribute__((ext_vector_type(4)));
typedef unsigned u32x2 __attribute__((ext_vector_type(2)));
typedef int i32x4 __attribute__((ext_vector_type(4)));
typedef int i32x8 __attribute__((ext_vector_type(8)));
#ifndef PG8_ALIGN_DEFAULT
#define PG8_ALIGN_DEFAULT true
#endif
namespace pg8 {
constexpr int BM = 256, BK = 64, HALF = 128, HTB = HALF * BK * 2  , STAGE_BYTES = 8 * HTB, NXCD = 8, WGM = 8;
__host__ __device__ __forceinline__ int lds_byte(int r, int c) { const int st = (r >> 4) * 2 + (c >> 5), rr = r & 15, cc = c & 31, ob = rr * 64 + cc * 2; return st * 1024 + (ob ^ (((ob >> 9) & 1) << 5)); }
__host__ __device__ __forceinline__ void stage_rc(int b, int& R, int& C) { const int st = b / 1024, sb = b % 1024, swz = sb ^ (((sb >> 9) & 1) << 5); R = (st >> 1) * 16 + swz / 64; C = (st & 1) * 32 + (swz % 64) / 2; }
__host__ __device__ __forceinline__ int perm32(int rho) { const int n = rho >> 4, i = rho & 15; return 8 * (i >> 2) + 4 * n + (i & 3); }

struct Unit { int pm, pn; };
struct Gemm { const bf16_t* A; const bf16_t* Bt; int K; };

struct StaticOrder {
    int nM, nN, nwg, G, c;
    __device__ void init(int nM_, int nN_, int G_, int c_) { nM = nM_; nN = nN_; nwg = nM * nN; G = G_; c = c_; }
    __device__ bool next(int i, Unit& u) const {
        const long L = (long)i * G + c; if (L >= nwg) return false;
        int wgid = (int)L; { const int q = nwg / NXCD, r = nwg % NXCD, xcd = wgid % NXCD, off = wgid / NXCD; wgid = (xcd < r ? xcd * (q + 1) : r * (q + 1) + (xcd - r) * q) + off; }
        const int nig = WGM * nN, gid = wgid / nig, fm = gid * WGM, gsz = (nM - fm) < WGM ? (nM - fm) : WGM;
        u.pm = fm + ((wgid % nig) % gsz); u.pn = (wgid % nig) / gsz; return true;
    }
};
struct MoeUpOrder {
    int c;
    __device__ bool next(int i, Unit& u) const {
        if (i >= 11) return false;
        const int g = i * 8 + (c & 7), j = c >> 3, combo = 4 * g + (j >> 3), mt = j & 7, be = combo / 11, pn = combo % 11;
        u.pm = be * 8 + mt; u.pn = (be & 15) * 11 + pn; return true;
    }
};
struct MoeDownOrder {
    int c;
    __device__ bool next(int i, Unit& u) const {
        if (i >= 4) return false;
        const int be = i * 8 + (c & 7), j = c >> 3, mt = j & 7, pn = j >> 3;
        u.pm = be * 8 + mt; u.pn = (be & 15) * 4 + pn; return true;
    }
};

__device__ __forceinline__ float fast_silu(float a) { return a * __builtin_amdgcn_rcpf(1.0f + __expf(-a)); }
typedef __bf16 bf16x2_t __attribute__((ext_vector_type(2)));
__device__ __forceinline__ unsigned cvt_pk_bf16(float lo, float hi) { const f32x2 v = {lo, hi}; const bf16x2_t r = __builtin_convertvector(v, bf16x2_t); return __builtin_bit_cast(unsigned, r); }

__device__ __forceinline__ unsigned pk_fp8x4(float a, float b, float c, float d) {
    a = __builtin_amdgcn_fmed3f(a, -448.f, 448.f); b = __builtin_amdgcn_fmed3f(b, -448.f, 448.f); c = __builtin_amdgcn_fmed3f(c, -448.f, 448.f); d = __builtin_amdgcn_fmed3f(d, -448.f, 448.f);
    int w = 0; w = __builtin_amdgcn_cvt_pk_fp8_f32(a, b, w, false); w = __builtin_amdgcn_cvt_pk_fp8_f32(c, d, w, true); return (unsigned)w;
}
template <class Epi, class Sched, bool GATHER, bool F8 = false, bool ALIGN_EPI = PG8_ALIGN_DEFAULT>
__device__ __forceinline__ void gemm_phase(LAS unsigned char* lds, const Gemm g, const Sched& S, const Epi& E, const LAS unsigned* gtab) {
    const int tid = threadIdx.x, wid = __builtin_amdgcn_readfirstlane(tid >> 6), lane = tid & 63, wr = wid >> 2, wc = wid & 3, fr = lane & 15, fq = lane >> 4;
    constexpr int ESZ = F8 ? 1 : 2;
    const int K = g.K, nt = K * ESZ / (BK * 2);
    int sR[2], sC[2];
    unsigned voffB[2], voffA[2];
#pragma unroll
    for (int i = 0; i < 2; ++i) { stage_rc(tid * 16 + i * 8192, sR[i], sC[i]); const int Rb = Epi::PERM ? ((sR[i] & ~31) + perm32(sR[i] & 31)) : sR[i];
        voffB[i] = (unsigned)(Rb * K * ESZ + sC[i] * 2); voffA[i] = (unsigned)(sR[i] * K * ESZ + sC[i] * 2); }
    const size_t kstep = (size_t)(BK * 2);
    const size_t hstep = (size_t)HALF * K * ESZ;
    const size_t tstep = 2 * hstep;
    const unsigned ldsw = (unsigned)wid * 1024u;
    const int aoff = lds_byte(wr * 64 + fr, fq * 8), boff = lds_byte(wc * 32 + fr, fq * 8);
    const int sw8 = (fq & 1) * 8;
    const int aoff8a = lds_byte(wr * 64 + fr, fq * 16 + sw8), aoff8b = lds_byte(wr * 64 + fr, fq * 16 + (8 - sw8)), boff8a = lds_byte(wc * 32 + fr, fq * 16 + sw8), boff8b = lds_byte(wc * 32 + fr, fq * 16 + (8 - sw8));
#define PG8_SA(b, h) (((b) * 2 + (h)) * HTB)
#define PG8_SB(b, h) ((4 + (b) * 2 + (h)) * HTB)
#define PG8_STAGE(bufoff, gbase, voff) do { _Pragma("unroll") for (int _i = 0; _i < 2; ++_i) \
        __builtin_amdgcn_global_load_lds((const unsigned*)((const char*)(gbase) + (voff)[_i]), (LAS unsigned*)(lds + (bufoff) + ldsw + _i * 8192), 16, 0, 0); } while (0)
#define PG8_LDA(dst, b, h) do { if constexpr (F8) { _Pragma("unroll") for (int m = 0; m < 4; ++m) { const i32x4 lo_ = *(const LAS i32x4*)(lds + PG8_SA(b, h) + aoff8a + m * 2048), hi_ = *(const LAS i32x4*)(lds + PG8_SA(b, h) + aoff8b + m * 2048); \
            dst##8[m] = __builtin_shufflevector(lo_, hi_, 0, 1, 2, 3, 4, 5, 6, 7); } } \
        else { _Pragma("unroll") for (int m = 0; m < 4; ++m) _Pragma("unroll") for (int k = 0; k < 2; ++k) dst[m][k] = *(const LAS bf16x8*)(lds + PG8_SA(b, h) + aoff + m * 2048 + k * 1024); } } while (0)
#define PG8_LDB(dst, b, h) do { if constexpr (F8) { _Pragma("unroll") for (int n = 0; n < 2; ++n) { const i32x4 lo_ = *(const LAS i32x4*)(lds + PG8_SB(b, h) + boff8a + n * 2048), hi_ = *(const LAS i32x4*)(lds + PG8_SB(b, h) + boff8b + n * 2048); \
            dst##8[n] = __builtin_shufflevector(lo_, hi_, 0, 1, 2, 3, 4, 5, 6, 7); } } \
        else { _Pragma("unroll") for (int n = 0; n < 2; ++n) _Pragma("unroll") for (int k = 0; k < 2; ++k) dst[n][k] = *(const LAS bf16x8*)(lds + PG8_SB(b, h) + boff + n * 2048 + k * 1024); } } while (0)
#define PG8_MMA(ai, bj, At, Bt) do { __builtin_amdgcn_s_setprio(1); if constexpr (F8) { _Pragma("unroll") for (int m = 0; m < 4; ++m) _Pragma("unroll") for (int n = 0; n < 2; ++n) \
            asm volatile("v_mfma_f32_16x16x128_f8f6f4 %0, %1, %2, %0" : "+v"(acc[ai][bj][m][n]) : "v"(Bt##8[n]), "v"(At##8[m])); } \
        else { _Pragma("unroll") for (int m = 0; m < 4; ++m) _Pragma("unroll") for (int n = 0; n < 2; ++n) _Pragma("unroll") for (int k = 0; k < 2; ++k) \
            acc[ai][bj][m][n] = __builtin_amdgcn_mfma_f32_16x16x32_bf16(Bt[n][k], At[m][k], acc[ai][bj][m][n], 0, 0, 0); } __builtin_amdgcn_s_setprio(0); } while (0)
#define PG8_WAIT_V(n) asm volatile("s_waitcnt vmcnt(" #n ")" ::: "memory")
#define PG8_WAIT_L(n) asm volatile("s_waitcnt lgkmcnt(" #n ")" ::: "memory")
#define PG8_BAR __builtin_amdgcn_s_barrier()
#define PG8_SCHED __builtin_amdgcn_sched_barrier(0)
#define PG8_HOFF(h) (GATHER ? (size_t)0 : (size_t)(h) * hstep)
#define PG8_STAGE_A(bufoff, base_, h_, uq_) do { if constexpr (GATHER) { unsigned vo_[2]; _Pragma("unroll") for (int _i = 0; _i < 2; ++_i) vo_[_i] = gtab[(uq_) * 256 + (h_) * HALF + sR[_i]] + (unsigned)sC[_i] * 2u; PG8_STAGE(bufoff, base_, vo_); } \
        else { PG8_STAGE(bufoff, (base_) + PG8_HOFF(h_), voffA); } } while (0)
    Unit cur, nxt; int ui = 0;
    if (!S.next(0, cur)) return;
    f32x4 acc[2][2][4][2];
#pragma unroll
    for (int a = 0; a < 2; ++a)
#pragma unroll
        for (int b = 0; b < 2; ++b)
#pragma unroll
            for (int m = 0; m < 4; ++m)
#pragma unroll
                for (int n = 0; n < 2; ++n) acc[a][b][m][n] = (f32x4){0.f, 0.f, 0.f, 0.f};
    bf16x8 At[4][2], B0[2][2], B1[2][2]; i32x8 At8[4], B08[2], B18[2];
    const char* cA = (const char*)g.A + (GATHER ? (size_t)0 : (size_t)cur.pm * tstep); const char* cB = (const char*)g.Bt + (size_t)cur.pn * tstep;
    PG8_STAGE(PG8_SB(0, 0), cB, voffB); PG8_STAGE(PG8_SB(0, 1), cB + hstep, voffB); PG8_STAGE_A(PG8_SA(0, 0), cA, 0, 0); PG8_STAGE_A(PG8_SA(0, 1), cA, 1, 0);
    if (wr == 1) PG8_BAR;
    PG8_WAIT_V(2); PG8_BAR;
    PG8_STAGE(PG8_SB(1, 0), cB + kstep, voffB); PG8_STAGE_A(PG8_SA(1, 0), cA + kstep, 0, 0); PG8_STAGE(PG8_SB(1, 1), cB + hstep + kstep, voffB);
    PG8_WAIT_V(6); PG8_BAR;
    for (;;) {
        const bool has_next = S.next(ui + 1, nxt);
        const char* nA = GATHER ? cA : (has_next ? (const char*)g.A + (size_t)nxt.pm * tstep : cA); const char* nB = has_next ? (const char*)g.Bt + (size_t)nxt.pn * tstep : cB;
#pragma unroll 1
        for (int t = 0; t < nt; t += 2) {
            const bool last = (t == nt - 2);
            const char* a1 = cA + (size_t)(t + 1) * kstep;
            const char* a2 = last ? nA : cA + (size_t)(t + 2) * kstep; const char* b2 = last ? nB : cB + (size_t)(t + 2) * kstep;
            const char* a3 = a2 + kstep; const char* b3 = b2 + kstep;
            const int uq = (last && has_next) ? ui + 1 : ui;
            PG8_LDB(B0, 0, 0); PG8_LDB(B1, 0, 1); PG8_SCHED; PG8_LDA(At, 0, 0); PG8_STAGE_A(PG8_SA(1, 1), a1, 1, ui);
            PG8_WAIT_V(8); PG8_WAIT_L(0); PG8_BAR; PG8_MMA(0, 0, At, B0); PG8_MMA(0, 1, At, B1); PG8_BAR; PG8_SCHED;
            PG8_LDA(At, 0, 1); PG8_STAGE(PG8_SB(0, 0), b2, voffB); PG8_STAGE(PG8_SB(0, 1), b2 + hstep, voffB); PG8_STAGE_A(PG8_SA(0, 0), a2, 0, uq);
            PG8_WAIT_V(8); PG8_WAIT_L(0); PG8_BAR; PG8_MMA(1, 0, At, B0); PG8_MMA(1, 1, At, B1); PG8_BAR; PG8_SCHED;
            PG8_LDB(B0, 1, 0); PG8_LDB(B1, 1, 1); PG8_SCHED; PG8_LDA(At, 1, 0); PG8_STAGE_A(PG8_SA(0, 1), a2, 1, uq);
            PG8_WAIT_V(8); PG8_WAIT_L(0); PG8_BAR; PG8_MMA(0, 0, At, B0); PG8_MMA(0, 1, At, B1); PG8_BAR; PG8_SCHED;
            PG8_LDA(At, 1, 1); PG8_STAGE(PG8_SB(1, 0), b3, voffB); PG8_STAGE(PG8_SB(1, 1), b3 + hstep, voffB); PG8_STAGE_A(PG8_SA(1, 0), a3, 0, uq);
            PG8_WAIT_V(8); PG8_WAIT_L(0); PG8_BAR; PG8_MMA(1, 0, At, B0); PG8_MMA(1, 1, At, B1); PG8_BAR; PG8_SCHED;
        }
        if constexpr (ALIGN_EPI) { if (wr == 0) PG8_BAR; }
        if constexpr (F8) { asm volatile("s_nop 15\n\ts_nop 15" ::: "memory"); PG8_SCHED; }
        E(acc, cur, ui, wr, wc, fr, fq);
        if (!has_next) break;
#pragma unroll
        for (int a = 0; a < 2; ++a)
#pragma unroll
            for (int b = 0; b < 2; ++b)
#pragma unroll
                for (int m = 0; m < 4; ++m)
#pragma unroll
                    for (int n = 0; n < 2; ++n) acc[a][b][m][n] = (f32x4){0.f, 0.f, 0.f, 0.f};
        cur = nxt; cA = nA; cB = nB; ++ui;
        if constexpr (ALIGN_EPI) { if (wr == 1) PG8_BAR; }
    }
    PG8_WAIT_V(0);
    if constexpr (!ALIGN_EPI) { if (wr == 0) PG8_BAR; }
    PG8_BAR;
#undef PG8_SA
#undef PG8_SB
#undef PG8_STAGE
#undef PG8_LDA
#undef PG8_LDB
#undef PG8_MMA
#undef PG8_WAIT_V
#undef PG8_WAIT_L
#undef PG8_BAR
#undef PG8_SCHED
#undef PG8_STAGE_A
#undef PG8_HOFF
}


struct EpiProj {
    static constexpr bool PERM = true;
    bf16_t* P; float* GZ; const float* tab;
    __device__ __forceinline__ void operator()(const f32x4 (&acc)[2][2][4][2], const Unit& u, int ui, int wr, int wc, int fr, int fq) const {
        const int pn = u.pn, row0 = u.pm * BM + wr * 64 + fr, colw = wc * 32 + 8 * fq;
        if (pn == 14) {
            if (wc == 0) {
#pragma unroll
                for (int ai = 0; ai < 2; ++ai)
#pragma unroll
                    for (int m = 0; m < 4; ++m) { float* o = GZ + (size_t)(row0 + ai * HALF + m * 16) * 32 + 8 * fq; *(f32x4*)o = acc[ai][0][m][0]; *(f32x4*)(o + 4) = acc[ai][0][m][1]; }
            }
            return;
        }
        const int mode = (pn == 0) ? 1 : ((pn == 4 || pn == 5 || pn >= 12) ? 2 : ((pn >= 6 && pn <= 9) ? 3 : 0));
        const float rks = (pn >= 8) ? 0.08838834764831845f : 1.0f;
        const bool lowhalf = wc < 2;
        const int f0 = (16 * wc + 4 * fq) & 31;
#pragma unroll
        for (int ai = 0; ai < 2; ++ai)
#pragma unroll
            for (int m = 0; m < 4; ++m) {
                const int row = row0 + ai * HALF + m * 16;
                bf16_t* rowp = P + ptile(row, pn * BM + colw);
                f32x4 cs0 = {1.f, 0.f, 1.f, 0.f}, cs1 = {1.f, 0.f, 1.f, 0.f};
                if (mode == 3 && row < NLAT) { const int t = row & (SEQ - 1), pos = lowhalf ? (t >> 6) : (t & 63); const float* tp = tab + 2 * (pos * 32 + f0); cs0 = *(const f32x4*)tp; cs1 = *(const f32x4*)(tp + 4); }
#pragma unroll
                for (int bj = 0; bj < 2; ++bj) {
                    f32x4 v0 = acc[ai][bj][m][0], v1 = acc[ai][bj][m][1];
                    if (mode == 1) { v0 = v0 * 0.125f; v1 = v1 * 0.125f; }
                    else if (mode == 2) {
#pragma unroll
                        for (int e = 0; e < 4; ++e) { v0[e] = fast_silu(v0[e]); v1[e] = fast_silu(v1[e]); }
                    } else if (mode == 3) {
                        v0 = v0 * rks; v1 = v1 * rks;
                        const float c[4] = {cs0[0], cs0[2], cs1[0], cs1[2]}, s[4] = {cs0[1], cs0[3], cs1[1], cs1[3]};
#pragma unroll
                        for (int e = 0; e < 4; ++e) { const float a1 = v0[e], a2 = v1[e]; v0[e] = a1 * c[e] - a2 * s[e]; v1[e] = a1 * s[e] + a2 * c[e]; }
                    }
                    u32x4 w; w.x = cvt_pk_bf16(v0[0], v0[1]); w.y = cvt_pk_bf16(v0[2], v0[3]); w.z = cvt_pk_bf16(v1[0], v1[1]); w.w = cvt_pk_bf16(v1[2], v1[3]);
                    *(u32x4*)(rowp + bj * 8192) = w;
                }
            }
    }
};
struct EpiOut {
    static constexpr bool PERM = true;
    bf16_t* XO; const float* mod;
    __device__ __forceinline__ void operator()(const f32x4 (&acc)[2][2][4][2], const Unit& u, int ui, int wr, int wc, int fr, int fq) const {
        const int col0 = u.pn * BM + wc * 32 + 8 * fq, b = (u.pm * BM) / SEQ;
        const float* m2 = mod + b * NADA * D + 2 * D;
        f32x4 mv[2][2];
#pragma unroll
        for (int bj = 0; bj < 2; ++bj)
#pragma unroll
            for (int n = 0; n < 2; ++n) mv[bj][n] = *(const f32x4*)(m2 + col0 + bj * HALF + 4 * n);
#pragma unroll
        for (int ai = 0; ai < 2; ++ai)
#pragma unroll
            for (int m = 0; m < 4; ++m) { bf16_t* rowp = XO + (size_t)(u.pm * BM + ai * HALF + wr * 64 + m * 16 + fr) * D + col0;
#pragma unroll
                for (int bj = 0; bj < 2; ++bj) { const f32x4 v0 = mv[bj][0] * acc[ai][bj][m][0], v1 = mv[bj][1] * acc[ai][bj][m][1];
                    u32x4 w; w.x = cvt_pk_bf16(v0[0], v0[1]); w.y = cvt_pk_bf16(v0[2], v0[3]); w.z = cvt_pk_bf16(v1[0], v1[1]); w.w = cvt_pk_bf16(v1[2], v1[3]);
                    *(u32x4*)(rowp + bj * HALF) = w; } }
    }
};
struct EpiAct {
    static constexpr bool PERM = true;
    unsigned char* ACT; float wscale, ascale;
    __device__ __forceinline__ void operator()(const f32x4 (&acc)[2][2][4][2], const Unit& u, int ui, int wr, int wc, int fr, int fq) const {
        const int pnl = u.pn % 11, col0 = pnl * HALF + wc * 32 + 8 * fq;
#pragma unroll
        for (int ai = 0; ai < 2; ++ai)
#pragma unroll
            for (int m = 0; m < 4; ++m) { unsigned char* rowp = ACT + (size_t)(u.pm * BM + ai * HALF + wr * 64 + m * 16 + fr) * FFP;
                f32x4 v0, v1;
#pragma unroll
                for (int e = 0; e < 4; ++e) { const float a0 = acc[ai][0][m][0][e] * wscale, a1 = acc[ai][0][m][1][e] * wscale;
                    v0[e] = fast_silu(a0) * (acc[ai][1][m][0][e] * (wscale * ascale)); v1[e] = fast_silu(a1) * (acc[ai][1][m][1][e] * (wscale * ascale)); }
                u32x2 w; w.x = pk_fp8x4(v0[0], v0[1], v0[2], v0[3]); w.y = pk_fp8x4(v1[0], v1[1], v1[2], v1[3]);
                *(u32x2*)(rowp + col0) = w;
                if (pnl == 10) *(u32x2*)(rowp + FF + wc * 32 + 8 * fq) = (u32x2){0u, 0u}; }
    }
};
struct EpiDown {
    static constexpr bool PERM = true;
    bf16_t* YE; const float* gate; float oscale;
    __device__ __forceinline__ void operator()(const f32x4 (&acc)[2][2][4][2], const Unit& u, int ui, int wr, int wc, int fr, int fq) const {
        const int col0 = (u.pn & 3) * BM + wc * 32 + 8 * fq;
#pragma unroll
        for (int ai = 0; ai < 2; ++ai)
#pragma unroll
            for (int m = 0; m < 4; ++m) { const int row = u.pm * BM + ai * HALF + wr * 64 + m * 16 + fr; const float gt = gate[row] * oscale; bf16_t* rowp = YE + (size_t)row * D + col0;
#pragma unroll
                for (int bj = 0; bj < 2; ++bj) { const f32x4 v0 = acc[ai][bj][m][0] * gt, v1 = acc[ai][bj][m][1] * gt;
                    u32x4 w; w.x = cvt_pk_bf16(v0[0], v0[1]); w.y = cvt_pk_bf16(v0[2], v0[3]); w.z = cvt_pk_bf16(v1[0], v1[1]); w.w = cvt_pk_bf16(v1[2], v1[3]);
                    *(u32x4*)(rowp + bj * HALF) = w; } }
    }
};
}

namespace scan {
constexpr int RS = 72;
constexpr int RS2 = 136;
constexpr int OS = 132;
constexpr int NSL = 260;
constexpr size_t GLA_SLOT = 128 * 64, RET_SLOT = 128 * 128;
constexpr size_t US_RET_OFF = (size_t)16 * NSL * GLA_SLOT;
__device__ __forceinline__ int slot_row0(int b, int slot) { return slot < 4 ? NLAT + b * CTX + slot * 64 : b * SEQ + (slot - 4) * 64; }
__device__ __forceinline__ int slot_at(int dir, int step) { return dir ? (step < 4 ? 3 - step : 263 - step) : step; }
__device__ __forceinline__ f32x4 mfma16(bf16x8 a, bf16x8 b, f32x4 c) { return __builtin_amdgcn_mfma_f32_16x16x32_bf16(a, b, c, 0, 0, 0); }
__device__ __forceinline__ bf16x8 lds_frag(const LAS bf16_t* base, int off) { return *(const LAS bf16x8*)(base + off); }
__device__ __forceinline__ int tsw_w(int row, int j) { return row * RS + ((((j >> 3) ^ ((row >> 4) & 7)) << 3) | (j & 7)); }
__device__ __forceinline__ int tsw_r(int row, int chunk) { return row * RS + ((chunk ^ ((row >> 4) & 7)) << 3); }
__device__ __forceinline__ bf16x8 lds_frag_pi(const LAS bf16_t* base, int off  ) {
    typedef short s4 __attribute__((ext_vector_type(4)));
    const s4 lo = *(const LAS s4*)(base + off), hi = *(const LAS s4*)(base + off + 16);
    return (bf16x8){lo[0], lo[1], lo[2], lo[3], hi[0], hi[1], hi[2], hi[3]};
}
__device__ __forceinline__ unsigned pk(float lo, float hi) { return pg8::cvt_pk_bf16(lo, hi); }
__device__ __forceinline__ bf16_t f2bf_hw(float x) { return (bf16_t)(pg8::cvt_pk_bf16(x, 0.f) & 0xffffu); }
__device__ __forceinline__ u32x2 pack_state8(const f32x4 a0, const f32x4 a1) { u32x2 o; o.x = pg8::pk_fp8x4(a0[0], a0[1], a0[2], a0[3]); o.y = pg8::pk_fp8x4(a1[0], a1[1], a1[2], a1[3]); return o; }
__device__ __forceinline__ bf16x8 unpack_state8(const u32x2 w) {
    const f32x2 a = __builtin_amdgcn_cvt_pk_f32_fp8((int)w.x, false), b = __builtin_amdgcn_cvt_pk_f32_fp8((int)w.x, true), c = __builtin_amdgcn_cvt_pk_f32_fp8((int)w.y, false), d = __builtin_amdgcn_cvt_pk_f32_fp8((int)w.y, true);
    const u32x4 r = {pk(a[0], a[1]), pk(b[0], b[1]), pk(c[0], c[1]), pk(d[0], d[1])};
    return __builtin_bit_cast(bf16x8, r);
}

typedef float f32x4m __attribute__((ext_vector_type(4)));
__device__ __forceinline__ void gla_stepA(const float (&wm)[2][2][4], float bf, float bb, int w, int lane, const LAS float* gz_s, LAS float* PR, LAS float* tot, float (&bi)[8], float (&ci)[8], float& allf, float& allb) {
    { const int it = w >> 1, c = lane & 15, q = lane >> 4;
      float a_f[4], a_b[4];
#pragma unroll
      for (int sx = 0; sx < 4; ++sx) { a_f[sx] = gz_s[(16 * it + c) * 36 + 4 * sx + q]; a_b[sx] = gz_s[(16 * it + c) * 36 + 16 + 4 * sx + q]; }
#pragma unroll
      for (int kk = 0; kk < 2; ++kk) { const int kt = 2 * (w & 1) + kk; f32x4 df = {0.f, 0.f, 0.f, 0.f}, db = {0.f, 0.f, 0.f, 0.f};
#pragma unroll
          for (int sx = 0; sx < 4; ++sx) { df = __builtin_amdgcn_mfma_f32_16x16x4f32(a_f[sx], wm[0][kk][sx], df, 0, 0, 0); db = __builtin_amdgcn_mfma_f32_16x16x4f32(a_b[sx], wm[1][kk][sx], db, 0, 0, 0); }
#pragma unroll
          for (int r = 0; r < 4; ++r) { PR[(16 * it + 4 * q + r) * 65 + 16 * kt + c] = df[r]; PR[64 * 65 + (16 * it + 4 * q + r) * 65 + 16 * kt + c] = db[r]; } } }
    __syncthreads();
    float laf[8], lab[8];
#pragma unroll
    for (int tt = 0; tt < 8; ++tt) {
        const float pf = bf + PR[(8 * w + tt) * 65 + lane], pb = bb + PR[64 * 65 + (8 * w + tt) * 65 + lane];
        laf[tt] = (fminf(pf, 0.f) - __logf(1.0f + __expf(-fabsf(pf)))) * 0.0625f;
        lab[tt] = (fminf(pb, 0.f) - __logf(1.0f + __expf(-fabsf(pb)))) * 0.0625f;
    }
#pragma unroll
    for (int tt = 1; tt < 8; ++tt) laf[tt] += laf[tt - 1];
#pragma unroll
    for (int tt = 6; tt >= 0; --tt) lab[tt] += lab[tt + 1];
    tot[w * 64 + lane] = laf[7]; tot[512 + w * 64 + lane] = lab[0];
    __syncthreads();
    float offf = 0.f, offb = 0.f; allf = 0.f; allb = 0.f;
#pragma unroll
    for (int w2 = 0; w2 < 8; ++w2) { const float tf = tot[w2 * 64 + lane], tb = tot[512 + w2 * 64 + lane]; allf += tf; allb += tb; if (w2 < w) offf += tf; if (w2 > w) offb += tb; }
#pragma unroll
    for (int tt = 0; tt < 8; ++tt) { bi[tt] = offf + laf[tt]; ci[tt] = offb + lab[tt]; }
}
__device__ __forceinline__ void load_gate_wm(const Ptrs& p, int h, int w, int lane, float (&wm)[2][2][4]) {
#pragma unroll
    for (int dir = 0; dir < 2; ++dir)
#pragma unroll
        for (int kk = 0; kk < 2; ++kk)
#pragma unroll
            for (int sx = 0; sx < 4; ++sx) wm[dir][kk][sx] = p.gla_gate_w[(dir * 16 + 4 * sx + (lane >> 4)) * 256 + h * 64 + 16 * (2 * (w & 1) + kk) + (lane & 15)];
}
__device__ __forceinline__ void stage_vt_regs(const u32x4 a, const u32x4 b, LAS bf16_t* VT, int tid) {
    const int j = tid >> 3, vg = tid & 7;
    const unsigned wv[8] = {a.x, a.y, a.z, a.w, b.x, b.y, b.z, b.w};
#pragma unroll
    for (int e = 0; e < 8; ++e) { VT[tsw_w(vg * 16 + 2 * e, j)] = (bf16_t)(wv[e] & 0xffffu); VT[tsw_w(vg * 16 + 2 * e + 1, j)] = (bf16_t)(wv[e] >> 16); }
}
#ifndef C1G_REP
#define C1G_REP 1
#endif
#ifndef C1R_REP
#define C1R_REP 1
#endif
#define SCAN_FENCE() asm volatile("" ::: "memory")

__device__ __forceinline__ void run_c1(const Ptrs& p, LAS unsigned char* lds, int bx) {
    const int tid = threadIdx.x, w = __builtin_amdgcn_readfirstlane(tid >> 6), lane = tid & 63, c = lane & 15, q = lane >> 4;
    const int bh = bx >> 5, b = bh >> 2, h = bh & 3, s0 = bx & 31;
    const bf16_t* P = (const bf16_t*)(p.ws + WS_P);
    const int jrow = tid >> 3, g8 = tid & 7;
    {
        LAS float* gz_s = (LAS float*)lds; LAS float* tot = (LAS float*)(lds + 91648); LAS float* PR = (LAS float*)(lds + 58368);
        LAS bf16_t* KfT = (LAS bf16_t*)(lds + 12288); LAS bf16_t* KbT = (LAS bf16_t*)(lds + 21504); LAS bf16_t* VT = (LAS bf16_t*)(lds + 30720); LAS bf16_t* Kraw = (LAS bf16_t*)(lds + 49152);
        float wm[2][2][4]; load_gate_wm(p, h, w, lane, wm);
        const float bf = p.gla_gate_b[h * 64 + lane], bb = p.gla_gate_b[256 + h * 64 + lane];
        f32x4 gzv_A, gzv_B; u32x4 va_A, vb_A, kv_A, va_B, vb_B, kv_B;
#define C1G_LOAD(S, slot_) do { const int r0_ = slot_row0(b, (slot_)); gzv_##S = ((const f32x4*)((const float*)(p.ws + WS_GZ) + (size_t)r0_ * 32))[tid]; \
            const bf16_t* rv_ = P + ptile(r0_ + jrow, C_GV + h * 128 + g8 * 16); va_##S = *(const u32x4*)rv_; vb_##S = *(const u32x4*)(rv_ + 8); \
            kv_##S = *(const u32x4*)(P + ptile(r0_ + jrow, C_GK + h * 64 + g8 * 8)); } while (0)
#define C1G_ITEM(S, slot) do { \
            *(LAS f32x4*)(gz_s + jrow * 36 + g8 * 4) = gzv_##S; stage_vt_regs(va_##S, vb_##S, VT, tid); *(LAS u32x4*)(Kraw + jrow * RS + g8 * 8) = kv_##S; \
            __syncthreads(); \
            if ((slot) + 64 < NSL) C1G_LOAD(S, (slot) + 64); \
            float bi[8], ci[8], allf, allb; \
            gla_stepA(wm, bf, bb, w, lane, gz_s, PR, tot, bi, ci, allf, allb); \
            { float ef[8], eb[8]; \
            _Pragma("unroll") \
              for (int tt = 0; tt < 8; ++tt) { const float kk = bf2f(Kraw[(8 * w + tt) * RS + lane]); ef[tt] = kk * __expf(allf - bi[tt]); eb[tt] = kk * __expf(allb - ci[tt]); } \
              u32x4 wf_, wb_; wf_.x = pk(ef[0], ef[1]); wf_.y = pk(ef[2], ef[3]); wf_.z = pk(ef[4], ef[5]); wf_.w = pk(ef[6], ef[7]); \
              wb_.x = pk(eb[0], eb[1]); wb_.y = pk(eb[2], eb[3]); wb_.z = pk(eb[4], eb[5]); wb_.w = pk(eb[6], eb[7]); \
              *(LAS u32x4*)(KfT + lane * RS + 8 * w) = wf_; *(LAS u32x4*)(KbT + lane * RS + 8 * w) = wb_; } \
            float* DCH = (float*)(p.ws + WS_DCH); \
            if (w == 0) { DCH[((size_t)(bh * 2 + 0) * NSL + (slot)) * 64 + lane] = __expf(allf); DCH[((size_t)(bh * 2 + 1) * NSL + (slot)) * 64 + lane] = __expf(allb); } \
            __syncthreads(); \
            unsigned char* US = (unsigned char*)p.out; \
            bf16x8 Bv[2]; \
            _Pragma("unroll") \
            for (int js = 0; js < 2; ++js) Bv[js] = lds_frag(VT, tsw_r(16 * w + c, 4 * js + q)); \
            _Pragma("unroll") \
            for (int dir = 0; dir < 2; ++dir) { const LAS bf16_t* KT = dir ? KbT : KfT; \
            _Pragma("unroll") \
                for (int ks = 0; ks < 2; ++ks) { f32x4 a0 = {0.f, 0.f, 0.f, 0.f}, a1 = {0.f, 0.f, 0.f, 0.f}; \
            _Pragma("unroll") \
                    for (int js = 0; js < 2; ++js) { a0 = mfma16(lds_frag(KT, (32 * ks + c) * RS + 32 * js + 8 * q), Bv[js], a0); a1 = mfma16(lds_frag(KT, (32 * ks + 16 + c) * RS + 32 * js + 8 * q), Bv[js], a1); } \
                    *(u32x2*)(US + ((size_t)(bh * 2 + dir) * NSL + (slot)) * GLA_SLOT + ((w * 2 + ks) * 64 + lane) * 8) = pack_state8(a0, a1); } } \
            __syncthreads(); \
        } while (0)
        for (int rep1_ = 0; rep1_ < C1G_REP; ++rep1_) {
        C1G_LOAD(A, s0); if (s0 + 32 < NSL) C1G_LOAD(B, s0 + 32);
        for (int slot = s0; slot < NSL; slot += 64) {
            C1G_ITEM(A, slot);
            if (slot + 32 < NSL) C1G_ITEM(B, slot + 32);
        }
        }
#undef C1G_ITEM
#undef C1G_LOAD
    }
    {
        LAS bf16_t* KT = (LAS bf16_t*)lds; LAS bf16_t* VfT = (LAS bf16_t*)(lds + 18432); LAS bf16_t* VbT = (LAS bf16_t*)(lds + 36864);
        const float lgf = log_sigmoidf(p.ret_decay_logit[h]), lgb = log_sigmoidf(p.ret_decay_logit[4 + h]);
        const float sf = __expf(lgf * (float)(63 - jrow)), sb = __expf(lgb * (float)jrow);
        u32x4 ka_A, kb_A, va_A, vb_A, ka_B, kb_B, va_B, vb_B;
#define C1R_LOAD(S, slot_) do { const int rr_ = slot_row0(b, (slot_)) + jrow; const bf16_t* rk_ = P + ptile(rr_, C_RK + h * 128 + g8 * 16); const bf16_t* rv_ = P + ptile(rr_, C_RV + h * 128 + g8 * 16); \
            ka_##S = *(const u32x4*)rk_; kb_##S = *(const u32x4*)(rk_ + 8); va_##S = *(const u32x4*)rv_; vb_##S = *(const u32x4*)(rv_ + 8); } while (0)
#define C1R_ITEM(S, slot) do { \
            { const unsigned kw[8] = {ka_##S.x, ka_##S.y, ka_##S.z, ka_##S.w, kb_##S.x, kb_##S.y, kb_##S.z, kb_##S.w}, vw[8] = {va_##S.x, va_##S.y, va_##S.z, va_##S.w, vb_##S.x, vb_##S.y, vb_##S.z, vb_##S.w}; \
            _Pragma("unroll") \
              for (int e = 0; e < 8; ++e) { const int r0 = tsw_w(g8 * 16 + 2 * e, jrow), r1 = tsw_w(g8 * 16 + 2 * e + 1, jrow); \
                  KT[r0] = (bf16_t)(kw[e] & 0xffffu); KT[r1] = (bf16_t)(kw[e] >> 16); \
                  const float v0 = __uint_as_float(vw[e] << 16), v1 = __uint_as_float(vw[e] & 0xffff0000u); \
                  VfT[r0] = f2bf_hw(v0 * sf); VfT[r1] = f2bf_hw(v1 * sf); VbT[r0] = f2bf_hw(v0 * sb); VbT[r1] = f2bf_hw(v1 * sb); } } \
            __syncthreads(); \
            if ((slot) + 64 < NSL) C1R_LOAD(S, (slot) + 64); \
            unsigned char* US = (unsigned char*)p.out + US_RET_OFF; \
            _Pragma("unroll") \
            for (int dir = 0; dir < 2; ++dir) { const LAS bf16_t* VT = dir ? VbT : VfT; \
                bf16x8 Bv[2]; \
            _Pragma("unroll") \
                for (int js = 0; js < 2; ++js) Bv[js] = lds_frag(VT, tsw_r(16 * w + c, 4 * js + q)); \
            _Pragma("unroll") \
                for (int ks = 0; ks < 4; ++ks) { f32x4 a0 = {0.f, 0.f, 0.f, 0.f}, a1 = {0.f, 0.f, 0.f, 0.f}; \
            _Pragma("unroll") \
                    for (int js = 0; js < 2; ++js) { a0 = mfma16(lds_frag(KT, tsw_r(32 * ks + c, 4 * js + q)), Bv[js], a0); a1 = mfma16(lds_frag(KT, tsw_r(32 * ks + 16 + c, 4 * js + q)), Bv[js], a1); } \
                    *(u32x2*)(US + ((size_t)(bh * 2 + dir) * NSL + (slot)) * RET_SLOT + ((w * 4 + ks) * 64 + lane) * 8) = pack_state8(a0, a1); } } \
            __syncthreads(); \
        } while (0)
        for (int rep2_ = 0; rep2_ < C1R_REP; ++rep2_) {
        C1R_LOAD(A, s0); if (s0 + 32 < NSL) C1R_LOAD(B, s0 + 32);
        for (int slot = s0; slot < NSL; slot += 64) {
            C1R_ITEM(A, slot);
            if (slot + 32 < NSL) C1R_ITEM(B, slot + 32);
        }
        }
#undef C1R_ITEM
#undef C1R_LOAD
    }
}
__device__ __forceinline__ void run_c2(const Ptrs& p, LAS unsigned char* lds, int bx) {
    constexpr int NB = 13, GLA_ELEMS = 16 * 8192;
    const int tid = threadIdx.x;
    LAS float* dl = (LAS float*)lds;
    const int e_blk = bx * 1536, c0 = e_blk >> 13;
    if (e_blk < GLA_ELEMS) {
        const int c1 = ((e_blk + 1535) >> 13) < 15 ? ((e_blk + 1535) >> 13) : 15;
        const f32x4* src = (const f32x4*)((const float*)(p.ws + WS_DCH) + (size_t)c0 * NSL * 64);
        const int n4 = (c1 - c0 + 1) * NSL * 16;
        for (int i = tid; i < n4; i += NTHR) ((LAS f32x4*)dl)[i] = src[i];
    }
    __syncthreads();
    if (tid < 192) {
        const int e = e_blk + tid * 8;
        const bool isG = e < GLA_ELEMS;
        const int er = isG ? e : e - GLA_ELEMS;
        const int chain = isG ? (er >> 13) : (er >> 14), el = isG ? (er & 8191) : (er & 16383);
        const size_t SLOT = isG ? GLA_SLOT : RET_SLOT;
        const int dir = chain & 1, h = (chain >> 1) & 3;
        const size_t off = (isG ? 0 : US_RET_OFF) + (size_t)chain * NSL * SLOT + el;
        const unsigned char* ubase = (const unsigned char*)p.out + off;
        bf16_t* sbase = (bf16_t*)(p.ws + WS_US) + off;
        const float dconst = __expf(64.0f * log_sigmoidf(p.ret_decay_logit[dir * 4 + h]));
        const int kb = 32 * ((el >> 9) & 1) + 4 * (((el >> 3) & 63) >> 4);
        const LAS float* dlc = dl + (isG ? (chain - c0) : 0) * NSL * 64 + kb;
        f32x4 s0 = {0.f, 0.f, 0.f, 0.f}, s1 = {0.f, 0.f, 0.f, 0.f};
        u32x2 uA[NB], uB[NB];
#define C2_LOAD(U_, bt_) do { _Pragma("unroll") for (int i = 0; i < NB; ++i) { const int slot = slot_at(dir, (bt_) * NB + i); U_[i] = *(const u32x2*)(ubase + (size_t)slot * SLOT); } } while (0)
#define C2_PROC(U_, bt_) do { _Pragma("unroll") for (int i = 0; i < NB; ++i) { const int slot = slot_at(dir, (bt_) * NB + i); \
        { u32x4 o_; o_.x = pk(s0[0], s0[1]); o_.y = pk(s0[2], s0[3]); o_.z = pk(s1[0], s1[1]); o_.w = pk(s1[2], s1[3]); *(u32x4*)(sbase + (size_t)slot * SLOT) = o_; } \
        const f32x2 a_ = __builtin_amdgcn_cvt_pk_f32_fp8((int)U_[i].x, false), b_ = __builtin_amdgcn_cvt_pk_f32_fp8((int)U_[i].x, true), c_ = __builtin_amdgcn_cvt_pk_f32_fp8((int)U_[i].y, false), d_ = __builtin_amdgcn_cvt_pk_f32_fp8((int)U_[i].y, true); \
        const f32x4 u0 = {a_[0], a_[1], b_[0], b_[1]}, u1 = {c_[0], c_[1], d_[0], d_[1]}; \
        if (isG) { const f32x4 d0 = *(const LAS f32x4*)(dlc + slot * 64), d1 = *(const LAS f32x4*)(dlc + slot * 64 + 16); s0 = s0 * d0 + u0; s1 = s1 * d1 + u1; } else { s0 = s0 * dconst + u0; s1 = s1 * dconst + u1; } } } while (0)
        C2_LOAD(uA, 0);
        for (int bt = 0; bt < NSL / NB; bt += 2) {
            C2_LOAD(uB, bt + 1);
            C2_PROC(uA, bt);
            if (bt + 2 < NSL / NB) C2_LOAD(uA, bt + 2);
            C2_PROC(uB, bt + 1);
        }
#undef C2_LOAD
#undef C2_PROC
    }
    __syncthreads();
}
__device__ __forceinline__ void run_c3(const Ptrs& p, LAS unsigned char* lds, int bx, bf16_t* Y) {
    const int tid = threadIdx.x, w = __builtin_amdgcn_readfirstlane(tid >> 6), lane = tid & 63, c = lane & 15, q = lane >> 4;
    const int bh = bx >> 5, b = bh >> 2, h = bh & 3, n0 = bx & 31;
    const bf16_t* P = (const bf16_t*)(p.ws + WS_P);
    const int jrow = tid >> 3, g8 = tid & 7;
    {
        LAS float* gz_s = (LAS float*)lds; LAS float* tot = (LAS float*)(lds + 110592);
        LAS bf16_t* QF = (LAS bf16_t*)(lds + 12288); LAS bf16_t* QB = (LAS bf16_t*)(lds + 21504); LAS bf16_t* KF = (LAS bf16_t*)(lds + 30720); LAS bf16_t* KB = (LAS bf16_t*)(lds + 39936);
        LAS bf16_t* VT = (LAS bf16_t*)(lds + 49152); LAS bf16_t* Pm = (LAS bf16_t*)(lds + 67584); LAS float* Os = (LAS float*)(lds + 76800);
        float wm[2][2][4]; load_gate_wm(p, h, w, lane, wm);
        const float bf = p.gla_gate_b[h * 64 + lane], bb = p.gla_gate_b[256 + h * 64 + lane];
        const f32x2 nw = *(const f32x2*)(p.gla_norm_w + h * 128 + 2 * lane);
        const bf16_t* US = (const bf16_t*)(p.ws + WS_US);
        f32x4 gzv; u32x4 va, vb, qv, kv; bf16x8 Sfn[2], Sbn[2]; unsigned gtn[8];
#define C3G_LOAD(n_) do { const int r0_ = b * SEQ + (n_) * 64; gzv = ((const f32x4*)((const float*)(p.ws + WS_GZ) + (size_t)r0_ * 32))[tid]; \
            const bf16_t* rv_ = P + ptile(r0_ + jrow, C_GV + h * 128 + g8 * 16); va = *(const u32x4*)rv_; vb = *(const u32x4*)(rv_ + 8); \
            qv = *(const u32x4*)(P + ptile(r0_ + jrow, C_GQ + h * 64 + g8 * 8)); kv = *(const u32x4*)(P + ptile(r0_ + jrow, C_GK + h * 64 + g8 * 8)); \
            _Pragma("unroll") for (int ks = 0; ks < 2; ++ks) { Sfn[ks] = *(const bf16x8*)(US + ((size_t)(bh * 2 + 0) * NSL + 4 + (n_)) * GLA_SLOT + ((w * 2 + ks) * 64 + lane) * 8); \
                                                          Sbn[ks] = *(const bf16x8*)(US + ((size_t)(bh * 2 + 1) * NSL + 4 + (n_)) * GLA_SLOT + ((w * 2 + ks) * 64 + lane) * 8); } \
            _Pragma("unroll") for (int tt = 0; tt < 8; ++tt) gtn[tt] = *(const unsigned*)(P + ptile(r0_ + 8 * w + tt, C_GG + h * 128 + 2 * lane)); } while (0)
        C3G_LOAD(n0);
        for (int n = n0; n < 256; n += 32) {
            const int row0 = b * SEQ + n * 64;
            *(LAS f32x4*)(gz_s + jrow * 36 + g8 * 4) = gzv; stage_vt_regs(va, vb, VT, tid);
            *(LAS u32x4*)(QF + jrow * RS + g8 * 8) = qv; *(LAS u32x4*)(KF + jrow * RS + g8 * 8) = kv;
            bf16x8 Sf[2], Sb[2]; unsigned gt[8];
#pragma unroll
            for (int ks = 0; ks < 2; ++ks) { Sf[ks] = Sfn[ks]; Sb[ks] = Sbn[ks]; }
#pragma unroll
            for (int tt = 0; tt < 8; ++tt) gt[tt] = gtn[tt];
            __syncthreads();
            if (n + 32 < 256) C3G_LOAD(n + 32);
            float bi[8], ci[8], allf, allb;
            gla_stepA(wm, bf, bb, w, lane, gz_s, (LAS float*)Os, tot, bi, ci, allf, allb);
#pragma unroll
            for (int tt = 0; tt < 8; ++tt) { const int i = 8 * w + tt; const float qq = bf2f(QF[i * RS + lane]), kk = bf2f(KF[i * RS + lane]);
                QF[i * RS + lane] = f2bf_hw(qq * __expf(bi[tt])); QB[i * RS + lane] = f2bf_hw(qq * __expf(ci[tt]));
                KF[i * RS + lane] = f2bf_hw(kk * __expf(-bi[tt])); KB[i * RS + lane] = f2bf_hw(kk * __expf(-ci[tt])); }
            __syncthreads();
            { const int it = w & 3, i = 16 * it + c;
              bf16x8 qf[2], qb[2];
#pragma unroll
              for (int ks = 0; ks < 2; ++ks) { qf[ks] = lds_frag(QF, i * RS + 32 * ks + 8 * q); qb[ks] = lds_frag(QB, i * RS + 32 * ks + 8 * q); }
#pragma unroll
              for (int jj = 0; jj < 2; ++jj) { const int jt = 2 * (w >> 2) + jj; f32x4 af = {0.f, 0.f, 0.f, 0.f}, ab = {0.f, 0.f, 0.f, 0.f};
#pragma unroll
                  for (int ks = 0; ks < 2; ++ks) { af = mfma16(lds_frag(KF, (16 * jt + c) * RS + 32 * ks + 8 * q), qf[ks], af); ab = mfma16(lds_frag(KB, (16 * jt + c) * RS + 32 * ks + 8 * q), qb[ks], ab); }
                  float v[4];
#pragma unroll
                  for (int r = 0; r < 4; ++r) { const int j = 16 * jt + 4 * q + r; v[r] = (j <= i ? af[r] : 0.f) + (j >= i ? ab[r] : 0.f); }
                  u32x2 o; o.x = pk(v[0], v[1]); o.y = pk(v[2], v[3]); *(LAS u32x2*)(Pm + i * RS + 16 * jt + 4 * q) = o; } }
            __syncthreads();
            { bf16x8 Bv[2];
#pragma unroll
              for (int js = 0; js < 2; ++js) Bv[js] = lds_frag(VT, tsw_r(16 * w + c, 4 * js + q));
#pragma unroll
              for (int it = 0; it < 4; ++it) { f32x4 a = {0.f, 0.f, 0.f, 0.f}; const int i = 16 * it + c;
#pragma unroll
                  for (int js = 0; js < 2; ++js) a = mfma16(lds_frag(Pm, i * RS + 32 * js + 8 * q), Bv[js], a);
#pragma unroll
                  for (int ks = 0; ks < 2; ++ks) { a = mfma16(lds_frag_pi(QF, i * RS + 32 * ks + 4 * q), Sf[ks], a); a = mfma16(lds_frag_pi(QB, i * RS + 32 * ks + 4 * q), Sb[ks], a); }
#pragma unroll
                  for (int r = 0; r < 4; ++r) Os[(16 * it + 4 * q + r) * OS + 16 * w + c] = a[r]; } }
            __syncthreads();
#pragma unroll
            for (int tt = 0; tt < 8; ++tt) { const int i = 8 * w + tt; const f32x2 o = *(const LAS f32x2*)(Os + i * OS + 2 * lane);
                const float r = rsqrtf(wave_sum(o[0] * o[0] + o[1] * o[1]) * (1.f / 128.f) + EPS);
                *(unsigned*)(Y + (size_t)(row0 + i) * D + h * 128 + 2 * lane) = pk(o[0] * r * nw[0] * __uint_as_float(gt[tt] << 16), o[1] * r * nw[1] * __uint_as_float(gt[tt] & 0xffff0000u)); }
        }
        __syncthreads();
#undef C3G_LOAD
    }
    {
        LAS bf16_t* Qs = (LAS bf16_t*)lds; LAS bf16_t* Ks = (LAS bf16_t*)(lds + 17408); LAS bf16_t* VT = (LAS bf16_t*)(lds + 34816); LAS bf16_t* Pm = (LAS bf16_t*)(lds + 53248);
        LAS float* Os = (LAS float*)(lds + 62464); LAS float* pwf = (LAS float*)(lds + 96256); LAS float* pwb = pwf + 80;
        const float lgf = log_sigmoidf(p.ret_decay_logit[h]), lgb = log_sigmoidf(p.ret_decay_logit[4 + h]);
        if (tid < 65) { pwf[tid] = __expf(lgf * (float)tid); pwb[tid] = __expf(lgb * (float)tid); }
        const f32x2 nw = *(const f32x2*)(p.ret_norm_w + h * 128 + 2 * lane);
        const bf16_t* US = (const bf16_t*)(p.ws + WS_US) + US_RET_OFF;
        u32x4 qa, qb2, ka, kb2, va, vb; bf16x8 Sfn[4], Sbn[4]; unsigned gtn[8];
#define C3R_LOAD(n_) do { const int r0_ = b * SEQ + (n_) * 64; const bf16_t* rq_ = P + ptile(r0_ + jrow, C_RQ + h * 128 + g8 * 16); const bf16_t* rk_ = P + ptile(r0_ + jrow, C_RK + h * 128 + g8 * 16); const bf16_t* rv_ = P + ptile(r0_ + jrow, C_RV + h * 128 + g8 * 16); \
            qa = *(const u32x4*)rq_; qb2 = *(const u32x4*)(rq_ + 8); ka = *(const u32x4*)rk_; kb2 = *(const u32x4*)(rk_ + 8); \
            va = *(const u32x4*)rv_; vb = *(const u32x4*)(rv_ + 8); \
            _Pragma("unroll") for (int ks = 0; ks < 4; ++ks) { Sfn[ks] = *(const bf16x8*)(US + ((size_t)(bh * 2 + 0) * NSL + 4 + (n_)) * RET_SLOT + ((w * 4 + ks) * 64 + lane) * 8); \
                                                          Sbn[ks] = *(const bf16x8*)(US + ((size_t)(bh * 2 + 1) * NSL + 4 + (n_)) * RET_SLOT + ((w * 4 + ks) * 64 + lane) * 8); } \
            _Pragma("unroll") for (int tt = 0; tt < 8; ++tt) gtn[tt] = *(const unsigned*)(P + ptile(r0_ + 8 * w + tt, C_RG + h * 128 + 2 * lane)); } while (0)
        C3R_LOAD(n0);
        for (int n = n0; n < 256; n += 32) {
            const int row0 = b * SEQ + n * 64;
            *(LAS u32x4*)(Qs + jrow * RS2 + g8 * 16) = qa; *(LAS u32x4*)(Qs + jrow * RS2 + g8 * 16 + 8) = qb2;
            *(LAS u32x4*)(Ks + jrow * RS2 + g8 * 16) = ka; *(LAS u32x4*)(Ks + jrow * RS2 + g8 * 16 + 8) = kb2;
            stage_vt_regs(va, vb, VT, tid);
            bf16x8 Sf[4], Sb[4]; unsigned gt[8];
#pragma unroll
            for (int ks = 0; ks < 4; ++ks) { Sf[ks] = Sfn[ks]; Sb[ks] = Sbn[ks]; }
#pragma unroll
            for (int tt = 0; tt < 8; ++tt) gt[tt] = gtn[tt];
            __syncthreads();
            if (n + 32 < 256) C3R_LOAD(n + 32);
            { const int it = w & 3, i = 16 * it + c;
              bf16x8 qf[4];
#pragma unroll
              for (int ks = 0; ks < 4; ++ks) qf[ks] = lds_frag(Qs, i * RS2 + 32 * ks + 8 * q);
#pragma unroll
              for (int jj = 0; jj < 2; ++jj) { const int jt = 2 * (w >> 2) + jj; f32x4 a = {0.f, 0.f, 0.f, 0.f};
#pragma unroll
                  for (int ks = 0; ks < 4; ++ks) a = mfma16(lds_frag(Ks, (16 * jt + c) * RS2 + 32 * ks + 8 * q), qf[ks], a);
                  float v[4];
#pragma unroll
                  for (int r = 0; r < 4; ++r) { const int j = 16 * jt + 4 * q + r; const int dd = i - j; const float dm = (dd >= 0 ? pwf[dd >= 0 ? dd : 0] : 0.f) + (dd <= 0 ? pwb[dd <= 0 ? -dd : 0] : 0.f); v[r] = a[r] * dm; }
                  u32x2 o; o.x = pk(v[0], v[1]); o.y = pk(v[2], v[3]); *(LAS u32x2*)(Pm + i * RS + 16 * jt + 4 * q) = o; } }
            __syncthreads();
            { bf16x8 Bv[2];
#pragma unroll
              for (int js = 0; js < 2; ++js) Bv[js] = lds_frag(VT, tsw_r(16 * w + c, 4 * js + q));
#pragma unroll
              for (int it = 0; it < 4; ++it) { f32x4 a = {0.f, 0.f, 0.f, 0.f}, af = {0.f, 0.f, 0.f, 0.f}, ab = {0.f, 0.f, 0.f, 0.f}; const int i = 16 * it + c;
#pragma unroll
                  for (int js = 0; js < 2; ++js) a = mfma16(lds_frag(Pm, i * RS + 32 * js + 8 * q), Bv[js], a);
#pragma unroll
                  for (int ks = 0; ks < 4; ++ks) { const bf16x8 qx = lds_frag_pi(Qs, i * RS2 + 32 * ks + 4 * q); af = mfma16(qx, Sf[ks], af); ab = mfma16(qx, Sb[ks], ab); }
#pragma unroll
                  for (int r = 0; r < 4; ++r) { const int ii = 16 * it + 4 * q + r; Os[ii * OS + 16 * w + c] = a[r] + pwf[ii + 1] * af[r] + pwb[64 - ii] * ab[r]; } } }
            __syncthreads();
#pragma unroll
            for (int tt = 0; tt < 8; ++tt) { const int i = 8 * w + tt; const f32x2 o = *(const LAS f32x2*)(Os + i * OS + 2 * lane);
                const float mu = wave_sum(o[0] + o[1]) * (1.f / 128.f); const float d0 = o[0] - mu, d1 = o[1] - mu;
                const float r = rsqrtf(wave_sum(d0 * d0 + d1 * d1) * (1.f / 128.f) + EPS);
                *(unsigned*)(Y + (size_t)(row0 + i) * D + 512 + h * 128 + 2 * lane) = pk(d0 * r * nw[0] * __uint_as_float(gt[tt] << 16), d1 * r * nw[1] * __uint_as_float(gt[tt] & 0xffff0000u)); }
        }
        __syncthreads();
#undef C3R_LOAD
    }
}
}

namespace misc {
__device__ __forceinline__ void p0_mod(const Ptrs& p, LAS unsigned char* lds, int bx) {
    LAS float* sc = (LAS float*)lds;
    LAS float* red = sc + 3 * D;
    const int tid = threadIdx.x;
    for (int i = tid; i < 3 * D; i += NTHR) { const int r = i >> 10, k = i & 1023; const float v = (r < 2) ? p.c[r * D + k] : p.c_ctx[k]; sc[i] = siluf(v); }
    __syncthreads();
    const int kg = tid >> 5, cl = tid & 31, col = 24 * bx + cl;
    float a0 = 0.f, a1 = 0.f, a2 = 0.f;
    if (cl < 24) {
#pragma unroll 8
        for (int k = kg * 64; k < kg * 64 + 64; ++k) { const float w = p.w_ada[(size_t)k * (NADA * D) + col]; a0 += sc[k] * w; a1 += sc[D + k] * w; a2 += sc[2 * D + k] * w; }
    }
    red[(kg * 3 + 0) * 32 + cl] = a0; red[(kg * 3 + 1) * 32 + cl] = a1; red[(kg * 3 + 2) * 32 + cl] = a2;
    __syncthreads();
    if (tid < 96) { const int r = tid >> 5, c2 = tid & 31; if (c2 < 24) { float s = 0.f;
#pragma unroll
        for (int g = 0; g < 16; ++g) s += red[(g * 3 + r) * 32 + c2];
        const int cc = 24 * bx + c2; ((float*)(p.ws + WS_MOD))[r * NADA * D + cc] = s + p.b_ada[cc]; } }
    __syncthreads();
}
__device__ __forceinline__ void p0_rope(const Ptrs& p, int gtid) {
    if (gtid < 256 * 32) { const int pos = gtid >> 5, f = gtid & 31; const float inv = powf(10000.0f, -(float)f / 32.0f); const float ang = (float)pos * inv;
        float* T = (float*)(p.ws + WS_ROPE); T[2 * gtid] = (float)cos((double)ang); T[2 * gtid + 1] = (float)sin((double)ang); }
}
constexpr int TSCR = 64 * 65 * 4;
__device__ __forceinline__ void transpose_tile(const float* src, int ldsrc, int k0, int n0s, bf16_t* dst, int ldt, int n0d, LAS float* scr, int lane) {
    const int kr = lane >> 4, nq = lane & 15;
    f32x4 v[16];
#pragma unroll
    for (int i = 0; i < 16; ++i) v[i] = *(const f32x4*)(src + (size_t)(k0 + 4 * i + kr) * ldsrc + n0s + 4 * nq);
#pragma unroll
    for (int i = 0; i < 16; ++i) { LAS float* s = scr + (4 * i + kr) * 65 + 4 * nq; s[0] = v[i][0]; s[1] = v[i][1]; s[2] = v[i][2]; s[3] = v[i][3]; }
    asm volatile("s_waitcnt lgkmcnt(0)" ::: "memory");
    const int c = lane & 7, ns = lane >> 3;
#pragma unroll
    for (int j = 0; j < 8; ++j) { const int n = ns + 8 * j; const LAS float* s = scr + (8 * c) * 65 + n;
        u32x4 o; o.x = pg8::cvt_pk_bf16(s[0 * 65], s[1 * 65]); o.y = pg8::cvt_pk_bf16(s[2 * 65], s[3 * 65]); o.z = pg8::cvt_pk_bf16(s[4 * 65], s[5 * 65]); o.w = pg8::cvt_pk_bf16(s[6 * 65], s[7 * 65]);
        *(u32x4*)(dst + (size_t)(n0d + n) * ldt + k0 + 8 * c) = o; }
    asm volatile("s_waitcnt lgkmcnt(0)" ::: "memory");
}
using pg8::pk_fp8x4;
__device__ __forceinline__ void zero_tile_f8(unsigned char* dst, int ldt, int n0d, int k0, int lane) {
    const int c = lane & 3, ns = lane >> 2;
#pragma unroll
    for (int j = 0; j < 4; ++j) *(u32x4*)(dst + (size_t)(n0d + ns + 16 * j) * ldt + k0 + 16 * c) = (u32x4){0u, 0u, 0u, 0u};
}
__device__ __forceinline__ void transpose_tile_f8(const float* src, int ldsrc, int k0, int n0s, unsigned char* dst, int ldt, int n0d, float scale, LAS float* scr, int lane) {
    const int kr = lane >> 4, nq = lane & 15;
    f32x4 v[16];
#pragma unroll
    for (int i = 0; i < 16; ++i) v[i] = *(const f32x4*)(src + (size_t)(k0 + 4 * i + kr) * ldsrc + n0s + 4 * nq);
#pragma unroll
    for (int i = 0; i < 16; ++i) { LAS float* s = scr + (4 * i + kr) * 65 + 4 * nq; s[0] = v[i][0] * scale; s[1] = v[i][1] * scale; s[2] = v[i][2] * scale; s[3] = v[i][3] * scale; }
    asm volatile("s_waitcnt lgkmcnt(0)" ::: "memory");
    const int c = lane & 3, ns = lane >> 2;
#pragma unroll
    for (int j = 0; j < 4; ++j) { const int n = ns + 16 * j; const LAS float* s = scr + (16 * c) * 65 + n;
        u32x4 o; o.x = pk_fp8x4(s[0 * 65], s[1 * 65], s[2 * 65], s[3 * 65]); o.y = pk_fp8x4(s[4 * 65], s[5 * 65], s[6 * 65], s[7 * 65]);
        o.z = pk_fp8x4(s[8 * 65], s[9 * 65], s[10 * 65], s[11 * 65]); o.w = pk_fp8x4(s[12 * 65], s[13 * 65], s[14 * 65], s[15 * 65]);
        *(u32x4*)(dst + (size_t)(n0d + n) * ldt + k0 + 16 * c) = o; }
    asm volatile("s_waitcnt lgkmcnt(0)" ::: "memory");
}
__device__ __forceinline__ void transpose_item(const float* src, int ldsrc, int k0, int col  , bf16_t* dst, int ldt, int n0, LAS float* scr, int lane) {
#pragma unroll 8
    for (int i = 0; i < 32; ++i) { const int kk = 2 * i + (lane >> 5); scr[kk * 33 + (lane & 31)] = (col >= 0) ? src[(size_t)(k0 + kk) * ldsrc + col] : 0.f; }
    asm volatile("s_waitcnt lgkmcnt(0)" ::: "memory");
    const int c = lane & 7;
#pragma unroll
    for (int j = 0; j < 4; ++j) { const int n = (lane >> 3) + 8 * j; const LAS float* s = scr + (8 * c) * 33 + n;
        u32x4 o; o.x = pg8::cvt_pk_bf16(s[0 * 33], s[1 * 33]); o.y = pg8::cvt_pk_bf16(s[2 * 33], s[3 * 33]); o.z = pg8::cvt_pk_bf16(s[4 * 33], s[5 * 33]); o.w = pg8::cvt_pk_bf16(s[6 * 33], s[7 * 33]);
        *(u32x4*)(dst + (size_t)(n0 + n) * ldt + k0 + 8 * c) = o; }
    asm volatile("s_waitcnt lgkmcnt(0)" ::: "memory");
}
constexpr int IT_WIN = 16 * 120, IT_WOUT = 16 * 16, IT_P0 = IT_WIN + IT_WOUT;
constexpr int IT_WGU = 16 * 2 * 22 * 16, IT_WD = 16 * 16 * 24, IT_EXP = IT_WGU + IT_WD;
__device__ __forceinline__ void conv_item_p0(const Ptrs& p, int it, LAS float* scr, int lane) {
    if (it < IT_WIN) { const int kb = it / 120, nb = it % 120, n = nb * 32 + (lane & 31); const int col = (n < NPROJ) ? proj_src_col(n) : -1;
        transpose_item(p.w_in, NPROJ, kb * 64, col, (bf16_t*)(p.ws + WS_WIN), D, nb * 32, scr, lane); }
    else { it -= IT_WIN; const int kb = it >> 4, nb = it & 15; transpose_tile(p.w_out, D, kb * 64, nb * 64, (bf16_t*)(p.ws + WS_WOUT), D, nb * 64, scr, lane); }
}
__device__ __forceinline__ void conv_item_exp(const Ptrs& p, int it, LAS float* scr, int lane) {
    if (it < IT_WGU) { const int kb = it & 15, nt = (it >> 4) % 22, half = ((it >> 4) / 22) & 1, e = (it >> 4) / 44; const int f0 = nt * 64, r0 = (f0 >> 7) * 256 + half * 128 + (f0 & 127);
        const float* src = (half ? p.w_exp_up : p.w_exp_gate) + (size_t)e * D * FF;
        transpose_tile_f8(src, FF, kb * 64, f0, (unsigned char*)(p.ws + WS_WGU) + (size_t)e * 2816 * D, D, r0, 32.0f, scr, lane); }
    else { it -= IT_WGU; const int kb = it % 24, nb = (it / 24) & 15, e = it / (24 * 16); unsigned char* dst = (unsigned char*)(p.ws + WS_WD) + (size_t)e * D * FFP;
        if (kb < 22) transpose_tile_f8(p.w_exp_down + (size_t)e * FF * D, D, kb * 64, nb * 64, dst, FFP, nb * 64, 32.0f, scr, lane); else zero_tile_f8(dst, FFP, nb * 64, kb * 64, lane); }
}
__device__ __forceinline__ void h_rows(const Ptrs& p, int row0, int rstep, int lane) {
    f32x4 xn[4];
#define H_LOAD(r_) do { const float* s_ = ((r_) < NLAT) ? p.x + (size_t)(r_) * D : p.ctx + (size_t)((r_) - NLAT) * D; _Pragma("unroll") for (int j = 0; j < 4; ++j) xn[j] = *(const f32x4*)(s_ + j * 256 + lane * 4); } while (0)
    if (row0 < NROWS) H_LOAD(row0);
    f32x4 w4[4];
#pragma unroll
    for (int j = 0; j < 4; ++j) w4[j] = *(const f32x4*)(p.norm1_w + j * 256 + lane * 4);
    for (int row = row0; row < NROWS; row += rstep) {
        const int m = (row < NLAT) ? row / SEQ : 2;
        const float* mod = (const float*)(p.ws + WS_MOD) + m * NADA * D;
        f32x4 v[4]; float ss = 0.f;
#pragma unroll
        for (int j = 0; j < 4; ++j) { v[j] = xn[j]; ss += v[j][0] * v[j][0] + v[j][1] * v[j][1] + v[j][2] * v[j][2] + v[j][3] * v[j][3]; }
        if (row + rstep < NROWS) H_LOAD(row + rstep);
        const float rstd = rsqrtf(wave_sum(ss) * (1.0f / D) + EPS);
        bf16_t* dst = (bf16_t*)(p.ws + WS_H) + (size_t)row * D;
#pragma unroll
        for (int j = 0; j < 4; ++j) { const int d = j * 256 + lane * 4; const f32x4 sc = *(const f32x4*)(mod + D + d), sh = *(const f32x4*)(mod + d);
            f32x4 o;
#pragma unroll
            for (int e = 0; e < 4; ++e) o[e] = v[j][e] * rstd * w4[j][e] * (1.0f + sc[e]) + sh[e];
            u32x2 pkd; pkd.x = pg8::cvt_pk_bf16(o[0], o[1]); pkd.y = pg8::cvt_pk_bf16(o[2], o[3]); *(u32x2*)(dst + d) = pkd; }
    }
#undef H_LOAD
}
__device__ __forceinline__ void stage_router(const Ptrs& p, LAS float* Wl, int tid) {
    for (int idx = tid; idx < D * NE / 4; idx += NTHR) { const int d = idx >> 2, q4 = idx & 3, j = d >> 8, ln = (d >> 2) & 63, e4 = d & 3;
        *(LAS f32x4*)(Wl + (((j * 4 + e4) * 4 + q4) * 64 + ln) * 4) = *(const f32x4*)(p.w_router + (size_t)d * NE + 4 * q4); }
}
__device__ __forceinline__ void norm2_router_rows(const Ptrs& p, const LAS float* Wl, int row0, int rstep, int lane) {
    const bf16_t* XO = (const bf16_t*)(p.ws + WS_XO);
    f32x4 xn[4]; u32x2 on[4];
#define N2_LOAD(r_) do { _Pragma("unroll") for (int j = 0; j < 4; ++j) { xn[j] = *(const f32x4*)(p.x + (size_t)(r_) * D + j * 256 + lane * 4); on[j] = *(const u32x2*)(XO + (size_t)(r_) * D + j * 256 + lane * 4); } } while (0)
    if (row0 < NLAT) N2_LOAD(row0);
    f32x4 w4[4];
#pragma unroll
    for (int j = 0; j < 4; ++j) w4[j] = *(const f32x4*)(p.norm2_w + j * 256 + lane * 4);
    for (int row = row0; row < NLAT; row += rstep) {
        const int b = row / SEQ, t = row % SEQ;
        const float* mod = (const float*)(p.ws + WS_MOD) + b * NADA * D;
        f32x4 v[4]; float ss = 0.f;
#pragma unroll
        for (int j = 0; j < 4; ++j) { v[j] = xn[j]; v[j][0] += __uint_as_float(on[j].x << 16); v[j][1] += __uint_as_float(on[j].x & 0xffff0000u); v[j][2] += __uint_as_float(on[j].y << 16); v[j][3] += __uint_as_float(on[j].y & 0xffff0000u);
            ss += v[j][0] * v[j][0] + v[j][1] * v[j][1] + v[j][2] * v[j][2] + v[j][3] * v[j][3]; }
        if (row + rstep < NLAT) N2_LOAD(row + rstep);
        const float rstd = rsqrtf(wave_sum(ss) * (1.0f / D) + EPS);
        unsigned char* dst = (unsigned char*)(p.ws + WS_H) + (size_t)row * D;
        float lg[NE];
#pragma unroll
        for (int e = 0; e < NE; ++e) lg[e] = 0.f;
        int wl_off = 0; asm volatile("" : "+v"(wl_off));
#pragma unroll
        for (int j = 0; j < 4; ++j) { const int d = j * 256 + lane * 4; const f32x4 sc = *(const f32x4*)(mod + 4 * D + d), sh = *(const f32x4*)(mod + 3 * D + d);
            f32x4 o;
#pragma unroll
            for (int e4 = 0; e4 < 4; ++e4) { o[e4] = v[j][e4] * rstd * w4[j][e4] * (1.0f + sc[e4]) + sh[e4];
                const LAS f32x4* wr = (const LAS f32x4*)(Wl + wl_off + ((j * 4 + e4) * 4 * 64 + lane) * 4);
#pragma unroll
                for (int q = 0; q < 4; ++q) { const f32x4 ww = wr[q * 64]; lg[4 * q] += o[e4] * ww[0]; lg[4 * q + 1] += o[e4] * ww[1]; lg[4 * q + 2] += o[e4] * ww[2]; lg[4 * q + 3] += o[e4] * ww[3]; } }
            *(unsigned*)(dst + d) = pk_fp8x4(o[0], o[1], o[2], o[3]); }
        float r8[8], r4[4], r2[2], r1;
        { const bool hi = lane & 32;
#pragma unroll
          for (int j = 0; j < 8; ++j) { const float keep = hi ? lg[8 + j] : lg[j], send = hi ? lg[j] : lg[8 + j]; r8[j] = keep + __shfl_xor(send, 32); } }
        { const bool hi = lane & 16;
#pragma unroll
          for (int j = 0; j < 4; ++j) { const float keep = hi ? r8[4 + j] : r8[j], send = hi ? r8[j] : r8[4 + j]; r4[j] = keep + __shfl_xor(send, 16); } }
        { const bool hi = lane & 8;
#pragma unroll
          for (int j = 0; j < 2; ++j) { const float keep = hi ? r4[2 + j] : r4[j], send = hi ? r4[j] : r4[2 + j]; r2[j] = keep + __shfl_xor(send, 8); } }
        { const bool hi = lane & 4; const float keep = hi ? r2[1] : r2[0], send = hi ? r2[0] : r2[1]; r1 = keep + __shfl_xor(send, 4); }
        r1 += __shfl_xor(r1, 2); r1 += __shfl_xor(r1, 1);
        float mx = r1;
#pragma unroll
        for (int o = 4; o < 64; o <<= 1) mx = fmaxf(mx, __shfl_xor(mx, o));
        const float ex = __expf(r1 - mx); float den = ex;
#pragma unroll
        for (int o = 4; o < 64; o <<= 1) den += __shfl_xor(den, o);
        if ((lane & 3) == 0) ((float*)(p.ws + WS_AFF))[((size_t)b * NE + ((lane >> 2) & 15)) * SEQ + t] = ex / den;
    }
#undef N2_LOAD
}
__device__ __forceinline__ void topk_set(const Ptrs& p, LAS unsigned char* lds, int be) {
    LAS unsigned* key = (LAS unsigned*)lds;
    LAS unsigned* hist = key + SEQ;
    LAS unsigned* sh = hist + 256;
    const int tid = threadIdx.x, lane = tid & 63, w = tid >> 6;
    const unsigned* A = (const unsigned*)(p.ws + WS_AFF) + (size_t)be * SEQ;
    for (int i = tid; i < SEQ / 4; i += NTHR) ((LAS u32x4*)key)[i] = ((const u32x4*)A)[i];
    if (tid == 0) { sh[0] = 0u; sh[1] = (unsigned)CAP; }
    __syncthreads();
#pragma unroll 1
    for (int pass = 0; pass < 4; ++pass) {
        const int shift = 24 - 8 * pass;
        if (tid < 256) hist[tid] = 0u;
        __syncthreads();
        const unsigned prefix = sh[0], kneed = sh[1];
        const unsigned himask = (pass == 0) ? 0u : (0xffffffffu << (shift + 8));
        for (int i = tid; i < SEQ; i += NTHR) { const unsigned kx = key[i]; if ((kx & himask) == prefix) __hip_atomic_fetch_add(&hist[(kx >> shift) & 255u], 1u, __ATOMIC_RELAXED, __HIP_MEMORY_SCOPE_WORKGROUP); }
        __syncthreads();
        if (w == 0) {
            unsigned c4[4]; unsigned s = 0u;
#pragma unroll
            for (int j = 0; j < 4; ++j) { c4[j] = hist[255 - (lane * 4 + j)]; s += c4[j]; }
            unsigned incl = s;
#pragma unroll
            for (int o = 1; o < 64; o <<= 1) { const unsigned t = __shfl_up(incl, o); if (lane >= o) incl += t; }
            const unsigned excl = incl - s;
            if (excl < kneed && kneed <= incl) { unsigned acc = excl;
#pragma unroll
                for (int j = 0; j < 4; ++j) { if (acc < kneed && kneed <= acc + c4[j]) { const unsigned bin = 255u - (unsigned)(lane * 4 + j); sh[0] = prefix | (bin << shift); sh[1] = kneed - acc; } acc += c4[j]; } }
        }
        __syncthreads();
    }
    const unsigned T = sh[0], need_eq = sh[1];
    unsigned cg = 0u, ce = 0u;
    for (int i = 0; i < 32; ++i) { const unsigned kx = key[tid * 32 + i]; cg += (kx > T) ? 1u : 0u; ce += (kx == T) ? 1u : 0u; }
    unsigned ig = cg, ie = ce;
#pragma unroll
    for (int o = 1; o < 64; o <<= 1) { const unsigned tg = __shfl_up(ig, o), te = __shfl_up(ie, o); if (lane >= o) { ig += tg; ie += te; } }
    if (lane == 63) { sh[16 + w] = ig; sh[32 + w] = ie; }
    __syncthreads();
    unsigned og = 0u, oe = 0u, totg = 0u;
#pragma unroll
    for (int w2 = 0; w2 < 8; ++w2) { const unsigned a = sh[16 + w2], b2 = sh[32 + w2]; if (w2 < w) { og += a; oe += b2; } totg += a; }
    unsigned pg = og + ig - cg, pe = oe + ie - ce;
    int* IDX = (int*)(p.ws + WS_IDX) + be * CAP; float* GATE = (float*)(p.ws + WS_GATE) + be * CAP; int* INV = (int*)(p.ws + WS_INV);
    const int b = be / NE, e = be % NE;
    for (int i = 0; i < 32; ++i) { const int t = tid * 32 + i; const unsigned kx = key[t]; int slot = -1;
        if (kx > T) slot = (int)(pg++); else if (kx == T) { if (pe < need_eq) slot = (int)(totg + pe); ++pe; }
        if (slot >= 0) { IDX[slot] = t; GATE[slot] = __uint_as_float(kx); }
        INV[((size_t)b * SEQ + t) * NE + e] = slot; }
    __syncthreads();
}
__device__ __forceinline__ void final_rows(const Ptrs& p, int row0, int rstep, int lane) {
    const bf16_t* XO = (const bf16_t*)(p.ws + WS_XO); const bf16_t* YE = (const bf16_t*)(p.ws + WS_YE); const int* INV = (const int*)(p.ws + WS_INV);
    f32x4 xn[4]; u32x2 on[4]; int invn = -1;
#define FN_LOAD(r_) do { _Pragma("unroll") for (int j = 0; j < 4; ++j) { xn[j] = *(const f32x4*)(p.x + (size_t)(r_) * D + j * 256 + lane * 4); on[j] = *(const u32x2*)(XO + (size_t)(r_) * D + j * 256 + lane * 4); } \
        invn = (lane < NE) ? INV[(size_t)(r_) * NE + lane] : -1; } while (0)
    if (row0 < NLAT) FN_LOAD(row0);
    f32x4 fw[4];
#pragma unroll
    for (int j = 0; j < 4; ++j) fw[j] = *(const f32x4*)(p.final_norm_w + j * 256 + lane * 4);
    for (int row = row0; row < NLAT; row += rstep) {
        const int b = row / SEQ;
        const float* mod = (const float*)(p.ws + WS_MOD) + b * NADA * D + 5 * D;
        f32x4 v[4];
#pragma unroll
        for (int j = 0; j < 4; ++j) { v[j] = xn[j]; v[j][0] += __uint_as_float(on[j].x << 16); v[j][1] += __uint_as_float(on[j].x & 0xffff0000u); v[j][2] += __uint_as_float(on[j].y << 16); v[j][3] += __uint_as_float(on[j].y & 0xffff0000u); }
        const int myinv = invn;
        if (row + rstep < NLAT) FN_LOAD(row + rstep);
        unsigned long long mask = __ballot(myinv >= 0);
        float acc[16];
#pragma unroll
        for (int i = 0; i < 16; ++i) acc[i] = 0.f;
        while (mask) {
            u32x2 yw[4][4]; bool has[4];
#pragma unroll
            for (int u = 0; u < 4; ++u) { has[u] = mask != 0ull; const int e = has[u] ? (int)__builtin_ctzll(mask) : 0; if (has[u]) mask &= mask - 1ull;
                const int s = __shfl(myinv, e); const bf16_t* y = YE + ((size_t)(b * NE + e) * CAP + (has[u] ? s : 0)) * D;
                if (has[u]) {
#pragma unroll
                    for (int j = 0; j < 4; ++j) yw[u][j] = *(const u32x2*)(y + j * 256 + lane * 4); } }
#pragma unroll
            for (int u = 0; u < 4; ++u) if (has[u]) {
#pragma unroll
                for (int j = 0; j < 4; ++j) { acc[4 * j] += __uint_as_float(yw[u][j].x << 16); acc[4 * j + 1] += __uint_as_float(yw[u][j].x & 0xffff0000u); acc[4 * j + 2] += __uint_as_float(yw[u][j].y << 16); acc[4 * j + 3] += __uint_as_float(yw[u][j].y & 0xffff0000u); } }
        }
        float ss = 0.f;
#pragma unroll
        for (int j = 0; j < 4; ++j) { const f32x4 m4 = *(const f32x4*)(mod + j * 256 + lane * 4);
#pragma unroll
            for (int e = 0; e < 4; ++e) { v[j][e] += m4[e] * acc[4 * j + e]; ss += v[j][e] * v[j][e]; } }
        const float rstd = rsqrtf(wave_sum(ss) * (1.0f / D) + EPS);
        float* xr = p.out + (size_t)row * D;
#pragma unroll
        for (int j = 0; j < 4; ++j) *(f32x4*)(xr + j * 256 + lane * 4) = v[j] * rstd * fw[j];
    }
#undef FN_LOAD
}
}

constexpr int RING_OFF = 0, RING_BYTES = 131072;
constexpr int GTAB_OFF = RING_BYTES;
constexpr int MISC_OFF = RING_BYTES + 12288;
constexpr int LDS_BYTES = 147456;
constexpr int CW_BAR = 4096;

#define RLX_AGENT __ATOMIC_RELAXED, __HIP_MEMORY_SCOPE_AGENT
#define XB_TMO      128
#define XB_XCNT(j)  (256  + 64 * (j))
#define XB_XSUB(j)  (1280 + 64 * (j))
#define XB_XGEN(j)  (2304 + 64 * (j))
#define XB_TOP      3328
#define XB_TOPGEN   3392
#define XCD_BAR_WORDS 3456
#define XB_SPIN_CAP (1u << 18)
__device__ __forceinline__ unsigned xb_ld(unsigned* p)              { return __hip_atomic_load(p, __ATOMIC_RELAXED, __HIP_MEMORY_SCOPE_AGENT); }
__device__ __forceinline__ unsigned xb_add(unsigned* p, unsigned v) { return __hip_atomic_fetch_add(p, v, __ATOMIC_RELAXED, __HIP_MEMORY_SCOPE_AGENT); }
__device__ __forceinline__ unsigned xb_xcc_id() { return (unsigned)__builtin_amdgcn_s_getreg((3 << 11) | 20) & 0xFu; }
#define XB_SPIN(cond, bar) do { unsigned _sp = 0; while (cond) { __builtin_amdgcn_s_sleep(1); \
    if ((++_sp & 255u) == 0u) { if (xb_ld(&(bar)[XB_TMO])) break; if (_sp > XB_SPIN_CAP) { atomicAdd(&(bar)[XB_TMO], 1u); break; } } } } while (0)
struct XcdBarrier { unsigned* bar; unsigned x; volatile LAS unsigned* st; };
__device__ __forceinline__ XcdBarrier xcd_barrier_post(unsigned* bar, volatile LAS unsigned* st) {
    XcdBarrier b; b.bar = bar; b.x = xb_xcc_id(); b.st = st;
    if (threadIdx.x == 0) (void)xb_add(&bar[XB_XCNT(b.x)], 1u);
    return b;
}
__device__ __forceinline__ void xcd_barrier_complete(unsigned* bar, unsigned x, unsigned& nloc, unsigned& nx) {
    const unsigned G = gridDim.x * gridDim.y * gridDim.z;
    unsigned sum, cnt, mine, sp = 0u;
    for (;;) {
        sum = 0u; cnt = 0u; mine = 0u;
#pragma unroll
        for (unsigned j = 0; j < 16; ++j) { const unsigned c = xb_ld(&bar[XB_XCNT(j)]); sum += c; cnt += (c > 0u) ? 1u : 0u; mine = (j == x) ? c : mine; }
        if (sum == G) break;
        __builtin_amdgcn_s_sleep(1);
        if ((++sp & 255u) == 0u) { if (xb_ld(&bar[XB_TMO])) break; if (sp > XB_SPIN_CAP) { atomicAdd(&bar[XB_TMO], 1u); break; } }
    }
    nloc = mine > 0u ? mine : 1u; nx = cnt > 0u ? cnt : 1u;
}
__device__ __forceinline__ void xcd_barrier(const XcdBarrier& b) {
    asm volatile("s_waitcnt vmcnt(0)" ::: "memory");
    __syncthreads();
    if (threadIdx.x == 0) {
        unsigned* bar = b.bar;
        __builtin_amdgcn_s_waitcnt(0);
        unsigned nloc = b.st[0], nx = b.st[1];
        if (nloc == 0u) { xcd_barrier_complete(bar, b.x, nloc, nx); b.st[0] = nloc; b.st[1] = nx; }
        const unsigned old = xb_add(&bar[XB_XSUB(b.x)], 1u);
        const unsigned gen = old / nloc;
        if (old + 1u == (gen + 1u) * nloc) {
            __builtin_amdgcn_fence(__ATOMIC_RELEASE, "agent");
            asm volatile("s_waitcnt vmcnt(0)" ::: "memory");
            const unsigned og = xb_add(&bar[XB_TOP], 1u);
            const unsigned tg = og / nx;
            if (og + 1u == (tg + 1u) * nx) xb_add(&bar[XB_TOPGEN], 1u);
            else XB_SPIN(xb_ld(&bar[XB_TOPGEN]) == tg, bar);
            __builtin_amdgcn_fence(__ATOMIC_ACQUIRE, "agent");
            xb_add(&bar[XB_XGEN(b.x)], 1u);
            asm volatile("s_waitcnt vmcnt(0)" ::: "memory");
        } else {
            XB_SPIN(xb_ld(&bar[XB_XGEN(b.x)]) == gen, bar);
            __builtin_amdgcn_fence(__ATOMIC_ACQUIRE, "agent");
            asm volatile("s_waitcnt vmcnt(0)" ::: "memory");
        }
    }
    __syncthreads();
}

struct Args { Ptrs p; int ph_lo, ph_hi, dbg, pad; };

__global__ void __launch_bounds__(NTHR, 2) mk_fwd(Args args) {
    extern __shared__ __attribute__((aligned(16))) unsigned char lds_raw[];
    LAS unsigned char* lds = (LAS unsigned char*)lds_raw;
    volatile LAS unsigned* MISC = (volatile LAS unsigned*)(lds + MISC_OFF);
    const Ptrs& p = args.p;
    unsigned char* ws = p.ws;
    const int tid = threadIdx.x, G = gridDim.x, bx = blockIdx.x;
    for (int u = tid; u < (LDS_BYTES - MISC_OFF) / 4; u += NTHR) ((LAS unsigned*)(lds + MISC_OFF))[u] = 0u;
    __syncthreads();
    const int lo = args.ph_lo, hi = args.ph_hi;
#ifndef REPS_LIST
#define REPS_LIST 1, 1, 1, 1, 1, 1, 1, 1, 1, 1, 1, 1
#endif
    constexpr int reps_tab[12] = {REPS_LIST};
    constexpr int CONV_SPLIT = 8192;
    XcdBarrier bar; bar.bar = (unsigned*)ws + CW_BAR; bar.x = 0; bar.st = nullptr;
    if (hi - lo > 1) bar = xcd_barrier_post((unsigned*)ws + CW_BAR, MISC + 8);
#define IN(k) (lo <= (k) && (k) < hi)
#define SEAM(k) do { if (IN(k) && IN((k) + 1)) xcd_barrier(bar); } while (0)

    const int wv = __builtin_amdgcn_readfirstlane(tid >> 6), ln = tid & 63, gw = bx * NWAVES + wv, NGW = G * NWAVES;
    if (IN(0)) {
        for (int cb = bx; cb < 256; cb += G) misc::p0_mod(p, lds, cb);
        misc::p0_rope(p, bx * NTHR + tid);
        LAS float* scr = (LAS float*)(lds + wv * misc::TSCR);
        for (int it = gw; it < misc::IT_P0; it += NGW) misc::conv_item_p0(p, it, scr, ln);
    }
    if constexpr (reps_tab[0] > 1) { xcd_barrier(bar);
    if (IN(0)) {
        for (int cb = bx; cb < 256; cb += G) misc::p0_mod(p, lds, cb);
        misc::p0_rope(p, bx * NTHR + tid);
        LAS float* scr = (LAS float*)(lds + wv * misc::TSCR);
        for (int it = gw; it < misc::IT_P0; it += NGW) misc::conv_item_p0(p, it, scr, ln);
    }
    }
    SEAM(0);
    if (IN(1)) { misc::h_rows(p, gw, NGW, ln); }
    if constexpr (reps_tab[1] > 1) { xcd_barrier(bar);
    if (IN(1)) { misc::h_rows(p, gw, NGW, ln); }
    }
    SEAM(1);
    if (IN(2)) {
        pg8::Gemm g{(const bf16_t*)(ws + WS_H), (const bf16_t*)(ws + WS_WIN), D};
        pg8::StaticOrder S; S.init(NROWS / 256, NPROJ_PAD / 256, G, bx);
        pg8::EpiProj E{(bf16_t*)(ws + WS_P), (float*)(ws + WS_GZ), (const float*)(ws + WS_ROPE)};
        pg8::gemm_phase<pg8::EpiProj, pg8::StaticOrder, false>(lds + RING_OFF, g, S, E, nullptr);
    }
    if constexpr (reps_tab[2] > 1) { xcd_barrier(bar);
    if (IN(2)) {
        pg8::Gemm g{(const bf16_t*)(ws + WS_H), (const bf16_t*)(ws + WS_WIN), D};
        pg8::StaticOrder S; S.init(NROWS / 256, NPROJ_PAD / 256, G, bx);
        pg8::EpiProj E{(bf16_t*)(ws + WS_P), (float*)(ws + WS_GZ), (const float*)(ws + WS_ROPE)};
        pg8::gemm_phase<pg8::EpiProj, pg8::StaticOrder, false>(lds + RING_OFF, g, S, E, nullptr);
    }
    }
    SEAM(2);
    if (IN(3)) {
        scan::run_c1(p, lds, bx);
    }
    SEAM(3);
    if (IN(4)) {
        scan::run_c2(p, lds, bx);
    }
    if constexpr (reps_tab[3] > 1) { xcd_barrier(bar);
    if (IN(3)) {
        scan::run_c1(p, lds, bx);
    }
    SEAM(3);
    if (IN(4)) {
        scan::run_c2(p, lds, bx);
    }
    }
    SEAM(4);
    if (IN(5)) {
        scan::run_c3(p, lds, bx, (bf16_t*)(ws + WS_H));
    }
    if constexpr (reps_tab[5] > 1) { xcd_barrier(bar);
    if (IN(5)) {
        scan::run_c3(p, lds, bx, (bf16_t*)(ws + WS_H));
    }
    }
    SEAM(5);
    if (IN(6)) {
        pg8::Gemm g{(const bf16_t*)(ws + WS_H), (const bf16_t*)(ws + WS_WOUT), D};
        pg8::StaticOrder S; S.init(NLAT / 256, D / 256, G, bx);
        pg8::EpiOut E{(bf16_t*)(ws + WS_XO), (const float*)(ws + WS_MOD)};
        pg8::gemm_phase<pg8::EpiOut, pg8::StaticOrder, false>(lds + RING_OFF, g, S, E, nullptr);
    }
    if constexpr (reps_tab[6] > 1) { xcd_barrier(bar);
    if (IN(6)) {
        pg8::Gemm g{(const bf16_t*)(ws + WS_H), (const bf16_t*)(ws + WS_WOUT), D};
        pg8::StaticOrder S; S.init(NLAT / 256, D / 256, G, bx);
        pg8::EpiOut E{(bf16_t*)(ws + WS_XO), (const float*)(ws + WS_MOD)};
        pg8::gemm_phase<pg8::EpiOut, pg8::StaticOrder, false>(lds + RING_OFF, g, S, E, nullptr);
    }
    }
    SEAM(6);
    if (IN(7)) {
        misc::stage_router(p, (LAS float*)lds, tid); __syncthreads();
        misc::norm2_router_rows(p, (const LAS float*)lds, gw, NGW, ln);
        __syncthreads();
        LAS float* scr = (LAS float*)(lds + wv * misc::TSCR);
        for (int it = gw; it < CONV_SPLIT; it += NGW) misc::conv_item_exp(p, it, scr, ln);
    }
    if constexpr (reps_tab[7] > 1) { xcd_barrier(bar);
    if (IN(7)) {
        misc::stage_router(p, (LAS float*)lds, tid); __syncthreads();
        misc::norm2_router_rows(p, (const LAS float*)lds, gw, NGW, ln);
        __syncthreads();
        LAS float* scr = (LAS float*)(lds + wv * misc::TSCR);
        for (int it = gw; it < CONV_SPLIT; it += NGW) misc::conv_item_exp(p, it, scr, ln);
    }
    }
    SEAM(7);
    if (IN(8)) { if (bx < 32) misc::topk_set(p, lds, bx);
        else { LAS float* scr = (LAS float*)(lds + wv * misc::TSCR); for (int it = CONV_SPLIT + (bx - 32) * NWAVES + wv; it < misc::IT_EXP; it += (G - 32) * NWAVES) misc::conv_item_exp(p, it, scr, ln); } }
    if constexpr (reps_tab[8] > 1) { xcd_barrier(bar);
    if (IN(8)) { if (bx < 32) misc::topk_set(p, lds, bx);
        else { LAS float* scr = (LAS float*)(lds + wv * misc::TSCR); for (int it = CONV_SPLIT + (bx - 32) * NWAVES + wv; it < misc::IT_EXP; it += (G - 32) * NWAVES) misc::conv_item_exp(p, it, scr, ln); } }
    }
    SEAM(8);
    if (IN(9)) {
        LAS unsigned* gtab = (LAS unsigned*)(lds + GTAB_OFF);
        pg8::MoeUpOrder S{bx};
        const int* IDX = (const int*)(ws + WS_IDX);
        for (int e = tid; e < 11 * 256; e += NTHR) { pg8::Unit u; S.next(e >> 8, u); const int R = u.pm * 256 + (e & 255); gtab[e] = (unsigned)((u.pm >> 7) * SEQ + (IDX[R] & (SEQ - 1))) * (unsigned)D; }
        __syncthreads();
        pg8::Gemm g{(const bf16_t*)(ws + WS_H), (const bf16_t*)(ws + WS_WGU), D};
        pg8::EpiAct E{(unsigned char*)(ws + WS_ACT), 1.0f / 32.0f, 8.0f};
        pg8::gemm_phase<pg8::EpiAct, pg8::MoeUpOrder, true, true>(lds + RING_OFF, g, S, E, gtab);
    }
    if constexpr (reps_tab[9] > 1) { xcd_barrier(bar);
    if (IN(9)) {
        LAS unsigned* gtab = (LAS unsigned*)(lds + GTAB_OFF);
        pg8::MoeUpOrder S{bx};
        const int* IDX = (const int*)(ws + WS_IDX);
        for (int e = tid; e < 11 * 256; e += NTHR) { pg8::Unit u; S.next(e >> 8, u); const int R = u.pm * 256 + (e & 255); gtab[e] = (unsigned)((u.pm >> 7) * SEQ + (IDX[R] & (SEQ - 1))) * (unsigned)D; }
        __syncthreads();
        pg8::Gemm g{(const bf16_t*)(ws + WS_H), (const bf16_t*)(ws + WS_WGU), D};
        pg8::EpiAct E{(unsigned char*)(ws + WS_ACT), 1.0f / 32.0f, 8.0f};
        pg8::gemm_phase<pg8::EpiAct, pg8::MoeUpOrder, true, true>(lds + RING_OFF, g, S, E, gtab);
    }
    }
    SEAM(9);
    if (IN(10)) {
        pg8::MoeDownOrder S{bx};
        pg8::Gemm g{(const bf16_t*)(ws + WS_ACT), (const bf16_t*)(ws + WS_WD), FFP};
        pg8::EpiDown E{(bf16_t*)(ws + WS_YE), (const float*)(ws + WS_GATE), 1.0f / 256.0f};
        pg8::gemm_phase<pg8::EpiDown, pg8::MoeDownOrder, false, true>(lds + RING_OFF, g, S, E, nullptr);
    }
    if constexpr (reps_tab[10] > 1) { xcd_barrier(bar);
    if (IN(10)) {
        pg8::MoeDownOrder S{bx};
        pg8::Gemm g{(const bf16_t*)(ws + WS_ACT), (const bf16_t*)(ws + WS_WD), FFP};
        pg8::EpiDown E{(bf16_t*)(ws + WS_YE), (const float*)(ws + WS_GATE), 1.0f / 256.0f};
        pg8::gemm_phase<pg8::EpiDown, pg8::MoeDownOrder, false, true>(lds + RING_OFF, g, S, E, nullptr);
    }
    }
    SEAM(10);
    if (IN(11)) { misc::final_rows(p, gw, NGW, ln); }
#undef IN
#undef SEAM
}

#ifndef USE_COOP
#define USE_COOP 1
#endif
extern "C" void kernel_launch(void* const* d_in, const int* in_sizes, int n_in, void* d_out, int out_size, void* d_ws, size_t ws_size, hipStream_t stream) {
    static int ready = 0;
    if (!ready) {
        if (n_in != 20 || in_sizes[0] != NLAT * D || out_size != NLAT * D || ws_size < WS_END) { fprintf(stderr, "kernel_launch: unexpected problem (n_in %d, out %d, ws %zu); nothing launched\n", n_in, out_size, ws_size); ready = -1; return; }
        if (hipFuncSetAttribute((const void*)mk_fwd, hipFuncAttributeMaxDynamicSharedMemorySize, LDS_BYTES) != hipSuccess) { fprintf(stderr, "kernel_launch: hipFuncSetAttribute failed\n"); ready = -1; return; }
        int dev = 0, cus = 0, per_cu = 0;
        (void)hipGetDevice(&dev); (void)hipDeviceGetAttribute(&cus, hipDeviceAttributeMultiprocessorCount, dev);
        (void)hipOccupancyMaxActiveBlocksPerMultiprocessor(&per_cu, (const void*)mk_fwd, NTHR, LDS_BYTES);
        if (cus * per_cu < 256) { fprintf(stderr, "kernel_launch: this kernel needs 256 co-resident workgroups (device reports %d CUs x %d); nothing launched\n", cus, per_cu); ready = -1; return; }
        ready = 1;
    }
    if (ready < 0) return;
    Args a{};
    const float** f = (const float**)&a.p;
    for (int i = 0; i < 20; ++i) f[i] = (const float*)d_in[i];
    a.p.out = (float*)d_out; a.p.ws = (unsigned char*)d_ws; a.ph_lo = 0; a.ph_hi = 12;
    (void)hipMemsetAsync((char*)d_ws + WS_CTL, 0, 64 * 1024, stream);
    void* args[] = {&a};
#if USE_COOP
    const hipError_t e = hipLaunchCooperativeKernel((const void*)mk_fwd, dim3(256), dim3(NTHR), args, LDS_BYTES, stream);
#else
    const hipError_t e = hipLaunchKernel((const void*)mk_fwd, dim3(256), dim3(NTHR), args, LDS_BYTES, stream);
#endif
    if (e != hipSuccess) fprintf(stderr, "kernel_launch: launch failed: %s\n", hipGetErrorString(e));
}
```

```cpp
#include <hip/hip_runtime.h>
#include <stdint.h>
#include <stdio.h>

typedef unsigned short bf16_t;
typedef unsigned int u32;

constexpr int D = 1024, BATCH = 2, SEQ = 16384, CTX = 256;
constexpr int NLAT = BATCH * SEQ;
constexpr int NCTX = BATCH * CTX;
constexpr int NROWS = NLAT + NCTX;
constexpr int NADA = 6;
constexpr int NE = 16, CAP = 2048, FF = 1408, FFP = 1536;
constexpr int NSLOT = BATCH * NE * CAP;
constexpr float EPS = 1e-6f;
constexpr int C_GQ = 0, C_GK = 256, C_GV = 512, C_GG = 1024, C_RQ = 1536, C_RK = 2048, C_RV = 2560, C_RG = 3072, C_GZ = 3584;
constexpr int PW = 3584;
constexpr int NPROJ = 3616, NPROJ_PAD = 3840;
__host__ __device__ __forceinline__ size_t ptile(int row, int col) { return ((size_t)((row >> 6) * 28 + (col >> 7)) * 64 + (row & 63)) * 128 + (col & 127); }

constexpr size_t MiB = 1u << 20;
constexpr size_t WS_CTL = 0;
constexpr size_t WS_MOD = 1 * MiB;
constexpr size_t WS_ROPE = WS_MOD + 128 * 1024;
constexpr size_t WS_DCH = 2 * MiB;
constexpr size_t WS_WIN = 4 * MiB;
constexpr size_t WS_WOUT = 12 * MiB;
constexpr size_t WS_GZ = 14 * MiB;
constexpr size_t WS_H = 19 * MiB;
constexpr size_t WS_P = 84 * MiB;
constexpr size_t WS_US = 312 * MiB;
constexpr size_t WS_WGU = 84 * MiB;
constexpr size_t WS_WD = 172 * MiB;
constexpr size_t WS_ACT = 216 * MiB;
constexpr size_t WS_XO = 312 * MiB;
constexpr size_t WS_AFF = 392 * MiB;
constexpr size_t WS_IDX = 394 * MiB;
constexpr size_t WS_GATE = 395 * MiB;
constexpr size_t WS_INV = 396 * MiB;
constexpr size_t WS_YE = 19 * MiB;
constexpr size_t WS_END = 508 * MiB;

__device__ __forceinline__ float bf2f(bf16_t v) { return __uint_as_float(((u32)v) << 16); }
__device__ __forceinline__ bf16_t f2bf(float f) { u32 u = __float_as_uint(f); return (bf16_t)((u + 0x7fffu + ((u >> 16) & 1u)) >> 16); }
__device__ __forceinline__ float siluf(float x) { return x / (1.0f + __expf(-x)); }
__device__ __forceinline__ float log_sigmoidf(float x) { return fminf(x, 0.f) - log1pf(__expf(-fabsf(x))); }
template <int CTRL, int RM> __device__ __forceinline__ float dppf(float v) { return __builtin_bit_cast(float, __builtin_amdgcn_update_dpp(0, __builtin_bit_cast(int, v), CTRL, RM, 0xF, false)); }
__device__ __forceinline__ float wave_sum(float v) {
    v += dppf<0xB1, 0xF>(v);
    v += dppf<0x4E, 0xF>(v);
    v += dppf<0x124, 0xF>(v);
    v += dppf<0x128, 0xF>(v);
    v += dppf<0x142, 0xA>(v);
    v += dppf<0x143, 0xC>(v);
    return __builtin_bit_cast(float, __builtin_amdgcn_readlane(__builtin_bit_cast(int, v), 63));
}
__host__ __device__ inline int proj_src_col(int n) {
    if (n < 1024) return n;
    if (n < 1536) return 1056 + (n - 1024);
    if (n < 2560) {
        const int base = (n < 2048) ? 1568 : 2080, m = (n < 2048) ? n - 1536 : n - 2048;
        const int hd = m >> 7, p = m & 127, g = p >> 3, nn = (p >> 2) & 1, e = p & 3;
        return base + hd * 128 + 64 * nn + 4 * g + e;
    }
    if (n < 3072) return 2592 + (n - 2560);
    if (n < 3584) return 3104 + (n - 3072);
    return 1024 + (n - 3584);
}

struct Ptrs {
    const float *x, *c, *ctx, *c_ctx, *w_ada, *b_ada, *norm1_w, *w_in, *gla_gate_w, *gla_gate_b, *ret_decay_logit, *gla_norm_w, *ret_norm_w,
        *w_out, *norm2_w, *w_router, *w_exp_gate, *w_exp_up, *w_exp_down, *final_norm_w;
    float* out;
    unsigned char* ws;
};


constexpr int NWAVES = 8, NTHR = NWAVES * 64;
#define LAS __attribute__((address_space(3)))
#define GAS __attribute__((address_space(1)))
typedef short bf16x8 __attribute__((ext_vector_type(8)));
typedef float f32x4 __attribute__((ext_vector_type(4)));
typedef float f32x2 __attribute__((ext_vector_type(2)));
typedef unsigned u32x4 __attribute__((ext_vector_type(4)));
typedef unsigned u32x2 __attribute__((ext_vector_type(2)));
typedef int i32x4 __attribute__((ext_vector_type(4)));
typedef int i32x8 __attribute__((ext_vector_type(8)));
#ifndef PG8_ALIGN_DEFAULT
#define PG8_ALIGN_DEFAULT true
#endif
namespace pg8 {
constexpr int BM = 256, BK = 64, HALF = 128, HTB = HALF * BK * 2  , STAGE_BYTES = 8 * HTB, NXCD = 8, WGM = 8;
__host__ __device__ __forceinline__ int lds_byte(int r, int c) { const int st = (r >> 4) * 2 + (c >> 5), rr = r & 15, cc = c & 31, ob = rr * 64 + cc * 2; return st * 1024 + (ob ^ (((ob >> 9) & 1) << 5)); }
__host__ __device__ __forceinline__ void stage_rc(int b, int& R, int& C) { const int st = b / 1024, sb = b % 1024, swz = sb ^ (((sb >> 9) & 1) << 5); R = (st >> 1) * 16 + swz / 64; C = (st & 1) * 32 + (swz % 64) / 2; }
__host__ __device__ __forceinline__ int perm32(int rho) { const int n = rho >> 4, i = rho & 15; return 8 * (i >> 2) + 4 * n + (i & 3); }

struct Unit { int pm, pn; };
struct Gemm { const bf16_t* A; const bf16_t* Bt; int K; };

struct StaticOrder {
    int nM, nN, nwg, G, c;
    __device__ void init(int nM_, int nN_, int G_, int c_) { nM = nM_; nN = nN_; nwg = nM * nN; G = G_; c = c_; }
    __device__ bool next(int i, Unit& u) const {
        const long L = (long)i * G + c; if (L >= nwg) return false;
        int wgid = (int)L; { const int q = nwg / NXCD, r = nwg % NXCD, xcd = wgid % NXCD, off = wgid / NXCD; wgid = (xcd < r ? xcd * (q + 1) : r * (q + 1) + (xcd - r) * q) + off; }
        const int nig = WGM * nN, gid = wgid / nig, fm = gid * WGM, gsz = (nM - fm) < WGM ? (nM - fm) : WGM;
        u.pm = fm + ((wgid % nig) % gsz); u.pn = (wgid % nig) / gsz; return true;
    }
};
struct MoeUpOrder {
    int c;
    __device__ bool next(int i, Unit& u) const {
        if (i >= 11) return false;
        const int g = i * 8 + (c & 7), j = c >> 3, combo = 4 * g + (j >> 3), mt = j & 7, be = combo / 11, pn = combo % 11;
        u.pm = be * 8 + mt; u.pn = (be & 15) * 11 + pn; return true;
    }
};
struct MoeDownOrder {
    int c;
    __device__ bool next(int i, Unit& u) const {
        if (i >= 4) return false;
        const int be = i * 8 + (c & 7), j = c >> 3, mt = j & 7, pn = j >> 3;
        u.pm = be * 8 + mt; u.pn = (be & 15) * 4 + pn; return true;
    }
};

__device__ __forceinline__ float fast_silu(float a) { return a * __builtin_amdgcn_rcpf(1.0f + __expf(-a)); }
typedef __bf16 bf16x2_t __attribute__((ext_vector_type(2)));
__device__ __forceinline__ unsigned cvt_pk_bf16(float lo, float hi) { const f32x2 v = {lo, hi}; const bf16x2_t r = __builtin_convertvector(v, bf16x2_t); return __builtin_bit_cast(unsigned, r); }

__device__ __forceinline__ unsigned pk_fp8x4(float a, float b, float c, float d) {
    a = __builtin_amdgcn_fmed3f(a, -448.f, 448.f); b = __builtin_amdgcn_fmed3f(b, -448.f, 448.f); c = __builtin_amdgcn_fmed3f(c, -448.f, 448.f); d = __builtin_amdgcn_fmed3f(d, -448.f, 448.f);
    int w = 0; w = __builtin_amdgcn_cvt_pk_fp8_f32(a, b, w, false); w = __builtin_amdgcn_cvt_pk_fp8_f32(c, d, w, true); return (unsigned)w;
}
template <class Epi, class Sched, bool GATHER, bool F8 = false, bool ALIGN_EPI = PG8_ALIGN_DEFAULT>
__device__ __forceinline__ void gemm_phase(LAS unsigned char* lds, const Gemm g, const Sched& S, const Epi& E, const LAS unsigned* gtab) {
    const int tid = threadIdx.x, wid = __builtin_amdgcn_readfirstlane(tid >> 6), lane = tid & 63, wr = wid >> 2, wc = wid & 3, fr = lane & 15, fq = lane >> 4;
    constexpr int ESZ = F8 ? 1 : 2;
    const int K = g.K, nt = K * ESZ / (BK * 2);
    int sR[2], sC[2];
    unsigned voffB[2], voffA[2];
#pragma unroll
    for (int i = 0; i < 2; ++i) { stage_rc(tid * 16 + i * 8192, sR[i], sC[i]); const int Rb = Epi::PERM ? ((sR[i] & ~31) + perm32(sR[i] & 31)) : sR[i];
        voffB[i] = (unsigned)(Rb * K * ESZ + sC[i] * 2); voffA[i] = (unsigned)(sR[i] * K * ESZ + sC[i] * 2); }
    const size_t kstep = (size_t)(BK * 2);
    const size_t hstep = (size_t)HALF * K * ESZ;
    const size_t tstep = 2 * hstep;
    const unsigned ldsw = (unsigned)wid * 1024u;
    const int aoff = lds_byte(wr * 64 + fr, fq * 8), boff = lds_byte(wc * 32 + fr, fq * 8);
    const int sw8 = (fq & 1) * 8;
    const int aoff8a = lds_byte(wr * 64 + fr, fq * 16 + sw8), aoff8b = lds_byte(wr * 64 + fr, fq * 16 + (8 - sw8)), boff8a = lds_byte(wc * 32 + fr, fq * 16 + sw8), boff8b = lds_byte(wc * 32 + fr, fq * 16 + (8 - sw8));
#define PG8_SA(b, h) (((b) * 2 + (h)) * HTB)
#define PG8_SB(b, h) ((4 + (b) * 2 + (h)) * HTB)
#define PG8_STAGE(bufoff, gbase, voff) do { _Pragma("unroll") for (int _i = 0; _i < 2; ++_i) \
        __builtin_amdgcn_global_load_lds((const unsigned*)((const char*)(gbase) + (voff)[_i]), (LAS unsigned*)(lds + (bufoff) + ldsw + _i * 8192), 16, 0, 0); } while (0)
#define PG8_LDA(dst, b, h) do { if constexpr (F8) { _Pragma("unroll") for (int m = 0; m < 4; ++m) { const i32x4 lo_ = *(const LAS i32x4*)(lds + PG8_SA(b, h) + aoff8a + m * 2048), hi_ = *(const LAS i32x4*)(lds + PG8_SA(b, h) + aoff8b + m * 2048); \
            dst##8[m] = __builtin_shufflevector(lo_, hi_, 0, 1, 2, 3, 4, 5, 6, 7); } } \
        else { _Pragma("unroll") for (int m = 0; m < 4; ++m) _Pragma("unroll") for (int k = 0; k < 2; ++k) dst[m][k] = *(const LAS bf16x8*)(lds + PG8_SA(b, h) + aoff + m * 2048 + k * 1024); } } while (0)
#define PG8_LDB(dst, b, h) do { if constexpr (F8) { _Pragma("unroll") for (int n = 0; n < 2; ++n) { const i32x4 lo_ = *(const LAS i32x4*)(lds + PG8_SB(b, h) + boff8a + n * 2048), hi_ = *(const LAS i32x4*)(lds + PG8_SB(b, h) + boff8b + n * 2048); \
            dst##8[n] = __builtin_shufflevector(lo_, hi_, 0, 1, 2, 3, 4, 5, 6, 7); } } \
        else { _Pragma("unroll") for (int n = 0; n < 2; ++n) _Pragma("unroll") for (int k = 0; k < 2; ++k) dst[n][k] = *(const LAS bf16x8*)(lds + PG8_SB(b, h) + boff + n * 2048 + k * 1024); } } while (0)
#define PG8_MMA(ai, bj, At, Bt) do { __builtin_amdgcn_s_setprio(1); if constexpr (F8) { _Pragma("unroll") for (int m = 0; m < 4; ++m) _Pragma("unroll") for (int n = 0; n < 2; ++n) \
            asm volatile("v_mfma_f32_16x16x128_f8f6f4 %0, %1, %2, %0" : "+v"(acc[ai][bj][m][n]) : "v"(Bt##8[n]), "v"(At##8[m])); } \
        else { _Pragma("unroll") for (int m = 0; m < 4; ++m) _Pragma("unroll") for (int n = 0; n < 2; ++n) _Pragma("unroll") for (int k = 0; k < 2; ++k) \
            acc[ai][bj][m][n] = __builtin_amdgcn_mfma_f32_16x16x32_bf16(Bt[n][k], At[m][k], acc[ai][bj][m][n], 0, 0, 0); } __builtin_amdgcn_s_setprio(0); } while (0)
#define PG8_WAIT_V(n) asm volatile("s_waitcnt vmcnt(" #n ")" ::: "memory")
#define PG8_WAIT_L(n) asm volatile("s_waitcnt lgkmcnt(" #n ")" ::: "memory")
#define PG8_BAR __builtin_amdgcn_s_barrier()
#define PG8_SCHED __builtin_amdgcn_sched_barrier(0)
#define PG8_HOFF(h) (GATHER ? (size_t)0 : (size_t)(h) * hstep)
#define PG8_STAGE_A(bufoff, base_, h_, uq_) do { if constexpr (GATHER) { unsigned vo_[2]; _Pragma("unroll") for (int _i = 0; _i < 2; ++_i) vo_[_i] = gtab[(uq_) * 256 + (h_) * HALF + sR[_i]] + (unsigned)sC[_i] * 2u; PG8_STAGE(bufoff, base_, vo_); } \
        else { PG8_STAGE(bufoff, (base_) + PG8_HOFF(h_), voffA); } } while (0)
    Unit cur, nxt; int ui = 0;
    if (!S.next(0, cur)) return;
    f32x4 acc[2][2][4][2];
#pragma unroll
    for (int a = 0; a < 2; ++a)
#pragma unroll
        for (int b = 0; b < 2; ++b)
#pragma unroll
            for (int m = 0; m < 4; ++m)
#pragma unroll
                for (int n = 0; n < 2; ++n) acc[a][b][m][n] = (f32x4){0.f, 0.f, 0.f, 0.f};
    bf16x8 At[4][2], B0[2][2], B1[2][2]; i32x8 At8[4], B08[2], B18[2];
    const char* cA = (const char*)g.A + (GATHER ? (size_t)0 : (size_t)cur.pm * tstep); const char* cB = (const char*)g.Bt + (size_t)cur.pn * tstep;
    PG8_STAGE(PG8_SB(0, 0), cB, voffB); PG8_STAGE(PG8_SB(0, 1), cB + hstep, voffB); PG8_STAGE_A(PG8_SA(0, 0), cA, 0, 0); PG8_STAGE_A(PG8_SA(0, 1), cA, 1, 0);
    if (wr == 1) PG8_BAR;
    PG8_WAIT_V(2); PG8_BAR;
    PG8_STAGE(PG8_SB(1, 0), cB + kstep, voffB); PG8_STAGE_A(PG8_SA(1, 0), cA + kstep, 0, 0); PG8_STAGE(PG8_SB(1, 1), cB + hstep + kstep, voffB);
    PG8_WAIT_V(6); PG8_BAR;
    for (;;) {
        const bool has_next = S.next(ui + 1, nxt);
        const char* nA = GATHER ? cA : (has_next ? (const char*)g.A + (size_t)nxt.pm * tstep : cA); const char* nB = has_next ? (const char*)g.Bt + (size_t)nxt.pn * tstep : cB;
#pragma unroll 1
        for (int t = 0; t < nt; t += 2) {
            const bool last = (t == nt - 2);
            const char* a1 = cA + (size_t)(t + 1) * kstep;
            const char* a2 = last ? nA : cA + (size_t)(t + 2) * kstep; const char* b2 = last ? nB : cB + (size_t)(t + 2) * kstep;
            const char* a3 = a2 + kstep; const char* b3 = b2 + kstep;
            const int uq = (last && has_next) ? ui + 1 : ui;
            PG8_LDB(B0, 0, 0); PG8_LDB(B1, 0, 1); PG8_SCHED; PG8_LDA(At, 0, 0); PG8_STAGE_A(PG8_SA(1, 1), a1, 1, ui);
            PG8_WAIT_V(8); PG8_WAIT_L(0); PG8_BAR; PG8_MMA(0, 0, At, B0); PG8_MMA(0, 1, At, B1); PG8_BAR; PG8_SCHED;
            PG8_LDA(At, 0, 1); PG8_STAGE(PG8_SB(0, 0), b2, voffB); PG8_STAGE(PG8_SB(0, 1), b2 + hstep, voffB); PG8_STAGE_A(PG8_SA(0, 0), a2, 0, uq);
            PG8_WAIT_V(8); PG8_WAIT_L(0); PG8_BAR; PG8_MMA(1, 0, At, B0); PG8_MMA(1, 1, At, B1); PG8_BAR; PG8_SCHED;
            PG8_LDB(B0, 1, 0); PG8_LDB(B1, 1, 1); PG8_SCHED; PG8_LDA(At, 1, 0); PG8_STAGE_A(PG8_SA(0, 1), a2, 1, uq);
            PG8_WAIT_V(8); PG8_WAIT_L(0); PG8_BAR; PG8_MMA(0, 0, At, B0); PG8_MMA(0, 1, At, B1); PG8_BAR; PG8_SCHED;
            PG8_LDA(At, 1, 1); PG8_STAGE(PG8_SB(1, 0), b3, voffB); PG8_STAGE(PG8_SB(1, 1), b3 + hstep, voffB); PG8_STAGE_A(PG8_SA(1, 0), a3, 0, uq);
            PG8_WAIT_V(8); PG8_WAIT_L(0); PG8_BAR; PG8_MMA(1, 0, At, B0); PG8_MMA(1, 1, At, B1); PG8_BAR; PG8_SCHED;
        }
        if constexpr (ALIGN_EPI) { if (wr == 0) PG8_BAR; }
        if constexpr (F8) { asm volatile("s_nop 15\n\ts_nop 15" ::: "memory"); PG8_SCHED; }
        E(acc, cur, ui, wr, wc, fr, fq);
        if (!has_next) break;
#pragma unroll
        for (int a = 0; a < 2; ++a)
#pragma unroll
            for (int b = 0; b < 2; ++b)
#pragma unroll
                for (int m = 0; m < 4; ++m)
#pragma unroll
                    for (int n = 0; n < 2; ++n) acc[a][b][m][n] = (f32x4){0.f, 0.f, 0.f, 0.f};
        cur = nxt; cA = nA; cB = nB; ++ui;
        if constexpr (ALIGN_EPI) { if (wr == 1) PG8_BAR; }
    }
    PG8_WAIT_V(0);
    if constexpr (!ALIGN_EPI) { if (wr == 0) PG8_BAR; }
    PG8_BAR;
#undef PG8_SA
#undef PG8_SB
#undef PG8_STAGE
#undef PG8_LDA
#undef PG8_LDB
#undef PG8_MMA
#undef PG8_WAIT_V
#undef PG8_WAIT_L
#undef PG8_BAR
#undef PG8_SCHED
#undef PG8_STAGE_A
#undef PG8_HOFF
}


struct EpiProj {
    static constexpr bool PERM = true;
    bf16_t* P; float* GZ; const float* tab;
    __device__ __forceinline__ void operator()(const f32x4 (&acc)[2][2][4][2], const Unit& u, int ui, int wr, int wc, int fr, int fq) const {
        const int pn = u.pn, row0 = u.pm * BM + wr * 64 + fr, colw = wc * 32 + 8 * fq;
        if (pn == 14) {
            if (wc == 0) {
#pragma unroll
                for (int ai = 0; ai < 2; ++ai)
#pragma unroll
                    for (int m = 0; m < 4; ++m) { float* o = GZ + (size_t)(row0 + ai * HALF + m * 16) * 32 + 8 * fq; *(f32x4*)o = acc[ai][0][m][0]; *(f32x4*)(o + 4) = acc[ai][0][m][1]; }
            }
            return;
        }
        const int mode = (pn == 0) ? 1 : ((pn == 4 || pn == 5 || pn >= 12) ? 2 : ((pn >= 6 && pn <= 9) ? 3 : 0));
        const float rks = (pn >= 8) ? 0.08838834764831845f : 1.0f;
        const bool lowhalf = wc < 2;
        const int f0 = (16 * wc + 4 * fq) & 31;
#pragma unroll
        for (int ai = 0; ai < 2; ++ai)
#pragma unroll
            for (int m = 0; m < 4; ++m) {
                const int row = row0 + ai * HALF + m * 16;
                bf16_t* rowp = P + ptile(row, pn * BM + colw);
                f32x4 cs0 = {1.f, 0.f, 1.f, 0.f}, cs1 = {1.f, 0.f, 1.f, 0.f};
                if (mode == 3 && row < NLAT) { const int t = row & (SEQ - 1), pos = lowhalf ? (t >> 6) : (t & 63); const float* tp = tab + 2 * (pos * 32 + f0); cs0 = *(const f32x4*)tp; cs1 = *(const f32x4*)(tp + 4); }
#pragma unroll
                for (int bj = 0; bj < 2; ++bj) {
                    f32x4 v0 = acc[ai][bj][m][0], v1 = acc[ai][bj][m][1];
                    if (mode == 1) { v0 = v0 * 0.125f; v1 = v1 * 0.125f; }
                    else if (mode == 2) {
#pragma unroll
                        for (int e = 0; e < 4; ++e) { v0[e] = fast_silu(v0[e]); v1[e] = fast_silu(v1[e]); }
                    } else if (mode == 3) {
                        v0 = v0 * rks; v1 = v1 * rks;
                        const float c[4] = {cs0[0], cs0[2], cs1[0], cs1[2]}, s[4] = {cs0[1], cs0[3], cs1[1], cs1[3]};
#pragma unroll
                        for (int e = 0; e < 4; ++e) { const float a1 = v0[e], a2 = v1[e]; v0[e] = a1 * c[e] - a2 * s[e]; v1[e] = a1 * s[e] + a2 * c[e]; }
                    }
                    u32x4 w; w.x = cvt_pk_bf16(v0[0], v0[1]); w.y = cvt_pk_bf16(v0[2], v0[3]); w.z = cvt_pk_bf16(v1[0], v1[1]); w.w = cvt_pk_bf16(v1[2], v1[3]);
                    *(u32x4*)(rowp + bj * 8192) = w;
                }
            }
    }
};
struct EpiOut {
    static constexpr bool PERM = true;
    bf16_t* XO; const float* mod;
    __device__ __forceinline__ void operator()(const f32x4 (&acc)[2][2][4][2], const Unit& u, int ui, int wr, int wc, int fr, int fq) const {
        const int col0 = u.pn * BM + wc * 32 + 8 * fq, b = (u.pm * BM) / SEQ;
        const float* m2 = mod + b * NADA * D + 2 * D;
        f32x4 mv[2][2];
#pragma unroll
        for (int bj = 0; bj < 2; ++bj)
#pragma unroll
            for (int n = 0; n < 2; ++n) mv[bj][n] = *(const f32x4*)(m2 + col0 + bj * HALF + 4 * n);
#pragma unroll
        for (int ai = 0; ai < 2; ++ai)
#pragma unroll
            for (int m = 0; m < 4; ++m) { bf16_t* rowp = XO + (size_t)(u.pm * BM + ai * HALF + wr * 64 + m * 16 + fr) * D + col0;
#pragma unroll
                for (int bj = 0; bj < 2; ++bj) { const f32x4 v0 = mv[bj][0] * acc[ai][bj][m][0], v1 = mv[bj][1] * acc[ai][bj][m][1];
                    u32x4 w; w.x = cvt_pk_bf16(v0[0], v0[1]); w.y = cvt_pk_bf16(v0[2], v0[3]); w.z = cvt_pk_bf16(v1[0], v1[1]); w.w = cvt_pk_bf16(v1[2], v1[3]);
                    *(u32x4*)(rowp + bj * HALF) = w; } }
    }
};
struct EpiAct {
    static constexpr bool PERM = true;
    unsigned char* ACT; float wscale, ascale;
    __device__ __forceinline__ void operator()(const f32x4 (&acc)[2][2][4][2], const Unit& u, int ui, int wr, int wc, int fr, int fq) const {
        const int pnl = u.pn % 11, col0 = pnl * HALF + wc * 32 + 8 * fq;
#pragma unroll
        for (int ai = 0; ai < 2; ++ai)
#pragma unroll
            for (int m = 0; m < 4; ++m) { unsigned char* rowp = ACT + (size_t)(u.pm * BM + ai * HALF + wr * 64 + m * 16 + fr) * FFP;
                f32x4 v0, v1;
#pragma unroll
                for (int e = 0; e < 4; ++e) { const float a0 = acc[ai][0][m][0][e] * wscale, a1 = acc[ai][0][m][1][e] * wscale;
                    v0[e] = fast_silu(a0) * (acc[ai][1][m][0][e] * (wscale * ascale)); v1[e] = fast_silu(a1) * (acc[ai][1][m][1][e] * (wscale * ascale)); }
                u32x2 w; w.x = pk_fp8x4(v0[0], v0[1], v0[2], v0[3]); w.y = pk_fp8x4(v1[0], v1[1], v1[2], v1[3]);
                *(u32x2*)(rowp + col0) = w;
                if (pnl == 10) *(u32x2*)(rowp + FF + wc * 32 + 8 * fq) = (u32x2){0u, 0u}; }
    }
};
struct EpiDown {
    static constexpr bool PERM = true;
    unsigned char* YE; const float* gate; float oscale;
    __device__ __forceinline__ void operator()(const f32x4 (&acc)[2][2][4][2], const Unit& u, int ui, int wr, int wc, int fr, int fq) const {
        const int col0 = (u.pn & 3) * BM + wc * 32 + 8 * fq;
#pragma unroll
        for (int ai = 0; ai < 2; ++ai)
#pragma unroll
            for (int m = 0; m < 4; ++m) { const int row = u.pm * BM + ai * HALF + wr * 64 + m * 16 + fr; const float gt = gate[row] * oscale; unsigned char* rowp = YE + (size_t)row * D + col0;
#pragma unroll
                for (int bj = 0; bj < 2; ++bj) { const f32x4 v0 = acc[ai][bj][m][0] * gt, v1 = acc[ai][bj][m][1] * gt;
                    u32x2 w; w.x = pk_fp8x4(v0[0], v0[1], v0[2], v0[3]); w.y = pk_fp8x4(v1[0], v1[1], v1[2], v1[3]);
                    *(u32x2*)(rowp + bj * HALF) = w; } }
    }
};
}

namespace scan {
constexpr int RS = 72;
constexpr int RS2 = 136;
constexpr int OS = 132;
constexpr int NSL = 260;
constexpr size_t GLA_SLOT = 128 * 64, RET_SLOT = 128 * 128;
constexpr size_t US_RET_OFF = (size_t)16 * NSL * GLA_SLOT;
__device__ __forceinline__ int slot_row0(int b, int slot) { return slot < 4 ? NLAT + b * CTX + slot * 64 : b * SEQ + (slot - 4) * 64; }
__device__ __forceinline__ int slot_at(int dir, int step) { return dir ? (step < 4 ? 3 - step : 263 - step) : step; }
__device__ __forceinline__ f32x4 mfma16(bf16x8 a, bf16x8 b, f32x4 c) { return __builtin_amdgcn_mfma_f32_16x16x32_bf16(a, b, c, 0, 0, 0); }
__device__ __forceinline__ bf16x8 lds_frag(const LAS bf16_t* base, int off) { return *(const LAS bf16x8*)(base + off); }
__device__ __forceinline__ int tsw_w(int row, int j) { return row * RS + ((((j >> 3) ^ ((row >> 4) & 7)) << 3) | (j & 7)); }
__device__ __forceinline__ int tsw_r(int row, int chunk) { return row * RS + ((chunk ^ ((row >> 4) & 7)) << 3); }
__device__ __forceinline__ bf16x8 lds_frag_pi(const LAS bf16_t* base, int off  ) {
    typedef short s4 __attribute__((ext_vector_type(4)));
    const s4 lo = *(const LAS s4*)(base + off), hi = *(const LAS s4*)(base + off + 16);
    return (bf16x8){lo[0], lo[1], lo[2], lo[3], hi[0], hi[1], hi[2], hi[3]};
}
__device__ __forceinline__ unsigned pk(float lo, float hi) { return pg8::cvt_pk_bf16(lo, hi); }
__device__ __forceinline__ bf16_t f2bf_hw(float x) { return (bf16_t)(pg8::cvt_pk_bf16(x, 0.f) & 0xffffu); }
__device__ __forceinline__ u32x2 pack_state8(const f32x4 a0, const f32x4 a1) { u32x2 o; o.x = pg8::pk_fp8x4(a0[0], a0[1], a0[2], a0[3]); o.y = pg8::pk_fp8x4(a1[0], a1[1], a1[2], a1[3]); return o; }
__device__ __forceinline__ bf16x8 unpack_state8(const u32x2 w) {
    const f32x2 a = __builtin_amdgcn_cvt_pk_f32_fp8((int)w.x, false), b = __builtin_amdgcn_cvt_pk_f32_fp8((int)w.x, true), c = __builtin_amdgcn_cvt_pk_f32_fp8((int)w.y, false), d = __builtin_amdgcn_cvt_pk_f32_fp8((int)w.y, true);
    const u32x4 r = {pk(a[0], a[1]), pk(b[0], b[1]), pk(c[0], c[1]), pk(d[0], d[1])};
    return __builtin_bit_cast(bf16x8, r);
}

typedef float f32x4m __attribute__((ext_vector_type(4)));
__device__ __forceinline__ void gla_stepA(const float (&wm)[2][2][4], float bf, float bb, int w, int lane, const LAS float* gz_s, LAS float* PR, LAS float* tot, float (&bi)[8], float (&ci)[8], float& allf, float& allb) {
    { const int it = w >> 1, c = lane & 15, q = lane >> 4;
      float a_f[4], a_b[4];
#pragma unroll
      for (int sx = 0; sx < 4; ++sx) { a_f[sx] = gz_s[(16 * it + c) * 36 + 4 * sx + q]; a_b[sx] = gz_s[(16 * it + c) * 36 + 16 + 4 * sx + q]; }
#pragma unroll
      for (int kk = 0; kk < 2; ++kk) { const int kt = 2 * (w & 1) + kk; f32x4 df = {0.f, 0.f, 0.f, 0.f}, db = {0.f, 0.f, 0.f, 0.f};
#pragma unroll
          for (int sx = 0; sx < 4; ++sx) { df = __builtin_amdgcn_mfma_f32_16x16x4f32(a_f[sx], wm[0][kk][sx], df, 0, 0, 0); db = __builtin_amdgcn_mfma_f32_16x16x4f32(a_b[sx], wm[1][kk][sx], db, 0, 0, 0); }
#pragma unroll
          for (int r = 0; r < 4; ++r) { PR[(16 * it + 4 * q + r) * 65 + 16 * kt + c] = df[r]; PR[64 * 65 + (16 * it + 4 * q + r) * 65 + 16 * kt + c] = db[r]; } } }
    __syncthreads();
    float laf[8], lab[8];
#pragma unroll
    for (int tt = 0; tt < 8; ++tt) {
        const float pf = bf + PR[(8 * w + tt) * 65 + lane], pb = bb + PR[64 * 65 + (8 * w + tt) * 65 + lane];
        laf[tt] = (fminf(pf, 0.f) - __logf(1.0f + __expf(-fabsf(pf)))) * 0.0625f;
        lab[tt] = (fminf(pb, 0.f) - __logf(1.0f + __expf(-fabsf(pb)))) * 0.0625f;
    }
#pragma unroll
    for (int tt = 1; tt < 8; ++tt) laf[tt] += laf[tt - 1];
#pragma unroll
    for (int tt = 6; tt >= 0; --tt) lab[tt] += lab[tt + 1];
    tot[w * 64 + lane] = laf[7]; tot[512 + w * 64 + lane] = lab[0];
    __syncthreads();
    float offf = 0.f, offb = 0.f; allf = 0.f; allb = 0.f;
#pragma unroll
    for (int w2 = 0; w2 < 8; ++w2) { const float tf = tot[w2 * 64 + lane], tb = tot[512 + w2 * 64 + lane]; allf += tf; allb += tb; if (w2 < w) offf += tf; if (w2 > w) offb += tb; }
#pragma unroll
    for (int tt = 0; tt < 8; ++tt) { bi[tt] = offf + laf[tt]; ci[tt] = offb + lab[tt]; }
}
__device__ __forceinline__ void load_gate_wm(const Ptrs& p, int h, int w, int lane, float (&wm)[2][2][4]) {
#pragma unroll
    for (int dir = 0; dir < 2; ++dir)
#pragma unroll
        for (int kk = 0; kk < 2; ++kk)
#pragma unroll
            for (int sx = 0; sx < 4; ++sx) wm[dir][kk][sx] = p.gla_gate_w[(dir * 16 + 4 * sx + (lane >> 4)) * 256 + h * 64 + 16 * (2 * (w & 1) + kk) + (lane & 15)];
}
__device__ __forceinline__ void stage_vt_regs(const u32x4 a, const u32x4 b, LAS bf16_t* VT, int tid) {
    const int j = tid >> 3, vg = tid & 7;
    const unsigned wa[4] = {a.x, a.y, a.z, a.w}, wb[4] = {b.x, b.y, b.z, b.w};
#pragma unroll
    for (int e = 0; e < 4; ++e) { VT[tsw_w(vg * 8 + 2 * e, j)] = (bf16_t)(wa[e] & 0xffffu); VT[tsw_w(vg * 8 + 2 * e + 1, j)] = (bf16_t)(wa[e] >> 16);
                                  VT[tsw_w(64 + vg * 8 + 2 * e, j)] = (bf16_t)(wb[e] & 0xffffu); VT[tsw_w(64 + vg * 8 + 2 * e + 1, j)] = (bf16_t)(wb[e] >> 16); }
}
#ifndef S_F8_GLA
#define S_F8_GLA 0
#endif
#ifndef S_F8_RET
#define S_F8_RET 0
#endif
#ifndef C1G_REP
#define C1G_REP 1
#endif
#ifndef C1R_REP
#define C1R_REP 1
#endif
#define SCAN_FENCE() asm volatile("" ::: "memory")

__device__ __forceinline__ void run_c1(const Ptrs& p, LAS unsigned char* lds, int bx) {
    const int tid = threadIdx.x, w = __builtin_amdgcn_readfirstlane(tid >> 6), lane = tid & 63, c = lane & 15, q = lane >> 4;
    const int bh = bx >> 5, b = bh >> 2, h = bh & 3, s0 = bx & 31;
    const bf16_t* P = (const bf16_t*)(p.ws + WS_P);
    const int jrow = tid >> 3, g8 = tid & 7;
    {
        LAS float* gz_s = (LAS float*)lds; LAS float* tot = (LAS float*)(lds + 91648); LAS float* PR = (LAS float*)(lds + 58368);
        LAS bf16_t* KfT = (LAS bf16_t*)(lds + 12288); LAS bf16_t* KbT = (LAS bf16_t*)(lds + 21504); LAS bf16_t* VT = (LAS bf16_t*)(lds + 30720); LAS bf16_t* Kraw = (LAS bf16_t*)(lds + 49152);
        float wm[2][2][4]; load_gate_wm(p, h, w, lane, wm);
        const float bf = p.gla_gate_b[h * 64 + lane], bb = p.gla_gate_b[256 + h * 64 + lane];
        f32x4 gzv_A, gzv_B; u32x4 va_A, vb_A, kv_A, va_B, vb_B, kv_B;
#define C1G_LOAD(S, slot_) do { const int r0_ = slot_row0(b, (slot_)); gzv_##S = ((const f32x4*)((const float*)(p.ws + WS_GZ) + (size_t)r0_ * 32))[tid]; \
            const bf16_t* rv_ = P + ptile(r0_ + jrow, C_GV + h * 128 + g8 * 8); va_##S = *(const u32x4*)rv_; vb_##S = *(const u32x4*)(rv_ + 64); \
            kv_##S = *(const u32x4*)(P + ptile(r0_ + jrow, C_GK + h * 64 + g8 * 8)); } while (0)
#define C1G_ITEM(S, slot) do { \
            *(LAS f32x4*)(gz_s + jrow * 36 + g8 * 4) = gzv_##S; stage_vt_regs(va_##S, vb_##S, VT, tid); *(LAS u32x4*)(Kraw + jrow * RS + g8 * 8) = kv_##S; \
            __syncthreads(); \
            if ((slot) + 64 < NSL) C1G_LOAD(S, (slot) + 64); \
            float bi[8], ci[8], allf, allb; \
            gla_stepA(wm, bf, bb, w, lane, gz_s, PR, tot, bi, ci, allf, allb); \
            { float ef[8], eb[8]; \
            _Pragma("unroll") \
              for (int tt = 0; tt < 8; ++tt) { const float kk = bf2f(Kraw[(8 * w + tt) * RS + lane]); ef[tt] = kk * __expf(allf - bi[tt]); eb[tt] = kk * __expf(allb - ci[tt]); } \
              u32x4 wf_, wb_; wf_.x = pk(ef[0], ef[1]); wf_.y = pk(ef[2], ef[3]); wf_.z = pk(ef[4], ef[5]); wf_.w = pk(ef[6], ef[7]); \
              wb_.x = pk(eb[0], eb[1]); wb_.y = pk(eb[2], eb[3]); wb_.z = pk(eb[4], eb[5]); wb_.w = pk(eb[6], eb[7]); \
              *(LAS u32x4*)(KfT + lane * RS + 8 * w) = wf_; *(LAS u32x4*)(KbT + lane * RS + 8 * w) = wb_; } \
            float* DCH = (float*)(p.ws + WS_DCH); \
            if (w == 0) { DCH[((size_t)(bh * 2 + 0) * NSL + (slot)) * 64 + lane] = __expf(allf); DCH[((size_t)(bh * 2 + 1) * NSL + (slot)) * 64 + lane] = __expf(allb); } \
            __syncthreads(); \
            unsigned char* US = (unsigned char*)p.out; \
            bf16x8 Bv[2]; \
            _Pragma("unroll") \
            for (int js = 0; js < 2; ++js) Bv[js] = lds_frag(VT, tsw_r(16 * w + c, 4 * js + q)); \
            _Pragma("unroll") \
            for (int dir = 0; dir < 2; ++dir) { const LAS bf16_t* KT = dir ? KbT : KfT; \
            _Pragma("unroll") \
                for (int ks = 0; ks < 2; ++ks) { f32x4 a0 = {0.f, 0.f, 0.f, 0.f}, a1 = {0.f, 0.f, 0.f, 0.f}; \
            _Pragma("unroll") \
                    for (int js = 0; js < 2; ++js) { a0 = mfma16(lds_frag(KT, (32 * ks + c) * RS + 32 * js + 8 * q), Bv[js], a0); a1 = mfma16(lds_frag(KT, (32 * ks + 16 + c) * RS + 32 * js + 8 * q), Bv[js], a1); } \
                    *(u32x2*)(US + ((size_t)(bh * 2 + dir) * NSL + (slot)) * GLA_SLOT + ((w * 2 + ks) * 64 + lane) * 8) = pack_state8(a0, a1); } } \
            __syncthreads(); \
        } while (0)
        for (int rep1_ = 0; rep1_ < C1G_REP; ++rep1_) {
        C1G_LOAD(A, s0); if (s0 + 32 < NSL) C1G_LOAD(B, s0 + 32);
        for (int slot = s0; slot < NSL; slot += 64) {
            C1G_ITEM(A, slot);
            if (slot + 32 < NSL) C1G_ITEM(B, slot + 32);
        }
        }
#undef C1G_ITEM
#undef C1G_LOAD
    }
    {
        LAS bf16_t* KT = (LAS bf16_t*)lds; LAS bf16_t* VfT = (LAS bf16_t*)(lds + 18432); LAS bf16_t* VbT = (LAS bf16_t*)(lds + 36864);
        const float lgf = log_sigmoidf(p.ret_decay_logit[h]), lgb = log_sigmoidf(p.ret_decay_logit[4 + h]);
        const float sf = __expf(lgf * (float)(63 - jrow)), sb = __expf(lgb * (float)jrow);
        u32x4 ka_A, kb_A, va_A, vb_A, ka_B, kb_B, va_B, vb_B;
#define C1R_LOAD(S, slot_) do { const int rr_ = slot_row0(b, (slot_)) + jrow; const bf16_t* rk_ = P + ptile(rr_, C_RK + h * 128 + g8 * 8); const bf16_t* rv_ = P + ptile(rr_, C_RV + h * 128 + g8 * 8); \
            ka_##S = *(const u32x4*)rk_; kb_##S = *(const u32x4*)(rk_ + 64); va_##S = *(const u32x4*)rv_; vb_##S = *(const u32x4*)(rv_ + 64); } while (0)
#define C1R_ITEM(S, slot) do { \
            { const unsigned kw[8] = {ka_##S.x, ka_##S.y, ka_##S.z, ka_##S.w, kb_##S.x, kb_##S.y, kb_##S.z, kb_##S.w}, vw[8] = {va_##S.x, va_##S.y, va_##S.z, va_##S.w, vb_##S.x, vb_##S.y, vb_##S.z, vb_##S.w}; \
            _Pragma("unroll") \
              for (int e = 0; e < 8; ++e) { const int rw_ = (e < 4 ? 0 : 56) + g8 * 8 + 2 * e; const int r0 = tsw_w(rw_, jrow), r1 = tsw_w(rw_ + 1, jrow); \
                  KT[r0] = (bf16_t)(kw[e] & 0xffffu); KT[r1] = (bf16_t)(kw[e] >> 16); \
                  const float v0 = __uint_as_float(vw[e] << 16), v1 = __uint_as_float(vw[e] & 0xffff0000u); \
                  VfT[r0] = f2bf_hw(v0 * sf); VfT[r1] = f2bf_hw(v1 * sf); VbT[r0] = f2bf_hw(v0 * sb); VbT[r1] = f2bf_hw(v1 * sb); } } \
            __syncthreads(); \
            if ((slot) + 64 < NSL) C1R_LOAD(S, (slot) + 64); \
            unsigned char* US = (unsigned char*)p.out + US_RET_OFF; \
            _Pragma("unroll") \
            for (int dir = 0; dir < 2; ++dir) { const LAS bf16_t* VT = dir ? VbT : VfT; \
                bf16x8 Bv[2]; \
            _Pragma("unroll") \
                for (int js = 0; js < 2; ++js) Bv[js] = lds_frag(VT, tsw_r(16 * w + c, 4 * js + q)); \
            _Pragma("unroll") \
                for (int ks = 0; ks < 4; ++ks) { f32x4 a0 = {0.f, 0.f, 0.f, 0.f}, a1 = {0.f, 0.f, 0.f, 0.f}; \
            _Pragma("unroll") \
                    for (int js = 0; js < 2; ++js) { a0 = mfma16(lds_frag(KT, tsw_r(32 * ks + c, 4 * js + q)), Bv[js], a0); a1 = mfma16(lds_frag(KT, tsw_r(32 * ks + 16 + c, 4 * js + q)), Bv[js], a1); } \
                    *(u32x2*)(US + ((size_t)(bh * 2 + dir) * NSL + (slot)) * RET_SLOT + ((w * 4 + ks) * 64 + lane) * 8) = pack_state8(a0, a1); } } \
            __syncthreads(); \
        } while (0)
        for (int rep2_ = 0; rep2_ < C1R_REP; ++rep2_) {
        C1R_LOAD(A, s0); if (s0 + 32 < NSL) C1R_LOAD(B, s0 + 32);
        for (int slot = s0; slot < NSL; slot += 64) {
            C1R_ITEM(A, slot);
            if (slot + 32 < NSL) C1R_ITEM(B, slot + 32);
        }
        }
#undef C1R_ITEM
#undef C1R_LOAD
    }
}
__device__ __forceinline__ void run_c2(const Ptrs& p, LAS unsigned char* lds, int bx) {
    constexpr int NB = 13, GLA_ELEMS = 16 * 8192;
    const int tid = threadIdx.x;
    LAS float* dl = (LAS float*)lds;
    const int e_blk = bx * 1536, c0 = e_blk >> 13;
    if (e_blk < GLA_ELEMS) {
        const int c1 = ((e_blk + 1535) >> 13) < 15 ? ((e_blk + 1535) >> 13) : 15;
        const f32x4* src = (const f32x4*)((const float*)(p.ws + WS_DCH) + (size_t)c0 * NSL * 64);
        const int n4 = (c1 - c0 + 1) * NSL * 16;
        for (int i = tid; i < n4; i += NTHR) ((LAS f32x4*)dl)[i] = src[i];
    }
    __syncthreads();
    if (tid < 192) {
        const int e = e_blk + tid * 8;
        const bool isG = e < GLA_ELEMS;
        const int er = isG ? e : e - GLA_ELEMS;
        const int chain = isG ? (er >> 13) : (er >> 14), el = isG ? (er & 8191) : (er & 16383);
        const size_t SLOT = isG ? GLA_SLOT : RET_SLOT;
        const int dir = chain & 1, h = (chain >> 1) & 3;
        const size_t off = (isG ? 0 : US_RET_OFF) + (size_t)chain * NSL * SLOT + el;
        const unsigned char* ubase = (const unsigned char*)p.out + off;
        bf16_t* sbase = (bf16_t*)(p.ws + WS_US) + off;
        const bool s8 = isG ? (S_F8_GLA != 0) : (S_F8_RET != 0);
        const float dconst = __expf(64.0f * log_sigmoidf(p.ret_decay_logit[dir * 4 + h]));
        const int kb = 32 * ((el >> 9) & 1) + 4 * (((el >> 3) & 63) >> 4);
        const LAS float* dlc = dl + (isG ? (chain - c0) : 0) * NSL * 64 + kb;
        f32x4 s0 = {0.f, 0.f, 0.f, 0.f}, s1 = {0.f, 0.f, 0.f, 0.f};
        u32x2 uA[NB], uB[NB];
#define C2_LOAD(U_, bt_) do { _Pragma("unroll") for (int i = 0; i < NB; ++i) { const int slot = slot_at(dir, (bt_) * NB + i); U_[i] = *(const u32x2*)(ubase + (size_t)slot * SLOT); } } while (0)
#define C2_PROC(U_, bt_) do { _Pragma("unroll") for (int i = 0; i < NB; ++i) { const int slot = slot_at(dir, (bt_) * NB + i); \
        if (s8) *(u32x2*)((unsigned char*)(p.ws + WS_US) + off * 2 - el + (size_t)slot * SLOT) = pack_state8(s0, s1); else { u32x4 o_; o_.x = pk(s0[0], s0[1]); o_.y = pk(s0[2], s0[3]); o_.z = pk(s1[0], s1[1]); o_.w = pk(s1[2], s1[3]); *(u32x4*)(sbase + (size_t)slot * SLOT) = o_; } \
        const f32x2 a_ = __builtin_amdgcn_cvt_pk_f32_fp8((int)U_[i].x, false), b_ = __builtin_amdgcn_cvt_pk_f32_fp8((int)U_[i].x, true), c_ = __builtin_amdgcn_cvt_pk_f32_fp8((int)U_[i].y, false), d_ = __builtin_amdgcn_cvt_pk_f32_fp8((int)U_[i].y, true); \
        const f32x4 u0 = {a_[0], a_[1], b_[0], b_[1]}, u1 = {c_[0], c_[1], d_[0], d_[1]}; \
        if (isG) { const f32x4 d0 = *(const LAS f32x4*)(dlc + slot * 64), d1 = *(const LAS f32x4*)(dlc + slot * 64 + 16); s0 = s0 * d0 + u0; s1 = s1 * d1 + u1; } else { s0 = s0 * dconst + u0; s1 = s1 * dconst + u1; } } } while (0)
        C2_LOAD(uA, 0);
        for (int bt = 0; bt < NSL / NB; bt += 2) {
            C2_LOAD(uB, bt + 1);
            C2_PROC(uA, bt);
            if (bt + 2 < NSL / NB) C2_LOAD(uA, bt + 2);
            C2_PROC(uB, bt + 1);
        }
#undef C2_LOAD
#undef C2_PROC
    }
    __syncthreads();
}
__device__ __forceinline__ void run_c3(const Ptrs& p, LAS unsigned char* lds, int bx, bf16_t* Y) {
    const int tid = threadIdx.x, w = __builtin_amdgcn_readfirstlane(tid >> 6), lane = tid & 63, c = lane & 15, q = lane >> 4;
    const int bh = bx >> 5, b = bh >> 2, h = bh & 3, n0 = bx & 31;
    const bf16_t* P = (const bf16_t*)(p.ws + WS_P);
    const int jrow = tid >> 3, g8 = tid & 7;
    {
        LAS float* gz_s = (LAS float*)lds; LAS float* tot = (LAS float*)(lds + 110592);
        LAS bf16_t* QF = (LAS bf16_t*)(lds + 12288); LAS bf16_t* QB = (LAS bf16_t*)(lds + 21504); LAS bf16_t* KF = (LAS bf16_t*)(lds + 30720); LAS bf16_t* KB = (LAS bf16_t*)(lds + 39936);
        LAS bf16_t* VT = (LAS bf16_t*)(lds + 49152); LAS bf16_t* Pm = (LAS bf16_t*)(lds + 67584); LAS float* Os = (LAS float*)(lds + 76800);
        float wm[2][2][4]; load_gate_wm(p, h, w, lane, wm);
        const float bf = p.gla_gate_b[h * 64 + lane], bb = p.gla_gate_b[256 + h * 64 + lane];
        const f32x2 nw = *(const f32x2*)(p.gla_norm_w + h * 128 + 2 * lane);
        const bf16_t* US = (const bf16_t*)(p.ws + WS_US);
        f32x4 gzv; u32x4 va, vb, qv, kv; bf16x8 Sfn[2], Sbn[2]; u32x2 Sfn8[2], Sbn8[2]; unsigned gtn[8];
#define C3G_LOAD(n_) do { const int r0_ = b * SEQ + (n_) * 64; gzv = ((const f32x4*)((const float*)(p.ws + WS_GZ) + (size_t)r0_ * 32))[tid]; \
            const bf16_t* rv_ = P + ptile(r0_ + jrow, C_GV + h * 128 + g8 * 8); va = *(const u32x4*)rv_; vb = *(const u32x4*)(rv_ + 64); \
            qv = *(const u32x4*)(P + ptile(r0_ + jrow, C_GQ + h * 64 + g8 * 8)); kv = *(const u32x4*)(P + ptile(r0_ + jrow, C_GK + h * 64 + g8 * 8)); \
            _Pragma("unroll") for (int ks = 0; ks < 2; ++ks) { if (S_F8_GLA) { \
                    Sfn8[ks] = *(const u32x2*)((const unsigned char*)US + (size_t)(bh * 2 + 0) * NSL * GLA_SLOT * 2 + (size_t)(4 + (n_)) * GLA_SLOT + ((w * 2 + ks) * 64 + lane) * 8); \
                    Sbn8[ks] = *(const u32x2*)((const unsigned char*)US + (size_t)(bh * 2 + 1) * NSL * GLA_SLOT * 2 + (size_t)(4 + (n_)) * GLA_SLOT + ((w * 2 + ks) * 64 + lane) * 8); } else { \
                    Sfn[ks] = *(const bf16x8*)(US + ((size_t)(bh * 2 + 0) * NSL + 4 + (n_)) * GLA_SLOT + ((w * 2 + ks) * 64 + lane) * 8); \
                    Sbn[ks] = *(const bf16x8*)(US + ((size_t)(bh * 2 + 1) * NSL + 4 + (n_)) * GLA_SLOT + ((w * 2 + ks) * 64 + lane) * 8); } } \
            _Pragma("unroll") for (int tt = 0; tt < 8; ++tt) gtn[tt] = *(const unsigned*)(P + ptile(r0_ + 8 * w + tt, C_GG + h * 128 + 2 * lane)); } while (0)
        C3G_LOAD(n0);
        for (int n = n0; n < 256; n += 32) {
            const int row0 = b * SEQ + n * 64;
            *(LAS f32x4*)(gz_s + jrow * 36 + g8 * 4) = gzv; stage_vt_regs(va, vb, VT, tid);
            *(LAS u32x4*)(QF + jrow * RS + g8 * 8) = qv; *(LAS u32x4*)(KF + jrow * RS + g8 * 8) = kv;
            bf16x8 Sf[2], Sb[2]; unsigned gt[8];
#pragma unroll
            for (int ks = 0; ks < 2; ++ks) { if (S_F8_GLA) { Sf[ks] = unpack_state8(Sfn8[ks]); Sb[ks] = unpack_state8(Sbn8[ks]); } else { Sf[ks] = Sfn[ks]; Sb[ks] = Sbn[ks]; } }
#pragma unroll
            for (int tt = 0; tt < 8; ++tt) gt[tt] = gtn[tt];
            __syncthreads();
            if (n + 32 < 256) C3G_LOAD(n + 32);
            float bi[8], ci[8], allf, allb;
            gla_stepA(wm, bf, bb, w, lane, gz_s, (LAS float*)Os, tot, bi, ci, allf, allb);
#pragma unroll
            for (int tt = 0; tt < 8; ++tt) { const int i = 8 * w + tt; const float qq = bf2f(QF[i * RS + lane]), kk = bf2f(KF[i * RS + lane]);
                QF[i * RS + lane] = f2bf_hw(qq * __expf(bi[tt])); QB[i * RS + lane] = f2bf_hw(qq * __expf(ci[tt]));
                KF[i * RS + lane] = f2bf_hw(kk * __expf(-bi[tt])); KB[i * RS + lane] = f2bf_hw(kk * __expf(-ci[tt])); }
            __syncthreads();
            { const int it = w & 3, i = 16 * it + c;
              bf16x8 qf[2], qb[2];
#pragma unroll
              for (int ks = 0; ks < 2; ++ks) { qf[ks] = lds_frag(QF, i * RS + 32 * ks + 8 * q); qb[ks] = lds_frag(QB, i * RS + 32 * ks + 8 * q); }
#pragma unroll
              for (int jj = 0; jj < 2; ++jj) { const int jt = 2 * (w >> 2) + jj; f32x4 af = {0.f, 0.f, 0.f, 0.f}, ab = {0.f, 0.f, 0.f, 0.f};
#pragma unroll
                  for (int ks = 0; ks < 2; ++ks) { af = mfma16(lds_frag(KF, (16 * jt + c) * RS + 32 * ks + 8 * q), qf[ks], af); ab = mfma16(lds_frag(KB, (16 * jt + c) * RS + 32 * ks + 8 * q), qb[ks], ab); }
                  float v[4];
#pragma unroll
                  for (int r = 0; r < 4; ++r) { const int j = 16 * jt + 4 * q + r; v[r] = (j <= i ? af[r] : 0.f) + (j >= i ? ab[r] : 0.f); }
                  u32x2 o; o.x = pk(v[0], v[1]); o.y = pk(v[2], v[3]); *(LAS u32x2*)(Pm + i * RS + 16 * jt + 4 * q) = o; } }
            __syncthreads();
            { bf16x8 Bv[2];
#pragma unroll
              for (int js = 0; js < 2; ++js) Bv[js] = lds_frag(VT, tsw_r(16 * w + c, 4 * js + q));
#pragma unroll
              for (int it = 0; it < 4; ++it) { f32x4 a = {0.f, 0.f, 0.f, 0.f}; const int i = 16 * it + c;
#pragma unroll
                  for (int js = 0; js < 2; ++js) a = mfma16(lds_frag(Pm, i * RS + 32 * js + 8 * q), Bv[js], a);
#pragma unroll
                  for (int ks = 0; ks < 2; ++ks) { a = mfma16(lds_frag_pi(QF, i * RS + 32 * ks + 4 * q), Sf[ks], a); a = mfma16(lds_frag_pi(QB, i * RS + 32 * ks + 4 * q), Sb[ks], a); }
#pragma unroll
                  for (int r = 0; r < 4; ++r) Os[(16 * it + 4 * q + r) * OS + 16 * w + c] = a[r]; } }
            __syncthreads();
#pragma unroll
            for (int tt = 0; tt < 8; ++tt) { const int i = 8 * w + tt; const f32x2 o = *(const LAS f32x2*)(Os + i * OS + 2 * lane);
                const float r = rsqrtf(wave_sum(o[0] * o[0] + o[1] * o[1]) * (1.f / 128.f) + EPS);
                *(unsigned*)(Y + (size_t)(row0 + i) * D + h * 128 + 2 * lane) = pk(o[0] * r * nw[0] * __uint_as_float(gt[tt] << 16), o[1] * r * nw[1] * __uint_as_float(gt[tt] & 0xffff0000u)); }
        }
        __syncthreads();
#undef C3G_LOAD
    }
    {
        LAS bf16_t* Qs = (LAS bf16_t*)lds; LAS bf16_t* Ks = (LAS bf16_t*)(lds + 17408); LAS bf16_t* VT = (LAS bf16_t*)(lds + 34816); LAS bf16_t* Pm = (LAS bf16_t*)(lds + 53248);
        LAS float* Os = (LAS float*)(lds + 62464); LAS float* pwf = (LAS float*)(lds + 96256); LAS float* pwb = pwf + 80;
        const float lgf = log_sigmoidf(p.ret_decay_logit[h]), lgb = log_sigmoidf(p.ret_decay_logit[4 + h]);
        if (tid < 65) { pwf[tid] = __expf(lgf * (float)tid); pwb[tid] = __expf(lgb * (float)tid); }
        const f32x2 nw = *(const f32x2*)(p.ret_norm_w + h * 128 + 2 * lane);
        const bf16_t* US = (const bf16_t*)(p.ws + WS_US) + US_RET_OFF;
        u32x4 qa, qb2, ka, kb2, va, vb; bf16x8 Sfn[4], Sbn[4]; u32x2 Sfn8[4], Sbn8[4]; unsigned gtn[8];
#define C3R_LOAD(n_) do { const int r0_ = b * SEQ + (n_) * 64; const bf16_t* rq_ = P + ptile(r0_ + jrow, C_RQ + h * 128 + g8 * 8); const bf16_t* rk_ = P + ptile(r0_ + jrow, C_RK + h * 128 + g8 * 8); const bf16_t* rv_ = P + ptile(r0_ + jrow, C_RV + h * 128 + g8 * 8); \
            qa = *(const u32x4*)rq_; qb2 = *(const u32x4*)(rq_ + 64); ka = *(const u32x4*)rk_; kb2 = *(const u32x4*)(rk_ + 64); \
            va = *(const u32x4*)rv_; vb = *(const u32x4*)(rv_ + 64); \
            _Pragma("unroll") for (int ks = 0; ks < 4; ++ks) { if (S_F8_RET) { \
                    Sfn8[ks] = *(const u32x2*)((const unsigned char*)US + (size_t)(bh * 2 + 0) * NSL * RET_SLOT * 2 + (size_t)(4 + (n_)) * RET_SLOT + ((w * 4 + ks) * 64 + lane) * 8); \
                    Sbn8[ks] = *(const u32x2*)((const unsigned char*)US + (size_t)(bh * 2 + 1) * NSL * RET_SLOT * 2 + (size_t)(4 + (n_)) * RET_SLOT + ((w * 4 + ks) * 64 + lane) * 8); } else { \
                    Sfn[ks] = *(const bf16x8*)(US + ((size_t)(bh * 2 + 0) * NSL + 4 + (n_)) * RET_SLOT + ((w * 4 + ks) * 64 + lane) * 8); \
                    Sbn[ks] = *(const bf16x8*)(US + ((size_t)(bh * 2 + 1) * NSL + 4 + (n_)) * RET_SLOT + ((w * 4 + ks) * 64 + lane) * 8); } } \
            _Pragma("unroll") for (int tt = 0; tt < 8; ++tt) gtn[tt] = *(const unsigned*)(P + ptile(r0_ + 8 * w + tt, C_RG + h * 128 + 2 * lane)); } while (0)
        C3R_LOAD(n0);
        for (int n = n0; n < 256; n += 32) {
            const int row0 = b * SEQ + n * 64;
            *(LAS u32x4*)(Qs + jrow * RS2 + g8 * 8) = qa; *(LAS u32x4*)(Qs + jrow * RS2 + 64 + g8 * 8) = qb2;
            *(LAS u32x4*)(Ks + jrow * RS2 + g8 * 8) = ka; *(LAS u32x4*)(Ks + jrow * RS2 + 64 + g8 * 8) = kb2;
            stage_vt_regs(va, vb, VT, tid);
            bf16x8 Sf[4], Sb[4]; unsigned gt[8];
#pragma unroll
            for (int ks = 0; ks < 4; ++ks) { if (S_F8_RET) { Sf[ks] = unpack_state8(Sfn8[ks]); Sb[ks] = unpack_state8(Sbn8[ks]); } else { Sf[ks] = Sfn[ks]; Sb[ks] = Sbn[ks]; } }
#pragma unroll
            for (int tt = 0; tt < 8; ++tt) gt[tt] = gtn[tt];
            __syncthreads();
            if (n + 32 < 256) C3R_LOAD(n + 32);
            { const int it = w & 3, i = 16 * it + c;
              bf16x8 qf[4];
#pragma unroll
              for (int ks = 0; ks < 4; ++ks) qf[ks] = lds_frag(Qs, i * RS2 + 32 * ks + 8 * q);
#pragma unroll
              for (int jj = 0; jj < 2; ++jj) { const int jt = 2 * (w >> 2) + jj; f32x4 a = {0.f, 0.f, 0.f, 0.f};
#pragma unroll
                  for (int ks = 0; ks < 4; ++ks) a = mfma16(lds_frag(Ks, (16 * jt + c) * RS2 + 32 * ks + 8 * q), qf[ks], a);
                  float v[4];
#pragma unroll
                  for (int r = 0; r < 4; ++r) { const int j = 16 * jt + 4 * q + r; const int dd = i - j; const float dm = (dd >= 0 ? pwf[dd >= 0 ? dd : 0] : 0.f) + (dd <= 0 ? pwb[dd <= 0 ? -dd : 0] : 0.f); v[r] = a[r] * dm; }
                  u32x2 o; o.x = pk(v[0], v[1]); o.y = pk(v[2], v[3]); *(LAS u32x2*)(Pm + i * RS + 16 * jt + 4 * q) = o; } }
            __syncthreads();
            { bf16x8 Bv[2];
#pragma unroll
              for (int js = 0; js < 2; ++js) Bv[js] = lds_frag(VT, tsw_r(16 * w + c, 4 * js + q));
#pragma unroll
              for (int it = 0; it < 4; ++it) { f32x4 a = {0.f, 0.f, 0.f, 0.f}, af = {0.f, 0.f, 0.f, 0.f}, ab = {0.f, 0.f, 0.f, 0.f}; const int i = 16 * it + c;
#pragma unroll
                  for (int js = 0; js < 2; ++js) a = mfma16(lds_frag(Pm, i * RS + 32 * js + 8 * q), Bv[js], a);
#pragma unroll
                  for (int ks = 0; ks < 4; ++ks) { const bf16x8 qx = lds_frag_pi(Qs, i * RS2 + 32 * ks + 4 * q); af = mfma16(qx, Sf[ks], af); ab = mfma16(qx, Sb[ks], ab); }
#pragma unroll
                  for (int r = 0; r < 4; ++r) { const int ii = 16 * it + 4 * q + r; Os[ii * OS + 16 * w + c] = a[r] + pwf[ii + 1] * af[r] + pwb[64 - ii] * ab[r]; } } }
            __syncthreads();
#pragma unroll
            for (int tt = 0; tt < 8; ++tt) { const int i = 8 * w + tt; const f32x2 o = *(const LAS f32x2*)(Os + i * OS + 2 * lane);
                const float mu = wave_sum(o[0] + o[1]) * (1.f / 128.f); const float d0 = o[0] - mu, d1 = o[1] - mu;
                const float r = rsqrtf(wave_sum(d0 * d0 + d1 * d1) * (1.f / 128.f) + EPS);
                *(unsigned*)(Y + (size_t)(row0 + i) * D + 512 + h * 128 + 2 * lane) = pk(d0 * r * nw[0] * __uint_as_float(gt[tt] << 16), d1 * r * nw[1] * __uint_as_float(gt[tt] & 0xffff0000u)); }
        }
        __syncthreads();
#undef C3R_LOAD
    }
}
}

namespace misc {
__device__ __forceinline__ void p0_mod(const Ptrs& p, LAS unsigned char* lds, int bx) {
    LAS float* sc = (LAS float*)lds;
    LAS float* red = sc + 3 * D;
    const int tid = threadIdx.x;
    for (int i = tid; i < 3 * D; i += NTHR) { const int r = i >> 10, k = i & 1023; const float v = (r < 2) ? p.c[r * D + k] : p.c_ctx[k]; sc[i] = siluf(v); }
    __syncthreads();
    const int kg = tid >> 5, cl = tid & 31, col = 24 * bx + cl;
    float a0 = 0.f, a1 = 0.f, a2 = 0.f;
    if (cl < 24) {
#pragma unroll 8
        for (int k = kg * 64; k < kg * 64 + 64; ++k) { const float w = p.w_ada[(size_t)k * (NADA * D) + col]; a0 += sc[k] * w; a1 += sc[D + k] * w; a2 += sc[2 * D + k] * w; }
    }
    red[(kg * 3 + 0) * 32 + cl] = a0; red[(kg * 3 + 1) * 32 + cl] = a1; red[(kg * 3 + 2) * 32 + cl] = a2;
    __syncthreads();
    if (tid < 96) { const int r = tid >> 5, c2 = tid & 31; if (c2 < 24) { float s = 0.f;
#pragma unroll
        for (int g = 0; g < 16; ++g) s += red[(g * 3 + r) * 32 + c2];
        const int cc = 24 * bx + c2; ((float*)(p.ws + WS_MOD))[r * NADA * D + cc] = s + p.b_ada[cc]; } }
    __syncthreads();
}
__device__ __forceinline__ void p0_rope(const Ptrs& p, int gtid) {
    if (gtid < 256 * 32) { const int pos = gtid >> 5, f = gtid & 31; const float inv = powf(10000.0f, -(float)f / 32.0f); const float ang = (float)pos * inv;
        float* T = (float*)(p.ws + WS_ROPE); T[2 * gtid] = (float)cos((double)ang); T[2 * gtid + 1] = (float)sin((double)ang); }
}
constexpr int TSCR = 64 * 65 * 4;
__device__ __forceinline__ void transpose_tile(const float* src, int ldsrc, int k0, int n0s, bf16_t* dst, int ldt, int n0d, LAS float* scr, int lane) {
    const int kr = lane >> 4, nq = lane & 15;
    f32x4 v[16];
#pragma unroll
    for (int i = 0; i < 16; ++i) v[i] = *(const f32x4*)(src + (size_t)(k0 + 4 * i + kr) * ldsrc + n0s + 4 * nq);
#pragma unroll
    for (int i = 0; i < 16; ++i) { LAS float* s = scr + (4 * i + kr) * 65 + 4 * nq; s[0] = v[i][0]; s[1] = v[i][1]; s[2] = v[i][2]; s[3] = v[i][3]; }
    asm volatile("s_waitcnt lgkmcnt(0)" ::: "memory");
    const int c = lane & 7, ns = lane >> 3;
#pragma unroll
    for (int j = 0; j < 8; ++j) { const int n = ns + 8 * j; const LAS float* s = scr + (8 * c) * 65 + n;
        u32x4 o; o.x = pg8::cvt_pk_bf16(s[0 * 65], s[1 * 65]); o.y = pg8::cvt_pk_bf16(s[2 * 65], s[3 * 65]); o.z = pg8::cvt_pk_bf16(s[4 * 65], s[5 * 65]); o.w = pg8::cvt_pk_bf16(s[6 * 65], s[7 * 65]);
        *(u32x4*)(dst + (size_t)(n0d + n) * ldt + k0 + 8 * c) = o; }
    asm volatile("s_waitcnt lgkmcnt(0)" ::: "memory");
}
using pg8::pk_fp8x4;
__device__ __forceinline__ void zero_tile_f8(unsigned char* dst, int ldt, int n0d, int k0, int lane) {
    const int c = lane & 3, ns = lane >> 2;
#pragma unroll
    for (int j = 0; j < 4; ++j) *(u32x4*)(dst + (size_t)(n0d + ns + 16 * j) * ldt + k0 + 16 * c) = (u32x4){0u, 0u, 0u, 0u};
}
__device__ __forceinline__ void transpose_tile_f8(const float* src, int ldsrc, int k0, int n0s, unsigned char* dst, int ldt, int n0d, float scale, LAS float* scr, int lane) {
    const int kr = lane >> 4, nq = lane & 15;
    f32x4 v[16];
#pragma unroll
    for (int i = 0; i < 16; ++i) v[i] = *(const f32x4*)(src + (size_t)(k0 + 4 * i + kr) * ldsrc + n0s + 4 * nq);
#pragma unroll
    for (int i = 0; i < 16; ++i) { LAS float* s = scr + (4 * i + kr) * 65 + 4 * nq; s[0] = v[i][0] * scale; s[1] = v[i][1] * scale; s[2] = v[i][2] * scale; s[3] = v[i][3] * scale; }
    asm volatile("s_waitcnt lgkmcnt(0)" ::: "memory");
    const int c = lane & 3, ns = lane >> 2;
#pragma unroll
    for (int j = 0; j < 4; ++j) { const int n = ns + 16 * j; const LAS float* s = scr + (16 * c) * 65 + n;
        u32x4 o; o.x = pk_fp8x4(s[0 * 65], s[1 * 65], s[2 * 65], s[3 * 65]); o.y = pk_fp8x4(s[4 * 65], s[5 * 65], s[6 * 65], s[7 * 65]);
        o.z = pk_fp8x4(s[8 * 65], s[9 * 65], s[10 * 65], s[11 * 65]); o.w = pk_fp8x4(s[12 * 65], s[13 * 65], s[14 * 65], s[15 * 65]);
        *(u32x4*)(dst + (size_t)(n0d + n) * ldt + k0 + 16 * c) = o; }
    asm volatile("s_waitcnt lgkmcnt(0)" ::: "memory");
}
__device__ __forceinline__ void transpose_item(const float* src, int ldsrc, int k0, int col  , bf16_t* dst, int ldt, int n0, LAS float* scr, int lane) {
#pragma unroll 8
    for (int i = 0; i < 32; ++i) { const int kk = 2 * i + (lane >> 5); scr[kk * 33 + (lane & 31)] = (col >= 0) ? src[(size_t)(k0 + kk) * ldsrc + col] : 0.f; }
    asm volatile("s_waitcnt lgkmcnt(0)" ::: "memory");
    const int c = lane & 7;
#pragma unroll
    for (int j = 0; j < 4; ++j) { const int n = (lane >> 3) + 8 * j; const LAS float* s = scr + (8 * c) * 33 + n;
        u32x4 o; o.x = pg8::cvt_pk_bf16(s[0 * 33], s[1 * 33]); o.y = pg8::cvt_pk_bf16(s[2 * 33], s[3 * 33]); o.z = pg8::cvt_pk_bf16(s[4 * 33], s[5 * 33]); o.w = pg8::cvt_pk_bf16(s[6 * 33], s[7 * 33]);
        *(u32x4*)(dst + (size_t)(n0 + n) * ldt + k0 + 8 * c) = o; }
    asm volatile("s_waitcnt lgkmcnt(0)" ::: "memory");
}
constexpr int IT_WIN = 16 * 120, IT_WOUT = 16 * 16, IT_P0 = IT_WIN + IT_WOUT;
constexpr int IT_WGU = 16 * 2 * 22 * 16, IT_WD = 16 * 16 * 24, IT_EXP = IT_WGU + IT_WD;
__device__ __forceinline__ void conv_item_p0(const Ptrs& p, int it, LAS float* scr, int lane) {
    if (it < IT_WIN) { const int kb = it / 120, nb = it % 120, n = nb * 32 + (lane & 31); const int col = (n < NPROJ) ? proj_src_col(n) : -1;
        transpose_item(p.w_in, NPROJ, kb * 64, col, (bf16_t*)(p.ws + WS_WIN), D, nb * 32, scr, lane); }
    else { it -= IT_WIN; const int kb = it >> 4, nb = it & 15; transpose_tile(p.w_out, D, kb * 64, nb * 64, (bf16_t*)(p.ws + WS_WOUT), D, nb * 64, scr, lane); }
}
__device__ __forceinline__ void conv_item_exp(const Ptrs& p, int it, LAS float* scr, int lane) {
    if (it < IT_WGU) { const int kb = it & 15, nt = (it >> 4) % 22, half = ((it >> 4) / 22) & 1, e = (it >> 4) / 44; const int f0 = nt * 64, r0 = (f0 >> 7) * 256 + half * 128 + (f0 & 127);
        const float* src = (half ? p.w_exp_up : p.w_exp_gate) + (size_t)e * D * FF;
        transpose_tile_f8(src, FF, kb * 64, f0, (unsigned char*)(p.ws + WS_WGU) + (size_t)e * 2816 * D, D, r0, 32.0f, scr, lane); }
    else { it -= IT_WGU; const int kb = it % 24, nb = (it / 24) & 15, e = it / (24 * 16); unsigned char* dst = (unsigned char*)(p.ws + WS_WD) + (size_t)e * D * FFP;
        if (kb < 22) transpose_tile_f8(p.w_exp_down + (size_t)e * FF * D, D, kb * 64, nb * 64, dst, FFP, nb * 64, 32.0f, scr, lane); else zero_tile_f8(dst, FFP, nb * 64, kb * 64, lane); }
}
__device__ __forceinline__ void h_rows(const Ptrs& p, int row0, int rstep, int lane) {
    f32x4 xn[4];
#define H_LOAD(r_) do { const float* s_ = ((r_) < NLAT) ? p.x + (size_t)(r_) * D : p.ctx + (size_t)((r_) - NLAT) * D; _Pragma("unroll") for (int j = 0; j < 4; ++j) xn[j] = *(const f32x4*)(s_ + j * 256 + lane * 4); } while (0)
    if (row0 < NROWS) H_LOAD(row0);
    f32x4 w4[4];
#pragma unroll
    for (int j = 0; j < 4; ++j) w4[j] = *(const f32x4*)(p.norm1_w + j * 256 + lane * 4);
    for (int row = row0; row < NROWS; row += rstep) {
        const int m = (row < NLAT) ? row / SEQ : 2;
        const float* mod = (const float*)(p.ws + WS_MOD) + m * NADA * D;
        f32x4 v[4]; float ss = 0.f;
#pragma unroll
        for (int j = 0; j < 4; ++j) { v[j] = xn[j]; ss += v[j][0] * v[j][0] + v[j][1] * v[j][1] + v[j][2] * v[j][2] + v[j][3] * v[j][3]; }
        if (row + rstep < NROWS) H_LOAD(row + rstep);
        const float rstd = rsqrtf(wave_sum(ss) * (1.0f / D) + EPS);
        bf16_t* dst = (bf16_t*)(p.ws + WS_H) + (size_t)row * D;
#pragma unroll
        for (int j = 0; j < 4; ++j) { const int d = j * 256 + lane * 4; const f32x4 sc = *(const f32x4*)(mod + D + d), sh = *(const f32x4*)(mod + d);
            f32x4 o;
#pragma unroll
            for (int e = 0; e < 4; ++e) o[e] = v[j][e] * rstd * w4[j][e] * (1.0f + sc[e]) + sh[e];
            u32x2 pkd; pkd.x = pg8::cvt_pk_bf16(o[0], o[1]); pkd.y = pg8::cvt_pk_bf16(o[2], o[3]); *(u32x2*)(dst + d) = pkd; }
    }
#undef H_LOAD
}
__device__ __forceinline__ void stage_router(const Ptrs& p, LAS float* Wl, int tid) {
    for (int idx = tid; idx < D * NE / 4; idx += NTHR) { const int d = idx >> 2, q4 = idx & 3, j = d >> 8, ln = (d >> 2) & 63, e4 = d & 3;
        *(LAS f32x4*)(Wl + (((j * 4 + e4) * 4 + q4) * 64 + ln) * 4) = *(const f32x4*)(p.w_router + (size_t)d * NE + 4 * q4); }
}
__device__ __forceinline__ void norm2_router_rows(const Ptrs& p, const LAS float* Wl, int row0, int rstep, int lane) {
    const bf16_t* XO = (const bf16_t*)(p.ws + WS_XO);
    f32x4 xn[4]; u32x2 on[4];
#define N2_LOAD(r_) do { _Pragma("unroll") for (int j = 0; j < 4; ++j) { xn[j] = *(const f32x4*)(p.x + (size_t)(r_) * D + j * 256 + lane * 4); on[j] = *(const u32x2*)(XO + (size_t)(r_) * D + j * 256 + lane * 4); } } while (0)
    if (row0 < NLAT) N2_LOAD(row0);
    f32x4 w4[4];
#pragma unroll
    for (int j = 0; j < 4; ++j) w4[j] = *(const f32x4*)(p.norm2_w + j * 256 + lane * 4);
    for (int row = row0; row < NLAT; row += rstep) {
        const int b = row / SEQ, t = row % SEQ;
        const float* mod = (const float*)(p.ws + WS_MOD) + b * NADA * D;
        f32x4 v[4]; float ss = 0.f;
#pragma unroll
        for (int j = 0; j < 4; ++j) { v[j] = xn[j]; v[j][0] += __uint_as_float(on[j].x << 16); v[j][1] += __uint_as_float(on[j].x & 0xffff0000u); v[j][2] += __uint_as_float(on[j].y << 16); v[j][3] += __uint_as_float(on[j].y & 0xffff0000u);
            ss += v[j][0] * v[j][0] + v[j][1] * v[j][1] + v[j][2] * v[j][2] + v[j][3] * v[j][3]; }
        if (row + rstep < NLAT) N2_LOAD(row + rstep);
        const float rstd = rsqrtf(wave_sum(ss) * (1.0f / D) + EPS);
        unsigned char* dst = (unsigned char*)(p.ws + WS_H) + (size_t)row * D;
        float lg[NE];
#pragma unroll
        for (int e = 0; e < NE; ++e) lg[e] = 0.f;
        int wl_off = 0; asm volatile("" : "+v"(wl_off));
#pragma unroll
        for (int j = 0; j < 4; ++j) { const int d = j * 256 + lane * 4; const f32x4 sc = *(const f32x4*)(mod + 4 * D + d), sh = *(const f32x4*)(mod + 3 * D + d);
            f32x4 o;
#pragma unroll
            for (int e4 = 0; e4 < 4; ++e4) { o[e4] = v[j][e4] * rstd * w4[j][e4] * (1.0f + sc[e4]) + sh[e4];
                const LAS f32x4* wr = (const LAS f32x4*)(Wl + wl_off + ((j * 4 + e4) * 4 * 64 + lane) * 4);
#pragma unroll
                for (int q = 0; q < 4; ++q) { const f32x4 ww = wr[q * 64]; lg[4 * q] += o[e4] * ww[0]; lg[4 * q + 1] += o[e4] * ww[1]; lg[4 * q + 2] += o[e4] * ww[2]; lg[4 * q + 3] += o[e4] * ww[3]; } }
            *(unsigned*)(dst + d) = pk_fp8x4(o[0], o[1], o[2], o[3]); }
        float r8[8], r4[4], r2[2], r1;
        { const bool hi = lane & 32;
#pragma unroll
          for (int j = 0; j < 8; ++j) { const float keep = hi ? lg[8 + j] : lg[j], send = hi ? lg[j] : lg[8 + j]; r8[j] = keep + __shfl_xor(send, 32); } }
        { const bool hi = lane & 16;
#pragma unroll
          for (int j = 0; j < 4; ++j) { const float keep = hi ? r8[4 + j] : r8[j], send = hi ? r8[j] : r8[4 + j]; r4[j] = keep + __shfl_xor(send, 16); } }
        { const bool hi = lane & 8;
#pragma unroll
          for (int j = 0; j < 2; ++j) { const float keep = hi ? r4[2 + j] : r4[j], send = hi ? r4[j] : r4[2 + j]; r2[j] = keep + __shfl_xor(send, 8); } }
        { const bool hi = lane & 4; const float keep = hi ? r2[1] : r2[0], send = hi ? r2[0] : r2[1]; r1 = keep + __shfl_xor(send, 4); }
        r1 += __shfl_xor(r1, 2); r1 += __shfl_xor(r1, 1);
        float mx = r1;
#pragma unroll
        for (int o = 4; o < 64; o <<= 1) mx = fmaxf(mx, __shfl_xor(mx, o));
        const float ex = __expf(r1 - mx); float den = ex;
#pragma unroll
        for (int o = 4; o < 64; o <<= 1) den += __shfl_xor(den, o);
        if ((lane & 3) == 0) ((float*)(p.ws + WS_AFF))[((size_t)b * NE + ((lane >> 2) & 15)) * SEQ + t] = ex / den;
    }
#undef N2_LOAD
}
__device__ __forceinline__ void topk_set(const Ptrs& p, LAS unsigned char* lds, int be) {
    LAS unsigned* key = (LAS unsigned*)lds;
    LAS unsigned* hist = key + SEQ;
    LAS unsigned* sh = hist + 256;
    const int tid = threadIdx.x, lane = tid & 63, w = tid >> 6;
    const unsigned* A = (const unsigned*)(p.ws + WS_AFF) + (size_t)be * SEQ;
    for (int i = tid; i < SEQ / 4; i += NTHR) ((LAS u32x4*)key)[i] = ((const u32x4*)A)[i];
    if (tid == 0) { sh[0] = 0u; sh[1] = (unsigned)CAP; }
    __syncthreads();
#pragma unroll 1
    for (int pass = 0; pass < 4; ++pass) {
        const int shift = 24 - 8 * pass;
        if (tid < 256) hist[tid] = 0u;
        __syncthreads();
        const unsigned prefix = sh[0], kneed = sh[1];
        const unsigned himask = (pass == 0) ? 0u : (0xffffffffu << (shift + 8));
        for (int i = tid; i < SEQ; i += NTHR) { const unsigned kx = key[i]; if ((kx & himask) == prefix) __hip_atomic_fetch_add(&hist[(kx >> shift) & 255u], 1u, __ATOMIC_RELAXED, __HIP_MEMORY_SCOPE_WORKGROUP); }
        __syncthreads();
        if (w == 0) {
            unsigned c4[4]; unsigned s = 0u;
#pragma unroll
            for (int j = 0; j < 4; ++j) { c4[j] = hist[255 - (lane * 4 + j)]; s += c4[j]; }
            unsigned incl = s;
#pragma unroll
            for (int o = 1; o < 64; o <<= 1) { const unsigned t = __shfl_up(incl, o); if (lane >= o) incl += t; }
            const unsigned excl = incl - s;
            if (excl < kneed && kneed <= incl) { unsigned acc = excl;
#pragma unroll
                for (int j = 0; j < 4; ++j) { if (acc < kneed && kneed <= acc + c4[j]) { const unsigned bin = 255u - (unsigned)(lane * 4 + j); sh[0] = prefix | (bin << shift); sh[1] = kneed - acc; } acc += c4[j]; } }
        }
        __syncthreads();
    }
    const unsigned T = sh[0], need_eq = sh[1];
    unsigned cg = 0u, ce = 0u;
    for (int i = 0; i < 32; ++i) { const unsigned kx = key[tid * 32 + i]; cg += (kx > T) ? 1u : 0u; ce += (kx == T) ? 1u : 0u; }
    unsigned ig = cg, ie = ce;
#pragma unroll
    for (int o = 1; o < 64; o <<= 1) { const unsigned tg = __shfl_up(ig, o), te = __shfl_up(ie, o); if (lane >= o) { ig += tg; ie += te; } }
    if (lane == 63) { sh[16 + w] = ig; sh[32 + w] = ie; }
    __syncthreads();
    unsigned og = 0u, oe = 0u, totg = 0u;
#pragma unroll
    for (int w2 = 0; w2 < 8; ++w2) { const unsigned a = sh[16 + w2], b2 = sh[32 + w2]; if (w2 < w) { og += a; oe += b2; } totg += a; }
    unsigned pg = og + ig - cg, pe = oe + ie - ce;
    int* IDX = (int*)(p.ws + WS_IDX) + be * CAP; float* GATE = (float*)(p.ws + WS_GATE) + be * CAP; int* INV = (int*)(p.ws + WS_INV);
    const int b = be / NE, e = be % NE;
    for (int i = 0; i < 32; ++i) { const int t = tid * 32 + i; const unsigned kx = key[t]; int slot = -1;
        if (kx > T) slot = (int)(pg++); else if (kx == T) { if (pe < need_eq) slot = (int)(totg + pe); ++pe; }
        if (slot >= 0) { IDX[slot] = t; GATE[slot] = __uint_as_float(kx); }
        INV[((size_t)b * SEQ + t) * NE + e] = slot; }
    __syncthreads();
}
__device__ __forceinline__ void final_rows(const Ptrs& p, int row0, int rstep, int lane) {
    const bf16_t* XO = (const bf16_t*)(p.ws + WS_XO); const unsigned char* YE = (const unsigned char*)(p.ws + WS_YE); const int* INV = (const int*)(p.ws + WS_INV);
    f32x4 xn[4]; u32x2 on[4]; int invn = -1;
#define FN_LOAD(r_) do { _Pragma("unroll") for (int j = 0; j < 4; ++j) { xn[j] = *(const f32x4*)(p.x + (size_t)(r_) * D + j * 256 + lane * 4); on[j] = *(const u32x2*)(XO + (size_t)(r_) * D + j * 256 + lane * 4); } \
        invn = (lane < NE) ? INV[(size_t)(r_) * NE + lane] : -1; } while (0)
    if (row0 < NLAT) FN_LOAD(row0);
    f32x4 fw[4];
#pragma unroll
    for (int j = 0; j < 4; ++j) fw[j] = *(const f32x4*)(p.final_norm_w + j * 256 + lane * 4);
    for (int row = row0; row < NLAT; row += rstep) {
        const int b = row / SEQ;
        const float* mod = (const float*)(p.ws + WS_MOD) + b * NADA * D + 5 * D;
        f32x4 v[4];
#pragma unroll
        for (int j = 0; j < 4; ++j) { v[j] = xn[j]; v[j][0] += __uint_as_float(on[j].x << 16); v[j][1] += __uint_as_float(on[j].x & 0xffff0000u); v[j][2] += __uint_as_float(on[j].y << 16); v[j][3] += __uint_as_float(on[j].y & 0xffff0000u); }
        const int myinv = invn;
        if (row + rstep < NLAT) FN_LOAD(row + rstep);
        unsigned long long mask = __ballot(myinv >= 0);
        float acc[16];
#pragma unroll
        for (int i = 0; i < 16; ++i) acc[i] = 0.f;
        while (mask) {
            unsigned yw[4][4]; bool has[4];
#pragma unroll
            for (int u = 0; u < 4; ++u) { has[u] = mask != 0ull; const int e = has[u] ? (int)__builtin_ctzll(mask) : 0; if (has[u]) mask &= mask - 1ull;
                const int s = __shfl(myinv, e); const unsigned char* y = YE + ((size_t)(b * NE + e) * CAP + (has[u] ? s : 0)) * D;
                if (has[u]) {
#pragma unroll
                    for (int j = 0; j < 4; ++j) yw[u][j] = *(const unsigned*)(y + j * 256 + lane * 4); } }
#pragma unroll
            for (int u = 0; u < 4; ++u) if (has[u]) {
#pragma unroll
                for (int j = 0; j < 4; ++j) { const f32x2 lo_ = __builtin_amdgcn_cvt_pk_f32_fp8((int)yw[u][j], false), hi_ = __builtin_amdgcn_cvt_pk_f32_fp8((int)yw[u][j], true); acc[4 * j] += lo_[0]; acc[4 * j + 1] += lo_[1]; acc[4 * j + 2] += hi_[0]; acc[4 * j + 3] += hi_[1]; } }
        }
        float ss = 0.f;
#pragma unroll
        for (int j = 0; j < 4; ++j) { const f32x4 m4 = *(const f32x4*)(mod + j * 256 + lane * 4);
#pragma unroll
            for (int e = 0; e < 4; ++e) { v[j][e] += m4[e] * (acc[4 * j + e] * 0.0625f); ss += v[j][e] * v[j][e]; } }
        const float rstd = rsqrtf(wave_sum(ss) * (1.0f / D) + EPS);
        float* xr = p.out + (size_t)row * D;
#pragma unroll
        for (int j = 0; j < 4; ++j) *(f32x4*)(xr + j * 256 + lane * 4) = v[j] * rstd * fw[j];
    }
#undef FN_LOAD
}
}

constexpr int RING_OFF = 0, RING_BYTES = 131072;
constexpr int GTAB_OFF = RING_BYTES;
constexpr int MISC_OFF = RING_BYTES + 12288;
constexpr int LDS_BYTES = 147456;
constexpr int CW_BAR = 4096;

#define RLX_AGENT __ATOMIC_RELAXED, __HIP_MEMORY_SCOPE_AGENT
#define XB_TMO      128
#define XB_XCNT(j)  (256  + 64 * (j))
#define XB_XSUB(j)  (1280 + 64 * (j))
#define XB_XGEN(j)  (2304 + 64 * (j))
#define XB_TOP      3328
#define XB_TOPGEN   3392
#define XCD_BAR_WORDS 3456
#define XB_SPIN_CAP (1u << 18)
__device__ __forceinline__ unsigned xb_ld(unsigned* p)              { return __hip_atomic_load(p, __ATOMIC_RELAXED, __HIP_MEMORY_SCOPE_AGENT); }
__device__ __forceinline__ unsigned xb_add(unsigned* p, unsigned v) { return __hip_atomic_fetch_add(p, v, __ATOMIC_RELAXED, __HIP_MEMORY_SCOPE_AGENT); }
__device__ __forceinline__ unsigned xb_xcc_id() { return (unsigned)__builtin_amdgcn_s_getreg((3 << 11) | 20) & 0xFu; }
#define XB_SPIN(cond, bar) do { unsigned _sp = 0; while (cond) { __builtin_amdgcn_s_sleep(1); \
    if ((++_sp & 255u) == 0u) { if (xb_ld(&(bar)[XB_TMO])) break; if (_sp > XB_SPIN_CAP) { atomicAdd(&(bar)[XB_TMO], 1u); break; } } } } while (0)
struct XcdBarrier { unsigned* bar; unsigned x; volatile LAS unsigned* st; };
__device__ __forceinline__ XcdBarrier xcd_barrier_post(unsigned* bar, volatile LAS unsigned* st) {
    XcdBarrier b; b.bar = bar; b.x = xb_xcc_id(); b.st = st;
    if (threadIdx.x == 0) (void)xb_add(&bar[XB_XCNT(b.x)], 1u);
    return b;
}
__device__ __forceinline__ void xcd_barrier_complete(unsigned* bar, unsigned x, unsigned& nloc, unsigned& nx) {
    const unsigned G = gridDim.x * gridDim.y * gridDim.z;
    unsigned sum, cnt, mine, sp = 0u;
    for (;;) {
        sum = 0u; cnt = 0u; mine = 0u;
#pragma unroll
        for (unsigned j = 0; j < 16; ++j) { const unsigned c = xb_ld(&bar[XB_XCNT(j)]); sum += c; cnt += (c > 0u) ? 1u : 0u; mine = (j == x) ? c : mine; }
        if (sum == G) break;
        __builtin_amdgcn_s_sleep(1);
        if ((++sp & 255u) == 0u) { if (xb_ld(&bar[XB_TMO])) break; if (sp > XB_SPIN_CAP) { atomicAdd(&bar[XB_TMO], 1u); break; } }
    }
    nloc = mine > 0u ? mine : 1u; nx = cnt > 0u ? cnt : 1u;
}
__device__ __forceinline__ void xcd_barrier(const XcdBarrier& b) {
    asm volatile("s_waitcnt vmcnt(0)" ::: "memory");
    __syncthreads();
    if (threadIdx.x == 0) {
        unsigned* bar = b.bar;
        __builtin_amdgcn_s_waitcnt(0);
        unsigned nloc = b.st[0], nx = b.st[1];
        if (nloc == 0u) { xcd_barrier_complete(bar, b.x, nloc, nx); b.st[0] = nloc; b.st[1] = nx; }
        const unsigned old = xb_add(&bar[XB_XSUB(b.x)], 1u);
        const unsigned gen = old / nloc;
        if (old + 1u == (gen + 1u) * nloc) {
            __builtin_amdgcn_fence(__ATOMIC_RELEASE, "agent");
            asm volatile("s_waitcnt vmcnt(0)" ::: "memory");
            const unsigned og = xb_add(&bar[XB_TOP], 1u);
            const unsigned tg = og / nx;
            if (og + 1u == (tg + 1u) * nx) xb_add(&bar[XB_TOPGEN], 1u);
            else XB_SPIN(xb_ld(&bar[XB_TOPGEN]) == tg, bar);
            __builtin_amdgcn_fence(__ATOMIC_ACQUIRE, "agent");
            xb_add(&bar[XB_XGEN(b.x)], 1u);
            asm volatile("s_waitcnt vmcnt(0)" ::: "memory");
        } else {
            XB_SPIN(xb_ld(&bar[XB_XGEN(b.x)]) == gen, bar);
            __builtin_amdgcn_fence(__ATOMIC_ACQUIRE, "agent");
            asm volatile("s_waitcnt vmcnt(0)" ::: "memory");
        }
    }
    __syncthreads();
}

struct Args { Ptrs p; int ph_lo, ph_hi, dbg, pad; };

__global__ void __launch_bounds__(NTHR, 2) mk_fwd(Args args) {
    extern __shared__ __attribute__((aligned(16))) unsigned char lds_raw[];
    LAS unsigned char* lds = (LAS unsigned char*)lds_raw;
    volatile LAS unsigned* MISC = (volatile LAS unsigned*)(lds + MISC_OFF);
    const Ptrs& p = args.p;
    unsigned char* ws = p.ws;
    const int tid = threadIdx.x, G = gridDim.x, bx = blockIdx.x;
    for (int u = tid; u < (LDS_BYTES - MISC_OFF) / 4; u += NTHR) ((LAS unsigned*)(lds + MISC_OFF))[u] = 0u;
    __syncthreads();
    const int lo = args.ph_lo, hi = args.ph_hi;
#ifndef REPS_LIST
#define REPS_LIST 1, 1, 1, 1, 1, 1, 1, 1, 1, 1, 1, 1
#endif
    constexpr int reps_tab[12] = {REPS_LIST};
    constexpr int CONV_SPLIT = 8192;
    XcdBarrier bar; bar.bar = (unsigned*)ws + CW_BAR; bar.x = 0; bar.st = nullptr;
    if (hi - lo > 1) bar = xcd_barrier_post((unsigned*)ws + CW_BAR, MISC + 8);
#define IN(k) (lo <= (k) && (k) < hi)
#define SEAM(k) do { if (IN(k) && IN((k) + 1)) xcd_barrier(bar); } while (0)

    const int wv = __builtin_amdgcn_readfirstlane(tid >> 6), ln = tid & 63, gw = bx * NWAVES + wv, NGW = G * NWAVES;
    if (IN(0)) {
        for (int cb = bx; cb < 256; cb += G) misc::p0_mod(p, lds, cb);
        misc::p0_rope(p, bx * NTHR + tid);
        LAS float* scr = (LAS float*)(lds + wv * misc::TSCR);
        for (int it = gw; it < misc::IT_P0; it += NGW) misc::conv_item_p0(p, it, scr, ln);
    }
    if constexpr (reps_tab[0] > 1) { xcd_barrier(bar);
    if (IN(0)) {
        for (int cb = bx; cb < 256; cb += G) misc::p0_mod(p, lds, cb);
        misc::p0_rope(p, bx * NTHR + tid);
        LAS float* scr = (LAS float*)(lds + wv * misc::TSCR);
        for (int it = gw; it < misc::IT_P0; it += NGW) misc::conv_item_p0(p, it, scr, ln);
    }
    }
    SEAM(0);
    if (IN(1)) { misc::h_rows(p, gw, NGW, ln); }
    if constexpr (reps_tab[1] > 1) { xcd_barrier(bar);
    if (IN(1)) { misc::h_rows(p, gw, NGW, ln); }
    }
    SEAM(1);
    if (IN(2)) {
        pg8::Gemm g{(const bf16_t*)(ws + WS_H), (const bf16_t*)(ws + WS_WIN), D};
        pg8::StaticOrder S; S.init(NROWS / 256, NPROJ_PAD / 256, G, bx);
        pg8::EpiProj E{(bf16_t*)(ws + WS_P), (float*)(ws + WS_GZ), (const float*)(ws + WS_ROPE)};
        pg8::gemm_phase<pg8::EpiProj, pg8::StaticOrder, false>(lds + RING_OFF, g, S, E, nullptr);
    }
    if constexpr (reps_tab[2] > 1) { xcd_barrier(bar);
    if (IN(2)) {
        pg8::Gemm g{(const bf16_t*)(ws + WS_H), (const bf16_t*)(ws + WS_WIN), D};
        pg8::StaticOrder S; S.init(NROWS / 256, NPROJ_PAD / 256, G, bx);
        pg8::EpiProj E{(bf16_t*)(ws + WS_P), (float*)(ws + WS_GZ), (const float*)(ws + WS_ROPE)};
        pg8::gemm_phase<pg8::EpiProj, pg8::StaticOrder, false>(lds + RING_OFF, g, S, E, nullptr);
    }
    }
    SEAM(2);
    if (IN(3)) {
        scan::run_c1(p, lds, bx);
    }
    SEAM(3);
    if (IN(4)) {
        scan::run_c2(p, lds, bx);
    }
    if constexpr (reps_tab[3] > 1) { xcd_barrier(bar);
    if (IN(3)) {
        scan::run_c1(p, lds, bx);
    }
    SEAM(3);
    if (IN(4)) {
        scan::run_c2(p, lds, bx);
    }
    }
    SEAM(4);
    if (IN(5)) {
        scan::run_c3(p, lds, bx, (bf16_t*)(ws + WS_H));
    }
    if constexpr (reps_tab[5] > 1) { xcd_barrier(bar);
    if (IN(5)) {
        scan::run_c3(p, lds, bx, (bf16_t*)(ws + WS_H));
    }
    }
    SEAM(5);
    if (IN(6)) {
        pg8::Gemm g{(const bf16_t*)(ws + WS_H), (const bf16_t*)(ws + WS_WOUT), D};
        pg8::StaticOrder S; S.init(NLAT / 256, D / 256, G, bx);
        pg8::EpiOut E{(bf16_t*)(ws + WS_XO), (const float*)(ws + WS_MOD)};
        pg8::gemm_phase<pg8::EpiOut, pg8::StaticOrder, false>(lds + RING_OFF, g, S, E, nullptr);
    }
    if constexpr (reps_tab[6] > 1) { xcd_barrier(bar);
    if (IN(6)) {
        pg8::Gemm g{(const bf16_t*)(ws + WS_H), (const bf16_t*)(ws + WS_WOUT), D};
        pg8::StaticOrder S; S.init(NLAT / 256, D / 256, G, bx);
        pg8::EpiOut E{(bf16_t*)(ws + WS_XO), (const float*)(ws + WS_MOD)};
        pg8::gemm_phase<pg8::EpiOut, pg8::StaticOrder, false>(lds + RING_OFF, g, S, E, nullptr);
    }
    }
    SEAM(6);
    if (IN(7)) {
        misc::stage_router(p, (LAS float*)lds, tid); __syncthreads();
        misc::norm2_router_rows(p, (const LAS float*)lds, gw, NGW, ln);
        __syncthreads();
        LAS float* scr = (LAS float*)(lds + wv * misc::TSCR);
        for (int it = gw; it < CONV_SPLIT; it += NGW) misc::conv_item_exp(p, it, scr, ln);
    }
    if constexpr (reps_tab[7] > 1) { xcd_barrier(bar);
    if (IN(7)) {
        misc::stage_router(p, (LAS float*)lds, tid); __syncthreads();
        misc::norm2_router_rows(p, (const LAS float*)lds, gw, NGW, ln);
        __syncthreads();
        LAS float* scr = (LAS float*)(lds + wv * misc::TSCR);
        for (int it = gw; it < CONV_SPLIT; it += NGW) misc::conv_item_exp(p, it, scr, ln);
    }
    }
    SEAM(7);
    if (IN(8)) { if (bx < 32) misc::topk_set(p, lds, bx);
        else { LAS float* scr = (LAS float*)(lds + wv * misc::TSCR); for (int it = CONV_SPLIT + (bx - 32) * NWAVES + wv; it < misc::IT_EXP; it += (G - 32) * NWAVES) misc::conv_item_exp(p, it, scr, ln); } }
    if constexpr (reps_tab[8] > 1) { xcd_barrier(bar);
    if (IN(8)) { if (bx < 32) misc::topk_set(p, lds, bx);
        else { LAS float* scr = (LAS float*)(lds + wv * misc::TSCR); for (int it = CONV_SPLIT + (bx - 32) * NWAVES + wv; it < misc::IT_EXP; it += (G - 32) * NWAVES) misc::conv_item_exp(p, it, scr, ln); } }
    }
    SEAM(8);
    if (IN(9)) {
        LAS unsigned* gtab = (LAS unsigned*)(lds + GTAB_OFF);
        pg8::MoeUpOrder S{bx};
        const int* IDX = (const int*)(ws + WS_IDX);
        for (int e = tid; e < 11 * 256; e += NTHR) { pg8::Unit u; S.next(e >> 8, u); const int R = u.pm * 256 + (e & 255); gtab[e] = (unsigned)((u.pm >> 7) * SEQ + (IDX[R] & (SEQ - 1))) * (unsigned)D; }
        __syncthreads();
        pg8::Gemm g{(const bf16_t*)(ws + WS_H), (const bf16_t*)(ws + WS_WGU), D};
        pg8::EpiAct E{(unsigned char*)(ws + WS_ACT), 1.0f / 32.0f, 8.0f};
        pg8::gemm_phase<pg8::EpiAct, pg8::MoeUpOrder, true, true>(lds + RING_OFF, g, S, E, gtab);
    }
    if constexpr (reps_tab[9] > 1) { xcd_barrier(bar);
    if (IN(9)) {
        LAS unsigned* gtab = (LAS unsigned*)(lds + GTAB_OFF);
        pg8::MoeUpOrder S{bx};
        const int* IDX = (const int*)(ws + WS_IDX);
        for (int e = tid; e < 11 * 256; e += NTHR) { pg8::Unit u; S.next(e >> 8, u); const int R = u.pm * 256 + (e & 255); gtab[e] = (unsigned)((u.pm >> 7) * SEQ + (IDX[R] & (SEQ - 1))) * (unsigned)D; }
        __syncthreads();
        pg8::Gemm g{(const bf16_t*)(ws + WS_H), (const bf16_t*)(ws + WS_WGU), D};
        pg8::EpiAct E{(unsigned char*)(ws + WS_ACT), 1.0f / 32.0f, 8.0f};
        pg8::gemm_phase<pg8::EpiAct, pg8::MoeUpOrder, true, true>(lds + RING_OFF, g, S, E, gtab);
    }
    }
    SEAM(9);
    if (IN(10)) {
        pg8::MoeDownOrder S{bx};
        pg8::Gemm g{(const bf16_t*)(ws + WS_ACT), (const bf16_t*)(ws + WS_WD), FFP};
        pg8::EpiDown E{(unsigned char*)(ws + WS_YE), (const float*)(ws + WS_GATE), 16.0f / 256.0f};
        pg8::gemm_phase<pg8::EpiDown, pg8::MoeDownOrder, false, true>(lds + RING_OFF, g, S, E, nullptr);
    }
    if constexpr (reps_tab[10] > 1) { xcd_barrier(bar);
    if (IN(10)) {
        pg8::MoeDownOrder S{bx};
        pg8::Gemm g{(const bf16_t*)(ws + WS_ACT), (const bf16_t*)(ws + WS_WD), FFP};
        pg8::EpiDown E{(unsigned char*)(ws + WS_YE), (const float*)(ws + WS_GATE), 16.0f / 256.0f};
        pg8::gemm_phase<pg8::EpiDown, pg8::MoeDownOrder, false, true>(lds + RING_OFF, g, S, E, nullptr);
    }
    }
    SEAM(10);
    if (IN(11)) { misc::final_rows(p, gw, NGW, ln); }
#undef IN
#undef SEAM
}

#ifndef USE_COOP
#define USE_COOP 1
#endif
extern "C" void kernel_launch(void* const* d_in, const int* in_sizes, int n_in, void* d_out, int out_size, void* d_ws, size_t ws_size, hipStream_t stream) {
    static int ready = 0;
    if (!ready) {
        if (n_in != 20 || in_sizes[0] != NLAT * D || out_size != NLAT * D || ws_size < WS_END) { fprintf(stderr, "kernel_launch: unexpected problem (n_in %d, out %d, ws %zu); nothing launched\n", n_in, out_size, ws_size); ready = -1; return; }
        if (hipFuncSetAttribute((const void*)mk_fwd, hipFuncAttributeMaxDynamicSharedMemorySize, LDS_BYTES) != hipSuccess) { fprintf(stderr, "kernel_launch: hipFuncSetAttribute failed\n"); ready = -1; return; }
        int dev = 0, cus = 0, per_cu = 0;
        (void)hipGetDevice(&dev); (void)hipDeviceGetAttribute(&cus, hipDeviceAttributeMultiprocessorCount, dev);
        (void)hipOccupancyMaxActiveBlocksPerMultiprocessor(&per_cu, (const void*)mk_fwd, NTHR, LDS_BYTES);
        if (cus * per_cu < 256) { fprintf(stderr, "kernel_launch: this kernel needs 256 co-resident workgroups (device reports %d CUs x %d); nothing launched\n", cus, per_cu); ready = -1; return; }
        ready = 1;
    }
    if (ready < 0) return;
    Args a{};
    const float** f = (const float**)&a.p;
    for (int i = 0; i < 20; ++i) f[i] = (const float*)d_in[i];
    a.p.out = (float*)d_out; a.p.ws = (unsigned char*)d_ws; a.ph_lo = 0; a.ph_hi = 12;
    (void)hipMemsetAsync((char*)d_ws + WS_CTL, 0, 64 * 1024, stream);
    void* args[] = {&a};
#if USE_COOP
    const hipError_t e = hipLaunchCooperativeKernel((const void*)mk_fwd, dim3(256), dim3(NTHR), args, LDS_BYTES, stream);
#else
    const hipError_t e = hipLaunchKernel((const void*)mk_fwd, dim3(256), dim3(NTHR), args, LDS_BYTES, stream);
#endif
    if (e != hipSuccess) fprintf(stderr, "kernel_launch: launch failed: %s\n", hipGetErrorString(e));
}
```

```cpp
#include <hip/hip_runtime.h>
#include <stdint.h>
#include <stdio.h>

typedef unsigned short bf16_t;
typedef unsigned int u32;

constexpr int D = 1024, BATCH = 2, SEQ = 16384, CTX = 256;
constexpr int NLAT = BATCH * SEQ;
constexpr int NCTX = BATCH * CTX;
constexpr int NROWS = NLAT + NCTX;
constexpr int NADA = 6;
constexpr int NE = 16, CAP = 2048, FF = 1408, FFP = 1536;
constexpr int NSLOT = BATCH * NE * CAP;
constexpr float EPS = 1e-6f;
constexpr int C_GQ = 0, C_GK = 256, C_GV = 512, C_GG = 1024, C_RQ = 1536, C_RK = 2048, C_RV = 2560, C_RG = 3072, C_GZ = 3584;
constexpr int PW = 3584;
constexpr int NPROJ = 3616, NPROJ_PAD = 3840;
__host__ __device__ __forceinline__ size_t ptile(int row, int col) { return ((size_t)((row >> 6) * 28 + (col >> 7)) * 64 + (row & 63)) * 128 + (col & 127); }

constexpr size_t MiB = 1u << 20;
constexpr size_t WS_CTL = 0;
constexpr size_t WS_MOD = 1 * MiB;
constexpr size_t WS_ROPE = WS_MOD + 128 * 1024;
constexpr size_t WS_DCH = 2 * MiB;
constexpr size_t WS_WIN = 4 * MiB;
constexpr size_t WS_WOUT = 12 * MiB;
constexpr size_t WS_GZ = 14 * MiB;
constexpr size_t WS_H = 19 * MiB;
constexpr size_t WS_P = 84 * MiB;
constexpr size_t WS_US = 312 * MiB;
constexpr size_t WS_WGU = 84 * MiB;
constexpr size_t OUT_WD = 100 * MiB;
constexpr size_t WS_ACT = 216 * MiB;
constexpr size_t WS_XO = 312 * MiB;
constexpr size_t WS_AFF = 392 * MiB;
constexpr size_t WS_IDX = 394 * MiB;
constexpr size_t WS_GATE = 395 * MiB;
constexpr size_t WS_INV = 396 * MiB;
constexpr size_t WS_YE = 19 * MiB;
constexpr size_t WS_END = 508 * MiB;

__device__ __forceinline__ float bf2f(bf16_t v) { return __uint_as_float(((u32)v) << 16); }
__device__ __forceinline__ bf16_t f2bf(float f) { u32 u = __float_as_uint(f); return (bf16_t)((u + 0x7fffu + ((u >> 16) & 1u)) >> 16); }
__device__ __forceinline__ float siluf(float x) { return x / (1.0f + __expf(-x)); }
__device__ __forceinline__ float log_sigmoidf(float x) { return fminf(x, 0.f) - log1pf(__expf(-fabsf(x))); }
template <int CTRL, int RM> __device__ __forceinline__ float dppf(float v) { return __builtin_bit_cast(float, __builtin_amdgcn_update_dpp(0, __builtin_bit_cast(int, v), CTRL, RM, 0xF, false)); }
__device__ __forceinline__ float wave_sum(float v) {
    v += dppf<0xB1, 0xF>(v);
    v += dppf<0x4E, 0xF>(v);
    v += dppf<0x124, 0xF>(v);
    v += dppf<0x128, 0xF>(v);
    v += dppf<0x142, 0xA>(v);
    v += dppf<0x143, 0xC>(v);
    return __builtin_bit_cast(float, __builtin_amdgcn_readlane(__builtin_bit_cast(int, v), 63));
}
template <int CTRL, int RM> __device__ __forceinline__ float dppk(float v) { return __builtin_bit_cast(float, __builtin_amdgcn_update_dpp(__builtin_bit_cast(int, v), __builtin_bit_cast(int, v), CTRL, RM, 0xF, false)); }
__device__ __forceinline__ float wave_max(float v) {
    v = fmaxf(v, dppk<0xB1, 0xF>(v)); v = fmaxf(v, dppk<0x4E, 0xF>(v)); v = fmaxf(v, dppk<0x124, 0xF>(v)); v = fmaxf(v, dppk<0x128, 0xF>(v));
    v = fmaxf(v, dppk<0x142, 0xA>(v)); v = fmaxf(v, dppk<0x143, 0xC>(v));
    return __builtin_bit_cast(float, __builtin_amdgcn_readlane(__builtin_bit_cast(int, v), 63));
}
__host__ __device__ inline int proj_src_col(int n) {
    if (n < 1024) return n;
    if (n < 1536) return 1056 + (n - 1024);
    if (n < 2560) {
        const int base = (n < 2048) ? 1568 : 2080, m = (n < 2048) ? n - 1536 : n - 2048;
        const int hd = m >> 7, p = m & 127, g = p >> 3, nn = (p >> 2) & 1, e = p & 3;
        return base + hd * 128 + 64 * nn + 4 * g + e;
    }
    if (n < 3072) return 2592 + (n - 2560);
    if (n < 3584) return 3104 + (n - 3072);
    return 1024 + (n - 3584);
}

struct Ptrs {
    const float *x, *c, *ctx, *c_ctx, *w_ada, *b_ada, *norm1_w, *w_in, *gla_gate_w, *gla_gate_b, *ret_decay_logit, *gla_norm_w, *ret_norm_w,
        *w_out, *norm2_w, *w_router, *w_exp_gate, *w_exp_up, *w_exp_down, *final_norm_w;
    float* out;
    unsigned char* ws;
};


constexpr int NWAVES = 8, NTHR = NWAVES * 64;
#define LAS __attribute__((address_space(3)))
#define GAS __attribute__((address_space(1)))
typedef short bf16x8 __attribute__((ext_vector_type(8)));
typedef float f32x4 __attribute__((ext_vector_type(4)));
typedef float f32x2 __attribute__((ext_vector_type(2)));
typedef unsigned u32x4 __attribute__((ext_vector_type(4)));
typedef unsigned u32x2 __attribute__((ext_vector_type(2)));
typedef int i32x4 __attribute__((ext_vector_type(4)));
typedef int i32x8 __attribute__((ext_vector_type(8)));
#ifndef PG8_RELAX
#define PG8_RELAX 0
#endif
#ifndef PG8_ALIGN_DEFAULT
#define PG8_ALIGN_DEFAULT true
#endif
namespace pg8 {
constexpr int BM = 256, BK = 64, HALF = 128, HTB = HALF * BK * 2  , STAGE_BYTES = 8 * HTB, NXCD = 8, WGM = 8;
__host__ __device__ __forceinline__ int lds_byte(int r, int c) { const int st = (r >> 4) * 2 + (c >> 5), rr = r & 15, cc = c & 31, ob = rr * 64 + cc * 2; return st * 1024 + (ob ^ (((ob >> 9) & 1) << 5)); }
__host__ __device__ __forceinline__ void stage_rc(int b, int& R, int& C) { const int st = b / 1024, sb = b % 1024, swz = sb ^ (((sb >> 9) & 1) << 5); R = (st >> 1) * 16 + swz / 64; C = (st & 1) * 32 + (swz % 64) / 2; }
__host__ __device__ __forceinline__ int perm32(int rho) { const int n = rho >> 4, i = rho & 15; return 8 * (i >> 2) + 4 * n + (i & 3); }

struct Unit { int pm, pn; };
struct Gemm { const bf16_t* A; const bf16_t* Bt; int K; };

struct StaticOrder {
    int nM, nN, nwg, G, c;
    __device__ void init(int nM_, int nN_, int G_, int c_) { nM = nM_; nN = nN_; nwg = nM * nN; G = G_; c = c_; }
    __device__ bool next(int i, Unit& u) const {
        const long L = (long)i * G + c; if (L >= nwg) return false;
        int wgid = (int)L; { const int q = nwg / NXCD, r = nwg % NXCD, xcd = wgid % NXCD, off = wgid / NXCD; wgid = (xcd < r ? xcd * (q + 1) : r * (q + 1) + (xcd - r) * q) + off; }
        const int nig = WGM * nN, gid = wgid / nig, fm = gid * WGM, gsz = (nM - fm) < WGM ? (nM - fm) : WGM;
        u.pm = fm + ((wgid % nig) % gsz); u.pn = (wgid % nig) / gsz; return true;
    }
};
struct MoeUpOrder {
    int c;
    __device__ bool next(int i, Unit& u) const {
        if (i >= 11) return false;
        const int g = i * 8 + (c & 7), j = c >> 3, combo = 4 * g + (j >> 3), mt = j & 7, be = combo / 11, pn = combo % 11;
        u.pm = be * 8 + mt; u.pn = (be & 15) * 11 + pn; return true;
    }
};
struct MoeDownOrder {
    int c;
    __device__ bool next(int i, Unit& u) const {
        if (i >= 4) return false;
        const int be = i * 8 + (c & 7), j = c >> 3, mt = j & 7, pn = j >> 3;
        u.pm = be * 8 + mt; u.pn = (be & 15) * 4 + pn; return true;
    }
};

__device__ __forceinline__ float fast_silu(float a) { return a * __builtin_amdgcn_rcpf(1.0f + __expf(-a)); }
typedef __bf16 bf16x2_t __attribute__((ext_vector_type(2)));
__device__ __forceinline__ unsigned cvt_pk_bf16(float lo, float hi) { const f32x2 v = {lo, hi}; const bf16x2_t r = __builtin_convertvector(v, bf16x2_t); return __builtin_bit_cast(unsigned, r); }

__device__ __forceinline__ unsigned pk_fp8x4(float a, float b, float c, float d) {
    a = __builtin_amdgcn_fmed3f(a, -448.f, 448.f); b = __builtin_amdgcn_fmed3f(b, -448.f, 448.f); c = __builtin_amdgcn_fmed3f(c, -448.f, 448.f); d = __builtin_amdgcn_fmed3f(d, -448.f, 448.f);
    int w = 0; w = __builtin_amdgcn_cvt_pk_fp8_f32(a, b, w, false); w = __builtin_amdgcn_cvt_pk_fp8_f32(c, d, w, true); return (unsigned)w;
}
template <class Epi, class Sched, bool GATHER, bool F8 = false, bool ALIGN_EPI = PG8_ALIGN_DEFAULT>
__device__ __forceinline__ void gemm_phase(LAS unsigned char* lds, const Gemm g, const Sched& S, const Epi& E, const LAS unsigned* gtab) {
    const int tid = threadIdx.x, wid = __builtin_amdgcn_readfirstlane(tid >> 6), lane = tid & 63, wr = wid >> 2, wc = wid & 3, fr = lane & 15, fq = lane >> 4;
    constexpr int ESZ = F8 ? 1 : 2;
    const int K = g.K, nt = K * ESZ / (BK * 2);
    int sR[2], sC[2];
    unsigned voffB[2], voffA[2];
#pragma unroll
    for (int i = 0; i < 2; ++i) { stage_rc(tid * 16 + i * 8192, sR[i], sC[i]); const int Rb = Epi::PERM ? ((sR[i] & ~31) + perm32(sR[i] & 31)) : sR[i];
        voffB[i] = (unsigned)(Rb * K * ESZ + sC[i] * 2); voffA[i] = (unsigned)(sR[i] * K * ESZ + sC[i] * 2); }
    const size_t kstep = (size_t)(BK * 2);
    const size_t hstep = (size_t)HALF * K * ESZ;
    const size_t tstep = 2 * hstep;
    const unsigned ldsw = (unsigned)wid * 1024u;
    const int aoff = lds_byte(wr * 64 + fr, fq * 8), boff = lds_byte(wc * 32 + fr, fq * 8);
    const int sw8 = (fq & 1) * 8;
    const int aoff8a = lds_byte(wr * 64 + fr, fq * 16 + sw8), aoff8b = lds_byte(wr * 64 + fr, fq * 16 + (8 - sw8)), boff8a = lds_byte(wc * 32 + fr, fq * 16 + sw8), boff8b = lds_byte(wc * 32 + fr, fq * 16 + (8 - sw8));
#define PG8_SA(b, h) (((b) * 2 + (h)) * HTB)
#define PG8_SB(b, h) ((4 + (b) * 2 + (h)) * HTB)
#define PG8_STAGE(bufoff, gbase, voff) do { _Pragma("unroll") for (int _i = 0; _i < 2; ++_i) \
        __builtin_amdgcn_global_load_lds((const unsigned*)((const char*)(gbase) + (voff)[_i]), (LAS unsigned*)(lds + (bufoff) + ldsw + _i * 8192), 16, 0, 0); } while (0)
#define PG8_LDA(dst, b, h) do { if constexpr (F8) { _Pragma("unroll") for (int m = 0; m < 4; ++m) { const i32x4 lo_ = *(const LAS i32x4*)(lds + PG8_SA(b, h) + aoff8a + m * 2048), hi_ = *(const LAS i32x4*)(lds + PG8_SA(b, h) + aoff8b + m * 2048); \
            dst##8[m] = __builtin_shufflevector(lo_, hi_, 0, 1, 2, 3, 4, 5, 6, 7); } } \
        else { _Pragma("unroll") for (int m = 0; m < 4; ++m) _Pragma("unroll") for (int k = 0; k < 2; ++k) dst[m][k] = *(const LAS bf16x8*)(lds + PG8_SA(b, h) + aoff + m * 2048 + k * 1024); } } while (0)
#define PG8_LDB(dst, b, h) do { if constexpr (F8) { _Pragma("unroll") for (int n = 0; n < 2; ++n) { const i32x4 lo_ = *(const LAS i32x4*)(lds + PG8_SB(b, h) + boff8a + n * 2048), hi_ = *(const LAS i32x4*)(lds + PG8_SB(b, h) + boff8b + n * 2048); \
            dst##8[n] = __builtin_shufflevector(lo_, hi_, 0, 1, 2, 3, 4, 5, 6, 7); } } \
        else { _Pragma("unroll") for (int n = 0; n < 2; ++n) _Pragma("unroll") for (int k = 0; k < 2; ++k) dst[n][k] = *(const LAS bf16x8*)(lds + PG8_SB(b, h) + boff + n * 2048 + k * 1024); } } while (0)
#define PG8_MMA(ai, bj, At, Bt) do { __builtin_amdgcn_s_setprio(1); if constexpr (F8) { _Pragma("unroll") for (int m = 0; m < 4; ++m) _Pragma("unroll") for (int n = 0; n < 2; ++n) \
            asm volatile("v_mfma_f32_16x16x128_f8f6f4 %0, %1, %2, %0" : "+v"(acc[ai][bj][m][n]) : "v"(Bt##8[n]), "v"(At##8[m])); } \
        else { _Pragma("unroll") for (int m = 0; m < 4; ++m) _Pragma("unroll") for (int n = 0; n < 2; ++n) _Pragma("unroll") for (int k = 0; k < 2; ++k) \
            acc[ai][bj][m][n] = __builtin_amdgcn_mfma_f32_16x16x32_bf16(Bt[n][k], At[m][k], acc[ai][bj][m][n], 0, 0, 0); } __builtin_amdgcn_s_setprio(0); } while (0)
#define PG8_WAIT_V(n) asm volatile("s_waitcnt vmcnt(" #n ")" ::: "memory")
#define PG8_WAIT_VX(rel_) do { if (rel_) asm volatile("s_waitcnt vmcnt(%0)" :: "n"(8 + Epi::NS) : "memory"); else asm volatile("s_waitcnt vmcnt(8)" ::: "memory"); } while (0)
#define PG8_WAIT_L(n) asm volatile("s_waitcnt lgkmcnt(" #n ")" ::: "memory")
#define PG8_BAR __builtin_amdgcn_s_barrier()
#define PG8_SCHED __builtin_amdgcn_sched_barrier(0)
#define PG8_HOFF(h) (GATHER ? (size_t)0 : (size_t)(h) * hstep)
#define PG8_STAGE_A(bufoff, base_, h_, uq_) do { if constexpr (GATHER) { unsigned vo_[2]; _Pragma("unroll") for (int _i = 0; _i < 2; ++_i) vo_[_i] = gtab[(uq_) * 256 + (h_) * HALF + sR[_i]] + (unsigned)sC[_i] * 2u; PG8_STAGE(bufoff, base_, vo_); } \
        else { PG8_STAGE(bufoff, (base_) + PG8_HOFF(h_), voffA); } } while (0)
    Unit cur, nxt; int ui = 0;
    if (!S.next(0, cur)) return;
    f32x4 acc[2][2][4][2];
#pragma unroll
    for (int a = 0; a < 2; ++a)
#pragma unroll
        for (int b = 0; b < 2; ++b)
#pragma unroll
            for (int m = 0; m < 4; ++m)
#pragma unroll
                for (int n = 0; n < 2; ++n) acc[a][b][m][n] = (f32x4){0.f, 0.f, 0.f, 0.f};
    bf16x8 At[4][2], B0[2][2], B1[2][2]; i32x8 At8[4], B08[2], B18[2];
    const char* cA = (const char*)g.A + (GATHER ? (size_t)0 : (size_t)cur.pm * tstep); const char* cB = (const char*)g.Bt + (size_t)cur.pn * tstep;
    PG8_STAGE(PG8_SB(0, 0), cB, voffB); PG8_STAGE(PG8_SB(0, 1), cB + hstep, voffB); PG8_STAGE_A(PG8_SA(0, 0), cA, 0, 0); PG8_STAGE_A(PG8_SA(0, 1), cA, 1, 0);
    if (wr == 1) PG8_BAR;
    PG8_WAIT_V(2); PG8_BAR;
    PG8_STAGE(PG8_SB(1, 0), cB + kstep, voffB); PG8_STAGE_A(PG8_SA(1, 0), cA + kstep, 0, 0); PG8_STAGE(PG8_SB(1, 1), cB + hstep + kstep, voffB);
    PG8_WAIT_V(6); PG8_BAR;
    bool relax = false;
    for (;;) {
        const bool has_next = S.next(ui + 1, nxt);
        const char* nA = GATHER ? cA : (has_next ? (const char*)g.A + (size_t)nxt.pm * tstep : cA); const char* nB = has_next ? (const char*)g.Bt + (size_t)nxt.pn * tstep : cB;
#pragma unroll 1
        for (int t = 0; t < nt; t += 2) {
            const bool last = (t == nt - 2);
            const bool fresh = ALIGN_EPI && Epi::NS > 0 && ui > 0 && t == 0;
            const bool rel = fresh && relax;
            const char* a1 = cA + (size_t)(t + 1) * kstep;
            const char* a2 = last ? nA : cA + (size_t)(t + 2) * kstep; const char* b2 = last ? nB : cB + (size_t)(t + 2) * kstep;
            const char* a3 = a2 + kstep; const char* b3 = b2 + kstep;
            const int uq = (last && has_next) ? ui + 1 : ui;
            PG8_LDB(B0, 0, 0); PG8_LDB(B1, 0, 1); PG8_SCHED; PG8_LDA(At, 0, 0); if (!fresh) PG8_STAGE_A(PG8_SA(1, 1), a1, 1, ui);
            PG8_WAIT_VX(rel); PG8_WAIT_L(0); PG8_BAR; PG8_MMA(0, 0, At, B0); PG8_MMA(0, 1, At, B1); PG8_BAR; PG8_SCHED;
            PG8_LDA(At, 0, 1); PG8_STAGE(PG8_SB(0, 0), b2, voffB); PG8_STAGE(PG8_SB(0, 1), b2 + hstep, voffB); PG8_STAGE_A(PG8_SA(0, 0), a2, 0, uq);
            PG8_WAIT_VX(rel); PG8_WAIT_L(0); PG8_BAR; PG8_MMA(1, 0, At, B0); PG8_MMA(1, 1, At, B1); PG8_BAR; PG8_SCHED;
            PG8_LDB(B0, 1, 0); PG8_LDB(B1, 1, 1); PG8_SCHED; PG8_LDA(At, 1, 0); PG8_STAGE_A(PG8_SA(0, 1), a2, 1, uq);
            PG8_WAIT_VX(rel); PG8_WAIT_L(0); PG8_BAR; PG8_MMA(0, 0, At, B0); PG8_MMA(0, 1, At, B1); PG8_BAR; PG8_SCHED;
            PG8_LDA(At, 1, 1); PG8_STAGE(PG8_SB(1, 0), b3, voffB); PG8_STAGE(PG8_SB(1, 1), b3 + hstep, voffB); PG8_STAGE_A(PG8_SA(1, 0), a3, 0, uq);
            PG8_WAIT_V(8); PG8_WAIT_L(0); PG8_BAR; PG8_MMA(1, 0, At, B0); PG8_MMA(1, 1, At, B1); PG8_BAR; PG8_SCHED;
        }
        if constexpr (ALIGN_EPI) { if (wr == 0) PG8_BAR; }
        if constexpr (ALIGN_EPI && Epi::NS > 0) {
            PG8_STAGE_A(PG8_SA(1, 1), nA + kstep, 1, (has_next ? ui + 1 : ui)); relax = E.stores_all(cur); }
        if constexpr (F8) { asm volatile("s_nop 15\n\ts_nop 15" ::: "memory"); PG8_SCHED; }
        E(acc, cur, ui, wr, wc, fr, fq);
        if (!has_next) break;
#pragma unroll
        for (int a = 0; a < 2; ++a)
#pragma unroll
            for (int b = 0; b < 2; ++b)
#pragma unroll
                for (int m = 0; m < 4; ++m)
#pragma unroll
                    for (int n = 0; n < 2; ++n) acc[a][b][m][n] = (f32x4){0.f, 0.f, 0.f, 0.f};
        cur = nxt; cA = nA; cB = nB; ++ui;
        if constexpr (ALIGN_EPI) { if (wr == 1) PG8_BAR; }
    }
    PG8_WAIT_V(0);
    if constexpr (!ALIGN_EPI) { if (wr == 0) PG8_BAR; }
    PG8_BAR;
#undef PG8_SA
#undef PG8_SB
#undef PG8_STAGE
#undef PG8_LDA
#undef PG8_LDB
#undef PG8_MMA
#undef PG8_WAIT_V
#undef PG8_WAIT_VX
#undef PG8_WAIT_L
#undef PG8_BAR
#undef PG8_SCHED
#undef PG8_STAGE_A
#undef PG8_HOFF
}


struct EpiProj {
    static constexpr bool PERM = true; static constexpr int NS = PG8_RELAX ? 16 : 0;
    __device__ __forceinline__ bool stores_all(const Unit& u) const { return u.pn != 14; }
    bf16_t* P; float* GZ; const float* tab;
    __device__ __forceinline__ void operator()(const f32x4 (&acc)[2][2][4][2], const Unit& u, int ui, int wr, int wc, int fr, int fq) const {
        const int pn = u.pn, row0 = u.pm * BM + wr * 64 + fr, colw = wc * 32 + 8 * fq;
        if (pn == 14) {
            if (wc == 0) {
#pragma unroll
                for (int ai = 0; ai < 2; ++ai)
#pragma unroll
                    for (int m = 0; m < 4; ++m) { float* o = GZ + (size_t)(row0 + ai * HALF + m * 16) * 32 + 8 * fq; *(f32x4*)o = acc[ai][0][m][0]; *(f32x4*)(o + 4) = acc[ai][0][m][1]; }
            }
            return;
        }
        const int mode = (pn == 0) ? 1 : ((pn >= 6 && pn <= 9) ? 3 : 0);
        const float rks = (pn >= 8) ? 0.08838834764831845f : 1.0f;
        const bool lowhalf = wc < 2;
        const int f0 = (16 * wc + 4 * fq) & 31;
        float invt[4];
#pragma unroll
        for (int e = 0; e < 4; ++e) invt[e] = __builtin_amdgcn_exp2f(-(float)(f0 + e) * (13.287712379549449f / 32.0f)) * 0.15915494309189535f;
#pragma unroll
        for (int ai = 0; ai < 2; ++ai)
#pragma unroll
            for (int m = 0; m < 4; ++m) {
                const int row = row0 + ai * HALF + m * 16;
                bf16_t* rowp = P + ptile(row, pn * BM + colw);
                float c[4] = {1.f, 1.f, 1.f, 1.f}, s[4] = {0.f, 0.f, 0.f, 0.f};
                if (mode == 3) { const int t = row & (SEQ - 1); const float pos = (row < NLAT) ? (float)(lowhalf ? (t >> 6) : (t & 63)) : 0.f;
#pragma unroll
                    for (int e = 0; e < 4; ++e) { const float tr = __builtin_amdgcn_fractf(pos * invt[e]); c[e] = __builtin_amdgcn_cosf(tr); s[e] = __builtin_amdgcn_sinf(tr); } }
#pragma unroll
                for (int bj = 0; bj < 2; ++bj) {
                    f32x4 v0 = acc[ai][bj][m][0], v1 = acc[ai][bj][m][1];
                    if (mode == 1) { v0 = v0 * 0.125f; v1 = v1 * 0.125f; }
                    else if (mode == 3) {
                        v0 = v0 * rks; v1 = v1 * rks;
#pragma unroll
                        for (int e = 0; e < 4; ++e) { const float a1 = v0[e], a2 = v1[e]; v0[e] = a1 * c[e] - a2 * s[e]; v1[e] = a1 * s[e] + a2 * c[e]; }
                    }
                    u32x4 w; w.x = cvt_pk_bf16(v0[0], v0[1]); w.y = cvt_pk_bf16(v0[2], v0[3]); w.z = cvt_pk_bf16(v1[0], v1[1]); w.w = cvt_pk_bf16(v1[2], v1[3]);
                    *(u32x4*)(rowp + bj * 8192) = w;
                }
            }
    }
};
struct EpiOut {
    static constexpr bool PERM = true; static constexpr int NS = PG8_RELAX ? 16 : 0;
    __device__ __forceinline__ bool stores_all(const Unit&) const { return true; }
    bf16_t* XO; const float* mod;
    __device__ __forceinline__ void operator()(const f32x4 (&acc)[2][2][4][2], const Unit& u, int ui, int wr, int wc, int fr, int fq) const {
        const int col0 = u.pn * BM + wc * 32 + 8 * fq, b = (u.pm * BM) / SEQ;
        const float* m2 = mod + b * NADA * D + 2 * D;
        f32x4 mv[2][2];
#pragma unroll
        for (int bj = 0; bj < 2; ++bj)
#pragma unroll
            for (int n = 0; n < 2; ++n) mv[bj][n] = *(const f32x4*)(m2 + col0 + bj * HALF + 4 * n);
#pragma unroll
        for (int ai = 0; ai < 2; ++ai)
#pragma unroll
            for (int m = 0; m < 4; ++m) { bf16_t* rowp = XO + (size_t)(u.pm * BM + ai * HALF + wr * 64 + m * 16 + fr) * D + col0;
#pragma unroll
                for (int bj = 0; bj < 2; ++bj) { const f32x4 v0 = mv[bj][0] * acc[ai][bj][m][0], v1 = mv[bj][1] * acc[ai][bj][m][1];
                    u32x4 w; w.x = cvt_pk_bf16(v0[0], v0[1]); w.y = cvt_pk_bf16(v0[2], v0[3]); w.z = cvt_pk_bf16(v1[0], v1[1]); w.w = cvt_pk_bf16(v1[2], v1[3]);
                    *(u32x4*)(rowp + bj * HALF) = w; } }
    }
};
struct EpiAct {
    static constexpr bool PERM = true; static constexpr int NS = PG8_RELAX ? 8 : 0;
    __device__ __forceinline__ bool stores_all(const Unit&) const { return true; }
    unsigned char* ACT; float wscale, ascale;
    __device__ __forceinline__ void operator()(const f32x4 (&acc)[2][2][4][2], const Unit& u, int ui, int wr, int wc, int fr, int fq) const {
        const int pnl = u.pn % 11, col0 = pnl * HALF + wc * 32 + 8 * fq;
        const float c1 = -1.4426950408889634f * wscale, kinv = 1.0f / (wscale * wscale * ascale);
#pragma unroll
        for (int ai = 0; ai < 2; ++ai)
#pragma unroll
            for (int m = 0; m < 4; ++m) { unsigned char* rowp = ACT + (size_t)(u.pm * BM + ai * HALF + wr * 64 + m * 16 + fr) * FFP;
                f32x4 v0, v1;
#pragma unroll
                for (int e = 0; e < 4; ++e) {
                    const float g0 = acc[ai][0][m][0][e], g1 = acc[ai][0][m][1][e];
                    v0[e] = (g0 * acc[ai][1][m][0][e]) * __builtin_amdgcn_rcpf(__builtin_fmaf(__builtin_amdgcn_exp2f(g0 * c1), kinv, kinv));
                    v1[e] = (g1 * acc[ai][1][m][1][e]) * __builtin_amdgcn_rcpf(__builtin_fmaf(__builtin_amdgcn_exp2f(g1 * c1), kinv, kinv)); }
                u32x2 w; w.x = pk_fp8x4(v0[0], v0[1], v0[2], v0[3]); w.y = pk_fp8x4(v1[0], v1[1], v1[2], v1[3]);
                *(u32x2*)(rowp + col0) = w;
                if (pnl == 10) *(u32x2*)(rowp + FF + wc * 32 + 8 * fq) = (u32x2){0u, 0u}; }
    }
};
struct EpiDown {
    static constexpr bool PERM = true; static constexpr int NS = PG8_RELAX ? 16 : 0;
    __device__ __forceinline__ bool stores_all(const Unit&) const { return true; }
    unsigned char* YE; const float* gate; float oscale;
    __device__ __forceinline__ void operator()(const f32x4 (&acc)[2][2][4][2], const Unit& u, int ui, int wr, int wc, int fr, int fq) const {
        const int col0 = (u.pn & 3) * BM + wc * 32 + 8 * fq;
        float gts[2][4];
#pragma unroll
        for (int ai = 0; ai < 2; ++ai)
#pragma unroll
            for (int m = 0; m < 4; ++m) gts[ai][m] = gate[u.pm * BM + ai * HALF + wr * 64 + m * 16 + fr];
#pragma unroll
        for (int ai = 0; ai < 2; ++ai)
#pragma unroll
            for (int m = 0; m < 4; ++m) { const int row = u.pm * BM + ai * HALF + wr * 64 + m * 16 + fr; const float gt = gts[ai][m] * oscale; unsigned char* rowp = YE + (size_t)row * D + col0;
#pragma unroll
                for (int bj = 0; bj < 2; ++bj) { const f32x4 v0 = acc[ai][bj][m][0] * gt, v1 = acc[ai][bj][m][1] * gt;
                    u32x2 w; w.x = pk_fp8x4(v0[0], v0[1], v0[2], v0[3]); w.y = pk_fp8x4(v1[0], v1[1], v1[2], v1[3]);
                    *(u32x2*)(rowp + bj * HALF) = w; } }
    }
};
}

namespace scan {
constexpr int RS = 72;
constexpr int RS2 = 136;
constexpr int OS = 132;
constexpr int NSL = 260;
constexpr size_t GLA_SLOT = 128 * 64, RET_SLOT = 128 * 128;
constexpr size_t US_RET_OFF = (size_t)16 * NSL * GLA_SLOT;
__device__ __forceinline__ int slot_row0(int b, int slot) { return slot < 4 ? NLAT + b * CTX + slot * 64 : b * SEQ + (slot - 4) * 64; }
__device__ __forceinline__ int slot_at(int dir, int step) { return dir ? (step < 4 ? 3 - step : 263 - step) : step; }
__device__ __forceinline__ f32x4 mfma16(bf16x8 a, bf16x8 b, f32x4 c) { return __builtin_amdgcn_mfma_f32_16x16x32_bf16(a, b, c, 0, 0, 0); }
__device__ __forceinline__ bf16x8 lds_frag(const LAS bf16_t* base, int off) { return *(const LAS bf16x8*)(base + off); }
__device__ __forceinline__ int tsw_w(int row, int j) { return row * RS + ((((j >> 3) ^ ((row >> 4) & 7)) << 3) | (j & 7)); }
__device__ __forceinline__ int tsw_r(int row, int chunk) { return row * RS + ((chunk ^ ((row >> 4) & 7)) << 3); }
__device__ __forceinline__ bf16x8 lds_frag_pi(const LAS bf16_t* base, int off  ) {
    typedef short s4 __attribute__((ext_vector_type(4)));
    const s4 lo = *(const LAS s4*)(base + off), hi = *(const LAS s4*)(base + off + 16);
    return (bf16x8){lo[0], lo[1], lo[2], lo[3], hi[0], hi[1], hi[2], hi[3]};
}
__device__ __forceinline__ unsigned pk(float lo, float hi) { return pg8::cvt_pk_bf16(lo, hi); }
__device__ __forceinline__ bf16_t f2bf_hw(float x) { return (bf16_t)(pg8::cvt_pk_bf16(x, 0.f) & 0xffffu); }
__device__ __forceinline__ float sum8(float v) { v += dppf<0xB1, 0xF>(v); v += dppf<0x4E, 0xF>(v); v += dppf<0x141, 0xF>(v); return v; }
__device__ __forceinline__ u32x2 pack_state8(const f32x4 a0, const f32x4 a1) { u32x2 o; o.x = pg8::pk_fp8x4(a0[0], a0[1], a0[2], a0[3]); o.y = pg8::pk_fp8x4(a1[0], a1[1], a1[2], a1[3]); return o; }
__device__ __forceinline__ bf16x8 unpack_state8(const u32x2 w) {
    const f32x2 a = __builtin_amdgcn_cvt_pk_f32_fp8((int)w.x, false), b = __builtin_amdgcn_cvt_pk_f32_fp8((int)w.x, true), c = __builtin_amdgcn_cvt_pk_f32_fp8((int)w.y, false), d = __builtin_amdgcn_cvt_pk_f32_fp8((int)w.y, true);
    const u32x4 r = {pk(a[0], a[1]), pk(b[0], b[1]), pk(c[0], c[1]), pk(d[0], d[1])};
    return __builtin_bit_cast(bf16x8, r);
}

typedef float f32x4m __attribute__((ext_vector_type(4)));
__device__ __forceinline__ void gla_stepA(const float (&wm)[2][2][4], float bf, float bb, int w, int lane, const LAS float* gz_s, LAS float* PR, LAS float* tot, float (&bi)[8], float (&ci)[8], float& allf, float& allb) {
    { const int it = w >> 1, c = lane & 15, q = lane >> 4;
      float a_f[4], a_b[4];
#pragma unroll
      for (int sx = 0; sx < 4; ++sx) { a_f[sx] = gz_s[(16 * it + c) * 36 + 4 * sx + q]; a_b[sx] = gz_s[(16 * it + c) * 36 + 16 + 4 * sx + q]; }
#pragma unroll
      for (int kk = 0; kk < 2; ++kk) { const int kt = 2 * (w & 1) + kk; f32x4 df = {0.f, 0.f, 0.f, 0.f}, db = {0.f, 0.f, 0.f, 0.f};
#pragma unroll
          for (int sx = 0; sx < 4; ++sx) { df = __builtin_amdgcn_mfma_f32_16x16x4f32(a_f[sx], wm[0][kk][sx], df, 0, 0, 0); db = __builtin_amdgcn_mfma_f32_16x16x4f32(a_b[sx], wm[1][kk][sx], db, 0, 0, 0); }
#pragma unroll
          for (int r = 0; r < 4; ++r) { PR[(16 * it + 4 * q + r) * 65 + 16 * kt + c] = df[r]; PR[64 * 65 + (16 * it + 4 * q + r) * 65 + 16 * kt + c] = db[r]; } } }
    __syncthreads();
    float laf[8], lab[8];
#pragma unroll
    for (int tt = 0; tt < 8; ++tt) {
        const float pf = bf + PR[(8 * w + tt) * 65 + lane], pb = bb + PR[64 * 65 + (8 * w + tt) * 65 + lane];
        laf[tt] = (fminf(pf, 0.f) - 0.6931471805599453f * __builtin_amdgcn_logf(1.0f + __builtin_amdgcn_exp2f(-1.4426950408889634f * fabsf(pf)))) * 0.0625f;
        lab[tt] = (fminf(pb, 0.f) - 0.6931471805599453f * __builtin_amdgcn_logf(1.0f + __builtin_amdgcn_exp2f(-1.4426950408889634f * fabsf(pb)))) * 0.0625f;
    }
#pragma unroll
    for (int tt = 1; tt < 8; ++tt) laf[tt] += laf[tt - 1];
#pragma unroll
    for (int tt = 6; tt >= 0; --tt) lab[tt] += lab[tt + 1];
    tot[w * 64 + lane] = laf[7]; tot[512 + w * 64 + lane] = lab[0];
    __syncthreads();
    float offf = 0.f, offb = 0.f; allf = 0.f; allb = 0.f;
#pragma unroll
    for (int w2 = 0; w2 < 8; ++w2) { const float tf = tot[w2 * 64 + lane], tb = tot[512 + w2 * 64 + lane]; allf += tf; allb += tb; if (w2 < w) offf += tf; if (w2 > w) offb += tb; }
#pragma unroll
    for (int tt = 0; tt < 8; ++tt) { bi[tt] = offf + laf[tt]; ci[tt] = offb + lab[tt]; }
}
__device__ __forceinline__ void load_gate_wm(const Ptrs& p, int h, int w, int lane, float (&wm)[2][2][4]) {
#pragma unroll
    for (int dir = 0; dir < 2; ++dir)
#pragma unroll
        for (int kk = 0; kk < 2; ++kk)
#pragma unroll
            for (int sx = 0; sx < 4; ++sx) wm[dir][kk][sx] = p.gla_gate_w[(dir * 16 + 4 * sx + (lane >> 4)) * 256 + h * 64 + 16 * (2 * (w & 1) + kk) + (lane & 15)];
}
__device__ __forceinline__ int img_off(int row, int ch) { return 256 * row + 16 * (ch ^ (((row & 3) << 2) | ((row >> 2) & 3))); }
__device__ __forceinline__ void stage_vt_regs(const u32x4 a, const u32x4 b, LAS bf16_t* VT, int tid) {
    const int j = tid >> 3, vg = tid & 7; LAS unsigned char* img = (LAS unsigned char*)VT;
    *(LAS u32x4*)(img + img_off(j, vg)) = a; *(LAS u32x4*)(img + img_off(j, 8 + vg)) = b;
}
typedef short s16x4 __attribute__((ext_vector_type(4)));
__device__ __forceinline__ bf16x8 tr_frag(const LAS bf16_t* T, int lane, int cb, int ks) {
    const LAS unsigned char* img = (const LAS unsigned char*)T;
    const int g = lane >> 4, qq = (lane & 15) >> 2, pp = lane & 3, r0 = 32 * ks + 8 * g + qq, ch = 2 * cb + (pp >> 1);
    const s16x4 lo = __builtin_amdgcn_ds_read_tr16_b64_v4i16((LAS s16x4*)(img + img_off(r0, ch) + 8 * (pp & 1)));
    const s16x4 hi = __builtin_amdgcn_ds_read_tr16_b64_v4i16((LAS s16x4*)(img + img_off(r0 + 4, ch) + 8 * (pp & 1)));
    return (bf16x8){lo[0], lo[1], lo[2], lo[3], hi[0], hi[1], hi[2], hi[3]};
}
#ifndef S_F8_GLA
#define S_F8_GLA 1
#endif
#ifndef S_F8_RET
#define S_F8_RET 1
#endif
#ifndef C1G_REP
#define C1G_REP 1
#endif
#ifndef C1R_REP
#define C1R_REP 1
#endif
#define SCAN_FENCE() asm volatile("" ::: "memory")

__device__ __forceinline__ void run_c1(const Ptrs& p, LAS unsigned char* lds, int bx) {
    const int tid = threadIdx.x, w = __builtin_amdgcn_readfirstlane(tid >> 6), lane = tid & 63, c = lane & 15, q = lane >> 4;
    const int bh = bx >> 5, b = bh >> 2, h = bh & 3, s0 = bx & 31;
    const bf16_t* P = (const bf16_t*)(p.ws + WS_P);
    const int jrow = tid >> 3, g8 = tid & 7;
#define C1_DUMMY(n_, g_) do { _Pragma("unroll") for (int d_ = 0; d_ < (n_); ++d_) *(u32x2*)(p.ws + 524288 + ((g_) * 8 + d_) * 4096 + tid * 8) = (u32x2){0u, 0u}; } while (0)
    {
        LAS float* gz_s = (LAS float*)lds; LAS float* tot = (LAS float*)(lds + 91648); LAS float* PR = (LAS float*)(lds + 58368);
        LAS bf16_t* KfT = (LAS bf16_t*)(lds + 12288); LAS bf16_t* KbT = (LAS bf16_t*)(lds + 21504); LAS bf16_t* VT = (LAS bf16_t*)(lds + 30720); LAS bf16_t* Kraw = (LAS bf16_t*)(lds + 49152);
        float wm[2][2][4]; load_gate_wm(p, h, w, lane, wm);
        const float bf = p.gla_gate_b[h * 64 + lane], bb = p.gla_gate_b[256 + h * 64 + lane];
        f32x4 gzv_A, gzv_B; u32x4 va_A, vb_A, kv_A, va_B, vb_B, kv_B;
#define C1G_LOAD(S, slot_) do { const int r0_ = slot_row0(b, (slot_)); gzv_##S = ((const f32x4*)((const float*)(p.ws + WS_GZ) + (size_t)r0_ * 32))[tid]; \
            const bf16_t* rv_ = P + ptile(r0_ + jrow, C_GV + h * 128 + g8 * 8); va_##S = *(const u32x4*)rv_; vb_##S = *(const u32x4*)(rv_ + 64); \
            kv_##S = *(const u32x4*)(P + ptile(r0_ + jrow, C_GK + h * 64 + g8 * 8)); } while (0)
#define C1G_ITEM(S, slot, PF) do { \
            *(LAS f32x4*)(gz_s + jrow * 36 + g8 * 4) = gzv_##S; stage_vt_regs(va_##S, vb_##S, VT, tid); *(LAS u32x4*)(Kraw + jrow * RS + g8 * 8) = kv_##S; \
            __syncthreads(); \
            if (PF && (slot) + 64 < NSL) C1G_LOAD(S, (slot) + 64); \
            float bi[8], ci[8], allf, allb; \
            gla_stepA(wm, bf, bb, w, lane, gz_s, PR, tot, bi, ci, allf, allb); \
            { float ef[8], eb[8]; \
            _Pragma("unroll") \
              for (int tt = 0; tt < 8; ++tt) { const float kk = bf2f(Kraw[(8 * w + tt) * RS + lane]); ef[tt] = kk * __expf(allf - bi[tt]); eb[tt] = kk * __expf(allb - ci[tt]); } \
              u32x4 wf_, wb_; wf_.x = pk(ef[0], ef[1]); wf_.y = pk(ef[2], ef[3]); wf_.z = pk(ef[4], ef[5]); wf_.w = pk(ef[6], ef[7]); \
              wb_.x = pk(eb[0], eb[1]); wb_.y = pk(eb[2], eb[3]); wb_.z = pk(eb[4], eb[5]); wb_.w = pk(eb[6], eb[7]); \
              *(LAS u32x4*)(KfT + lane * RS + 8 * w) = wf_; *(LAS u32x4*)(KbT + lane * RS + 8 * w) = wb_; } \
            float* DCH = (float*)(p.ws + WS_DCH); \
            DCH[((size_t)(bh * 2 + 0) * NSL + (slot)) * 64 + lane] = __expf(allf); DCH[((size_t)(bh * 2 + 1) * NSL + (slot)) * 64 + lane] = __expf(allb);     \
            __syncthreads(); \
            unsigned char* US = (unsigned char*)p.out; \
            bf16x8 Bv[2]; \
            _Pragma("unroll") \
            for (int js = 0; js < 2; ++js) Bv[js] = tr_frag(VT, lane, w, js); \
            _Pragma("unroll") \
            for (int dir = 0; dir < 2; ++dir) { const LAS bf16_t* KT = dir ? KbT : KfT; \
            _Pragma("unroll") \
                for (int ks = 0; ks < 2; ++ks) { f32x4 a0 = {0.f, 0.f, 0.f, 0.f}, a1 = {0.f, 0.f, 0.f, 0.f}; \
            _Pragma("unroll") \
                    for (int js = 0; js < 2; ++js) { a0 = mfma16(lds_frag(KT, (32 * ks + c) * RS + 32 * js + 8 * q), Bv[js], a0); a1 = mfma16(lds_frag(KT, (32 * ks + 16 + c) * RS + 32 * js + 8 * q), Bv[js], a1); } \
                    *(u32x2*)(US + ((size_t)(bh * 2 + dir) * NSL + (slot)) * GLA_SLOT + ((w * 2 + ks) * 64 + lane) * 8) = pack_state8(a0, a1); } } \
            __syncthreads(); \
        } while (0)
        for (int rep1_ = 0; rep1_ < C1G_REP; ++rep1_) {
        C1G_LOAD(A, s0); C1_DUMMY(6, 0); C1G_LOAD(B, s0 + 32); C1_DUMMY(6, 1);
        int slot = s0;
        for (; slot + 32 < NSL; slot += 64) {
            C1G_ITEM(A, slot, 1);
            C1G_ITEM(B, slot + 32, 1);
        }
        if (slot < NSL) C1G_ITEM(A, slot, 0);
        }
#undef C1G_ITEM
#undef C1G_LOAD
    }
    {
        LAS bf16_t* Kr = (LAS bf16_t*)lds; LAS bf16_t* Vr = (LAS bf16_t*)(lds + 18432);
        const float lgf = log_sigmoidf(p.ret_decay_logit[h]), lgb = log_sigmoidf(p.ret_decay_logit[4 + h]);
        float sfv[2][8], sbv[2][8];
#pragma unroll
        for (int js = 0; js < 2; ++js)
#pragma unroll
            for (int e = 0; e < 8; ++e) { const int j = 32 * js + 8 * q + e; sfv[js][e] = __expf(lgf * (float)(63 - j)); sbv[js][e] = __expf(lgb * (float)j); }
        u32x4 ka_A, kb_A, va_A, vb_A, ka_B, kb_B, va_B, vb_B;
#define C1R_LOAD(S, slot_) do { const int rr_ = slot_row0(b, (slot_)) + jrow; const bf16_t* rk_ = P + ptile(rr_, C_RK + h * 128 + g8 * 8); const bf16_t* rv_ = P + ptile(rr_, C_RV + h * 128 + g8 * 8); \
            ka_##S = *(const u32x4*)rk_; kb_##S = *(const u32x4*)(rk_ + 64); va_##S = *(const u32x4*)rv_; vb_##S = *(const u32x4*)(rv_ + 64); } while (0)
#define C1R_SCALE(dst, raw, s_) do { const u32x4 rw_ = __builtin_bit_cast(u32x4, raw); u32x4 o_; \
            o_.x = pk(__uint_as_float(rw_.x << 16) * s_[0], __uint_as_float(rw_.x & 0xffff0000u) * s_[1]); o_.y = pk(__uint_as_float(rw_.y << 16) * s_[2], __uint_as_float(rw_.y & 0xffff0000u) * s_[3]); \
            o_.z = pk(__uint_as_float(rw_.z << 16) * s_[4], __uint_as_float(rw_.z & 0xffff0000u) * s_[5]); o_.w = pk(__uint_as_float(rw_.w << 16) * s_[6], __uint_as_float(rw_.w & 0xffff0000u) * s_[7]); \
            dst = __builtin_bit_cast(bf16x8, o_); } while (0)
#define C1R_ITEM(S, slot, PF) do { \
            stage_vt_regs(ka_##S, kb_##S, Kr, tid); stage_vt_regs(va_##S, vb_##S, Vr, tid); \
            __syncthreads(); \
            if (PF && (slot) + 64 < NSL) C1R_LOAD(S, (slot) + 64); \
            unsigned char* US = (unsigned char*)p.out + US_RET_OFF; \
            bf16x8 Bv[2][2]; \
            _Pragma("unroll") \
            for (int js = 0; js < 2; ++js) { const bf16x8 raw_ = tr_frag(Vr, lane, w, js); C1R_SCALE(Bv[0][js], raw_, sfv[js]); C1R_SCALE(Bv[1][js], raw_, sbv[js]); } \
            _Pragma("unroll") \
            for (int ks = 0; ks < 4; ++ks) { f32x4 a0 = {0.f, 0.f, 0.f, 0.f}, a1 = {0.f, 0.f, 0.f, 0.f}, b0 = {0.f, 0.f, 0.f, 0.f}, b1 = {0.f, 0.f, 0.f, 0.f}; \
            _Pragma("unroll") \
                for (int js = 0; js < 2; ++js) { const bf16x8 k0_ = tr_frag(Kr, lane, 2 * ks, js), k1_ = tr_frag(Kr, lane, 2 * ks + 1, js); \
                    a0 = mfma16(k0_, Bv[0][js], a0); a1 = mfma16(k1_, Bv[0][js], a1); b0 = mfma16(k0_, Bv[1][js], b0); b1 = mfma16(k1_, Bv[1][js], b1); } \
                *(u32x2*)(US + ((size_t)(bh * 2 + 0) * NSL + (slot)) * RET_SLOT + ((w * 4 + ks) * 64 + lane) * 8) = pack_state8(a0, a1); \
                *(u32x2*)(US + ((size_t)(bh * 2 + 1) * NSL + (slot)) * RET_SLOT + ((w * 4 + ks) * 64 + lane) * 8) = pack_state8(b0, b1); } \
            __syncthreads(); \
        } while (0)
        for (int rep2_ = 0; rep2_ < C1R_REP; ++rep2_) {
        const int s0r = (s0 + 28) & 31;
        C1R_LOAD(A, s0r); C1_DUMMY(8, 2); C1R_LOAD(B, s0r + 32); C1_DUMMY(8, 3);
        int slot = s0r;
        for (; slot + 32 < NSL; slot += 64) {
            C1R_ITEM(A, slot, 1);
            C1R_ITEM(B, slot + 32, 1);
        }
        if (slot < NSL) C1R_ITEM(A, slot, 0);
        }
#undef C1R_ITEM
#undef C1R_LOAD
#undef C1R_SCALE
    }
#undef C1_DUMMY
}
__device__ __forceinline__ void run_c2(const Ptrs& p, LAS unsigned char* lds, int bx) {
    constexpr int NB = 13, GLA_ELEMS = 16 * 8192;
    const int tid = threadIdx.x;
    LAS float* dl = (LAS float*)lds;
    const int e_blk = bx * 1536, c0 = e_blk >> 13;
    if (e_blk < GLA_ELEMS) {
        const int c1 = ((e_blk + 1535) >> 13) < 15 ? ((e_blk + 1535) >> 13) : 15;
        const f32x4* src = (const f32x4*)((const float*)(p.ws + WS_DCH) + (size_t)c0 * NSL * 64);
        const int n4 = (c1 - c0 + 1) * NSL * 16;
        for (int i0 = tid; i0 < n4; i0 += 4 * NTHR) {
            f32x4 dv[4];
#pragma unroll
            for (int q4 = 0; q4 < 4; ++q4) { const int i = i0 + q4 * NTHR; dv[q4] = src[i < n4 ? i : i0]; }
#pragma unroll
            for (int q4 = 0; q4 < 4; ++q4) { const int i = i0 + q4 * NTHR; if (i < n4) ((LAS f32x4*)dl)[i] = dv[q4]; } }
    }
    __syncthreads();
    if (tid < 192) {
        const int e = e_blk + tid * 8;
        const bool isG = e < GLA_ELEMS;
        const int er = isG ? e : e - GLA_ELEMS;
        const int chain = isG ? (er >> 13) : (er >> 14), el = isG ? (er & 8191) : (er & 16383);
        const size_t SLOT = isG ? GLA_SLOT : RET_SLOT;
        const int dir = chain & 1, h = (chain >> 1) & 3;
        const size_t off = (isG ? 0 : US_RET_OFF) + (size_t)chain * NSL * SLOT + el;
        const unsigned char* ubase = (const unsigned char*)p.out + off;
        bf16_t* sbase = (bf16_t*)(p.ws + WS_US) + off;
        const bool s8 = isG ? (S_F8_GLA != 0) : (S_F8_RET != 0);
        const float dconst = __expf(64.0f * log_sigmoidf(p.ret_decay_logit[dir * 4 + h]));
        const int kb = 32 * ((el >> 9) & 1) + 4 * (((el >> 3) & 63) >> 4);
        const LAS float* dlc = dl + (isG ? (chain - c0) : 0) * NSL * 64 + kb;
        f32x4 s0 = {0.f, 0.f, 0.f, 0.f}, s1 = {0.f, 0.f, 0.f, 0.f};
        u32x2 uA[NB], uB[NB];
#define C2_LOAD(U_, bt_) do { _Pragma("unroll") for (int i = 0; i < NB; ++i) { const int slot = slot_at(dir, (bt_) * NB + i); U_[i] = *(const u32x2*)(ubase + (size_t)slot * SLOT); } } while (0)
#define C2_PROC(U_, bt_) do { _Pragma("unroll") for (int i = 0; i < NB; ++i) { const int slot = slot_at(dir, (bt_) * NB + i); \
        if (s8) *(u32x2*)((unsigned char*)(p.ws + WS_US) + off * 2 - el + (size_t)slot * SLOT) = pack_state8(s0, s1); else { u32x4 o_; o_.x = pk(s0[0], s0[1]); o_.y = pk(s0[2], s0[3]); o_.z = pk(s1[0], s1[1]); o_.w = pk(s1[2], s1[3]); *(u32x4*)(sbase + (size_t)slot * SLOT) = o_; } \
        const f32x2 a_ = __builtin_amdgcn_cvt_pk_f32_fp8((int)U_[i].x, false), b_ = __builtin_amdgcn_cvt_pk_f32_fp8((int)U_[i].x, true), c_ = __builtin_amdgcn_cvt_pk_f32_fp8((int)U_[i].y, false), d_ = __builtin_amdgcn_cvt_pk_f32_fp8((int)U_[i].y, true); \
        const f32x4 u0 = {a_[0], a_[1], b_[0], b_[1]}, u1 = {c_[0], c_[1], d_[0], d_[1]}; \
        if (isG) { const f32x4 d0 = *(const LAS f32x4*)(dlc + slot * 64), d1 = *(const LAS f32x4*)(dlc + slot * 64 + 16); s0 = s0 * d0 + u0; s1 = s1 * d1 + u1; } else { s0 = s0 * dconst + u0; s1 = s1 * dconst + u1; } } } while (0)
        C2_LOAD(uA, 0);
        for (int bt = 0; bt < NSL / NB; bt += 2) {
            C2_LOAD(uB, bt + 1);
            C2_PROC(uA, bt);
            if (bt + 2 < NSL / NB) C2_LOAD(uA, bt + 2);
            C2_PROC(uB, bt + 1);
        }
#undef C2_LOAD
#undef C2_PROC
    }
    __syncthreads();
}
__device__ __forceinline__ void run_c3(const Ptrs& p, LAS unsigned char* lds, int bx, bf16_t* Y) {
    const int tid = threadIdx.x, w = __builtin_amdgcn_readfirstlane(tid >> 6), lane = tid & 63, c = lane & 15, q = lane >> 4;
    const int bh = bx >> 5, b = bh >> 2, h = bh & 3, n0 = bx & 31;
    const bf16_t* P = (const bf16_t*)(p.ws + WS_P);
    const int jrow = tid >> 3, g8 = tid & 7;
#define C3_SB() __builtin_amdgcn_sched_barrier(0)
    {
        LAS float* gz_s = (LAS float*)lds; LAS float* tot = (LAS float*)(lds + 110592);
        LAS bf16_t* QF = (LAS bf16_t*)(lds + 12288); LAS bf16_t* QB = (LAS bf16_t*)(lds + 21504); LAS bf16_t* KF = (LAS bf16_t*)(lds + 30720); LAS bf16_t* KB = (LAS bf16_t*)(lds + 39936);
        LAS bf16_t* VT = (LAS bf16_t*)(lds + 49152); LAS bf16_t* Pm = (LAS bf16_t*)(lds + 67584); LAS float* Os = (LAS float*)(lds + 76800);
        float wm[2][2][4]; load_gate_wm(p, h, w, lane, wm);
        const float bf = p.gla_gate_b[h * 64 + lane], bb = p.gla_gate_b[256 + h * 64 + lane];
        f32x4 nwv[4];
#pragma unroll
        for (int k = 0; k < 4; ++k) nwv[k] = *(const f32x4*)(p.gla_norm_w + h * 128 + 16 * g8 + 4 * k);
        const bf16_t* US = (const bf16_t*)(p.ws + WS_US);
        f32x4 gzv; u32x4 va, vb, qv, kv; bf16x8 Sf[2], Sb[2]; u32x2 Sf8[2], Sb8[2]; u32x4 ga, gb;
#define C3G_LOAD1(n_) do { const int r0_ = b * SEQ + (n_) * 64; gzv = ((const f32x4*)((const float*)(p.ws + WS_GZ) + (size_t)r0_ * 32))[tid]; \
            const bf16_t* rv_ = P + ptile(r0_ + jrow, C_GV + h * 128 + g8 * 8); va = *(const u32x4*)rv_; vb = *(const u32x4*)(rv_ + 64); \
            qv = *(const u32x4*)(P + ptile(r0_ + jrow, C_GQ + h * 64 + g8 * 8)); kv = *(const u32x4*)(P + ptile(r0_ + jrow, C_GK + h * 64 + g8 * 8)); } while (0)
#define C3G_LOADS(n_) do { _Pragma("unroll") for (int ks = 0; ks < 2; ++ks) { if (S_F8_GLA) { \
                    Sf8[ks] = *(const u32x2*)((const unsigned char*)US + (size_t)(bh * 2 + 0) * NSL * GLA_SLOT * 2 + (size_t)(4 + (n_)) * GLA_SLOT + ((w * 2 + ks) * 64 + lane) * 8); \
                    Sb8[ks] = *(const u32x2*)((const unsigned char*)US + (size_t)(bh * 2 + 1) * NSL * GLA_SLOT * 2 + (size_t)(4 + (n_)) * GLA_SLOT + ((w * 2 + ks) * 64 + lane) * 8); } else { \
                    Sf[ks] = *(const bf16x8*)(US + ((size_t)(bh * 2 + 0) * NSL + 4 + (n_)) * GLA_SLOT + ((w * 2 + ks) * 64 + lane) * 8); \
                    Sb[ks] = *(const bf16x8*)(US + ((size_t)(bh * 2 + 1) * NSL + 4 + (n_)) * GLA_SLOT + ((w * 2 + ks) * 64 + lane) * 8); } } } while (0)
#define C3G_LOADG(n_) do { const bf16_t* rg_ = P + ptile(b * SEQ + (n_) * 64 + jrow, C_GG + h * 128 + 16 * g8); ga = *(const u32x4*)rg_; gb = *(const u32x4*)(rg_ + 8); } while (0)
        C3G_LOAD1(n0); C3G_LOADS(n0); C3G_LOADG(n0);
        for (int n = n0; n < 256; n += 32) {
            const int row0 = b * SEQ + n * 64, nn = (n + 32 < 256) ? n + 32 : n;
            *(LAS f32x4*)(gz_s + jrow * 36 + g8 * 4) = gzv; stage_vt_regs(va, vb, VT, tid);
            *(LAS u32x4*)(QF + jrow * RS + g8 * 8) = qv; *(LAS u32x4*)(KF + jrow * RS + g8 * 8) = kv;
            __syncthreads();
            C3G_LOAD1(nn);
            float bi[8], ci[8], allf, allb;
            gla_stepA(wm, bf, bb, w, lane, gz_s, (LAS float*)Os, tot, bi, ci, allf, allb);
#pragma unroll
            for (int tt = 0; tt < 8; ++tt) { const int i = 8 * w + tt; const float qq = bf2f(QF[i * RS + lane]), kk = bf2f(KF[i * RS + lane]);
                QF[i * RS + lane] = f2bf_hw(qq * __expf(bi[tt])); QB[i * RS + lane] = f2bf_hw(qq * __expf(ci[tt]));
                KF[i * RS + lane] = f2bf_hw(kk * __expf(fminf(-bi[tt], 80.f))); KB[i * RS + lane] = f2bf_hw(kk * __expf(fminf(-ci[tt], 80.f))); }
            __syncthreads();
            { const int it = w & 3, i = 16 * it + c;
              bf16x8 qf[2], qb[2];
#pragma unroll
              for (int ks = 0; ks < 2; ++ks) { qf[ks] = lds_frag(QF, i * RS + 32 * ks + 8 * q); qb[ks] = lds_frag(QB, i * RS + 32 * ks + 8 * q); }
#pragma unroll
              for (int jj = 0; jj < 2; ++jj) { const int jt = 2 * (w >> 2) + jj; f32x4 af = {0.f, 0.f, 0.f, 0.f}, ab = {0.f, 0.f, 0.f, 0.f};
#pragma unroll
                  for (int ks = 0; ks < 2; ++ks) { af = mfma16(lds_frag(KF, (16 * jt + c) * RS + 32 * ks + 8 * q), qf[ks], af); ab = mfma16(lds_frag(KB, (16 * jt + c) * RS + 32 * ks + 8 * q), qb[ks], ab); }
                  float v[4];
#pragma unroll
                  for (int r = 0; r < 4; ++r) { const int j = 16 * jt + 4 * q + r; v[r] = (j <= i ? af[r] : 0.f) + (j >= i ? ab[r] : 0.f); }
                  u32x2 o; o.x = pk(v[0], v[1]); o.y = pk(v[2], v[3]); *(LAS u32x2*)(Pm + i * RS + 16 * jt + 4 * q) = o; } }
            __syncthreads();
            if (S_F8_GLA) {
#pragma unroll
                for (int ks = 0; ks < 2; ++ks) { Sf[ks] = unpack_state8(Sf8[ks]); Sb[ks] = unpack_state8(Sb8[ks]); } }
            { bf16x8 Bv[2], fr[2][6];
#pragma unroll
              for (int js = 0; js < 2; ++js) Bv[js] = tr_frag(VT, lane, w, js);
#define C3G_FR(F, it_) do { const int i_ = 16 * (it_) + c; F[0] = lds_frag(Pm, i_ * RS + 8 * q); F[1] = lds_frag(Pm, i_ * RS + 32 + 8 * q); F[2] = lds_frag_pi(QF, i_ * RS + 4 * q); F[3] = lds_frag_pi(QF, i_ * RS + 32 + 4 * q); \
                  F[4] = lds_frag_pi(QB, i_ * RS + 4 * q); F[5] = lds_frag_pi(QB, i_ * RS + 32 + 4 * q); } while (0)
              C3G_FR(fr[0], 0);
#pragma unroll
              for (int it = 0; it < 4; ++it) {
                  if (it < 3) C3G_FR(fr[(it + 1) & 1], it + 1);
                  C3_SB();
                  const bf16x8 (&F)[6] = fr[it & 1];
                  f32x4 a0 = mfma16(F[0], Bv[0], (f32x4){0.f, 0.f, 0.f, 0.f}), a1 = mfma16(F[2], Sf[0], (f32x4){0.f, 0.f, 0.f, 0.f});
                  a0 = mfma16(F[1], Bv[1], a0); a1 = mfma16(F[3], Sf[1], a1); a0 = mfma16(F[4], Sb[0], a0); a1 = mfma16(F[5], Sb[1], a1);
#pragma unroll
                  for (int r = 0; r < 4; ++r) Os[(16 * it + 4 * q + r) * OS + 16 * w + c] = a0[r] + a1[r];
                  C3_SB(); }
#undef C3G_FR
            }
            C3G_LOADS(nn);
            __syncthreads();
            { const LAS float* orow = Os + jrow * OS + 16 * g8;
              f32x4 o4[4];
#pragma unroll
              for (int k = 0; k < 4; ++k) o4[k] = *(const LAS f32x4*)(orow + 4 * k);
              float ss = 0.f;
#pragma unroll
              for (int k = 0; k < 4; ++k)
#pragma unroll
                  for (int e = 0; e < 4; ++e) ss = fmaf(o4[k][e], o4[k][e], ss);
              ss = sum8(ss);
              const float r = __builtin_amdgcn_rsqf(ss * (1.f / 128.f) + EPS);
              const unsigned gw[8] = {ga.x, ga.y, ga.z, ga.w, gb.x, gb.y, gb.z, gb.w}; unsigned ow[8];
#pragma unroll
              for (int k = 0; k < 4; ++k)
#pragma unroll
                  for (int hh = 0; hh < 2; ++hh) { const unsigned g = gw[2 * k + hh];
                      ow[2 * k + hh] = pk(o4[k][2 * hh] * r * nwv[k][2 * hh] * pg8::fast_silu(__uint_as_float(g << 16)), o4[k][2 * hh + 1] * r * nwv[k][2 * hh + 1] * pg8::fast_silu(__uint_as_float(g & 0xffff0000u))); }
              bf16_t* yp = Y + (size_t)(row0 + jrow) * D + h * 128 + 16 * g8;
              *(u32x4*)yp = (u32x4){ow[0], ow[1], ow[2], ow[3]}; *(u32x4*)(yp + 8) = (u32x4){ow[4], ow[5], ow[6], ow[7]}; }
            C3G_LOADG(nn);
        }
        __syncthreads();
#undef C3G_LOAD1
#undef C3G_LOADS
#undef C3G_LOADG
    }
    {
        LAS bf16_t* Qs = (LAS bf16_t*)lds; LAS bf16_t* Ks = (LAS bf16_t*)(lds + 17408); LAS bf16_t* VT = (LAS bf16_t*)(lds + 34816); LAS bf16_t* Pm = (LAS bf16_t*)(lds + 53248);
        LAS float* Os = (LAS float*)(lds + 62464); LAS float* pwf = (LAS float*)(lds + 96256); LAS float* pwb = pwf + 80;
        const float lgf = log_sigmoidf(p.ret_decay_logit[h]), lgb = log_sigmoidf(p.ret_decay_logit[4 + h]);
        if (tid < 65) { pwf[tid] = __expf(lgf * (float)tid); pwb[tid] = __expf(lgb * (float)tid); }
        f32x4 nwv[4];
#pragma unroll
        for (int k = 0; k < 4; ++k) nwv[k] = *(const f32x4*)(p.ret_norm_w + h * 128 + 16 * g8 + 4 * k);
        const bf16_t* US = (const bf16_t*)(p.ws + WS_US) + US_RET_OFF;
        u32x4 qa, qb2, ka, kb2, va, vb; bf16x8 Sf[4], Sb[4]; u32x2 Sf8[4], Sb8[4]; u32x4 ga, gb;
#define C3R_LOAD1(n_) do { const int r0_ = b * SEQ + (n_) * 64; const bf16_t* rq_ = P + ptile(r0_ + jrow, C_RQ + h * 128 + g8 * 8); const bf16_t* rk_ = P + ptile(r0_ + jrow, C_RK + h * 128 + g8 * 8); const bf16_t* rv_ = P + ptile(r0_ + jrow, C_RV + h * 128 + g8 * 8); \
            qa = *(const u32x4*)rq_; qb2 = *(const u32x4*)(rq_ + 64); ka = *(const u32x4*)rk_; kb2 = *(const u32x4*)(rk_ + 64); \
            va = *(const u32x4*)rv_; vb = *(const u32x4*)(rv_ + 64); } while (0)
#define C3R_LOADS(n_) do { _Pragma("unroll") for (int ks = 0; ks < 4; ++ks) { if (S_F8_RET) { \
                    Sf8[ks] = *(const u32x2*)((const unsigned char*)US + (size_t)(bh * 2 + 0) * NSL * RET_SLOT * 2 + (size_t)(4 + (n_)) * RET_SLOT + ((w * 4 + ks) * 64 + lane) * 8); \
                    Sb8[ks] = *(const u32x2*)((const unsigned char*)US + (size_t)(bh * 2 + 1) * NSL * RET_SLOT * 2 + (size_t)(4 + (n_)) * RET_SLOT + ((w * 4 + ks) * 64 + lane) * 8); } else { \
                    Sf[ks] = *(const bf16x8*)(US + ((size_t)(bh * 2 + 0) * NSL + 4 + (n_)) * RET_SLOT + ((w * 4 + ks) * 64 + lane) * 8); \
                    Sb[ks] = *(const bf16x8*)(US + ((size_t)(bh * 2 + 1) * NSL + 4 + (n_)) * RET_SLOT + ((w * 4 + ks) * 64 + lane) * 8); } } } while (0)
#define C3R_LOADG(n_) do { const bf16_t* rg_ = P + ptile(b * SEQ + (n_) * 64 + jrow, C_RG + h * 128 + 16 * g8); ga = *(const u32x4*)rg_; gb = *(const u32x4*)(rg_ + 8); } while (0)
        C3R_LOAD1(n0); C3R_LOADS(n0); C3R_LOADG(n0);
        for (int n = n0; n < 256; n += 32) {
            const int row0 = b * SEQ + n * 64, nn = (n + 32 < 256) ? n + 32 : n;
            *(LAS u32x4*)(Qs + jrow * RS2 + g8 * 8) = qa; *(LAS u32x4*)(Qs + jrow * RS2 + 64 + g8 * 8) = qb2;
            *(LAS u32x4*)(Ks + jrow * RS2 + g8 * 8) = ka; *(LAS u32x4*)(Ks + jrow * RS2 + 64 + g8 * 8) = kb2;
            stage_vt_regs(va, vb, VT, tid);
            __syncthreads();
            C3R_LOAD1(nn);
            { const int it = w & 3, i = 16 * it + c;
              bf16x8 qf[4];
#pragma unroll
              for (int ks = 0; ks < 4; ++ks) qf[ks] = lds_frag(Qs, i * RS2 + 32 * ks + 8 * q);
#pragma unroll
              for (int jj = 0; jj < 2; ++jj) { const int jt = 2 * (w >> 2) + jj; f32x4 a = {0.f, 0.f, 0.f, 0.f};
#pragma unroll
                  for (int ks = 0; ks < 4; ++ks) a = mfma16(lds_frag(Ks, (16 * jt + c) * RS2 + 32 * ks + 8 * q), qf[ks], a);
                  float v[4];
#pragma unroll
                  for (int r = 0; r < 4; ++r) { const int j = 16 * jt + 4 * q + r; const int dd = i - j; const float dm = (dd >= 0 ? pwf[dd >= 0 ? dd : 0] : 0.f) + (dd <= 0 ? pwb[dd <= 0 ? -dd : 0] : 0.f); v[r] = a[r] * dm; }
                  u32x2 o; o.x = pk(v[0], v[1]); o.y = pk(v[2], v[3]); *(LAS u32x2*)(Pm + i * RS + 16 * jt + 4 * q) = o; } }
            __syncthreads();
            if (S_F8_RET) {
#pragma unroll
                for (int ks = 0; ks < 4; ++ks) { Sf[ks] = unpack_state8(Sf8[ks]); Sb[ks] = unpack_state8(Sb8[ks]); } }
            { bf16x8 Bv[2], fr[2][6]; f32x4 dwf[2], dwb[2];
#pragma unroll
              for (int js = 0; js < 2; ++js) Bv[js] = tr_frag(VT, lane, w, js);
#define C3R_FR(F, WF, WB, it_) do { const int i_ = 16 * (it_) + c; F[0] = lds_frag(Pm, i_ * RS + 8 * q); F[1] = lds_frag(Pm, i_ * RS + 32 + 8 * q); \
                  _Pragma("unroll") for (int ks = 0; ks < 4; ++ks) F[2 + ks] = lds_frag_pi(Qs, i_ * RS2 + 32 * ks + 4 * q); \
                  _Pragma("unroll") for (int r = 0; r < 4; ++r) { WF[r] = pwf[16 * (it_) + 4 * q + r + 1]; WB[r] = pwb[64 - (16 * (it_) + 4 * q + r)]; } } while (0)
              C3R_FR(fr[0], dwf[0], dwb[0], 0);
#pragma unroll
              for (int it = 0; it < 4; ++it) {
                  if (it < 3) C3R_FR(fr[(it + 1) & 1], dwf[(it + 1) & 1], dwb[(it + 1) & 1], it + 1);
                  C3_SB();
                  const bf16x8 (&F)[6] = fr[it & 1];
                  f32x4 a = mfma16(F[0], Bv[0], (f32x4){0.f, 0.f, 0.f, 0.f}), af = mfma16(F[2], Sf[0], (f32x4){0.f, 0.f, 0.f, 0.f}), ab = mfma16(F[2], Sb[0], (f32x4){0.f, 0.f, 0.f, 0.f});
                  a = mfma16(F[1], Bv[1], a); af = mfma16(F[3], Sf[1], af); ab = mfma16(F[3], Sb[1], ab);
                  af = mfma16(F[4], Sf[2], af); ab = mfma16(F[4], Sb[2], ab); af = mfma16(F[5], Sf[3], af); ab = mfma16(F[5], Sb[3], ab);
#pragma unroll
                  for (int r = 0; r < 4; ++r) Os[(16 * it + 4 * q + r) * OS + 16 * w + c] = a[r] + dwf[it & 1][r] * af[r] + dwb[it & 1][r] * ab[r];
                  C3_SB(); }
#undef C3R_FR
            }
            C3R_LOADS(nn);
            __syncthreads();
            { const LAS float* orow = Os + jrow * OS + 16 * g8;
              f32x4 o4[4];
#pragma unroll
              for (int k = 0; k < 4; ++k) o4[k] = *(const LAS f32x4*)(orow + 4 * k);
              float s1 = 0.f;
#pragma unroll
              for (int k = 0; k < 4; ++k) s1 += (o4[k][0] + o4[k][1]) + (o4[k][2] + o4[k][3]);
              const float mu = sum8(s1) * (1.f / 128.f);
              float ss = 0.f;
#pragma unroll
              for (int k = 0; k < 4; ++k)
#pragma unroll
                  for (int e = 0; e < 4; ++e) { o4[k][e] -= mu; ss = fmaf(o4[k][e], o4[k][e], ss); }
              ss = sum8(ss);
              const float r = __builtin_amdgcn_rsqf(ss * (1.f / 128.f) + EPS);
              const unsigned gw[8] = {ga.x, ga.y, ga.z, ga.w, gb.x, gb.y, gb.z, gb.w}; unsigned ow[8];
#pragma unroll
              for (int k = 0; k < 4; ++k)
#pragma unroll
                  for (int hh = 0; hh < 2; ++hh) { const unsigned g = gw[2 * k + hh];
                      ow[2 * k + hh] = pk(o4[k][2 * hh] * r * nwv[k][2 * hh] * pg8::fast_silu(__uint_as_float(g << 16)), o4[k][2 * hh + 1] * r * nwv[k][2 * hh + 1] * pg8::fast_silu(__uint_as_float(g & 0xffff0000u))); }
              bf16_t* yp = Y + (size_t)(row0 + jrow) * D + 512 + h * 128 + 16 * g8;
              *(u32x4*)yp = (u32x4){ow[0], ow[1], ow[2], ow[3]}; *(u32x4*)(yp + 8) = (u32x4){ow[4], ow[5], ow[6], ow[7]}; }
            C3R_LOADG(nn);
        }
        __syncthreads();
#undef C3R_LOAD1
#undef C3R_LOADS
#undef C3R_LOADG
    }
#undef C3_SB
}
}

namespace misc {
__device__ __forceinline__ void p0_mod(const Ptrs& p, LAS unsigned char* lds, int bx) {
    LAS float* sc = (LAS float*)lds;
    LAS float* red = sc + 3 * D;
    const int tid = threadIdx.x;
    { float cv[6];
#pragma unroll
      for (int q6 = 0; q6 < 6; ++q6) { const int i = tid + q6 * NTHR, r = i >> 10, k = i & 1023; cv[q6] = (r < 2) ? p.c[r * D + k] : p.c_ctx[k]; }
#pragma unroll
      for (int q6 = 0; q6 < 6; ++q6) sc[tid + q6 * NTHR] = siluf(cv[q6]); }
    __syncthreads();
    const int kg = tid >> 5, cl = tid & 31, col = 24 * bx + cl;
    float a0 = 0.f, a1 = 0.f, a2 = 0.f;
    if (cl < 24) {
#pragma unroll 16
        for (int k = kg * 64; k < kg * 64 + 64; ++k) { const float w = p.w_ada[(size_t)k * (NADA * D) + col]; a0 += sc[k] * w; a1 += sc[D + k] * w; a2 += sc[2 * D + k] * w; }
    }
    red[(kg * 3 + 0) * 32 + cl] = a0; red[(kg * 3 + 1) * 32 + cl] = a1; red[(kg * 3 + 2) * 32 + cl] = a2;
    __syncthreads();
    if (tid < 96) { const int r = tid >> 5, c2 = tid & 31; if (c2 < 24) { float s = 0.f;
#pragma unroll
        for (int g = 0; g < 16; ++g) s += red[(g * 3 + r) * 32 + c2];
        const int cc = 24 * bx + c2; ((float*)(p.ws + WS_MOD))[r * NADA * D + cc] = s + p.b_ada[cc]; } }
    __syncthreads();
}
constexpr int TSCR = 64 * 65 * 4;
__device__ __forceinline__ void transpose_tile(const float* src, int ldsrc, int k0, int n0s, bf16_t* dst, int ldt, int n0d, LAS float* scr, int lane) {
    const int kr = lane >> 4, nq = lane & 15;
    f32x4 v[16];
#pragma unroll
    for (int i = 0; i < 16; ++i) v[i] = *(const f32x4*)(src + (size_t)(k0 + 4 * i + kr) * ldsrc + n0s + 4 * nq);
#pragma unroll
    for (int i = 0; i < 16; ++i) { LAS float* s = scr + (4 * i + kr) * 65 + 4 * nq; s[0] = v[i][0]; s[1] = v[i][1]; s[2] = v[i][2]; s[3] = v[i][3]; }
    asm volatile("s_waitcnt lgkmcnt(0)" ::: "memory");
    const int c = lane & 7, ns = lane >> 3;
#pragma unroll
    for (int j = 0; j < 8; ++j) { const int n = ns + 8 * j; const LAS float* s = scr + (8 * c) * 65 + n;
        u32x4 o; o.x = pg8::cvt_pk_bf16(s[0 * 65], s[1 * 65]); o.y = pg8::cvt_pk_bf16(s[2 * 65], s[3 * 65]); o.z = pg8::cvt_pk_bf16(s[4 * 65], s[5 * 65]); o.w = pg8::cvt_pk_bf16(s[6 * 65], s[7 * 65]);
        *(u32x4*)(dst + (size_t)(n0d + n) * ldt + k0 + 8 * c) = o; }
    asm volatile("s_waitcnt lgkmcnt(0)" ::: "memory");
}
using pg8::pk_fp8x4;
__device__ __forceinline__ void zero_tile_f8(unsigned char* dst, int ldt, int n0d, int k0, int lane) {
    const int c = lane & 3, ns = lane >> 2;
#pragma unroll
    for (int j = 0; j < 4; ++j) *(u32x4*)(dst + (size_t)(n0d + ns + 16 * j) * ldt + k0 + 16 * c) = (u32x4){0u, 0u, 0u, 0u};
}
__device__ __forceinline__ void transpose_tile_f8(const float* src, int ldsrc, int k0, int n0s, unsigned char* dst, int ldt, int n0d, float scale, LAS float* scr, int lane) {
    const int kr = lane >> 4, nq = lane & 15;
    f32x4 v[16];
#pragma unroll
    for (int i = 0; i < 16; ++i) v[i] = *(const f32x4*)(src + (size_t)(k0 + 4 * i + kr) * ldsrc + n0s + 4 * nq);
#pragma unroll
    for (int i = 0; i < 16; ++i) { LAS float* s = scr + (4 * i + kr) * 65 + 4 * nq; s[0] = v[i][0] * scale; s[1] = v[i][1] * scale; s[2] = v[i][2] * scale; s[3] = v[i][3] * scale; }
    asm volatile("s_waitcnt lgkmcnt(0)" ::: "memory");
    const int c = lane & 3, ns = lane >> 2;
#pragma unroll
    for (int j = 0; j < 4; ++j) { const int n = ns + 16 * j; const LAS float* s = scr + (16 * c) * 65 + n;
        u32x4 o; o.x = pk_fp8x4(s[0 * 65], s[1 * 65], s[2 * 65], s[3 * 65]); o.y = pk_fp8x4(s[4 * 65], s[5 * 65], s[6 * 65], s[7 * 65]);
        o.z = pk_fp8x4(s[8 * 65], s[9 * 65], s[10 * 65], s[11 * 65]); o.w = pk_fp8x4(s[12 * 65], s[13 * 65], s[14 * 65], s[15 * 65]);
        *(u32x4*)(dst + (size_t)(n0d + n) * ldt + k0 + 16 * c) = o; }
    asm volatile("s_waitcnt lgkmcnt(0)" ::: "memory");
}
__device__ __forceinline__ void transpose_item(const float* src, int ldsrc, int k0, int col  , bf16_t* dst, int ldt, int n0, LAS float* scr, int lane) {
    const int colc = col >= 0 ? col : 0;
#pragma unroll 8
    for (int i = 0; i < 32; ++i) { const int kk = 2 * i + (lane >> 5); const float x_ = src[(size_t)(k0 + kk) * ldsrc + colc]; scr[kk * 33 + (lane & 31)] = (col >= 0) ? x_ : 0.f; }
    asm volatile("s_waitcnt lgkmcnt(0)" ::: "memory");
    const int c = lane & 7;
#pragma unroll
    for (int j = 0; j < 4; ++j) { const int n = (lane >> 3) + 8 * j; const LAS float* s = scr + (8 * c) * 33 + n;
        u32x4 o; o.x = pg8::cvt_pk_bf16(s[0 * 33], s[1 * 33]); o.y = pg8::cvt_pk_bf16(s[2 * 33], s[3 * 33]); o.z = pg8::cvt_pk_bf16(s[4 * 33], s[5 * 33]); o.w = pg8::cvt_pk_bf16(s[6 * 33], s[7 * 33]);
        *(u32x4*)(dst + (size_t)(n0 + n) * ldt + k0 + 8 * c) = o; }
    asm volatile("s_waitcnt lgkmcnt(0)" ::: "memory");
}
constexpr int IT_WIN = 16 * 120, IT_WOUT = 16 * 16, IT_P0 = IT_WIN + IT_WOUT;
constexpr int IT_WGU = 16 * 2 * 22 * 16, IT_WD = 16 * 16 * 24, IT_EXP = IT_WGU + IT_WD;
__device__ __forceinline__ void conv_item_p0(const Ptrs& p, int it, LAS float* scr, int lane) {
    if (it < IT_WIN) { const int kb = it / 120, nb = it % 120, n = nb * 32 + (lane & 31); const int col = (n < NPROJ) ? proj_src_col(n) : -1;
        transpose_item(p.w_in, NPROJ, kb * 64, col, (bf16_t*)(p.ws + WS_WIN), D, nb * 32, scr, lane); }
    else { it -= IT_WIN; const int kb = it >> 4, nb = it & 15; transpose_tile(p.w_out, D, kb * 64, nb * 64, (bf16_t*)(p.ws + WS_WOUT), D, nb * 64, scr, lane); }
}
__device__ __forceinline__ void conv_item_exp(const Ptrs& p, int it, LAS float* scr, int lane) {
    if (it < IT_WGU) { const int kb = it & 15, nt = (it >> 4) % 22, half = ((it >> 4) / 22) & 1, e = (it >> 4) / 44; const int f0 = nt * 64, r0 = (f0 >> 7) * 256 + half * 128 + (f0 & 127);
        const float* src = (half ? p.w_exp_up : p.w_exp_gate) + (size_t)e * D * FF;
        transpose_tile_f8(src, FF, kb * 64, f0, (unsigned char*)(p.ws + WS_WGU) + (size_t)e * 2816 * D, D, r0, 32.0f, scr, lane); }
    else { it -= IT_WGU; const int kb = it % 24, nb = (it / 24) & 15, e = it / (24 * 16); unsigned char* dst = (unsigned char*)p.out + OUT_WD + (size_t)e * D * FFP;
        if (kb < 22) transpose_tile_f8(p.w_exp_down + (size_t)e * FF * D, D, kb * 64, nb * 64, dst, FFP, nb * 64, 32.0f, scr, lane); else zero_tile_f8(dst, FFP, nb * 64, kb * 64, lane); }
}
__device__ __forceinline__ void h_rows(const Ptrs& p, int row0, int rstep, int lane) {
    f32x4 xn[4], scn[4], shn[4];
#define H_LOAD(r_) do { const float* s_ = ((r_) < NLAT) ? p.x + (size_t)(r_) * D : p.ctx + (size_t)((r_) - NLAT) * D; _Pragma("unroll") for (int j = 0; j < 4; ++j) xn[j] = *(const f32x4*)(s_ + j * 256 + lane * 4); \
        const float* mod_ = (const float*)(p.ws + WS_MOD) + (((r_) < NLAT) ? (r_) / SEQ : 2) * NADA * D; \
        _Pragma("unroll") for (int j = 0; j < 4; ++j) { scn[j] = *(const f32x4*)(mod_ + D + j * 256 + lane * 4); shn[j] = *(const f32x4*)(mod_ + j * 256 + lane * 4); } } while (0)
    if (row0 >= NROWS) return;
    H_LOAD(row0);
    __builtin_amdgcn_sched_barrier(0);
    f32x4 w4[4];
#pragma unroll
    for (int j = 0; j < 4; ++j) w4[j] = *(const f32x4*)(p.norm1_w + j * 256 + lane * 4);
    for (int row = row0; row < NROWS; row += rstep) {
        f32x4 v[4], sc[4], sh[4]; float ss = 0.f;
#pragma unroll
        for (int j = 0; j < 4; ++j) { v[j] = xn[j]; sc[j] = scn[j]; sh[j] = shn[j]; ss += v[j][0] * v[j][0] + v[j][1] * v[j][1] + v[j][2] * v[j][2] + v[j][3] * v[j][3]; }
        { const int rn = (row + rstep < NROWS) ? row + rstep : row; H_LOAD(rn); }
        const float rstd = rsqrtf(wave_sum(ss) * (1.0f / D) + EPS);
        bf16_t* dst = (bf16_t*)(p.ws + WS_H) + (size_t)row * D;
#pragma unroll
        for (int j = 0; j < 4; ++j) { const int d = j * 256 + lane * 4;
            f32x4 o;
#pragma unroll
            for (int e = 0; e < 4; ++e) o[e] = v[j][e] * rstd * w4[j][e] * (1.0f + sc[j][e]) + sh[j][e];
            u32x2 pkd; pkd.x = pg8::cvt_pk_bf16(o[0], o[1]); pkd.y = pg8::cvt_pk_bf16(o[2], o[3]); *(u32x2*)(dst + d) = pkd; }
    }
#undef H_LOAD
}
__device__ __forceinline__ void stage_router(const Ptrs& p, LAS float* Wl, int tid) {
    for (int idx = tid; idx < D * NE / 4; idx += NTHR) { const int d = idx >> 2, q4 = idx & 3, j = d >> 8, ln = (d >> 2) & 63, e4 = d & 3;
        *(LAS f32x4*)(Wl + (((j * 4 + e4) * 4 + q4) * 64 + ln) * 4) = *(const f32x4*)(p.w_router + (size_t)d * NE + 4 * q4); }
}
__device__ __forceinline__ void norm2_router_rows(const Ptrs& p, const LAS float* Wl, int row0, int rstep, int lane) {
    const bf16_t* XO = (const bf16_t*)(p.ws + WS_XO);
    f32x4 xn[4], scn[4], shn[4]; u32x2 on[4];
#define N2_LOAD(r_) do { _Pragma("unroll") for (int j = 0; j < 4; ++j) { xn[j] = *(const f32x4*)(p.x + (size_t)(r_) * D + j * 256 + lane * 4); on[j] = *(const u32x2*)(XO + (size_t)(r_) * D + j * 256 + lane * 4); } \
        const float* mod_ = (const float*)(p.ws + WS_MOD) + ((r_) / SEQ) * NADA * D; \
        _Pragma("unroll") for (int j = 0; j < 4; ++j) { scn[j] = *(const f32x4*)(mod_ + 4 * D + j * 256 + lane * 4); shn[j] = *(const f32x4*)(mod_ + 3 * D + j * 256 + lane * 4); } } while (0)
    if (row0 >= NLAT) return;
    N2_LOAD(row0);
    __builtin_amdgcn_sched_barrier(0);
    f32x4 w4[4];
#pragma unroll
    for (int j = 0; j < 4; ++j) w4[j] = *(const f32x4*)(p.norm2_w + j * 256 + lane * 4);
    for (int row = row0; row < NLAT; row += rstep) {
        const int b = row / SEQ, t = row % SEQ;
        f32x4 v[4], scv[4], shv[4]; float ss = 0.f;
#pragma unroll
        for (int j = 0; j < 4; ++j) { scv[j] = scn[j]; shv[j] = shn[j]; }
#pragma unroll
        for (int j = 0; j < 4; ++j) { v[j] = xn[j]; v[j][0] += __uint_as_float(on[j].x << 16); v[j][1] += __uint_as_float(on[j].x & 0xffff0000u); v[j][2] += __uint_as_float(on[j].y << 16); v[j][3] += __uint_as_float(on[j].y & 0xffff0000u);
            ss += v[j][0] * v[j][0] + v[j][1] * v[j][1] + v[j][2] * v[j][2] + v[j][3] * v[j][3];
            u32x2 x1w; x1w.x = pg8::cvt_pk_bf16(v[j][0], v[j][1]); x1w.y = pg8::cvt_pk_bf16(v[j][2], v[j][3]); *(u32x2*)((bf16_t*)(p.ws + WS_XO) + (size_t)row * D + j * 256 + lane * 4) = x1w; }
        { const int rn = (row + rstep < NLAT) ? row + rstep : row; N2_LOAD(rn); }
        const float rstd = rsqrtf(wave_sum(ss) * (1.0f / D) + EPS);
        unsigned char* dst = (unsigned char*)(p.ws + WS_H) + (size_t)row * D;
        f32x2 lg2[8];
#pragma unroll
        for (int e = 0; e < 8; ++e) lg2[e] = (f32x2){0.f, 0.f};
        int wl_off = 0; asm volatile("" : "+v"(wl_off));
#pragma unroll
        for (int j = 0; j < 4; ++j) { const int d = j * 256 + lane * 4; const f32x4 sc = scv[j], sh = shv[j];
            f32x4 ww[4][4];
#pragma unroll
            for (int e4 = 0; e4 < 4; ++e4)
#pragma unroll
                for (int q = 0; q < 4; ++q) ww[e4][q] = *(const LAS f32x4*)(Wl + wl_off + (((j * 4 + e4) * 4 + q) * 64 + lane) * 4);
            f32x4 o;
#pragma unroll
            for (int e4 = 0; e4 < 4; ++e4) { o[e4] = v[j][e4] * rstd * w4[j][e4] * (1.0f + sc[e4]) + sh[e4]; const f32x2 o2 = {o[e4], o[e4]};
#pragma unroll
                for (int q = 0; q < 4; ++q) { lg2[2 * q] = __builtin_elementwise_fma(o2, (f32x2){ww[e4][q][0], ww[e4][q][1]}, lg2[2 * q]); lg2[2 * q + 1] = __builtin_elementwise_fma(o2, (f32x2){ww[e4][q][2], ww[e4][q][3]}, lg2[2 * q + 1]); } }
            *(unsigned*)(dst + d) = pk_fp8x4(o[0], o[1], o[2], o[3]); }
        float lg[NE];
#pragma unroll
        for (int q = 0; q < 4; ++q) { lg[4 * q] = lg2[2 * q][0]; lg[4 * q + 1] = lg2[2 * q][1]; lg[4 * q + 2] = lg2[2 * q + 1][0]; lg[4 * q + 3] = lg2[2 * q + 1][1]; }
        float r8[8], r4[4], r2[2], r1;
        { const bool hi = lane & 32;
#pragma unroll
          for (int j = 0; j < 8; ++j) { const float keep = hi ? lg[8 + j] : lg[j], send = hi ? lg[j] : lg[8 + j]; r8[j] = keep + __shfl_xor(send, 32); } }
        { const bool hi = lane & 16;
#pragma unroll
          for (int j = 0; j < 4; ++j) { const float keep = hi ? r8[4 + j] : r8[j], send = hi ? r8[j] : r8[4 + j]; r4[j] = keep + __shfl_xor(send, 16); } }
        { const bool hi = lane & 8;
#pragma unroll
          for (int j = 0; j < 2; ++j) { const float keep = hi ? r4[2 + j] : r4[j], send = hi ? r4[j] : r4[2 + j]; r2[j] = keep + __shfl_xor(send, 8); } }
        { const bool hi = lane & 4; const float keep = hi ? r2[1] : r2[0], send = hi ? r2[0] : r2[1]; r1 = keep + __shfl_xor(send, 4); }
        r1 += __shfl_xor(r1, 2); r1 += __shfl_xor(r1, 1);
        const float mx = wave_max(r1);
        const float ex = __expf(r1 - mx); const float den = wave_sum(ex) * 0.25f;
        if ((lane & 3) == 0) ((float*)(p.ws + WS_AFF))[((size_t)b * NE + ((lane >> 2) & 15)) * SEQ + t] = ex / den;
    }
#undef N2_LOAD
}
__device__ __forceinline__ void topk_set(const Ptrs& p, LAS unsigned char* lds, int be) {
    LAS unsigned* key = (LAS unsigned*)lds;
    LAS unsigned* hist = key + SEQ;
    LAS unsigned* sh = hist + 256;
    const int tid = threadIdx.x, lane = tid & 63, w = tid >> 6;
    const unsigned* A = (const unsigned*)(p.ws + WS_AFF) + (size_t)be * SEQ;
    { u32x4 kv[8];
#pragma unroll
      for (int q8 = 0; q8 < 8; ++q8) kv[q8] = ((const u32x4*)A)[tid + q8 * NTHR];
#pragma unroll
      for (int q8 = 0; q8 < 8; ++q8) ((LAS u32x4*)key)[tid + q8 * NTHR] = kv[q8]; }
    if (tid == 0) { sh[0] = 0u; sh[1] = (unsigned)CAP; }
    __syncthreads();
#pragma unroll 1
    for (int pass = 0; pass < 4; ++pass) {
        const int shift = 24 - 8 * pass;
        if (tid < 256) hist[tid] = 0u;
        __syncthreads();
        const unsigned prefix = sh[0], kneed = sh[1];
        const unsigned himask = (pass == 0) ? 0u : (0xffffffffu << (shift + 8));
        for (int i = tid; i < SEQ; i += NTHR) { const unsigned kx = key[i]; if ((kx & himask) == prefix) __hip_atomic_fetch_add(&hist[(kx >> shift) & 255u], 1u, __ATOMIC_RELAXED, __HIP_MEMORY_SCOPE_WORKGROUP); }
        __syncthreads();
        if (w == 0) {
            unsigned c4[4]; unsigned s = 0u;
#pragma unroll
            for (int j = 0; j < 4; ++j) { c4[j] = hist[255 - (lane * 4 + j)]; s += c4[j]; }
            unsigned incl = s;
#pragma unroll
            for (int o = 1; o < 64; o <<= 1) { const unsigned t = __shfl_up(incl, o); if (lane >= o) incl += t; }
            const unsigned excl = incl - s;
            if (excl < kneed && kneed <= incl) { unsigned acc = excl;
#pragma unroll
                for (int j = 0; j < 4; ++j) { if (acc < kneed && kneed <= acc + c4[j]) { const unsigned bin = 255u - (unsigned)(lane * 4 + j); sh[0] = prefix | (bin << shift); sh[1] = kneed - acc; } acc += c4[j]; } }
        }
        __syncthreads();
    }
    const unsigned T = sh[0], need_eq = sh[1];
    unsigned cg = 0u, ce = 0u;
    for (int i = 0; i < 32; ++i) { const unsigned kx = key[tid * 32 + i]; cg += (kx > T) ? 1u : 0u; ce += (kx == T) ? 1u : 0u; }
    unsigned ig = cg, ie = ce;
#pragma unroll
    for (int o = 1; o < 64; o <<= 1) { const unsigned tg = __shfl_up(ig, o), te = __shfl_up(ie, o); if (lane >= o) { ig += tg; ie += te; } }
    if (lane == 63) { sh[16 + w] = ig; sh[32 + w] = ie; }
    __syncthreads();
    unsigned og = 0u, oe = 0u, totg = 0u;
#pragma unroll
    for (int w2 = 0; w2 < 8; ++w2) { const unsigned a = sh[16 + w2], b2 = sh[32 + w2]; if (w2 < w) { og += a; oe += b2; } totg += a; }
    unsigned pg = og + ig - cg, pe = oe + ie - ce;
    int* IDX = (int*)(p.ws + WS_IDX) + be * CAP; float* GATE = (float*)(p.ws + WS_GATE) + be * CAP; int* INV = (int*)(p.ws + WS_INV);
    const int b = be / NE, e = be % NE;
    for (int i = 0; i < 32; ++i) { const int t = tid * 32 + i; const unsigned kx = key[t]; int slot = -1;
        if (kx > T) slot = (int)(pg++); else if (kx == T) { if (pe < need_eq) slot = (int)(totg + pe); ++pe; }
        if (slot >= 0) { IDX[slot] = t; GATE[slot] = __uint_as_float(kx); }
        INV[((size_t)b * SEQ + t) * NE + e] = slot; }
    __syncthreads();
}
__device__ __forceinline__ void final_rows(const Ptrs& p, int row0, int rstep, int lane) {
    const bf16_t* XO = (const bf16_t*)(p.ws + WS_XO); const unsigned char* YE = (const unsigned char*)(p.ws + WS_YE); const int* INV = (const int*)(p.ws + WS_INV);
    u32x2 on[4]; int invn = -1; f32x4 m4n[4];
#define FN_LOAD(r_) do { _Pragma("unroll") for (int j = 0; j < 4; ++j) { on[j] = *(const u32x2*)(XO + (size_t)(r_) * D + j * 256 + lane * 4); } \
        invn = INV[(size_t)(r_) * NE + (lane & (NE - 1))]; \
        const float* mod_ = (const float*)(p.ws + WS_MOD) + ((r_) / SEQ) * NADA * D + 5 * D; \
        _Pragma("unroll") for (int j = 0; j < 4; ++j) m4n[j] = *(const f32x4*)(mod_ + j * 256 + lane * 4); } while (0)
    if (row0 >= NLAT) return;
    FN_LOAD(row0);
    __builtin_amdgcn_sched_barrier(0);
    f32x4 fw[4];
#pragma unroll
    for (int j = 0; j < 4; ++j) fw[j] = *(const f32x4*)(p.final_norm_w + j * 256 + lane * 4);
    u32x2 oc[4]; f32x4 m4[4]; int myinv;
#define FN_TAKE() do { _Pragma("unroll") for (int j = 0; j < 4; ++j) { oc[j] = on[j]; m4[j] = m4n[j]; } myinv = (lane < NE) ? invn : -1; } while (0)
    FN_TAKE();
    for (int row = row0; row < NLAT; row += rstep) {
        const int b = row / SEQ;
        f32x4 v[4];
#pragma unroll
        for (int j = 0; j < 4; ++j) { v[j][0] = __uint_as_float(oc[j].x << 16); v[j][1] = __uint_as_float(oc[j].x & 0xffff0000u); v[j][2] = __uint_as_float(oc[j].y << 16); v[j][3] = __uint_as_float(oc[j].y & 0xffff0000u); }
        unsigned long long mask = __ballot(myinv >= 0);
        float acc[16];
#pragma unroll
        for (int i = 0; i < 16; ++i) acc[i] = 0.f;
        unsigned yw[4][4]; bool has[4];
#pragma unroll
        for (int u = 0; u < 4; ++u) { has[u] = mask != 0ull; const int e = has[u] ? (int)__builtin_ctzll(mask) : 0; if (has[u]) mask &= mask - 1ull;
            const int s = __shfl(myinv, e); const unsigned char* y = has[u] ? YE + ((size_t)(b * NE + e) * CAP + s) * D : YE;
#pragma unroll
            for (int j = 0; j < 4; ++j) yw[u][j] = *(const unsigned*)(y + j * 256 + lane * 4); }
        { const int rn = (row + rstep < NLAT) ? row + rstep : row; FN_LOAD(rn); }
#pragma unroll
        for (int u = 0; u < 4; ++u) { const float hs = has[u] ? 1.f : 0.f;
#pragma unroll
            for (int j = 0; j < 4; ++j) { const f32x2 lo_ = __builtin_amdgcn_cvt_pk_f32_fp8((int)yw[u][j], false), hi_ = __builtin_amdgcn_cvt_pk_f32_fp8((int)yw[u][j], true);
                acc[4 * j] += hs * lo_[0]; acc[4 * j + 1] += hs * lo_[1]; acc[4 * j + 2] += hs * hi_[0]; acc[4 * j + 3] += hs * hi_[1]; } }
#pragma unroll
        for (int blk = 0; blk < 3; ++blk) if (mask) {
#pragma unroll
            for (int u = 0; u < 4; ++u) { has[u] = mask != 0ull; const int e = has[u] ? (int)__builtin_ctzll(mask) : 0; if (has[u]) mask &= mask - 1ull;
                const int s = __shfl(myinv, e); const unsigned char* y = has[u] ? YE + ((size_t)(b * NE + e) * CAP + s) * D : YE;
#pragma unroll
                for (int j = 0; j < 4; ++j) yw[u][j] = *(const unsigned*)(y + j * 256 + lane * 4); }
#pragma unroll
            for (int u = 0; u < 4; ++u) { const float hs = has[u] ? 1.f : 0.f;
#pragma unroll
                for (int j = 0; j < 4; ++j) { const f32x2 lo_ = __builtin_amdgcn_cvt_pk_f32_fp8((int)yw[u][j], false), hi_ = __builtin_amdgcn_cvt_pk_f32_fp8((int)yw[u][j], true);
                    acc[4 * j] += hs * lo_[0]; acc[4 * j + 1] += hs * lo_[1]; acc[4 * j + 2] += hs * hi_[0]; acc[4 * j + 3] += hs * hi_[1]; } }
        }
        float ss = 0.f;
#pragma unroll
        for (int j = 0; j < 4; ++j) {
#pragma unroll
            for (int e = 0; e < 4; ++e) { v[j][e] += m4[j][e] * (acc[4 * j + e] * 0.0625f); ss += v[j][e] * v[j][e]; } }
        const float rstd = rsqrtf(wave_sum(ss) * (1.0f / D) + EPS);
        float* xr = p.out + (size_t)row * D;
#pragma unroll
        for (int j = 0; j < 4; ++j) *(f32x4*)(xr + j * 256 + lane * 4) = v[j] * rstd * fw[j];
        FN_TAKE();
    }
#undef FN_TAKE
#undef FN_LOAD
}
}

constexpr int RING_OFF = 0, RING_BYTES = 131072;
constexpr int GTAB_OFF = RING_BYTES;
constexpr int MISC_OFF = RING_BYTES + 12288;
constexpr int LDS_BYTES = 147456;
constexpr int CW_BAR = 4096;

#define RLX_AGENT __ATOMIC_RELAXED, __HIP_MEMORY_SCOPE_AGENT
#define XB_TMO      128
#define XB_XCNT(j)  (256  + 64 * (j))
#define XB_XSUB(j)  (1280 + 64 * (j))
#define XB_XGEN(j)  (2304 + 64 * (j))
#define XB_TOP      3328
#define XB_TOPGEN   3392
#define XCD_BAR_WORDS 3456
#define XB_SPIN_CAP (1u << 18)
__device__ __forceinline__ unsigned xb_ld(unsigned* p)              { return __hip_atomic_load(p, __ATOMIC_RELAXED, __HIP_MEMORY_SCOPE_AGENT); }
__device__ __forceinline__ unsigned xb_add(unsigned* p, unsigned v) { return __hip_atomic_fetch_add(p, v, __ATOMIC_RELAXED, __HIP_MEMORY_SCOPE_AGENT); }
__device__ __forceinline__ unsigned xb_xcc_id() { return (unsigned)__builtin_amdgcn_s_getreg((3 << 11) | 20) & 0xFu; }
#define XB_SPIN(cond, bar) do { unsigned _sp = 0; while (cond) { __builtin_amdgcn_s_sleep(1); \
    if ((++_sp & 255u) == 0u) { if (xb_ld(&(bar)[XB_TMO])) break; if (_sp > XB_SPIN_CAP) { atomicAdd(&(bar)[XB_TMO], 1u); break; } } } } while (0)
struct XcdBarrier { unsigned* bar; unsigned x; volatile LAS unsigned* st; };
__device__ __forceinline__ XcdBarrier xcd_barrier_post(unsigned* bar, volatile LAS unsigned* st) {
    XcdBarrier b; b.bar = bar; b.x = xb_xcc_id(); b.st = st;
    if (threadIdx.x == 0) (void)xb_add(&bar[XB_XCNT(b.x)], 1u);
    return b;
}
__device__ __forceinline__ void xcd_barrier_complete(unsigned* bar, unsigned x, unsigned& nloc, unsigned& nx) {
    const unsigned G = gridDim.x * gridDim.y * gridDim.z;
    unsigned sum, cnt, mine, sp = 0u;
    for (;;) {
        sum = 0u; cnt = 0u; mine = 0u;
#pragma unroll
        for (unsigned j = 0; j < 16; ++j) { const unsigned c = xb_ld(&bar[XB_XCNT(j)]); sum += c; cnt += (c > 0u) ? 1u : 0u; mine = (j == x) ? c : mine; }
        if (sum == G) break;
        __builtin_amdgcn_s_sleep(1);
        if ((++sp & 255u) == 0u) { if (xb_ld(&bar[XB_TMO])) break; if (sp > XB_SPIN_CAP) { atomicAdd(&bar[XB_TMO], 1u); break; } }
    }
    nloc = mine > 0u ? mine : 1u; nx = cnt > 0u ? cnt : 1u;
}
__device__ __forceinline__ void xcd_barrier(const XcdBarrier& b) {
    asm volatile("s_waitcnt vmcnt(0)" ::: "memory");
    __syncthreads();
    if (threadIdx.x == 0) {
        unsigned* bar = b.bar;
        __builtin_amdgcn_s_waitcnt(0);
        unsigned nloc = b.st[0], nx = b.st[1];
        if (nloc == 0u) { xcd_barrier_complete(bar, b.x, nloc, nx); b.st[0] = nloc; b.st[1] = nx; }
        const unsigned old = xb_add(&bar[XB_XSUB(b.x)], 1u);
        const unsigned gen = old / nloc;
        if (old + 1u == (gen + 1u) * nloc) {
            __builtin_amdgcn_fence(__ATOMIC_RELEASE, "agent");
            asm volatile("s_waitcnt vmcnt(0)" ::: "memory");
            const unsigned og = xb_add(&bar[XB_TOP], 1u);
            const unsigned tg = og / nx;
            if (og + 1u == (tg + 1u) * nx) xb_add(&bar[XB_TOPGEN], 1u);
            else XB_SPIN(xb_ld(&bar[XB_TOPGEN]) == tg, bar);
            __builtin_amdgcn_fence(__ATOMIC_ACQUIRE, "agent");
            xb_add(&bar[XB_XGEN(b.x)], 1u);
            asm volatile("s_waitcnt vmcnt(0)" ::: "memory");
        } else {
            XB_SPIN(xb_ld(&bar[XB_XGEN(b.x)]) == gen, bar);
            __builtin_amdgcn_fence(__ATOMIC_ACQUIRE, "agent");
            asm volatile("s_waitcnt vmcnt(0)" ::: "memory");
        }
    }
    __syncthreads();
}

struct Args { Ptrs p; int ph_lo, ph_hi, dbg, pad; };

#ifndef CONV_SPLIT_V
#define CONV_SPLIT_V 4096
#endif
#ifndef CONV_TAIL_V
#define CONV_TAIL_V 4096
#endif
__global__ void __launch_bounds__(NTHR, 2) mk_fwd(Args args) {
    extern __shared__ __attribute__((aligned(16))) unsigned char lds_raw[];
    LAS unsigned char* lds = (LAS unsigned char*)lds_raw;
    volatile LAS unsigned* MISC = (volatile LAS unsigned*)(lds + MISC_OFF);
    const Ptrs& p = args.p;
    unsigned char* ws = p.ws;
    const int tid = threadIdx.x, G = gridDim.x, bx = blockIdx.x;
    for (int u = tid; u < (LDS_BYTES - MISC_OFF) / 4; u += NTHR) ((LAS unsigned*)(lds + MISC_OFF))[u] = 0u;
    __syncthreads();
    const int lo = args.ph_lo, hi = args.ph_hi;
#ifndef REPS_LIST
#define REPS_LIST 1, 1, 1, 1, 1, 1, 1, 1, 1, 1, 1, 1
#endif
    constexpr int reps_tab[12] = {REPS_LIST};
    constexpr int CONV_SPLIT = CONV_SPLIT_V;
    constexpr int CONV_TAIL = CONV_TAIL_V;
    constexpr int P2_UNITS = (NROWS / 256) * (NPROJ_PAD / 256), P2_FULL = P2_UNITS - (P2_UNITS / 256) * 256;
    XcdBarrier bar; bar.bar = (unsigned*)ws + CW_BAR; bar.x = 0; bar.st = nullptr;
    if (hi - lo > 1) bar = xcd_barrier_post((unsigned*)ws + CW_BAR, MISC + 8);
#define IN(k) (lo <= (k) && (k) < hi)
#define SEAM(k) do { if (IN(k) && IN((k) + 1)) xcd_barrier(bar); } while (0)

    const int wv = __builtin_amdgcn_readfirstlane(tid >> 6), ln = tid & 63, gw = bx * NWAVES + wv, NGW = G * NWAVES;
    if (IN(0)) {
        for (int cb = bx; cb < 256; cb += G) misc::p0_mod(p, lds, cb);
        LAS float* scr = (LAS float*)(lds + wv * misc::TSCR);
        for (int it = gw; it < misc::IT_P0; it += NGW) misc::conv_item_p0(p, it, scr, ln);
    }
    if constexpr (reps_tab[0] > 1) { xcd_barrier(bar);
    if (IN(0)) {
        for (int cb = bx; cb < 256; cb += G) misc::p0_mod(p, lds, cb);
        LAS float* scr = (LAS float*)(lds + wv * misc::TSCR);
        for (int it = gw; it < misc::IT_P0; it += NGW) misc::conv_item_p0(p, it, scr, ln);
    }
    }
    SEAM(0);
    if (IN(1)) { misc::h_rows(p, gw, NGW, ln); }
    if constexpr (reps_tab[1] > 1) { xcd_barrier(bar);
    if (IN(1)) { misc::h_rows(p, gw, NGW, ln); }
    }
    SEAM(1);
    if (IN(2)) {
        pg8::Gemm g{(const bf16_t*)(ws + WS_H), (const bf16_t*)(ws + WS_WIN), D};
        pg8::StaticOrder S; S.init(NROWS / 256, NPROJ_PAD / 256, G, bx);
        pg8::EpiProj E{(bf16_t*)(ws + WS_P), (float*)(ws + WS_GZ), (const float*)(ws + WS_ROPE)};
        pg8::gemm_phase<pg8::EpiProj, pg8::StaticOrder, false>(lds + RING_OFF, g, S, E, nullptr);
        if (CONV_TAIL > 0 && bx >= P2_FULL) { LAS float* scr = (LAS float*)(lds + wv * misc::TSCR);
            for (int it = misc::IT_EXP - CONV_TAIL + (bx - P2_FULL) * NWAVES + wv; it < misc::IT_EXP; it += (G - P2_FULL) * NWAVES) misc::conv_item_exp(p, it, scr, ln); }
    }
    if constexpr (reps_tab[2] > 1) { xcd_barrier(bar);
    if (IN(2)) {
        pg8::Gemm g{(const bf16_t*)(ws + WS_H), (const bf16_t*)(ws + WS_WIN), D};
        pg8::StaticOrder S; S.init(NROWS / 256, NPROJ_PAD / 256, G, bx);
        pg8::EpiProj E{(bf16_t*)(ws + WS_P), (float*)(ws + WS_GZ), (const float*)(ws + WS_ROPE)};
        pg8::gemm_phase<pg8::EpiProj, pg8::StaticOrder, false>(lds + RING_OFF, g, S, E, nullptr);
    }
    }
    SEAM(2);
    if (IN(3)) {
        scan::run_c1(p, lds, bx);
    }
    SEAM(3);
    if (IN(4)) {
        scan::run_c2(p, lds, bx);
    }
    if constexpr (reps_tab[3] > 1) { xcd_barrier(bar);
    if (IN(3)) {
        scan::run_c1(p, lds, bx);
    }
    SEAM(3);
    if (IN(4)) {
        scan::run_c2(p, lds, bx);
    }
    }
    SEAM(4);
    if (IN(5)) {
        scan::run_c3(p, lds, bx, (bf16_t*)(ws + WS_H));
    }
    if constexpr (reps_tab[5] > 1) { xcd_barrier(bar);
    if (IN(5)) {
        scan::run_c3(p, lds, bx, (bf16_t*)(ws + WS_H));
    }
    }
    SEAM(5);
    if (IN(6)) {
        pg8::Gemm g{(const bf16_t*)(ws + WS_H), (const bf16_t*)(ws + WS_WOUT), D};
        pg8::StaticOrder S; S.init(NLAT / 256, D / 256, G, bx);
        pg8::EpiOut E{(bf16_t*)(ws + WS_XO), (const float*)(ws + WS_MOD)};
        pg8::gemm_phase<pg8::EpiOut, pg8::StaticOrder, false>(lds + RING_OFF, g, S, E, nullptr);
    }
    if constexpr (reps_tab[6] > 1) { xcd_barrier(bar);
    if (IN(6)) {
        pg8::Gemm g{(const bf16_t*)(ws + WS_H), (const bf16_t*)(ws + WS_WOUT), D};
        pg8::StaticOrder S; S.init(NLAT / 256, D / 256, G, bx);
        pg8::EpiOut E{(bf16_t*)(ws + WS_XO), (const float*)(ws + WS_MOD)};
        pg8::gemm_phase<pg8::EpiOut, pg8::StaticOrder, false>(lds + RING_OFF, g, S, E, nullptr);
    }
    }
    SEAM(6);
    if (IN(7)) {
        misc::stage_router(p, (LAS float*)lds, tid); __syncthreads();
        misc::norm2_router_rows(p, (const LAS float*)lds, gw, NGW, ln);
        __syncthreads();
        LAS float* scr = (LAS float*)(lds + wv * misc::TSCR);
        for (int it = gw; it < CONV_SPLIT; it += NGW) misc::conv_item_exp(p, it, scr, ln);
    }
    if constexpr (reps_tab[7] > 1) { xcd_barrier(bar);
    if (IN(7)) {
        misc::stage_router(p, (LAS float*)lds, tid); __syncthreads();
        misc::norm2_router_rows(p, (const LAS float*)lds, gw, NGW, ln);
        __syncthreads();
        LAS float* scr = (LAS float*)(lds + wv * misc::TSCR);
        for (int it = gw; it < CONV_SPLIT; it += NGW) misc::conv_item_exp(p, it, scr, ln);
    }
    }
    SEAM(7);
    if (IN(8)) { if (bx < 32) misc::topk_set(p, lds, bx);
        else { LAS float* scr = (LAS float*)(lds + wv * misc::TSCR); for (int it = CONV_SPLIT + (bx - 32) * NWAVES + wv; it < misc::IT_EXP - CONV_TAIL; it += (G - 32) * NWAVES) misc::conv_item_exp(p, it, scr, ln); } }
    if constexpr (reps_tab[8] > 1) { xcd_barrier(bar);
    if (IN(8)) { if (bx < 32) misc::topk_set(p, lds, bx);
        else { LAS float* scr = (LAS float*)(lds + wv * misc::TSCR); for (int it = CONV_SPLIT + (bx - 32) * NWAVES + wv; it < misc::IT_EXP - CONV_TAIL; it += (G - 32) * NWAVES) misc::conv_item_exp(p, it, scr, ln); } }
    }
    SEAM(8);
    if (IN(9)) {
        LAS unsigned* gtab = (LAS unsigned*)(lds + GTAB_OFF);
        pg8::MoeUpOrder S{bx};
        const int* IDX = (const int*)(ws + WS_IDX);
        { int idxv[6];
#pragma unroll
          for (int q6 = 0; q6 < 6; ++q6) { const int e = tid + q6 * NTHR, ec = e < 11 * 256 ? e : 11 * 256 - 1; pg8::Unit u; S.next(ec >> 8, u); idxv[q6] = IDX[u.pm * 256 + (ec & 255)]; }
#pragma unroll
          for (int q6 = 0; q6 < 6; ++q6) { const int e = tid + q6 * NTHR; if (e < 11 * 256) { pg8::Unit u; S.next(e >> 8, u); gtab[e] = (unsigned)((u.pm >> 7) * SEQ + (idxv[q6] & (SEQ - 1))) * (unsigned)D; } } }
        __syncthreads();
        pg8::Gemm g{(const bf16_t*)(ws + WS_H), (const bf16_t*)(ws + WS_WGU), D};
        pg8::EpiAct E{(unsigned char*)(ws + WS_ACT), 1.0f / 32.0f, 8.0f};
        pg8::gemm_phase<pg8::EpiAct, pg8::MoeUpOrder, true, true>(lds + RING_OFF, g, S, E, gtab);
    }
    if constexpr (reps_tab[9] > 1) { xcd_barrier(bar);
    if (IN(9)) {
        LAS unsigned* gtab = (LAS unsigned*)(lds + GTAB_OFF);
        pg8::MoeUpOrder S{bx};
        const int* IDX = (const int*)(ws + WS_IDX);
        { int idxv[6];
#pragma unroll
          for (int q6 = 0; q6 < 6; ++q6) { const int e = tid + q6 * NTHR, ec = e < 11 * 256 ? e : 11 * 256 - 1; pg8::Unit u; S.next(ec >> 8, u); idxv[q6] = IDX[u.pm * 256 + (ec & 255)]; }
#pragma unroll
          for (int q6 = 0; q6 < 6; ++q6) { const int e = tid + q6 * NTHR; if (e < 11 * 256) { pg8::Unit u; S.next(e >> 8, u); gtab[e] = (unsigned)((u.pm >> 7) * SEQ + (idxv[q6] & (SEQ - 1))) * (unsigned)D; } } }
        __syncthreads();
        pg8::Gemm g{(const bf16_t*)(ws + WS_H), (const bf16_t*)(ws + WS_WGU), D};
        pg8::EpiAct E{(unsigned char*)(ws + WS_ACT), 1.0f / 32.0f, 8.0f};
        pg8::gemm_phase<pg8::EpiAct, pg8::MoeUpOrder, true, true>(lds + RING_OFF, g, S, E, gtab);
    }
    }
    SEAM(9);
    if (IN(10)) {
        pg8::MoeDownOrder S{bx};
        pg8::Gemm g{(const bf16_t*)(ws + WS_ACT), (const bf16_t*)((const unsigned char*)p.out + OUT_WD), FFP};
        pg8::EpiDown E{(unsigned char*)(ws + WS_YE), (const float*)(ws + WS_GATE), 16.0f / 256.0f};
        pg8::gemm_phase<pg8::EpiDown, pg8::MoeDownOrder, false, true>(lds + RING_OFF, g, S, E, nullptr);
    }
    if constexpr (reps_tab[10] > 1) { xcd_barrier(bar);
    if (IN(10)) {
        pg8::MoeDownOrder S{bx};
        pg8::Gemm g{(const bf16_t*)(ws + WS_ACT), (const bf16_t*)((const unsigned char*)p.out + OUT_WD), FFP};
        pg8::EpiDown E{(unsigned char*)(ws + WS_YE), (const float*)(ws + WS_GATE), 16.0f / 256.0f};
        pg8::gemm_phase<pg8::EpiDown, pg8::MoeDownOrder, false, true>(lds + RING_OFF, g, S, E, nullptr);
    }
    }
    SEAM(10);
    if (IN(11)) { misc::final_rows(p, gw, NGW, ln); }
#undef IN
#undef SEAM
}

#ifndef USE_COOP
#define USE_COOP 1
#endif
extern "C" void kernel_launch(void* const* d_in, const int* in_sizes, int n_in, void* d_out, int out_size, void* d_ws, size_t ws_size, hipStream_t stream) {
    static int ready = 0;
    if (!ready) {
        if (n_in != 20 || in_sizes[0] != NLAT * D || out_size != NLAT * D || ws_size < WS_END) { fprintf(stderr, "kernel_launch: unexpected problem (n_in %d, out %d, ws %zu); nothing launched\n", n_in, out_size, ws_size); ready = -1; return; }
        if (hipFuncSetAttribute((const void*)mk_fwd, hipFuncAttributeMaxDynamicSharedMemorySize, LDS_BYTES) != hipSuccess) { fprintf(stderr, "kernel_launch: hipFuncSetAttribute failed\n"); ready = -1; return; }
        int dev = 0, cus = 0, per_cu = 0;
        (void)hipGetDevice(&dev); (void)hipDeviceGetAttribute(&cus, hipDeviceAttributeMultiprocessorCount, dev);
        (void)hipOccupancyMaxActiveBlocksPerMultiprocessor(&per_cu, (const void*)mk_fwd, NTHR, LDS_BYTES);
        if (cus * per_cu < 256) { fprintf(stderr, "kernel_launch: this kernel needs 256 co-resident workgroups (device reports %d CUs x %d); nothing launched\n", cus, per_cu); ready = -1; return; }
        ready = 1;
    }
    if (ready < 0) return;
    Args a{};
    const float** f = (const float**)&a.p;
    for (int i = 0; i < 20; ++i) f[i] = (const float*)d_in[i];
    a.p.out = (float*)d_out; a.p.ws = (unsigned char*)d_ws; a.ph_lo = 0; a.ph_hi = 12;
    (void)hipMemsetAsync((char*)d_ws + WS_CTL, 0, 64 * 1024, stream);
    void* args[] = {&a};
#if USE_COOP
    const hipError_t e = hipLaunchCooperativeKernel((const void*)mk_fwd, dim3(256), dim3(NTHR), args, LDS_BYTES, stream);
#else
    const hipError_t e = hipLaunchKernel((const void*)mk_fwd, dim3(256), dim3(NTHR), args, LDS_BYTES, stream);
#endif
    if (e != hipSuccess) fprintf(stderr, "kernel_launch: launch failed: %s\n", hipGetErrorString(e));
}
```

```cpp
#include <hip/hip_runtime.h>
#include <stdint.h>
#include <stdio.h>

typedef unsigned short bf16_t;
typedef unsigned int u32;

constexpr int D = 1024, BATCH = 2, SEQ = 16384, CTX = 256;
constexpr int NLAT = BATCH * SEQ;
constexpr int NCTX = BATCH * CTX;
constexpr int NROWS = NLAT + NCTX;
constexpr int NADA = 6;
constexpr int NE = 16, CAP = 2048, FF = 1408, FFP = 1536;
constexpr int NSLOT = BATCH * NE * CAP;
constexpr float EPS = 1e-6f;
constexpr int C_GQ = 0, C_GK = 256, C_GV = 512, C_GG = 1024, C_RQ = 1536, C_RK = 2048, C_RV = 2560, C_RG = 3072, C_GZ = 3584;
constexpr int PW = 3584;
constexpr int NPROJ = 3616, NPROJ_PAD = 3840;
__host__ __device__ __forceinline__ size_t ptile(int row, int col) { return ((size_t)((row >> 6) * 28 + (col >> 7)) * 64 + (row & 63)) * 128 + (col & 127); }

constexpr size_t MiB = 1u << 20;
constexpr size_t WS_CTL = 0;
constexpr size_t WS_MOD = 1 * MiB;
constexpr size_t WS_ROPE = WS_MOD + 128 * 1024;
constexpr size_t WS_DCH = 2 * MiB;
constexpr size_t WS_WIN = 4 * MiB;
constexpr size_t WS_WOUT = 12 * MiB;
constexpr size_t WS_GZ = 14 * MiB;
constexpr size_t WS_H = 19 * MiB;
constexpr size_t WS_P = 84 * MiB;
constexpr size_t WS_US = 312 * MiB;
constexpr size_t WS_WGU = 84 * MiB;
constexpr size_t OUT_WD = 100 * MiB;
constexpr size_t WS_ACT = 216 * MiB;
constexpr size_t WS_XO = 312 * MiB;
constexpr size_t WS_AFF = 392 * MiB;
constexpr size_t WS_IDX = 394 * MiB;
constexpr size_t WS_GATE = 395 * MiB;
constexpr size_t WS_INV = 396 * MiB;
constexpr size_t WS_YE = 19 * MiB;
constexpr size_t WS_END = 508 * MiB;

__device__ __forceinline__ float bf2f(bf16_t v) { return __uint_as_float(((u32)v) << 16); }
__device__ __forceinline__ bf16_t f2bf(float f) { u32 u = __float_as_uint(f); return (bf16_t)((u + 0x7fffu + ((u >> 16) & 1u)) >> 16); }
__device__ __forceinline__ float siluf(float x) { return x / (1.0f + __expf(-x)); }
__device__ __forceinline__ float log_sigmoidf(float x) { return fminf(x, 0.f) - log1pf(__expf(-fabsf(x))); }
template <int CTRL, int RM> __device__ __forceinline__ float dppf(float v) { return __builtin_bit_cast(float, __builtin_amdgcn_update_dpp(0, __builtin_bit_cast(int, v), CTRL, RM, 0xF, false)); }
__device__ __forceinline__ float wave_sum(float v) {
    v += dppf<0xB1, 0xF>(v);
    v += dppf<0x4E, 0xF>(v);
    v += dppf<0x124, 0xF>(v);
    v += dppf<0x128, 0xF>(v);
    v += dppf<0x142, 0xA>(v);
    v += dppf<0x143, 0xC>(v);
    return __builtin_bit_cast(float, __builtin_amdgcn_readlane(__builtin_bit_cast(int, v), 63));
}
template <int CTRL, int RM> __device__ __forceinline__ float dppk(float v) { return __builtin_bit_cast(float, __builtin_amdgcn_update_dpp(__builtin_bit_cast(int, v), __builtin_bit_cast(int, v), CTRL, RM, 0xF, false)); }
__device__ __forceinline__ float wave_max(float v) {
    v = fmaxf(v, dppk<0xB1, 0xF>(v)); v = fmaxf(v, dppk<0x4E, 0xF>(v)); v = fmaxf(v, dppk<0x124, 0xF>(v)); v = fmaxf(v, dppk<0x128, 0xF>(v));
    v = fmaxf(v, dppk<0x142, 0xA>(v)); v = fmaxf(v, dppk<0x143, 0xC>(v));
    return __builtin_bit_cast(float, __builtin_amdgcn_readlane(__builtin_bit_cast(int, v), 63));
}
__host__ __device__ inline int proj_src_col(int n) {
    if (n < 1024) return n;
    if (n < 1536) return 1056 + (n - 1024);
    if (n < 2560) {
        const int base = (n < 2048) ? 1568 : 2080, m = (n < 2048) ? n - 1536 : n - 2048;
        const int hd = m >> 7, p = m & 127, g = p >> 3, nn = (p >> 2) & 1, e = p & 3;
        return base + hd * 128 + 64 * nn + 4 * g + e;
    }
    if (n < 3072) return 2592 + (n - 2560);
    if (n < 3584) return 3104 + (n - 3072);
    return 1024 + (n - 3584);
}

struct Ptrs {
    const float *x, *c, *ctx, *c_ctx, *w_ada, *b_ada, *norm1_w, *w_in, *gla_gate_w, *gla_gate_b, *ret_decay_logit, *gla_norm_w, *ret_norm_w,
        *w_out, *norm2_w, *w_router, *w_exp_gate, *w_exp_up, *w_exp_down, *final_norm_w;
    float* out;
    unsigned char* ws;
};


constexpr int NWAVES = 8, NTHR = NWAVES * 64;
#define LAS __attribute__((address_space(3)))
#define GAS __attribute__((address_space(1)))
typedef short bf16x8 __attribute__((ext_vector_type(8)));
typedef float f32x4 __attribute__((ext_vector_type(4)));
typedef float f32x2 __attribute__((ext_vector_type(2)));
typedef unsigned u32x4 __attribute__((ext_vector_type(4)));
typedef unsigned u32x2 __attribute__((ext_vector_type(2)));
typedef int i32x4 __attribute__((ext_vector_type(4)));
typedef int i32x8 __attribute__((ext_vector_type(8)));
#ifndef PG8_RELAX
#define PG8_RELAX 1
#ifndef PG8_RELAXW
#define PG8_RELAXW 0
#endif
#endif
#ifndef PG8_ALIGN_DEFAULT
#define PG8_ALIGN_DEFAULT true
#endif
namespace pg8 {
constexpr int BM = 256, BK = 64, HALF = 128, HTB = HALF * BK * 2  , STAGE_BYTES = 8 * HTB, NXCD = 8, WGM = 8;
__host__ __device__ __forceinline__ int lds_byte(int r, int c) { const int st = (r >> 4) * 2 + (c >> 5), rr = r & 15, cc = c & 31, ob = rr * 64 + cc * 2; return st * 1024 + (ob ^ (((ob >> 9) & 1) << 5)); }
__host__ __device__ __forceinline__ void stage_rc(int b, int& R, int& C) { const int st = b / 1024, sb = b % 1024, swz = sb ^ (((sb >> 9) & 1) << 5); R = (st >> 1) * 16 + swz / 64; C = (st & 1) * 32 + (swz % 64) / 2; }
__host__ __device__ __forceinline__ int perm32(int rho) { const int n = rho >> 4, i = rho & 15; return 8 * (i >> 2) + 4 * n + (i & 3); }

struct Unit { int pm, pn; };
struct Gemm { const bf16_t* A; const bf16_t* Bt; int K; };

struct StaticOrder {
    int nM, nN, nwg, G, c;
    __device__ void init(int nM_, int nN_, int G_, int c_) { nM = nM_; nN = nN_; nwg = nM * nN; G = G_; c = c_; }
    __device__ bool next(int i, Unit& u) const {
        const long L = (long)i * G + c; if (L >= nwg) return false;
        int wgid = (int)L; { const int q = nwg / NXCD, r = nwg % NXCD, xcd = wgid % NXCD, off = wgid / NXCD; wgid = (xcd < r ? xcd * (q + 1) : r * (q + 1) + (xcd - r) * q) + off; }
        const int nig = WGM * nN, gid = wgid / nig, fm = gid * WGM, gsz = (nM - fm) < WGM ? (nM - fm) : WGM;
        u.pm = fm + ((wgid % nig) % gsz); u.pn = (wgid % nig) / gsz; return true;
    }
};
struct MoeUpOrder {
    int c;
    __device__ bool next(int i, Unit& u) const {
        if (i >= 11) return false;
        const int g = i * 8 + (c & 7), j = c >> 3, combo = 4 * g + (j >> 3), mt = j & 7, be = combo / 11, pn = combo % 11;
        u.pm = be * 8 + mt; u.pn = (be & 15) * 11 + pn; return true;
    }
};
struct MoeDownOrder {
    int c;
    __device__ bool next(int i, Unit& u) const {
        if (i >= 4) return false;
        const int be = i * 8 + (c & 7), j = c >> 3, mt = j & 7, pn = j >> 3;
        u.pm = be * 8 + mt; u.pn = (be & 15) * 4 + pn; return true;
    }
};

__device__ __forceinline__ float fast_silu(float a) { return a * __builtin_amdgcn_rcpf(1.0f + __expf(-a)); }
typedef __bf16 bf16x2_t __attribute__((ext_vector_type(2)));
__device__ __forceinline__ unsigned cvt_pk_bf16(float lo, float hi) { const f32x2 v = {lo, hi}; const bf16x2_t r = __builtin_convertvector(v, bf16x2_t); return __builtin_bit_cast(unsigned, r); }

__device__ __forceinline__ unsigned pk_fp8x4(float a, float b, float c, float d) {
    a = __builtin_amdgcn_fmed3f(a, -448.f, 448.f); b = __builtin_amdgcn_fmed3f(b, -448.f, 448.f); c = __builtin_amdgcn_fmed3f(c, -448.f, 448.f); d = __builtin_amdgcn_fmed3f(d, -448.f, 448.f);
    int w = 0; w = __builtin_amdgcn_cvt_pk_fp8_f32(a, b, w, false); w = __builtin_amdgcn_cvt_pk_fp8_f32(c, d, w, true); return (unsigned)w;
}
template <class Epi, class Sched, bool GATHER, bool F8 = false, bool ALIGN_EPI = PG8_ALIGN_DEFAULT>
__device__ __forceinline__ void gemm_phase(LAS unsigned char* lds, const Gemm g, const Sched& S, const Epi& E, const LAS unsigned* gtab) {
    const int tid = threadIdx.x, wid = __builtin_amdgcn_readfirstlane(tid >> 6), lane = tid & 63, wr = wid >> 2, wc = wid & 3, fr = lane & 15, fq = lane >> 4;
    constexpr int ESZ = F8 ? 1 : 2;
    const int K = g.K, nt = K * ESZ / (BK * 2);
    int sR[2], sC[2];
    unsigned voffB[2], voffA[2];
#pragma unroll
    for (int i = 0; i < 2; ++i) { stage_rc(tid * 16 + i * 8192, sR[i], sC[i]); const int Rb = Epi::PERM ? ((sR[i] & ~31) + perm32(sR[i] & 31)) : sR[i];
        voffB[i] = (unsigned)(Rb * K * ESZ + sC[i] * 2); voffA[i] = (unsigned)(sR[i] * K * ESZ + sC[i] * 2); }
    const size_t kstep = (size_t)(BK * 2);
    const size_t hstep = (size_t)HALF * K * ESZ;
    const size_t tstep = 2 * hstep;
    const unsigned ldsw = (unsigned)wid * 1024u;
    const int aoff = lds_byte(wr * 64 + fr, fq * 8), boff = lds_byte(wc * 32 + fr, fq * 8);
    const int sw8 = (fq & 1) * 8;
    const int aoff8a = lds_byte(wr * 64 + fr, fq * 16 + sw8), aoff8b = lds_byte(wr * 64 + fr, fq * 16 + (8 - sw8)), boff8a = lds_byte(wc * 32 + fr, fq * 16 + sw8), boff8b = lds_byte(wc * 32 + fr, fq * 16 + (8 - sw8));
#define PG8_SA(b, h) (((b) * 2 + (h)) * HTB)
#define PG8_SB(b, h) ((4 + (b) * 2 + (h)) * HTB)
#define PG8_STAGE(bufoff, gbase, voff) do { _Pragma("unroll") for (int _i = 0; _i < 2; ++_i) \
        __builtin_amdgcn_global_load_lds((const unsigned*)((const char*)(gbase) + (voff)[_i]), (LAS unsigned*)(lds + (bufoff) + ldsw + _i * 8192), 16, 0, 0); } while (0)
#define PG8_LDA(dst, b, h) do { if constexpr (F8) { _Pragma("unroll") for (int m = 0; m < 4; ++m) { const i32x4 lo_ = *(const LAS i32x4*)(lds + PG8_SA(b, h) + aoff8a + m * 2048), hi_ = *(const LAS i32x4*)(lds + PG8_SA(b, h) + aoff8b + m * 2048); \
            dst##8[m] = __builtin_shufflevector(lo_, hi_, 0, 1, 2, 3, 4, 5, 6, 7); } } \
        else { _Pragma("unroll") for (int m = 0; m < 4; ++m) _Pragma("unroll") for (int k = 0; k < 2; ++k) dst[m][k] = *(const LAS bf16x8*)(lds + PG8_SA(b, h) + aoff + m * 2048 + k * 1024); } } while (0)
#define PG8_LDB(dst, b, h) do { if constexpr (F8) { _Pragma("unroll") for (int n = 0; n < 2; ++n) { const i32x4 lo_ = *(const LAS i32x4*)(lds + PG8_SB(b, h) + boff8a + n * 2048), hi_ = *(const LAS i32x4*)(lds + PG8_SB(b, h) + boff8b + n * 2048); \
            dst##8[n] = __builtin_shufflevector(lo_, hi_, 0, 1, 2, 3, 4, 5, 6, 7); } } \
        else { _Pragma("unroll") for (int n = 0; n < 2; ++n) _Pragma("unroll") for (int k = 0; k < 2; ++k) dst[n][k] = *(const LAS bf16x8*)(lds + PG8_SB(b, h) + boff + n * 2048 + k * 1024); } } while (0)
#define PG8_MMA(ai, bj, At, Bt) do { __builtin_amdgcn_s_setprio(1); if constexpr (F8) { _Pragma("unroll") for (int m = 0; m < 4; ++m) _Pragma("unroll") for (int n = 0; n < 2; ++n) \
            asm volatile("v_mfma_f32_16x16x128_f8f6f4 %0, %1, %2, %0" : "+v"(acc[ai][bj][m][n]) : "v"(Bt##8[n]), "v"(At##8[m])); } \
        else { _Pragma("unroll") for (int m = 0; m < 4; ++m) _Pragma("unroll") for (int n = 0; n < 2; ++n) _Pragma("unroll") for (int k = 0; k < 2; ++k) \
            acc[ai][bj][m][n] = __builtin_amdgcn_mfma_f32_16x16x32_bf16(Bt[n][k], At[m][k], acc[ai][bj][m][n], 0, 0, 0); } __builtin_amdgcn_s_setprio(0); } while (0)
#define PG8_WAIT_V(n) asm volatile("s_waitcnt vmcnt(" #n ")" ::: "memory")
#define PG8_WAIT_VX(rel_) do { if (rel_) asm volatile("s_waitcnt vmcnt(%0)" :: "n"(8 + Epi::NS) : "memory"); else asm volatile("s_waitcnt vmcnt(8)" ::: "memory"); } while (0)
#define PG8_WAIT_L(n) asm volatile("s_waitcnt lgkmcnt(" #n ")" ::: "memory")
#define PG8_BAR __builtin_amdgcn_s_barrier()
#define PG8_SCHED __builtin_amdgcn_sched_barrier(0)
#define PG8_HOFF(h) (GATHER ? (size_t)0 : (size_t)(h) * hstep)
#define PG8_STAGE_A(bufoff, base_, h_, uq_) do { if constexpr (GATHER) { unsigned vo_[2]; _Pragma("unroll") for (int _i = 0; _i < 2; ++_i) vo_[_i] = gtab[(uq_) * 256 + (h_) * HALF + sR[_i]] + (unsigned)sC[_i] * 2u; PG8_STAGE(bufoff, base_, vo_); } \
        else { PG8_STAGE(bufoff, (base_) + PG8_HOFF(h_), voffA); } } while (0)
    Unit cur, nxt; int ui = 0;
    if (!S.next(0, cur)) return;
    f32x4 acc[2][2][4][2];
#pragma unroll
    for (int a = 0; a < 2; ++a)
#pragma unroll
        for (int b = 0; b < 2; ++b)
#pragma unroll
            for (int m = 0; m < 4; ++m)
#pragma unroll
                for (int n = 0; n < 2; ++n) acc[a][b][m][n] = (f32x4){0.f, 0.f, 0.f, 0.f};
    bf16x8 At[4][2], B0[2][2], B1[2][2]; i32x8 At8[4], B08[2], B18[2];
    const char* cA = (const char*)g.A + (GATHER ? (size_t)0 : (size_t)cur.pm * tstep); const char* cB = (const char*)g.Bt + (size_t)cur.pn * tstep;
    PG8_STAGE(PG8_SB(0, 0), cB, voffB); PG8_STAGE(PG8_SB(0, 1), cB + hstep, voffB); PG8_STAGE_A(PG8_SA(0, 0), cA, 0, 0); PG8_STAGE_A(PG8_SA(0, 1), cA, 1, 0);
    if (wr == 1) PG8_BAR;
    PG8_WAIT_V(2); PG8_BAR;
    PG8_STAGE(PG8_SB(1, 0), cB + kstep, voffB); PG8_STAGE_A(PG8_SA(1, 0), cA + kstep, 0, 0); PG8_STAGE(PG8_SB(1, 1), cB + hstep + kstep, voffB);
    PG8_WAIT_V(6); PG8_BAR;
    bool relax = false;
    for (;;) {
        const bool has_next = S.next(ui + 1, nxt);
        const char* nA = GATHER ? cA : (has_next ? (const char*)g.A + (size_t)nxt.pm * tstep : cA); const char* nB = has_next ? (const char*)g.Bt + (size_t)nxt.pn * tstep : cB;
#pragma unroll 1
        for (int t = 0; t < nt; t += 2) {
            const bool last = (t == nt - 2);
            const bool fresh = ALIGN_EPI && Epi::NS > 0 && ui > 0 && t == 0;
            const bool rel = fresh && relax;
            const char* a1 = cA + (size_t)(t + 1) * kstep;
            const char* a2 = last ? nA : cA + (size_t)(t + 2) * kstep; const char* b2 = last ? nB : cB + (size_t)(t + 2) * kstep;
            const char* a3 = a2 + kstep; const char* b3 = b2 + kstep;
            const int uq = (last && has_next) ? ui + 1 : ui;
            PG8_LDB(B0, 0, 0); PG8_LDB(B1, 0, 1); PG8_SCHED; PG8_LDA(At, 0, 0); if (!fresh) PG8_STAGE_A(PG8_SA(1, 1), a1, 1, ui);
            PG8_WAIT_VX(rel); PG8_WAIT_L(0); PG8_BAR; PG8_MMA(0, 0, At, B0); PG8_MMA(0, 1, At, B1); PG8_BAR; PG8_SCHED;
            PG8_LDA(At, 0, 1); PG8_STAGE(PG8_SB(0, 0), b2, voffB); PG8_STAGE(PG8_SB(0, 1), b2 + hstep, voffB); PG8_STAGE_A(PG8_SA(0, 0), a2, 0, uq);
            PG8_WAIT_VX(rel); PG8_WAIT_L(0); PG8_BAR; PG8_MMA(1, 0, At, B0); PG8_MMA(1, 1, At, B1); PG8_BAR; PG8_SCHED;
            PG8_LDB(B0, 1, 0); PG8_LDB(B1, 1, 1); PG8_SCHED; PG8_LDA(At, 1, 0); PG8_STAGE_A(PG8_SA(0, 1), a2, 1, uq);
            PG8_WAIT_VX(rel); PG8_WAIT_L(0); PG8_BAR; PG8_MMA(0, 0, At, B0); PG8_MMA(0, 1, At, B1); PG8_BAR; PG8_SCHED;
            PG8_LDA(At, 1, 1); PG8_STAGE(PG8_SB(1, 0), b3, voffB); PG8_STAGE(PG8_SB(1, 1), b3 + hstep, voffB); PG8_STAGE_A(PG8_SA(1, 0), a3, 0, uq);
            PG8_WAIT_V(8); PG8_WAIT_L(0); PG8_BAR; PG8_MMA(1, 0, At, B0); PG8_MMA(1, 1, At, B1); PG8_BAR; PG8_SCHED;
        }
        if constexpr (ALIGN_EPI) { if (wr == 0) PG8_BAR; }
        if constexpr (ALIGN_EPI && Epi::NS > 0) {
            PG8_STAGE_A(PG8_SA(1, 1), nA + kstep, 1, (has_next ? ui + 1 : ui)); relax = PG8_RELAXW && E.stores_all(cur); }
        if constexpr (F8) { asm volatile("s_nop 15\n\ts_nop 15" ::: "memory"); PG8_SCHED; }
        E(acc, cur, ui, wr, wc, fr, fq);
        if (!has_next) break;
#pragma unroll
        for (int a = 0; a < 2; ++a)
#pragma unroll
            for (int b = 0; b < 2; ++b)
#pragma unroll
                for (int m = 0; m < 4; ++m)
#pragma unroll
                    for (int n = 0; n < 2; ++n) acc[a][b][m][n] = (f32x4){0.f, 0.f, 0.f, 0.f};
        cur = nxt; cA = nA; cB = nB; ++ui;
        if constexpr (ALIGN_EPI) { if (wr == 1) PG8_BAR; }
    }
    PG8_WAIT_V(0);
    if constexpr (!ALIGN_EPI) { if (wr == 0) PG8_BAR; }
    PG8_BAR;
#undef PG8_SA
#undef PG8_SB
#undef PG8_STAGE
#undef PG8_LDA
#undef PG8_LDB
#undef PG8_MMA
#undef PG8_WAIT_V
#undef PG8_WAIT_VX
#undef PG8_WAIT_L
#undef PG8_BAR
#undef PG8_SCHED
#undef PG8_STAGE_A
#undef PG8_HOFF
}


struct EpiProj {
    static constexpr bool PERM = true; static constexpr int NS = PG8_RELAX ? 16 : 0;
    __device__ __forceinline__ bool stores_all(const Unit& u) const { return u.pn != 14; }
    bf16_t* P; float* GZ; const float* tab;
    __device__ __forceinline__ void operator()(const f32x4 (&acc)[2][2][4][2], const Unit& u, int ui, int wr, int wc, int fr, int fq) const {
        const int pn = u.pn, row0 = u.pm * BM + wr * 64 + fr, colw = wc * 32 + 8 * fq;
        if (pn == 14) {
            if (wc == 0) {
#pragma unroll
                for (int ai = 0; ai < 2; ++ai)
#pragma unroll
                    for (int m = 0; m < 4; ++m) { float* o = GZ + (size_t)(row0 + ai * HALF + m * 16) * 32 + 8 * fq; *(f32x4*)o = acc[ai][0][m][0]; *(f32x4*)(o + 4) = acc[ai][0][m][1]; }
            }
            return;
        }
        const int mode = (pn == 0) ? 1 : ((pn >= 6 && pn <= 9) ? 3 : 0);
        const float rks = (pn >= 8) ? 0.08838834764831845f : 1.0f;
        const bool lowhalf = wc < 2;
        const int f0 = (16 * wc + 4 * fq) & 31;
        float invt[4];
#pragma unroll
        for (int e = 0; e < 4; ++e) invt[e] = __builtin_amdgcn_exp2f(-(float)(f0 + e) * (13.287712379549449f / 32.0f)) * 0.15915494309189535f;
#pragma unroll
        for (int ai = 0; ai < 2; ++ai)
#pragma unroll
            for (int m = 0; m < 4; ++m) {
                const int row = row0 + ai * HALF + m * 16;
                bf16_t* rowp = P + ptile(row, pn * BM + colw);
                float c[4] = {1.f, 1.f, 1.f, 1.f}, s[4] = {0.f, 0.f, 0.f, 0.f};
                if (mode == 3) { const int t = row & (SEQ - 1); const float pos = (row < NLAT) ? (float)(lowhalf ? (t >> 6) : (t & 63)) : 0.f;
#pragma unroll
                    for (int e = 0; e < 4; ++e) { const float tr = __builtin_amdgcn_fractf(pos * invt[e]); c[e] = __builtin_amdgcn_cosf(tr); s[e] = __builtin_amdgcn_sinf(tr); } }
#pragma unroll
                for (int bj = 0; bj < 2; ++bj) {
                    f32x4 v0 = acc[ai][bj][m][0], v1 = acc[ai][bj][m][1];
                    if (mode == 1) { v0 = v0 * 0.125f; v1 = v1 * 0.125f; }
                    else if (mode == 3) {
                        v0 = v0 * rks; v1 = v1 * rks;
#pragma unroll
                        for (int e = 0; e < 4; ++e) { const float a1 = v0[e], a2 = v1[e]; v0[e] = a1 * c[e] - a2 * s[e]; v1[e] = a1 * s[e] + a2 * c[e]; }
                    }
                    u32x4 w; w.x = cvt_pk_bf16(v0[0], v0[1]); w.y = cvt_pk_bf16(v0[2], v0[3]); w.z = cvt_pk_bf16(v1[0], v1[1]); w.w = cvt_pk_bf16(v1[2], v1[3]);
                    *(u32x4*)(rowp + bj * 8192) = w;
                }
            }
    }
};
struct EpiOut {
    static constexpr bool PERM = true; static constexpr int NS = PG8_RELAX ? 16 : 0;
    __device__ __forceinline__ bool stores_all(const Unit&) const { return true; }
    bf16_t* XO; const float* mod;
    __device__ __forceinline__ void operator()(const f32x4 (&acc)[2][2][4][2], const Unit& u, int ui, int wr, int wc, int fr, int fq) const {
        const int col0 = u.pn * BM + wc * 32 + 8 * fq, b = (u.pm * BM) / SEQ;
        const float* m2 = mod + b * NADA * D + 2 * D;
        f32x4 mv[2][2];
#pragma unroll
        for (int bj = 0; bj < 2; ++bj)
#pragma unroll
            for (int n = 0; n < 2; ++n) mv[bj][n] = *(const f32x4*)(m2 + col0 + bj * HALF + 4 * n);
#pragma unroll
        for (int ai = 0; ai < 2; ++ai)
#pragma unroll
            for (int m = 0; m < 4; ++m) { bf16_t* rowp = XO + (size_t)(u.pm * BM + ai * HALF + wr * 64 + m * 16 + fr) * D + col0;
#pragma unroll
                for (int bj = 0; bj < 2; ++bj) { const f32x4 v0 = mv[bj][0] * acc[ai][bj][m][0], v1 = mv[bj][1] * acc[ai][bj][m][1];
                    u32x4 w; w.x = cvt_pk_bf16(v0[0], v0[1]); w.y = cvt_pk_bf16(v0[2], v0[3]); w.z = cvt_pk_bf16(v1[0], v1[1]); w.w = cvt_pk_bf16(v1[2], v1[3]);
                    *(u32x4*)(rowp + bj * HALF) = w; } }
    }
};
struct EpiAct {
    static constexpr bool PERM = true; static constexpr int NS = PG8_RELAX ? 8 : 0;
    __device__ __forceinline__ bool stores_all(const Unit&) const { return true; }
    unsigned char* ACT; float wscale, ascale;
    __device__ __forceinline__ void operator()(const f32x4 (&acc)[2][2][4][2], const Unit& u, int ui, int wr, int wc, int fr, int fq) const {
        const int pnl = u.pn % 11, col0 = pnl * HALF + wc * 32 + 8 * fq;
        const float c1 = -1.4426950408889634f * wscale, kinv = 1.0f / (wscale * wscale * ascale);
#pragma unroll
        for (int ai = 0; ai < 2; ++ai)
#pragma unroll
            for (int m = 0; m < 4; ++m) { unsigned char* rowp = ACT + (size_t)(u.pm * BM + ai * HALF + wr * 64 + m * 16 + fr) * FFP;
                f32x4 v0, v1;
#pragma unroll
                for (int e = 0; e < 4; ++e) {
                    const float g0 = acc[ai][0][m][0][e], g1 = acc[ai][0][m][1][e];
                    v0[e] = (g0 * acc[ai][1][m][0][e]) * __builtin_amdgcn_rcpf(__builtin_fmaf(__builtin_amdgcn_exp2f(g0 * c1), kinv, kinv));
                    v1[e] = (g1 * acc[ai][1][m][1][e]) * __builtin_amdgcn_rcpf(__builtin_fmaf(__builtin_amdgcn_exp2f(g1 * c1), kinv, kinv)); }
                u32x2 w; w.x = pk_fp8x4(v0[0], v0[1], v0[2], v0[3]); w.y = pk_fp8x4(v1[0], v1[1], v1[2], v1[3]);
                *(u32x2*)(rowp + col0) = w;
                if (pnl == 10) *(u32x2*)(rowp + FF + wc * 32 + 8 * fq) = (u32x2){0u, 0u}; }
    }
};
struct EpiDown {
    static constexpr bool PERM = true; static constexpr int NS = PG8_RELAX ? 16 : 0;
    __device__ __forceinline__ bool stores_all(const Unit&) const { return true; }
    unsigned char* YE; const float* gate; float oscale;
    __device__ __forceinline__ void operator()(const f32x4 (&acc)[2][2][4][2], const Unit& u, int ui, int wr, int wc, int fr, int fq) const {
        const int col0 = (u.pn & 3) * BM + wc * 32 + 8 * fq;
        float gts[2][4];
#pragma unroll
        for (int ai = 0; ai < 2; ++ai)
#pragma unroll
            for (int m = 0; m < 4; ++m) gts[ai][m] = gate[u.pm * BM + ai * HALF + wr * 64 + m * 16 + fr];
#pragma unroll
        for (int ai = 0; ai < 2; ++ai)
#pragma unroll
            for (int m = 0; m < 4; ++m) { const int row = u.pm * BM + ai * HALF + wr * 64 + m * 16 + fr; const float gt = gts[ai][m] * oscale; unsigned char* rowp = YE + (size_t)row * D + col0;
#pragma unroll
                for (int bj = 0; bj < 2; ++bj) { const f32x4 v0 = acc[ai][bj][m][0] * gt, v1 = acc[ai][bj][m][1] * gt;
                    u32x2 w; w.x = pk_fp8x4(v0[0], v0[1], v0[2], v0[3]); w.y = pk_fp8x4(v1[0], v1[1], v1[2], v1[3]);
                    *(u32x2*)(rowp + bj * HALF) = w; } }
    }
};
}

namespace scan {
constexpr int RS = 72;
constexpr int RS2 = 136;
constexpr int OS = 132;
constexpr int NSL = 260;
constexpr size_t GLA_SLOT = 128 * 64, RET_SLOT = 128 * 128;
constexpr size_t US_RET_OFF = (size_t)16 * NSL * GLA_SLOT;
__device__ __forceinline__ int slot_row0(int b, int slot) { return slot < 4 ? NLAT + b * CTX + slot * 64 : b * SEQ + (slot - 4) * 64; }
__device__ __forceinline__ int slot_at(int dir, int step) { return dir ? (step < 4 ? 3 - step : 263 - step) : step; }
__device__ __forceinline__ f32x4 mfma16(bf16x8 a, bf16x8 b, f32x4 c) { return __builtin_amdgcn_mfma_f32_16x16x32_bf16(a, b, c, 0, 0, 0); }
__device__ __forceinline__ bf16x8 lds_frag(const LAS bf16_t* base, int off) { return *(const LAS bf16x8*)(base + off); }
__device__ __forceinline__ int tsw_w(int row, int j) { return row * RS + ((((j >> 3) ^ ((row >> 4) & 7)) << 3) | (j & 7)); }
__device__ __forceinline__ int tsw_r(int row, int chunk) { return row * RS + ((chunk ^ ((row >> 4) & 7)) << 3); }
__device__ __forceinline__ bf16x8 lds_frag_pi(const LAS bf16_t* base, int off  ) {
    typedef short s4 __attribute__((ext_vector_type(4)));
    const s4 lo = *(const LAS s4*)(base + off), hi = *(const LAS s4*)(base + off + 16);
    return (bf16x8){lo[0], lo[1], lo[2], lo[3], hi[0], hi[1], hi[2], hi[3]};
}
__device__ __forceinline__ unsigned pk(float lo, float hi) { return pg8::cvt_pk_bf16(lo, hi); }
__device__ __forceinline__ bf16_t f2bf_hw(float x) { return (bf16_t)(pg8::cvt_pk_bf16(x, 0.f) & 0xffffu); }
__device__ __forceinline__ float sum8(float v) { v += dppf<0xB1, 0xF>(v); v += dppf<0x4E, 0xF>(v); v += dppf<0x141, 0xF>(v); return v; }
__device__ __forceinline__ u32x2 pack_state8(const f32x4 a0, const f32x4 a1) { u32x2 o; o.x = pg8::pk_fp8x4(a0[0], a0[1], a0[2], a0[3]); o.y = pg8::pk_fp8x4(a1[0], a1[1], a1[2], a1[3]); return o; }
__device__ __forceinline__ bf16x8 unpack_state8(const u32x2 w) {
    const f32x2 a = __builtin_amdgcn_cvt_pk_f32_fp8((int)w.x, false), b = __builtin_amdgcn_cvt_pk_f32_fp8((int)w.x, true), c = __builtin_amdgcn_cvt_pk_f32_fp8((int)w.y, false), d = __builtin_amdgcn_cvt_pk_f32_fp8((int)w.y, true);
    const u32x4 r = {pk(a[0], a[1]), pk(b[0], b[1]), pk(c[0], c[1]), pk(d[0], d[1])};
    return __builtin_bit_cast(bf16x8, r);
}

typedef float f32x4m __attribute__((ext_vector_type(4)));
__device__ __forceinline__ void gla_stepA(const float (&wm)[2][2][4], float bf, float bb, int w, int lane, const LAS float* gz_s, LAS float* PR, LAS float* tot, float (&bi)[8], float (&ci)[8], float& allf, float& allb) {
    { const int it = w >> 1, c = lane & 15, q = lane >> 4;
      float a_f[4], a_b[4];
#pragma unroll
      for (int sx = 0; sx < 4; ++sx) { a_f[sx] = gz_s[(16 * it + c) * 36 + 4 * sx + q]; a_b[sx] = gz_s[(16 * it + c) * 36 + 16 + 4 * sx + q]; }
#pragma unroll
      for (int kk = 0; kk < 2; ++kk) { const int kt = 2 * (w & 1) + kk; f32x4 df = {0.f, 0.f, 0.f, 0.f}, db = {0.f, 0.f, 0.f, 0.f};
#pragma unroll
          for (int sx = 0; sx < 4; ++sx) { df = __builtin_amdgcn_mfma_f32_16x16x4f32(a_f[sx], wm[0][kk][sx], df, 0, 0, 0); db = __builtin_amdgcn_mfma_f32_16x16x4f32(a_b[sx], wm[1][kk][sx], db, 0, 0, 0); }
#pragma unroll
          for (int r = 0; r < 4; ++r) { PR[(16 * it + 4 * q + r) * 65 + 16 * kt + c] = df[r]; PR[64 * 65 + (16 * it + 4 * q + r) * 65 + 16 * kt + c] = db[r]; } } }
    __syncthreads();
    float laf[8], lab[8];
#pragma unroll
    for (int tt = 0; tt < 8; ++tt) {
        const float pf = bf + PR[(8 * w + tt) * 65 + lane], pb = bb + PR[64 * 65 + (8 * w + tt) * 65 + lane];
        laf[tt] = (fminf(pf, 0.f) - 0.6931471805599453f * __builtin_amdgcn_logf(1.0f + __builtin_amdgcn_exp2f(-1.4426950408889634f * fabsf(pf)))) * 0.0625f;
        lab[tt] = (fminf(pb, 0.f) - 0.6931471805599453f * __builtin_amdgcn_logf(1.0f + __builtin_amdgcn_exp2f(-1.4426950408889634f * fabsf(pb)))) * 0.0625f;
    }
#pragma unroll
    for (int tt = 1; tt < 8; ++tt) laf[tt] += laf[tt - 1];
#pragma unroll
    for (int tt = 6; tt >= 0; --tt) lab[tt] += lab[tt + 1];
    tot[w * 64 + lane] = laf[7]; tot[512 + w * 64 + lane] = lab[0];
    __syncthreads();
    float offf = 0.f, offb = 0.f; allf = 0.f; allb = 0.f;
#pragma unroll
    for (int w2 = 0; w2 < 8; ++w2) { const float tf = tot[w2 * 64 + lane], tb = tot[512 + w2 * 64 + lane]; allf += tf; allb += tb; if (w2 < w) offf += tf; if (w2 > w) offb += tb; }
#pragma unroll
    for (int tt = 0; tt < 8; ++tt) { bi[tt] = offf + laf[tt]; ci[tt] = offb + lab[tt]; }
}
__device__ __forceinline__ void load_gate_wm(const Ptrs& p, int h, int w, int lane, float (&wm)[2][2][4]) {
#pragma unroll
    for (int dir = 0; dir < 2; ++dir)
#pragma unroll
        for (int kk = 0; kk < 2; ++kk)
#pragma unroll
            for (int sx = 0; sx < 4; ++sx) wm[dir][kk][sx] = p.gla_gate_w[(dir * 16 + 4 * sx + (lane >> 4)) * 256 + h * 64 + 16 * (2 * (w & 1) + kk) + (lane & 15)];
}
__device__ __forceinline__ int img_off(int row, int ch) { return 256 * row + 16 * (ch ^ (((row & 3) << 2) | ((row >> 2) & 3))); }
__device__ __forceinline__ void stage_vt_regs(const u32x4 a, const u32x4 b, LAS bf16_t* VT, int tid) {
    const int j = tid >> 3, vg = tid & 7; LAS unsigned char* img = (LAS unsigned char*)VT;
    *(LAS u32x4*)(img + img_off(j, vg)) = a; *(LAS u32x4*)(img + img_off(j, 8 + vg)) = b;
}
typedef short s16x4 __attribute__((ext_vector_type(4)));
__device__ __forceinline__ bf16x8 tr_frag(const LAS bf16_t* T, int lane, int cb, int ks) {
    const LAS unsigned char* img = (const LAS unsigned char*)T;
    const int g = lane >> 4, qq = (lane & 15) >> 2, pp = lane & 3, r0 = 32 * ks + 8 * g + qq, ch = 2 * cb + (pp >> 1);
    const s16x4 lo = __builtin_amdgcn_ds_read_tr16_b64_v4i16((LAS s16x4*)(img + img_off(r0, ch) + 8 * (pp & 1)));
    const s16x4 hi = __builtin_amdgcn_ds_read_tr16_b64_v4i16((LAS s16x4*)(img + img_off(r0 + 4, ch) + 8 * (pp & 1)));
    return (bf16x8){lo[0], lo[1], lo[2], lo[3], hi[0], hi[1], hi[2], hi[3]};
}
#ifndef S_F8_GLA
#define S_F8_GLA 1
#endif
#ifndef S_F8_RET
#define S_F8_RET 1
#endif
#ifndef C1G_REP
#define C1G_REP 1
#endif
#ifndef C1R_REP
#define C1R_REP 1
#endif
#define SCAN_FENCE() asm volatile("" ::: "memory")

__device__ __forceinline__ void run_c1(const Ptrs& p, LAS unsigned char* lds, int bx) {
    const int tid = threadIdx.x, w = __builtin_amdgcn_readfirstlane(tid >> 6), lane = tid & 63, c = lane & 15, q = lane >> 4;
    const int bh = bx >> 5, b = bh >> 2, h = bh & 3, s0 = bx & 31;
    const bf16_t* P = (const bf16_t*)(p.ws + WS_P);
    const int jrow = tid >> 3, g8 = tid & 7;
#define C1_DUMMY(n_, g_) do { _Pragma("unroll") for (int d_ = 0; d_ < (n_); ++d_) *(u32x2*)(p.ws + 524288 + ((g_) * 8 + d_) * 4096 + tid * 8) = (u32x2){0u, 0u}; } while (0)
    {
        LAS float* gz_s = (LAS float*)lds; LAS float* tot = (LAS float*)(lds + 91648); LAS float* PR = (LAS float*)(lds + 58368);
        LAS bf16_t* KfT = (LAS bf16_t*)(lds + 12288); LAS bf16_t* KbT = (LAS bf16_t*)(lds + 21504); LAS bf16_t* VT = (LAS bf16_t*)(lds + 30720); LAS bf16_t* Kraw = (LAS bf16_t*)(lds + 49152);
        float wm[2][2][4]; load_gate_wm(p, h, w, lane, wm);
        const float bf = p.gla_gate_b[h * 64 + lane], bb = p.gla_gate_b[256 + h * 64 + lane];
        f32x4 gzv_A, gzv_B; u32x4 va_A, vb_A, kv_A, va_B, vb_B, kv_B;
#define C1G_LOAD(S, slot_) do { const int r0_ = slot_row0(b, (slot_)); gzv_##S = ((const f32x4*)((const float*)(p.ws + WS_GZ) + (size_t)r0_ * 32))[tid]; \
            const bf16_t* rv_ = P + ptile(r0_ + jrow, C_GV + h * 128 + g8 * 8); va_##S = *(const u32x4*)rv_; vb_##S = *(const u32x4*)(rv_ + 64); \
            kv_##S = *(const u32x4*)(P + ptile(r0_ + jrow, C_GK + h * 64 + g8 * 8)); } while (0)
#define C1G_ITEM(S, slot, PF) do { \
            *(LAS f32x4*)(gz_s + jrow * 36 + g8 * 4) = gzv_##S; stage_vt_regs(va_##S, vb_##S, VT, tid); *(LAS u32x4*)(Kraw + jrow * RS + g8 * 8) = kv_##S; \
            __syncthreads(); \
            if (PF && (slot) + 64 < NSL) C1G_LOAD(S, (slot) + 64); \
            float bi[8], ci[8], allf, allb; \
            gla_stepA(wm, bf, bb, w, lane, gz_s, PR, tot, bi, ci, allf, allb); \
            { float ef[8], eb[8]; \
            _Pragma("unroll") \
              for (int tt = 0; tt < 8; ++tt) { const float kk = bf2f(Kraw[(8 * w + tt) * RS + lane]); ef[tt] = kk * __expf(allf - bi[tt]); eb[tt] = kk * __expf(allb - ci[tt]); } \
              u32x4 wf_, wb_; wf_.x = pk(ef[0], ef[1]); wf_.y = pk(ef[2], ef[3]); wf_.z = pk(ef[4], ef[5]); wf_.w = pk(ef[6], ef[7]); \
              wb_.x = pk(eb[0], eb[1]); wb_.y = pk(eb[2], eb[3]); wb_.z = pk(eb[4], eb[5]); wb_.w = pk(eb[6], eb[7]); \
              *(LAS u32x4*)(KfT + lane * RS + 8 * w) = wf_; *(LAS u32x4*)(KbT + lane * RS + 8 * w) = wb_; } \
            float* DCH = (float*)(p.ws + WS_DCH); \
            DCH[((size_t)(bh * 2 + 0) * NSL + (slot)) * 64 + lane] = __expf(allf); DCH[((size_t)(bh * 2 + 1) * NSL + (slot)) * 64 + lane] = __expf(allb);     \
            __syncthreads(); \
            unsigned char* US = (unsigned char*)p.out; \
            bf16x8 Bv[2]; \
            _Pragma("unroll") \
            for (int js = 0; js < 2; ++js) Bv[js] = tr_frag(VT, lane, w, js); \
            _Pragma("unroll") \
            for (int dir = 0; dir < 2; ++dir) { const LAS bf16_t* KT = dir ? KbT : KfT; \
            _Pragma("unroll") \
                for (int ks = 0; ks < 2; ++ks) { f32x4 a0 = {0.f, 0.f, 0.f, 0.f}, a1 = {0.f, 0.f, 0.f, 0.f}; \
            _Pragma("unroll") \
                    for (int js = 0; js < 2; ++js) { a0 = mfma16(lds_frag(KT, (32 * ks + c) * RS + 32 * js + 8 * q), Bv[js], a0); a1 = mfma16(lds_frag(KT, (32 * ks + 16 + c) * RS + 32 * js + 8 * q), Bv[js], a1); } \
                    *(u32x2*)(US + ((size_t)(bh * 2 + dir) * NSL + (slot)) * GLA_SLOT + ((w * 2 + ks) * 64 + lane) * 8) = pack_state8(a0, a1); } } \
            __syncthreads(); \
        } while (0)
        for (int rep1_ = 0; rep1_ < C1G_REP; ++rep1_) {
        C1G_LOAD(A, s0); C1_DUMMY(6, 0); C1G_LOAD(B, s0 + 32); C1_DUMMY(6, 1);
        int slot = s0;
        for (; slot + 32 < NSL; slot += 64) {
            C1G_ITEM(A, slot, 1);
            C1G_ITEM(B, slot + 32, 1);
        }
        if (slot < NSL) C1G_ITEM(A, slot, 0);
        }
#undef C1G_ITEM
#undef C1G_LOAD
    }
    {
        LAS bf16_t* Kr = (LAS bf16_t*)lds; LAS bf16_t* Vr = (LAS bf16_t*)(lds + 18432);
        const float lgf = log_sigmoidf(p.ret_decay_logit[h]), lgb = log_sigmoidf(p.ret_decay_logit[4 + h]);
        float sfv[2][8], sbv[2][8];
#pragma unroll
        for (int js = 0; js < 2; ++js)
#pragma unroll
            for (int e = 0; e < 8; ++e) { const int j = 32 * js + 8 * q + e; sfv[js][e] = __expf(lgf * (float)(63 - j)); sbv[js][e] = __expf(lgb * (float)j); }
        u32x4 ka_A, kb_A, va_A, vb_A, ka_B, kb_B, va_B, vb_B;
#define C1R_LOAD(S, slot_) do { const int rr_ = slot_row0(b, (slot_)) + jrow; const bf16_t* rk_ = P + ptile(rr_, C_RK + h * 128 + g8 * 8); const bf16_t* rv_ = P + ptile(rr_, C_RV + h * 128 + g8 * 8); \
            ka_##S = *(const u32x4*)rk_; kb_##S = *(const u32x4*)(rk_ + 64); va_##S = *(const u32x4*)rv_; vb_##S = *(const u32x4*)(rv_ + 64); } while (0)
#define C1R_SCALE(dst, raw, s_) do { const u32x4 rw_ = __builtin_bit_cast(u32x4, raw); u32x4 o_; \
            o_.x = pk(__uint_as_float(rw_.x << 16) * s_[0], __uint_as_float(rw_.x & 0xffff0000u) * s_[1]); o_.y = pk(__uint_as_float(rw_.y << 16) * s_[2], __uint_as_float(rw_.y & 0xffff0000u) * s_[3]); \
            o_.z = pk(__uint_as_float(rw_.z << 16) * s_[4], __uint_as_float(rw_.z & 0xffff0000u) * s_[5]); o_.w = pk(__uint_as_float(rw_.w << 16) * s_[6], __uint_as_float(rw_.w & 0xffff0000u) * s_[7]); \
            dst = __builtin_bit_cast(bf16x8, o_); } while (0)
#define C1R_ITEM(S, slot, PF) do { \
            stage_vt_regs(ka_##S, kb_##S, Kr, tid); stage_vt_regs(va_##S, vb_##S, Vr, tid); \
            __syncthreads(); \
            if (PF && (slot) + 64 < NSL) C1R_LOAD(S, (slot) + 64); \
            unsigned char* US = (unsigned char*)p.out + US_RET_OFF; \
            bf16x8 Bv[2][2]; \
            _Pragma("unroll") \
            for (int js = 0; js < 2; ++js) { const bf16x8 raw_ = tr_frag(Vr, lane, w, js); C1R_SCALE(Bv[0][js], raw_, sfv[js]); C1R_SCALE(Bv[1][js], raw_, sbv[js]); } \
            _Pragma("unroll") \
            for (int ks = 0; ks < 4; ++ks) { f32x4 a0 = {0.f, 0.f, 0.f, 0.f}, a1 = {0.f, 0.f, 0.f, 0.f}, b0 = {0.f, 0.f, 0.f, 0.f}, b1 = {0.f, 0.f, 0.f, 0.f}; \
            _Pragma("unroll") \
                for (int js = 0; js < 2; ++js) { const bf16x8 k0_ = tr_frag(Kr, lane, 2 * ks, js), k1_ = tr_frag(Kr, lane, 2 * ks + 1, js); \
                    a0 = mfma16(k0_, Bv[0][js], a0); a1 = mfma16(k1_, Bv[0][js], a1); b0 = mfma16(k0_, Bv[1][js], b0); b1 = mfma16(k1_, Bv[1][js], b1); } \
                *(u32x2*)(US + ((size_t)(bh * 2 + 0) * NSL + (slot)) * RET_SLOT + ((w * 4 + ks) * 64 + lane) * 8) = pack_state8(a0, a1); \
                *(u32x2*)(US + ((size_t)(bh * 2 + 1) * NSL + (slot)) * RET_SLOT + ((w * 4 + ks) * 64 + lane) * 8) = pack_state8(b0, b1); } \
            __syncthreads(); \
        } while (0)
        for (int rep2_ = 0; rep2_ < C1R_REP; ++rep2_) {
        const int s0r = (s0 + 28) & 31;
        C1R_LOAD(A, s0r); C1_DUMMY(8, 2); C1R_LOAD(B, s0r + 32); C1_DUMMY(8, 3);
        int slot = s0r;
        for (; slot + 32 < NSL; slot += 64) {
            C1R_ITEM(A, slot, 1);
            C1R_ITEM(B, slot + 32, 1);
        }
        if (slot < NSL) C1R_ITEM(A, slot, 0);
        }
#undef C1R_ITEM
#undef C1R_LOAD
#undef C1R_SCALE
    }
#undef C1_DUMMY
}
__device__ __forceinline__ void run_c2(const Ptrs& p, LAS unsigned char* lds, int bx) {
    constexpr int NB = 13, GLA_ELEMS = 16 * 8192;
    const int tid = threadIdx.x;
    LAS float* dl = (LAS float*)lds;
    const int e_blk = bx * 1536, c0 = e_blk >> 13;
    if (e_blk < GLA_ELEMS) {
        const int c1 = ((e_blk + 1535) >> 13) < 15 ? ((e_blk + 1535) >> 13) : 15;
        const f32x4* src = (const f32x4*)((const float*)(p.ws + WS_DCH) + (size_t)c0 * NSL * 64);
        const int n4 = (c1 - c0 + 1) * NSL * 16;
        for (int i0 = tid; i0 < n4; i0 += 4 * NTHR) {
            f32x4 dv[4];
#pragma unroll
            for (int q4 = 0; q4 < 4; ++q4) { const int i = i0 + q4 * NTHR; dv[q4] = src[i < n4 ? i : i0]; }
#pragma unroll
            for (int q4 = 0; q4 < 4; ++q4) { const int i = i0 + q4 * NTHR; if (i < n4) ((LAS f32x4*)dl)[i] = dv[q4]; } }
    }
    __syncthreads();
    if (tid < 192) {
        const int e = e_blk + tid * 8;
        const bool isG = e < GLA_ELEMS;
        const int er = isG ? e : e - GLA_ELEMS;
        const int chain = isG ? (er >> 13) : (er >> 14), el = isG ? (er & 8191) : (er & 16383);
        const size_t SLOT = isG ? GLA_SLOT : RET_SLOT;
        const int dir = chain & 1, h = (chain >> 1) & 3;
        const size_t off = (isG ? 0 : US_RET_OFF) + (size_t)chain * NSL * SLOT + el;
        const unsigned char* ubase = (const unsigned char*)p.out + off;
        bf16_t* sbase = (bf16_t*)(p.ws + WS_US) + off;
        const bool s8 = isG ? (S_F8_GLA != 0) : (S_F8_RET != 0);
        const float dconst = __expf(64.0f * log_sigmoidf(p.ret_decay_logit[dir * 4 + h]));
        const int kb = 32 * ((el >> 9) & 1) + 4 * (((el >> 3) & 63) >> 4);
        const LAS float* dlc = dl + (isG ? (chain - c0) : 0) * NSL * 64 + kb;
        f32x4 s0 = {0.f, 0.f, 0.f, 0.f}, s1 = {0.f, 0.f, 0.f, 0.f};
        u32x2 uA[NB], uB[NB];
#define C2_LOAD(U_, bt_) do { _Pragma("unroll") for (int i = 0; i < NB; ++i) { const int slot = slot_at(dir, (bt_) * NB + i); U_[i] = *(const u32x2*)(ubase + (size_t)slot * SLOT); } } while (0)
#define C2_PROC(U_, bt_) do { _Pragma("unroll") for (int i = 0; i < NB; ++i) { const int slot = slot_at(dir, (bt_) * NB + i); \
        if (s8) *(u32x2*)((unsigned char*)(p.ws + WS_US) + off * 2 - el + (size_t)slot * SLOT) = pack_state8(s0, s1); else { u32x4 o_; o_.x = pk(s0[0], s0[1]); o_.y = pk(s0[2], s0[3]); o_.z = pk(s1[0], s1[1]); o_.w = pk(s1[2], s1[3]); *(u32x4*)(sbase + (size_t)slot * SLOT) = o_; } \
        const f32x2 a_ = __builtin_amdgcn_cvt_pk_f32_fp8((int)U_[i].x, false), b_ = __builtin_amdgcn_cvt_pk_f32_fp8((int)U_[i].x, true), c_ = __builtin_amdgcn_cvt_pk_f32_fp8((int)U_[i].y, false), d_ = __builtin_amdgcn_cvt_pk_f32_fp8((int)U_[i].y, true); \
        const f32x4 u0 = {a_[0], a_[1], b_[0], b_[1]}, u1 = {c_[0], c_[1], d_[0], d_[1]}; \
        if (isG) { const f32x4 d0 = *(const LAS f32x4*)(dlc + slot * 64), d1 = *(const LAS f32x4*)(dlc + slot * 64 + 16); s0 = s0 * d0 + u0; s1 = s1 * d1 + u1; } else { s0 = s0 * dconst + u0; s1 = s1 * dconst + u1; } } } while (0)
        C2_LOAD(uA, 0);
        for (int bt = 0; bt < NSL / NB; bt += 2) {
            C2_LOAD(uB, bt + 1);
            C2_PROC(uA, bt);
            if (bt + 2 < NSL / NB) C2_LOAD(uA, bt + 2);
            C2_PROC(uB, bt + 1);
        }
#undef C2_LOAD
#undef C2_PROC
    }
    __syncthreads();
}
__device__ __forceinline__ void run_c3(const Ptrs& p, LAS unsigned char* lds, int bx, bf16_t* Y) {
    const int tid = threadIdx.x, w = __builtin_amdgcn_readfirstlane(tid >> 6), lane = tid & 63, c = lane & 15, q = lane >> 4;
    const int bh = bx >> 5, b = bh >> 2, h = bh & 3, n0 = bx & 31;
    const bf16_t* P = (const bf16_t*)(p.ws + WS_P);
    const int jrow = tid >> 3, g8 = tid & 7;
#define C3_SB() __builtin_amdgcn_sched_barrier(0)
    {
        LAS float* gz_s = (LAS float*)lds; LAS float* tot = (LAS float*)(lds + 110592);
        LAS bf16_t* QF = (LAS bf16_t*)(lds + 12288); LAS bf16_t* QB = (LAS bf16_t*)(lds + 21504); LAS bf16_t* KF = (LAS bf16_t*)(lds + 30720); LAS bf16_t* KB = (LAS bf16_t*)(lds + 39936);
        LAS bf16_t* VT = (LAS bf16_t*)(lds + 49152); LAS bf16_t* Pm = (LAS bf16_t*)(lds + 67584); LAS float* Os = (LAS float*)(lds + 76800);
        float wm[2][2][4]; load_gate_wm(p, h, w, lane, wm);
        const float bf = p.gla_gate_b[h * 64 + lane], bb = p.gla_gate_b[256 + h * 64 + lane];
        f32x4 nwv[4];
#pragma unroll
        for (int k = 0; k < 4; ++k) nwv[k] = *(const f32x4*)(p.gla_norm_w + h * 128 + 16 * g8 + 4 * k);
        const bf16_t* US = (const bf16_t*)(p.ws + WS_US);
        f32x4 gzv; u32x4 va, vb, qv, kv; bf16x8 Sf[2], Sb[2]; u32x2 Sf8[2], Sb8[2]; u32x4 ga, gb;
#define C3G_LOAD1(n_) do { const int r0_ = b * SEQ + (n_) * 64; gzv = ((const f32x4*)((const float*)(p.ws + WS_GZ) + (size_t)r0_ * 32))[tid]; \
            const bf16_t* rv_ = P + ptile(r0_ + jrow, C_GV + h * 128 + g8 * 8); va = *(const u32x4*)rv_; vb = *(const u32x4*)(rv_ + 64); \
            qv = *(const u32x4*)(P + ptile(r0_ + jrow, C_GQ + h * 64 + g8 * 8)); kv = *(const u32x4*)(P + ptile(r0_ + jrow, C_GK + h * 64 + g8 * 8)); } while (0)
#define C3G_LOADS(n_) do { _Pragma("unroll") for (int ks = 0; ks < 2; ++ks) { if (S_F8_GLA) { \
                    Sf8[ks] = *(const u32x2*)((const unsigned char*)US + (size_t)(bh * 2 + 0) * NSL * GLA_SLOT * 2 + (size_t)(4 + (n_)) * GLA_SLOT + ((w * 2 + ks) * 64 + lane) * 8); \
                    Sb8[ks] = *(const u32x2*)((const unsigned char*)US + (size_t)(bh * 2 + 1) * NSL * GLA_SLOT * 2 + (size_t)(4 + (n_)) * GLA_SLOT + ((w * 2 + ks) * 64 + lane) * 8); } else { \
                    Sf[ks] = *(const bf16x8*)(US + ((size_t)(bh * 2 + 0) * NSL + 4 + (n_)) * GLA_SLOT + ((w * 2 + ks) * 64 + lane) * 8); \
                    Sb[ks] = *(const bf16x8*)(US + ((size_t)(bh * 2 + 1) * NSL + 4 + (n_)) * GLA_SLOT + ((w * 2 + ks) * 64 + lane) * 8); } } } while (0)
#define C3G_LOADG(n_) do { const bf16_t* rg_ = P + ptile(b * SEQ + (n_) * 64 + jrow, C_GG + h * 128 + 16 * g8); ga = *(const u32x4*)rg_; gb = *(const u32x4*)(rg_ + 8); } while (0)
        C3G_LOAD1(n0); C3G_LOADS(n0); C3G_LOADG(n0);
        for (int n = n0; n < 256; n += 32) {
            const int row0 = b * SEQ + n * 64, nn = (n + 32 < 256) ? n + 32 : n;
            *(LAS f32x4*)(gz_s + jrow * 36 + g8 * 4) = gzv; stage_vt_regs(va, vb, VT, tid);
            *(LAS u32x4*)(QF + jrow * RS + g8 * 8) = qv; *(LAS u32x4*)(KF + jrow * RS + g8 * 8) = kv;
            __syncthreads();
            C3G_LOAD1(nn);
            float bi[8], ci[8], allf, allb;
            gla_stepA(wm, bf, bb, w, lane, gz_s, (LAS float*)Os, tot, bi, ci, allf, allb);
#pragma unroll
            for (int tt = 0; tt < 8; ++tt) { const int i = 8 * w + tt; const float qq = bf2f(QF[i * RS + lane]), kk = bf2f(KF[i * RS + lane]);
                QF[i * RS + lane] = f2bf_hw(qq * __expf(bi[tt])); QB[i * RS + lane] = f2bf_hw(qq * __expf(ci[tt]));
                KF[i * RS + lane] = f2bf_hw(kk * __expf(fminf(-bi[tt], 80.f))); KB[i * RS + lane] = f2bf_hw(kk * __expf(fminf(-ci[tt], 80.f))); }
            __syncthreads();
            { const int it = w & 3, i = 16 * it + c;
              bf16x8 qf[2], qb[2];
#pragma unroll
              for (int ks = 0; ks < 2; ++ks) { qf[ks] = lds_frag(QF, i * RS + 32 * ks + 8 * q); qb[ks] = lds_frag(QB, i * RS + 32 * ks + 8 * q); }
#pragma unroll
              for (int jj = 0; jj < 2; ++jj) { const int jt = 2 * (w >> 2) + jj; f32x4 af = {0.f, 0.f, 0.f, 0.f}, ab = {0.f, 0.f, 0.f, 0.f};
#pragma unroll
                  for (int ks = 0; ks < 2; ++ks) { af = mfma16(lds_frag(KF, (16 * jt + c) * RS + 32 * ks + 8 * q), qf[ks], af); ab = mfma16(lds_frag(KB, (16 * jt + c) * RS + 32 * ks + 8 * q), qb[ks], ab); }
                  float v[4];
#pragma unroll
                  for (int r = 0; r < 4; ++r) { const int j = 16 * jt + 4 * q + r; v[r] = (j <= i ? af[r] : 0.f) + (j >= i ? ab[r] : 0.f); }
                  u32x2 o; o.x = pk(v[0], v[1]); o.y = pk(v[2], v[3]); *(LAS u32x2*)(Pm + i * RS + 16 * jt + 4 * q) = o; } }
            __syncthreads();
            if (S_F8_GLA) {
#pragma unroll
                for (int ks = 0; ks < 2; ++ks) { Sf[ks] = unpack_state8(Sf8[ks]); Sb[ks] = unpack_state8(Sb8[ks]); } }
            { bf16x8 Bv[2], fr[2][6];
#pragma unroll
              for (int js = 0; js < 2; ++js) Bv[js] = tr_frag(VT, lane, w, js);
#define C3G_FR(F, it_) do { const int i_ = 16 * (it_) + c; F[0] = lds_frag(Pm, i_ * RS + 8 * q); F[1] = lds_frag(Pm, i_ * RS + 32 + 8 * q); F[2] = lds_frag_pi(QF, i_ * RS + 4 * q); F[3] = lds_frag_pi(QF, i_ * RS + 32 + 4 * q); \
                  F[4] = lds_frag_pi(QB, i_ * RS + 4 * q); F[5] = lds_frag_pi(QB, i_ * RS + 32 + 4 * q); } while (0)
              C3G_FR(fr[0], 0);
#pragma unroll
              for (int it = 0; it < 4; ++it) {
                  if (it < 3) C3G_FR(fr[(it + 1) & 1], it + 1);
                  C3_SB();
                  const bf16x8 (&F)[6] = fr[it & 1];
                  f32x4 a0 = mfma16(F[0], Bv[0], (f32x4){0.f, 0.f, 0.f, 0.f}), a1 = mfma16(F[2], Sf[0], (f32x4){0.f, 0.f, 0.f, 0.f});
                  a0 = mfma16(F[1], Bv[1], a0); a1 = mfma16(F[3], Sf[1], a1); a0 = mfma16(F[4], Sb[0], a0); a1 = mfma16(F[5], Sb[1], a1);
#pragma unroll
                  for (int r = 0; r < 4; ++r) Os[(16 * it + 4 * q + r) * OS + 16 * w + c] = a0[r] + a1[r];
                  C3_SB(); }
#undef C3G_FR
            }
            C3G_LOADS(nn);
            __syncthreads();
            { const LAS float* orow = Os + jrow * OS + 16 * g8;
              f32x4 o4[4];
#pragma unroll
              for (int k = 0; k < 4; ++k) o4[k] = *(const LAS f32x4*)(orow + 4 * k);
              float ss = 0.f;
#pragma unroll
              for (int k = 0; k < 4; ++k)
#pragma unroll
                  for (int e = 0; e < 4; ++e) ss = fmaf(o4[k][e], o4[k][e], ss);
              ss = sum8(ss);
              const float r = __builtin_amdgcn_rsqf(ss * (1.f / 128.f) + EPS);
              const unsigned gw[8] = {ga.x, ga.y, ga.z, ga.w, gb.x, gb.y, gb.z, gb.w}; unsigned ow[8];
#pragma unroll
              for (int k = 0; k < 4; ++k)
#pragma unroll
                  for (int hh = 0; hh < 2; ++hh) { const unsigned g = gw[2 * k + hh];
                      ow[2 * k + hh] = pk(o4[k][2 * hh] * r * nwv[k][2 * hh] * pg8::fast_silu(__uint_as_float(g << 16)), o4[k][2 * hh + 1] * r * nwv[k][2 * hh + 1] * pg8::fast_silu(__uint_as_float(g & 0xffff0000u))); }
              bf16_t* yp = Y + (size_t)(row0 + jrow) * D + h * 128 + 16 * g8;
              *(u32x4*)yp = (u32x4){ow[0], ow[1], ow[2], ow[3]}; *(u32x4*)(yp + 8) = (u32x4){ow[4], ow[5], ow[6], ow[7]}; }
            C3G_LOADG(nn);
        }
        __syncthreads();
#undef C3G_LOAD1
#undef C3G_LOADS
#undef C3G_LOADG
    }
    {
        LAS bf16_t* Qs = (LAS bf16_t*)lds; LAS bf16_t* Ks = (LAS bf16_t*)(lds + 17408); LAS bf16_t* VT = (LAS bf16_t*)(lds + 34816); LAS bf16_t* Pm = (LAS bf16_t*)(lds + 53248);
        LAS float* Os = (LAS float*)(lds + 62464); LAS float* pwf = (LAS float*)(lds + 96256); LAS float* pwb = pwf + 80;
        const float lgf = log_sigmoidf(p.ret_decay_logit[h]), lgb = log_sigmoidf(p.ret_decay_logit[4 + h]);
        if (tid < 65) { pwf[tid] = __expf(lgf * (float)tid); pwb[tid] = __expf(lgb * (float)tid); }
        f32x4 nwv[4];
#pragma unroll
        for (int k = 0; k < 4; ++k) nwv[k] = *(const f32x4*)(p.ret_norm_w + h * 128 + 16 * g8 + 4 * k);
        const bf16_t* US = (const bf16_t*)(p.ws + WS_US) + US_RET_OFF;
        u32x4 qa, qb2, ka, kb2, va, vb; bf16x8 Sf[4], Sb[4]; u32x2 Sf8[4], Sb8[4]; u32x4 ga, gb;
#define C3R_LOAD1(n_) do { const int r0_ = b * SEQ + (n_) * 64; const bf16_t* rq_ = P + ptile(r0_ + jrow, C_RQ + h * 128 + g8 * 8); const bf16_t* rk_ = P + ptile(r0_ + jrow, C_RK + h * 128 + g8 * 8); const bf16_t* rv_ = P + ptile(r0_ + jrow, C_RV + h * 128 + g8 * 8); \
            qa = *(const u32x4*)rq_; qb2 = *(const u32x4*)(rq_ + 64); ka = *(const u32x4*)rk_; kb2 = *(const u32x4*)(rk_ + 64); \
            va = *(const u32x4*)rv_; vb = *(const u32x4*)(rv_ + 64); } while (0)
#define C3R_LOADS(n_) do { _Pragma("unroll") for (int ks = 0; ks < 4; ++ks) { if (S_F8_RET) { \
                    Sf8[ks] = *(const u32x2*)((const unsigned char*)US + (size_t)(bh * 2 + 0) * NSL * RET_SLOT * 2 + (size_t)(4 + (n_)) * RET_SLOT + ((w * 4 + ks) * 64 + lane) * 8); \
                    Sb8[ks] = *(const u32x2*)((const unsigned char*)US + (size_t)(bh * 2 + 1) * NSL * RET_SLOT * 2 + (size_t)(4 + (n_)) * RET_SLOT + ((w * 4 + ks) * 64 + lane) * 8); } else { \
                    Sf[ks] = *(const bf16x8*)(US + ((size_t)(bh * 2 + 0) * NSL + 4 + (n_)) * RET_SLOT + ((w * 4 + ks) * 64 + lane) * 8); \
                    Sb[ks] = *(const bf16x8*)(US + ((size_t)(bh * 2 + 1) * NSL + 4 + (n_)) * RET_SLOT + ((w * 4 + ks) * 64 + lane) * 8); } } } while (0)
#define C3R_LOADG(n_) do { const bf16_t* rg_ = P + ptile(b * SEQ + (n_) * 64 + jrow, C_RG + h * 128 + 16 * g8); ga = *(const u32x4*)rg_; gb = *(const u32x4*)(rg_ + 8); } while (0)
        C3R_LOAD1(n0); C3R_LOADS(n0); C3R_LOADG(n0);
        for (int n = n0; n < 256; n += 32) {
            const int row0 = b * SEQ + n * 64, nn = (n + 32 < 256) ? n + 32 : n;
            *(LAS u32x4*)(Qs + jrow * RS2 + g8 * 8) = qa; *(LAS u32x4*)(Qs + jrow * RS2 + 64 + g8 * 8) = qb2;
            *(LAS u32x4*)(Ks + jrow * RS2 + g8 * 8) = ka; *(LAS u32x4*)(Ks + jrow * RS2 + 64 + g8 * 8) = kb2;
            stage_vt_regs(va, vb, VT, tid);
            __syncthreads();
            C3R_LOAD1(nn);
            { const int it = w & 3, i = 16 * it + c;
              bf16x8 qf[4];
#pragma unroll
              for (int ks = 0; ks < 4; ++ks) qf[ks] = lds_frag(Qs, i * RS2 + 32 * ks + 8 * q);
#pragma unroll
              for (int jj = 0; jj < 2; ++jj) { const int jt = 2 * (w >> 2) + jj; f32x4 a = {0.f, 0.f, 0.f, 0.f};
#pragma unroll
                  for (int ks = 0; ks < 4; ++ks) a = mfma16(lds_frag(Ks, (16 * jt + c) * RS2 + 32 * ks + 8 * q), qf[ks], a);
                  float v[4];
#pragma unroll
                  for (int r = 0; r < 4; ++r) { const int j = 16 * jt + 4 * q + r; const int dd = i - j; const float dm = (dd >= 0 ? pwf[dd >= 0 ? dd : 0] : 0.f) + (dd <= 0 ? pwb[dd <= 0 ? -dd : 0] : 0.f); v[r] = a[r] * dm; }
                  u32x2 o; o.x = pk(v[0], v[1]); o.y = pk(v[2], v[3]); *(LAS u32x2*)(Pm + i * RS + 16 * jt + 4 * q) = o; } }
            __syncthreads();
            if (S_F8_RET) {
#pragma unroll
                for (int ks = 0; ks < 4; ++ks) { Sf[ks] = unpack_state8(Sf8[ks]); Sb[ks] = unpack_state8(Sb8[ks]); } }
            { bf16x8 Bv[2], fr[2][6]; f32x4 dwf[2], dwb[2];
#pragma unroll
              for (int js = 0; js < 2; ++js) Bv[js] = tr_frag(VT, lane, w, js);
#define C3R_FR(F, WF, WB, it_) do { const int i_ = 16 * (it_) + c; F[0] = lds_frag(Pm, i_ * RS + 8 * q); F[1] = lds_frag(Pm, i_ * RS + 32 + 8 * q); \
                  _Pragma("unroll") for (int ks = 0; ks < 4; ++ks) F[2 + ks] = lds_frag_pi(Qs, i_ * RS2 + 32 * ks + 4 * q); \
                  _Pragma("unroll") for (int r = 0; r < 4; ++r) { WF[r] = pwf[16 * (it_) + 4 * q + r + 1]; WB[r] = pwb[64 - (16 * (it_) + 4 * q + r)]; } } while (0)
              C3R_FR(fr[0], dwf[0], dwb[0], 0);
#pragma unroll
              for (int it = 0; it < 4; ++it) {
                  if (it < 3) C3R_FR(fr[(it + 1) & 1], dwf[(it + 1) & 1], dwb[(it + 1) & 1], it + 1);
                  C3_SB();
                  const bf16x8 (&F)[6] = fr[it & 1];
                  f32x4 a = mfma16(F[0], Bv[0], (f32x4){0.f, 0.f, 0.f, 0.f}), af = mfma16(F[2], Sf[0], (f32x4){0.f, 0.f, 0.f, 0.f}), ab = mfma16(F[2], Sb[0], (f32x4){0.f, 0.f, 0.f, 0.f});
                  a = mfma16(F[1], Bv[1], a); af = mfma16(F[3], Sf[1], af); ab = mfma16(F[3], Sb[1], ab);
                  af = mfma16(F[4], Sf[2], af); ab = mfma16(F[4], Sb[2], ab); af = mfma16(F[5], Sf[3], af); ab = mfma16(F[5], Sb[3], ab);
#pragma unroll
                  for (int r = 0; r < 4; ++r) Os[(16 * it + 4 * q + r) * OS + 16 * w + c] = a[r] + dwf[it & 1][r] * af[r] + dwb[it & 1][r] * ab[r];
                  C3_SB(); }
#undef C3R_FR
            }
            C3R_LOADS(nn);
            __syncthreads();
            { const LAS float* orow = Os + jrow * OS + 16 * g8;
              f32x4 o4[4];
#pragma unroll
              for (int k = 0; k < 4; ++k) o4[k] = *(const LAS f32x4*)(orow + 4 * k);
              float s1 = 0.f;
#pragma unroll
              for (int k = 0; k < 4; ++k) s1 += (o4[k][0] + o4[k][1]) + (o4[k][2] + o4[k][3]);
              const float mu = sum8(s1) * (1.f / 128.f);
              float ss = 0.f;
#pragma unroll
              for (int k = 0; k < 4; ++k)
#pragma unroll
                  for (int e = 0; e < 4; ++e) { o4[k][e] -= mu; ss = fmaf(o4[k][e], o4[k][e], ss); }
              ss = sum8(ss);
              const float r = __builtin_amdgcn_rsqf(ss * (1.f / 128.f) + EPS);
              const unsigned gw[8] = {ga.x, ga.y, ga.z, ga.w, gb.x, gb.y, gb.z, gb.w}; unsigned ow[8];
#pragma unroll
              for (int k = 0; k < 4; ++k)
#pragma unroll
                  for (int hh = 0; hh < 2; ++hh) { const unsigned g = gw[2 * k + hh];
                      ow[2 * k + hh] = pk(o4[k][2 * hh] * r * nwv[k][2 * hh] * pg8::fast_silu(__uint_as_float(g << 16)), o4[k][2 * hh + 1] * r * nwv[k][2 * hh + 1] * pg8::fast_silu(__uint_as_float(g & 0xffff0000u))); }
              bf16_t* yp = Y + (size_t)(row0 + jrow) * D + 512 + h * 128 + 16 * g8;
              *(u32x4*)yp = (u32x4){ow[0], ow[1], ow[2], ow[3]}; *(u32x4*)(yp + 8) = (u32x4){ow[4], ow[5], ow[6], ow[7]}; }
            C3R_LOADG(nn);
        }
        __syncthreads();
#undef C3R_LOAD1
#undef C3R_LOADS
#undef C3R_LOADG
    }
#undef C3_SB
}
}

namespace misc {
__device__ __forceinline__ void p0_mod(const Ptrs& p, LAS unsigned char* lds, int bx) {
    LAS float* sc = (LAS float*)lds;
    LAS float* red = sc + 3 * D;
    const int tid = threadIdx.x;
    { float cv[6];
#pragma unroll
      for (int q6 = 0; q6 < 6; ++q6) { const int i = tid + q6 * NTHR, r = i >> 10, k = i & 1023; cv[q6] = (r < 2) ? p.c[r * D + k] : p.c_ctx[k]; }
#pragma unroll
      for (int q6 = 0; q6 < 6; ++q6) sc[tid + q6 * NTHR] = siluf(cv[q6]); }
    __syncthreads();
    const int kg = tid >> 5, cl = tid & 31, col = 24 * bx + cl;
    float a0 = 0.f, a1 = 0.f, a2 = 0.f;
    if (cl < 24) {
#pragma unroll 16
        for (int k = kg * 64; k < kg * 64 + 64; ++k) { const float w = p.w_ada[(size_t)k * (NADA * D) + col]; a0 += sc[k] * w; a1 += sc[D + k] * w; a2 += sc[2 * D + k] * w; }
    }
    red[(kg * 3 + 0) * 32 + cl] = a0; red[(kg * 3 + 1) * 32 + cl] = a1; red[(kg * 3 + 2) * 32 + cl] = a2;
    __syncthreads();
    if (tid < 96) { const int r = tid >> 5, c2 = tid & 31; if (c2 < 24) { float s = 0.f;
#pragma unroll
        for (int g = 0; g < 16; ++g) s += red[(g * 3 + r) * 32 + c2];
        const int cc = 24 * bx + c2; ((float*)(p.ws + WS_MOD))[r * NADA * D + cc] = s + p.b_ada[cc]; } }
    __syncthreads();
}
constexpr int TSCR = 64 * 65 * 4;
__device__ __forceinline__ void transpose_tile(const float* src, int ldsrc, int k0, int n0s, bf16_t* dst, int ldt, int n0d, LAS float* scr, int lane) {
    const int kr = lane >> 4, nq = lane & 15;
    f32x4 v[16];
#pragma unroll
    for (int i = 0; i < 16; ++i) v[i] = *(const f32x4*)(src + (size_t)(k0 + 4 * i + kr) * ldsrc + n0s + 4 * nq);
#pragma unroll
    for (int i = 0; i < 16; ++i) { LAS float* s = scr + (4 * i + kr) * 65 + 4 * nq; s[0] = v[i][0]; s[1] = v[i][1]; s[2] = v[i][2]; s[3] = v[i][3]; }
    asm volatile("s_waitcnt lgkmcnt(0)" ::: "memory");
    const int c = lane & 7, ns = lane >> 3;
#pragma unroll
    for (int j = 0; j < 8; ++j) { const int n = ns + 8 * j; const LAS float* s = scr + (8 * c) * 65 + n;
        u32x4 o; o.x = pg8::cvt_pk_bf16(s[0 * 65], s[1 * 65]); o.y = pg8::cvt_pk_bf16(s[2 * 65], s[3 * 65]); o.z = pg8::cvt_pk_bf16(s[4 * 65], s[5 * 65]); o.w = pg8::cvt_pk_bf16(s[6 * 65], s[7 * 65]);
        *(u32x4*)(dst + (size_t)(n0d + n) * ldt + k0 + 8 * c) = o; }
    asm volatile("s_waitcnt lgkmcnt(0)" ::: "memory");
}
using pg8::pk_fp8x4;
__device__ __forceinline__ void zero_tile_f8(unsigned char* dst, int ldt, int n0d, int k0, int lane) {
    const int c = lane & 3, ns = lane >> 2;
#pragma unroll
    for (int j = 0; j < 4; ++j) *(u32x4*)(dst + (size_t)(n0d + ns + 16 * j) * ldt + k0 + 16 * c) = (u32x4){0u, 0u, 0u, 0u};
}
__device__ __forceinline__ void transpose_tile_f8(const float* src, int ldsrc, int k0, int n0s, unsigned char* dst, int ldt, int n0d, float scale, LAS float* scr, int lane) {
    const int kr = lane >> 4, nq = lane & 15;
    f32x4 v[16];
#pragma unroll
    for (int i = 0; i < 16; ++i) v[i] = *(const f32x4*)(src + (size_t)(k0 + 4 * i + kr) * ldsrc + n0s + 4 * nq);
#pragma unroll
    for (int i = 0; i < 16; ++i) { LAS float* s = scr + (4 * i + kr) * 65 + 4 * nq; s[0] = v[i][0] * scale; s[1] = v[i][1] * scale; s[2] = v[i][2] * scale; s[3] = v[i][3] * scale; }
    asm volatile("s_waitcnt lgkmcnt(0)" ::: "memory");
    const int c = lane & 3, ns = lane >> 2;
#pragma unroll
    for (int j = 0; j < 4; ++j) { const int n = ns + 16 * j; const LAS float* s = scr + (16 * c) * 65 + n;
        u32x4 o; o.x = pk_fp8x4(s[0 * 65], s[1 * 65], s[2 * 65], s[3 * 65]); o.y = pk_fp8x4(s[4 * 65], s[5 * 65], s[6 * 65], s[7 * 65]);
        o.z = pk_fp8x4(s[8 * 65], s[9 * 65], s[10 * 65], s[11 * 65]); o.w = pk_fp8x4(s[12 * 65], s[13 * 65], s[14 * 65], s[15 * 65]);
        *(u32x4*)(dst + (size_t)(n0d + n) * ldt + k0 + 16 * c) = o; }
    asm volatile("s_waitcnt lgkmcnt(0)" ::: "memory");
}
__device__ __forceinline__ void transpose_item(const float* src, int ldsrc, int k0, int col  , bf16_t* dst, int ldt, int n0, LAS float* scr, int lane) {
    const int colc = col >= 0 ? col : 0;
#pragma unroll 8
    for (int i = 0; i < 32; ++i) { const int kk = 2 * i + (lane >> 5); const float x_ = src[(size_t)(k0 + kk) * ldsrc + colc]; scr[kk * 33 + (lane & 31)] = (col >= 0) ? x_ : 0.f; }
    asm volatile("s_waitcnt lgkmcnt(0)" ::: "memory");
    const int c = lane & 7;
#pragma unroll
    for (int j = 0; j < 4; ++j) { const int n = (lane >> 3) + 8 * j; const LAS float* s = scr + (8 * c) * 33 + n;
        u32x4 o; o.x = pg8::cvt_pk_bf16(s[0 * 33], s[1 * 33]); o.y = pg8::cvt_pk_bf16(s[2 * 33], s[3 * 33]); o.z = pg8::cvt_pk_bf16(s[4 * 33], s[5 * 33]); o.w = pg8::cvt_pk_bf16(s[6 * 33], s[7 * 33]);
        *(u32x4*)(dst + (size_t)(n0 + n) * ldt + k0 + 8 * c) = o; }
    asm volatile("s_waitcnt lgkmcnt(0)" ::: "memory");
}
constexpr int IT_WIN = 16 * 120, IT_WOUT = 16 * 16, IT_P0 = IT_WIN + IT_WOUT;
constexpr int IT_WGU = 16 * 2 * 22 * 16, IT_WD = 16 * 16 * 24, IT_EXP = IT_WGU + IT_WD;
__device__ __forceinline__ void conv_item_p0(const Ptrs& p, int it, LAS float* scr, int lane) {
    if (it < IT_WIN) { const int kb = it / 120, nb = it % 120, n = nb * 32 + (lane & 31); const int col = (n < NPROJ) ? proj_src_col(n) : -1;
        transpose_item(p.w_in, NPROJ, kb * 64, col, (bf16_t*)(p.ws + WS_WIN), D, nb * 32, scr, lane); }
    else { it -= IT_WIN; const int kb = it >> 4, nb = it & 15; transpose_tile(p.w_out, D, kb * 64, nb * 64, (bf16_t*)(p.ws + WS_WOUT), D, nb * 64, scr, lane); }
}
__device__ __forceinline__ void conv_item_exp(const Ptrs& p, int it, LAS float* scr, int lane) {
    if (it < IT_WGU) { const int kb = it & 15, nt = (it >> 4) % 22, half = ((it >> 4) / 22) & 1, e = (it >> 4) / 44; const int f0 = nt * 64, r0 = (f0 >> 7) * 256 + half * 128 + (f0 & 127);
        const float* src = (half ? p.w_exp_up : p.w_exp_gate) + (size_t)e * D * FF;
        transpose_tile_f8(src, FF, kb * 64, f0, (unsigned char*)(p.ws + WS_WGU) + (size_t)e * 2816 * D, D, r0, 32.0f, scr, lane); }
    else { it -= IT_WGU; const int kb = it % 24, nb = (it / 24) & 15, e = it / (24 * 16); unsigned char* dst = (unsigned char*)p.out + OUT_WD + (size_t)e * D * FFP;
        if (kb < 22) transpose_tile_f8(p.w_exp_down + (size_t)e * FF * D, D, kb * 64, nb * 64, dst, FFP, nb * 64, 32.0f, scr, lane); else zero_tile_f8(dst, FFP, nb * 64, kb * 64, lane); }
}
__device__ __forceinline__ void h_rows(const Ptrs& p, int row0, int rstep, int lane) {
    f32x4 xn[4], scn[4], shn[4];
#define H_LOAD(r_) do { const float* s_ = ((r_) < NLAT) ? p.x + (size_t)(r_) * D : p.ctx + (size_t)((r_) - NLAT) * D; _Pragma("unroll") for (int j = 0; j < 4; ++j) xn[j] = *(const f32x4*)(s_ + j * 256 + lane * 4); \
        const float* mod_ = (const float*)(p.ws + WS_MOD) + (((r_) < NLAT) ? (r_) / SEQ : 2) * NADA * D; \
        _Pragma("unroll") for (int j = 0; j < 4; ++j) { scn[j] = *(const f32x4*)(mod_ + D + j * 256 + lane * 4); shn[j] = *(const f32x4*)(mod_ + j * 256 + lane * 4); } } while (0)
    if (row0 >= NROWS) return;
    H_LOAD(row0);
    __builtin_amdgcn_sched_barrier(0);
    f32x4 w4[4];
#pragma unroll
    for (int j = 0; j < 4; ++j) w4[j] = *(const f32x4*)(p.norm1_w + j * 256 + lane * 4);
    for (int row = row0; row < NROWS; row += rstep) {
        f32x4 v[4], sc[4], sh[4]; float ss = 0.f;
#pragma unroll
        for (int j = 0; j < 4; ++j) { v[j] = xn[j]; sc[j] = scn[j]; sh[j] = shn[j]; ss += v[j][0] * v[j][0] + v[j][1] * v[j][1] + v[j][2] * v[j][2] + v[j][3] * v[j][3]; }
        { const int rn = (row + rstep < NROWS) ? row + rstep : row; H_LOAD(rn); }
        const float rstd = rsqrtf(wave_sum(ss) * (1.0f / D) + EPS);
        bf16_t* dst = (bf16_t*)(p.ws + WS_H) + (size_t)row * D;
#pragma unroll
        for (int j = 0; j < 4; ++j) { const int d = j * 256 + lane * 4;
            f32x4 o;
#pragma unroll
            for (int e = 0; e < 4; ++e) o[e] = v[j][e] * rstd * w4[j][e] * (1.0f + sc[j][e]) + sh[j][e];
            u32x2 pkd; pkd.x = pg8::cvt_pk_bf16(o[0], o[1]); pkd.y = pg8::cvt_pk_bf16(o[2], o[3]); *(u32x2*)(dst + d) = pkd; }
    }
#undef H_LOAD
}
__device__ __forceinline__ void stage_router(const Ptrs& p, LAS float* Wl, int tid) {
    for (int idx = tid; idx < D * NE / 4; idx += NTHR) { const int d = idx >> 2, q4 = idx & 3, j = d >> 8, ln = (d >> 2) & 63, e4 = d & 3;
        *(LAS f32x4*)(Wl + (((j * 4 + e4) * 4 + q4) * 64 + ln) * 4) = *(const f32x4*)(p.w_router + (size_t)d * NE + 4 * q4); }
}
__device__ __forceinline__ void norm2_router_rows(const Ptrs& p, const LAS float* Wl, int row0, int rstep, int lane) {
    const bf16_t* XO = (const bf16_t*)(p.ws + WS_XO);
    f32x4 xn[4], scn[4], shn[4]; u32x2 on[4];
#define N2_LOAD(r_) do { _Pragma("unroll") for (int j = 0; j < 4; ++j) { xn[j] = *(const f32x4*)(p.x + (size_t)(r_) * D + j * 256 + lane * 4); on[j] = *(const u32x2*)(XO + (size_t)(r_) * D + j * 256 + lane * 4); } \
        const float* mod_ = (const float*)(p.ws + WS_MOD) + ((r_) / SEQ) * NADA * D; \
        _Pragma("unroll") for (int j = 0; j < 4; ++j) { scn[j] = *(const f32x4*)(mod_ + 4 * D + j * 256 + lane * 4); shn[j] = *(const f32x4*)(mod_ + 3 * D + j * 256 + lane * 4); } } while (0)
    if (row0 >= NLAT) return;
    N2_LOAD(row0);
    __builtin_amdgcn_sched_barrier(0);
    f32x4 w4[4];
#pragma unroll
    for (int j = 0; j < 4; ++j) w4[j] = *(const f32x4*)(p.norm2_w + j * 256 + lane * 4);
    for (int row = row0; row < NLAT; row += rstep) {
        const int b = row / SEQ, t = row % SEQ;
        f32x4 v[4], scv[4], shv[4]; float ss = 0.f;
#pragma unroll
        for (int j = 0; j < 4; ++j) { scv[j] = scn[j]; shv[j] = shn[j]; }
#pragma unroll
        for (int j = 0; j < 4; ++j) { v[j] = xn[j]; v[j][0] += __uint_as_float(on[j].x << 16); v[j][1] += __uint_as_float(on[j].x & 0xffff0000u); v[j][2] += __uint_as_float(on[j].y << 16); v[j][3] += __uint_as_float(on[j].y & 0xffff0000u);
            ss += v[j][0] * v[j][0] + v[j][1] * v[j][1] + v[j][2] * v[j][2] + v[j][3] * v[j][3];
            u32x2 x1w; x1w.x = pg8::cvt_pk_bf16(v[j][0], v[j][1]); x1w.y = pg8::cvt_pk_bf16(v[j][2], v[j][3]); *(u32x2*)((bf16_t*)(p.ws + WS_XO) + (size_t)row * D + j * 256 + lane * 4) = x1w; }
        { const int rn = (row + rstep < NLAT) ? row + rstep : row; N2_LOAD(rn); }
        const float rstd = rsqrtf(wave_sum(ss) * (1.0f / D) + EPS);
        unsigned char* dst = (unsigned char*)(p.ws + WS_H) + (size_t)row * D;
        f32x2 lg2[8];
#pragma unroll
        for (int e = 0; e < 8; ++e) lg2[e] = (f32x2){0.f, 0.f};
        int wl_off = 0; asm volatile("" : "+v"(wl_off));
#pragma unroll
        for (int j = 0; j < 4; ++j) { const int d = j * 256 + lane * 4; const f32x4 sc = scv[j], sh = shv[j];
            f32x4 ww[4][4];
#pragma unroll
            for (int e4 = 0; e4 < 4; ++e4)
#pragma unroll
                for (int q = 0; q < 4; ++q) ww[e4][q] = *(const LAS f32x4*)(Wl + wl_off + (((j * 4 + e4) * 4 + q) * 64 + lane) * 4);
            f32x4 o;
#pragma unroll
            for (int e4 = 0; e4 < 4; ++e4) { o[e4] = v[j][e4] * rstd * w4[j][e4] * (1.0f + sc[e4]) + sh[e4]; const f32x2 o2 = {o[e4], o[e4]};
#pragma unroll
                for (int q = 0; q < 4; ++q) { lg2[2 * q] = __builtin_elementwise_fma(o2, (f32x2){ww[e4][q][0], ww[e4][q][1]}, lg2[2 * q]); lg2[2 * q + 1] = __builtin_elementwise_fma(o2, (f32x2){ww[e4][q][2], ww[e4][q][3]}, lg2[2 * q + 1]); } }
            *(unsigned*)(dst + d) = pk_fp8x4(o[0], o[1], o[2], o[3]); }
        float lg[NE];
#pragma unroll
        for (int q = 0; q < 4; ++q) { lg[4 * q] = lg2[2 * q][0]; lg[4 * q + 1] = lg2[2 * q][1]; lg[4 * q + 2] = lg2[2 * q + 1][0]; lg[4 * q + 3] = lg2[2 * q + 1][1]; }
        float r8[8], r4[4], r2[2], r1;
        { const bool hi = lane & 32;
#pragma unroll
          for (int j = 0; j < 8; ++j) { const float keep = hi ? lg[8 + j] : lg[j], send = hi ? lg[j] : lg[8 + j]; r8[j] = keep + __shfl_xor(send, 32); } }
        { const bool hi = lane & 16;
#pragma unroll
          for (int j = 0; j < 4; ++j) { const float keep = hi ? r8[4 + j] : r8[j], send = hi ? r8[j] : r8[4 + j]; r4[j] = keep + __shfl_xor(send, 16); } }
        { const bool hi = lane & 8;
#pragma unroll
          for (int j = 0; j < 2; ++j) { const float keep = hi ? r4[2 + j] : r4[j], send = hi ? r4[j] : r4[2 + j]; r2[j] = keep + __shfl_xor(send, 8); } }
        { const bool hi = lane & 4; const float keep = hi ? r2[1] : r2[0], send = hi ? r2[0] : r2[1]; r1 = keep + __shfl_xor(send, 4); }
        r1 += __shfl_xor(r1, 2); r1 += __shfl_xor(r1, 1);
        const float mx = wave_max(r1);
        const float ex = __expf(r1 - mx); const float den = wave_sum(ex) * 0.25f;
        if ((lane & 3) == 0) ((float*)(p.ws + WS_AFF))[((size_t)b * NE + ((lane >> 2) & 15)) * SEQ + t] = ex / den;
    }
#undef N2_LOAD
}
__device__ __forceinline__ void topk_set(const Ptrs& p, LAS unsigned char* lds, int be) {
    LAS unsigned* key = (LAS unsigned*)lds;
    LAS unsigned* hist = key + SEQ;
    LAS unsigned* sh = hist + 256;
    const int tid = threadIdx.x, lane = tid & 63, w = tid >> 6;
    const unsigned* A = (const unsigned*)(p.ws + WS_AFF) + (size_t)be * SEQ;
    { u32x4 kv[8];
#pragma unroll
      for (int q8 = 0; q8 < 8; ++q8) kv[q8] = ((const u32x4*)A)[tid + q8 * NTHR];
#pragma unroll
      for (int q8 = 0; q8 < 8; ++q8) ((LAS u32x4*)key)[tid + q8 * NTHR] = kv[q8]; }
    if (tid == 0) { sh[0] = 0u; sh[1] = (unsigned)CAP; }
    __syncthreads();
#pragma unroll 1
    for (int pass = 0; pass < 4; ++pass) {
        const int shift = 24 - 8 * pass;
        if (tid < 256) hist[tid] = 0u;
        __syncthreads();
        const unsigned prefix = sh[0], kneed = sh[1];
        const unsigned himask = (pass == 0) ? 0u : (0xffffffffu << (shift + 8));
        for (int i = tid; i < SEQ; i += NTHR) { const unsigned kx = key[i]; if ((kx & himask) == prefix) __hip_atomic_fetch_add(&hist[(kx >> shift) & 255u], 1u, __ATOMIC_RELAXED, __HIP_MEMORY_SCOPE_WORKGROUP); }
        __syncthreads();
        if (w == 0) {
            unsigned c4[4]; unsigned s = 0u;
#pragma unroll
            for (int j = 0; j < 4; ++j) { c4[j] = hist[255 - (lane * 4 + j)]; s += c4[j]; }
            unsigned incl = s;
#pragma unroll
            for (int o = 1; o < 64; o <<= 1) { const unsigned t = __shfl_up(incl, o); if (lane >= o) incl += t; }
            const unsigned excl = incl - s;
            if (excl < kneed && kneed <= incl) { unsigned acc = excl;
#pragma unroll
                for (int j = 0; j < 4; ++j) { if (acc < kneed && kneed <= acc + c4[j]) { const unsigned bin = 255u - (unsigned)(lane * 4 + j); sh[0] = prefix | (bin << shift); sh[1] = kneed - acc; } acc += c4[j]; } }
        }
        __syncthreads();
    }
    const unsigned T = sh[0], need_eq = sh[1];
    unsigned cg = 0u, ce = 0u;
    for (int i = 0; i < 32; ++i) { const unsigned kx = key[tid * 32 + i]; cg += (kx > T) ? 1u : 0u; ce += (kx == T) ? 1u : 0u; }
    unsigned ig = cg, ie = ce;
#pragma unroll
    for (int o = 1; o < 64; o <<= 1) { const unsigned tg = __shfl_up(ig, o), te = __shfl_up(ie, o); if (lane >= o) { ig += tg; ie += te; } }
    if (lane == 63) { sh[16 + w] = ig; sh[32 + w] = ie; }
    __syncthreads();
    unsigned og = 0u, oe = 0u, totg = 0u;
#pragma unroll
    for (int w2 = 0; w2 < 8; ++w2) { const unsigned a = sh[16 + w2], b2 = sh[32 + w2]; if (w2 < w) { og += a; oe += b2; } totg += a; }
    unsigned pg = og + ig - cg, pe = oe + ie - ce;
    int* IDX = (int*)(p.ws + WS_IDX) + be * CAP; float* GATE = (float*)(p.ws + WS_GATE) + be * CAP; int* INV = (int*)(p.ws + WS_INV);
    const int b = be / NE, e = be % NE;
    for (int i = 0; i < 32; ++i) { const int t = tid * 32 + i; const unsigned kx = key[t]; int slot = -1;
        if (kx > T) slot = (int)(pg++); else if (kx == T) { if (pe < need_eq) slot = (int)(totg + pe); ++pe; }
        if (slot >= 0) { IDX[slot] = t; GATE[slot] = __uint_as_float(kx); }
        INV[((size_t)b * SEQ + t) * NE + e] = slot; }
    __syncthreads();
}
__device__ __forceinline__ void final_rows(const Ptrs& p, int row0, int rstep, int lane) {
    const bf16_t* XO = (const bf16_t*)(p.ws + WS_XO); const unsigned char* YE = (const unsigned char*)(p.ws + WS_YE); const int* INV = (const int*)(p.ws + WS_INV);
    u32x2 on[4]; int invn = -1; f32x4 m4n[4];
#define FN_LOAD(r_) do { _Pragma("unroll") for (int j = 0; j < 4; ++j) { on[j] = *(const u32x2*)(XO + (size_t)(r_) * D + j * 256 + lane * 4); } \
        invn = INV[(size_t)(r_) * NE + (lane & (NE - 1))]; \
        const float* mod_ = (const float*)(p.ws + WS_MOD) + ((r_) / SEQ) * NADA * D + 5 * D; \
        _Pragma("unroll") for (int j = 0; j < 4; ++j) m4n[j] = *(const f32x4*)(mod_ + j * 256 + lane * 4); } while (0)
    if (row0 >= NLAT) return;
    FN_LOAD(row0);
    __builtin_amdgcn_sched_barrier(0);
    f32x4 fw[4];
#pragma unroll
    for (int j = 0; j < 4; ++j) fw[j] = *(const f32x4*)(p.final_norm_w + j * 256 + lane * 4);
    u32x2 oc[4]; f32x4 m4[4]; int myinv;
#define FN_TAKE() do { _Pragma("unroll") for (int j = 0; j < 4; ++j) { oc[j] = on[j]; m4[j] = m4n[j]; } myinv = (lane < NE) ? invn : -1; } while (0)
    FN_TAKE();
    for (int row = row0; row < NLAT; row += rstep) {
        const int b = row / SEQ;
        f32x4 v[4];
#pragma unroll
        for (int j = 0; j < 4; ++j) { v[j][0] = __uint_as_float(oc[j].x << 16); v[j][1] = __uint_as_float(oc[j].x & 0xffff0000u); v[j][2] = __uint_as_float(oc[j].y << 16); v[j][3] = __uint_as_float(oc[j].y & 0xffff0000u); }
        unsigned long long mask = __ballot(myinv >= 0);
        float acc[16];
#pragma unroll
        for (int i = 0; i < 16; ++i) acc[i] = 0.f;
        unsigned yw[4][4]; bool has[4];
#pragma unroll
        for (int u = 0; u < 4; ++u) { has[u] = mask != 0ull; const int e = has[u] ? (int)__builtin_ctzll(mask) : 0; if (has[u]) mask &= mask - 1ull;
            const int s = __shfl(myinv, e); const unsigned char* y = has[u] ? YE + ((size_t)(b * NE + e) * CAP + s) * D : YE;
#pragma unroll
            for (int j = 0; j < 4; ++j) yw[u][j] = *(const unsigned*)(y + j * 256 + lane * 4); }
        { const int rn = (row + rstep < NLAT) ? row + rstep : row; FN_LOAD(rn); }
#pragma unroll
        for (int u = 0; u < 4; ++u) { const float hs = has[u] ? 1.f : 0.f;
#pragma unroll
            for (int j = 0; j < 4; ++j) { const f32x2 lo_ = __builtin_amdgcn_cvt_pk_f32_fp8((int)yw[u][j], false), hi_ = __builtin_amdgcn_cvt_pk_f32_fp8((int)yw[u][j], true);
                acc[4 * j] += hs * lo_[0]; acc[4 * j + 1] += hs * lo_[1]; acc[4 * j + 2] += hs * hi_[0]; acc[4 * j + 3] += hs * hi_[1]; } }
#pragma unroll
        for (int blk = 0; blk < 3; ++blk) if (mask) {
#pragma unroll
            for (int u = 0; u < 4; ++u) { has[u] = mask != 0ull; const int e = has[u] ? (int)__builtin_ctzll(mask) : 0; if (has[u]) mask &= mask - 1ull;
                const int s = __shfl(myinv, e); const unsigned char* y = has[u] ? YE + ((size_t)(b * NE + e) * CAP + s) * D : YE;
#pragma unroll
                for (int j = 0; j < 4; ++j) yw[u][j] = *(const unsigned*)(y + j * 256 + lane * 4); }
#pragma unroll
            for (int u = 0; u < 4; ++u) { const float hs = has[u] ? 1.f : 0.f;
#pragma unroll
                for (int j = 0; j < 4; ++j) { const f32x2 lo_ = __builtin_amdgcn_cvt_pk_f32_fp8((int)yw[u][j], false), hi_ = __builtin_amdgcn_cvt_pk_f32_fp8((int)yw[u][j], true);
                    acc[4 * j] += hs * lo_[0]; acc[4 * j + 1] += hs * lo_[1]; acc[4 * j + 2] += hs * hi_[0]; acc[4 * j + 3] += hs * hi_[1]; } }
        }
        float ss = 0.f;
#pragma unroll
        for (int j = 0; j < 4; ++j) {
#pragma unroll
            for (int e = 0; e < 4; ++e) { v[j][e] += m4[j][e] * (acc[4 * j + e] * 0.0625f); ss += v[j][e] * v[j][e]; } }
        const float rstd = rsqrtf(wave_sum(ss) * (1.0f / D) + EPS);
        float* xr = p.out + (size_t)row * D;
#pragma unroll
        for (int j = 0; j < 4; ++j) *(f32x4*)(xr + j * 256 + lane * 4) = v[j] * rstd * fw[j];
        FN_TAKE();
    }
#undef FN_TAKE
#undef FN_LOAD
}
}

constexpr int RING_OFF = 0, RING_BYTES = 131072;
constexpr int GTAB_OFF = RING_BYTES;
constexpr int MISC_OFF = RING_BYTES + 12288;
constexpr int LDS_BYTES = 147456;
constexpr int CW_BAR = 4096;

#define RLX_AGENT __ATOMIC_RELAXED, __HIP_MEMORY_SCOPE_AGENT
#define XB_TMO      128
#define XB_XCNT(j)  (256  + 64 * (j))
#define XB_XSUB(j)  (1280 + 64 * (j))
#define XB_XGEN(j)  (2304 + 64 * (j))
#define XB_TOP      3328
#define XB_TOPGEN   3392
#define XCD_BAR_WORDS 3456
#define XB_SPIN_CAP (1u << 18)
__device__ __forceinline__ unsigned xb_ld(unsigned* p)              { return __hip_atomic_load(p, __ATOMIC_RELAXED, __HIP_MEMORY_SCOPE_AGENT); }
__device__ __forceinline__ unsigned xb_add(unsigned* p, unsigned v) { return __hip_atomic_fetch_add(p, v, __ATOMIC_RELAXED, __HIP_MEMORY_SCOPE_AGENT); }
__device__ __forceinline__ unsigned xb_xcc_id() { return (unsigned)__builtin_amdgcn_s_getreg((3 << 11) | 20) & 0xFu; }
#define XB_SPIN(cond, bar) do { unsigned _sp = 0; while (cond) { __builtin_amdgcn_s_sleep(1); \
    if ((++_sp & 255u) == 0u) { if (xb_ld(&(bar)[XB_TMO])) break; if (_sp > XB_SPIN_CAP) { atomicAdd(&(bar)[XB_TMO], 1u); break; } } } } while (0)
struct XcdBarrier { unsigned* bar; unsigned x; volatile LAS unsigned* st; };
__device__ __forceinline__ XcdBarrier xcd_barrier_post(unsigned* bar, volatile LAS unsigned* st) {
    XcdBarrier b; b.bar = bar; b.x = xb_xcc_id(); b.st = st;
    if (threadIdx.x == 0) (void)xb_add(&bar[XB_XCNT(b.x)], 1u);
    return b;
}
__device__ __forceinline__ void xcd_barrier_complete(unsigned* bar, unsigned x, unsigned& nloc, unsigned& nx) {
    const unsigned G = gridDim.x * gridDim.y * gridDim.z;
    unsigned sum, cnt, mine, sp = 0u;
    for (;;) {
        sum = 0u; cnt = 0u; mine = 0u;
#pragma unroll
        for (unsigned j = 0; j < 16; ++j) { const unsigned c = xb_ld(&bar[XB_XCNT(j)]); sum += c; cnt += (c > 0u) ? 1u : 0u; mine = (j == x) ? c : mine; }
        if (sum == G) break;
        __builtin_amdgcn_s_sleep(1);
        if ((++sp & 255u) == 0u) { if (xb_ld(&bar[XB_TMO])) break; if (sp > XB_SPIN_CAP) { atomicAdd(&bar[XB_TMO], 1u); break; } }
    }
    nloc = mine > 0u ? mine : 1u; nx = cnt > 0u ? cnt : 1u;
}
__device__ __forceinline__ void xcd_barrier(const XcdBarrier& b) {
    asm volatile("s_waitcnt vmcnt(0)" ::: "memory");
    __syncthreads();
    if (threadIdx.x == 0) {
        unsigned* bar = b.bar;
        __builtin_amdgcn_s_waitcnt(0);
        unsigned nloc = b.st[0], nx = b.st[1];
        if (nloc == 0u) { xcd_barrier_complete(bar, b.x, nloc, nx); b.st[0] = nloc; b.st[1] = nx; }
        const unsigned old = xb_add(&bar[XB_XSUB(b.x)], 1u);
        const unsigned gen = old / nloc;
        if (old + 1u == (gen + 1u) * nloc) {
            __builtin_amdgcn_fence(__ATOMIC_RELEASE, "agent");
            asm volatile("s_waitcnt vmcnt(0)" ::: "memory");
            const unsigned og = xb_add(&bar[XB_TOP], 1u);
            const unsigned tg = og / nx;
            if (og + 1u == (tg + 1u) * nx) xb_add(&bar[XB_TOPGEN], 1u);
            else XB_SPIN(xb_ld(&bar[XB_TOPGEN]) == tg, bar);
            __builtin_amdgcn_fence(__ATOMIC_ACQUIRE, "agent");
            xb_add(&bar[XB_XGEN(b.x)], 1u);
            asm volatile("s_waitcnt vmcnt(0)" ::: "memory");
        } else {
            XB_SPIN(xb_ld(&bar[XB_XGEN(b.x)]) == gen, bar);
            __builtin_amdgcn_fence(__ATOMIC_ACQUIRE, "agent");
            asm volatile("s_waitcnt vmcnt(0)" ::: "memory");
        }
    }
    __syncthreads();
}

struct Args { Ptrs p; int ph_lo, ph_hi, dbg, pad; };

#ifndef CONV_SPLIT_V
#define CONV_SPLIT_V 4096
#endif
#ifndef CONV_TAIL_V
#define CONV_TAIL_V 4096
#endif
__global__ void __launch_bounds__(NTHR, 2) mk_fwd(Args args) {
    extern __shared__ __attribute__((aligned(16))) unsigned char lds_raw[];
    LAS unsigned char* lds = (LAS unsigned char*)lds_raw;
    volatile LAS unsigned* MISC = (volatile LAS unsigned*)(lds + MISC_OFF);
    const Ptrs& p = args.p;
    unsigned char* ws = p.ws;
    const int tid = threadIdx.x, G = gridDim.x, bx = blockIdx.x;
    for (int u = tid; u < (LDS_BYTES - MISC_OFF) / 4; u += NTHR) ((LAS unsigned*)(lds + MISC_OFF))[u] = 0u;
    __syncthreads();
    const int lo = args.ph_lo, hi = args.ph_hi;
#ifndef REPS_LIST
#define REPS_LIST 1, 1, 1, 1, 1, 1, 1, 1, 1, 1, 1, 1
#endif
    constexpr int reps_tab[12] = {REPS_LIST};
    constexpr int CONV_SPLIT = CONV_SPLIT_V;
    constexpr int CONV_TAIL = CONV_TAIL_V;
    constexpr int P2_UNITS = (NROWS / 256) * (NPROJ_PAD / 256), P2_FULL = P2_UNITS - (P2_UNITS / 256) * 256;
    XcdBarrier bar; bar.bar = (unsigned*)ws + CW_BAR; bar.x = 0; bar.st = nullptr;
    if (hi - lo > 1) bar = xcd_barrier_post((unsigned*)ws + CW_BAR, MISC + 8);
#define IN(k) (lo <= (k) && (k) < hi)
#define SEAM(k) do { if (IN(k) && IN((k) + 1)) xcd_barrier(bar); } while (0)

    const int wv = __builtin_amdgcn_readfirstlane(tid >> 6), ln = tid & 63, gw = bx * NWAVES + wv, NGW = G * NWAVES;
    if (IN(0)) {
        for (int cb = bx; cb < 256; cb += G) misc::p0_mod(p, lds, cb);
        LAS float* scr = (LAS float*)(lds + wv * misc::TSCR);
        for (int it = gw; it < misc::IT_P0; it += NGW) misc::conv_item_p0(p, it, scr, ln);
    }
    if constexpr (reps_tab[0] > 1) { xcd_barrier(bar);
    if (IN(0)) {
        for (int cb = bx; cb < 256; cb += G) misc::p0_mod(p, lds, cb);
        LAS float* scr = (LAS float*)(lds + wv * misc::TSCR);
        for (int it = gw; it < misc::IT_P0; it += NGW) misc::conv_item_p0(p, it, scr, ln);
    }
    }
    SEAM(0);
    if (IN(1)) { misc::h_rows(p, gw, NGW, ln); }
    if constexpr (reps_tab[1] > 1) { xcd_barrier(bar);
    if (IN(1)) { misc::h_rows(p, gw, NGW, ln); }
    }
    SEAM(1);
    if (IN(2)) {
        pg8::Gemm g{(const bf16_t*)(ws + WS_H), (const bf16_t*)(ws + WS_WIN), D};
        pg8::StaticOrder S; S.init(NROWS / 256, NPROJ_PAD / 256, G, bx);
        pg8::EpiProj E{(bf16_t*)(ws + WS_P), (float*)(ws + WS_GZ), (const float*)(ws + WS_ROPE)};
        pg8::gemm_phase<pg8::EpiProj, pg8::StaticOrder, false>(lds + RING_OFF, g, S, E, nullptr);
        if (CONV_TAIL > 0 && bx >= P2_FULL) { LAS float* scr = (LAS float*)(lds + wv * misc::TSCR);
            for (int it = misc::IT_EXP - CONV_TAIL + (bx - P2_FULL) * NWAVES + wv; it < misc::IT_EXP; it += (G - P2_FULL) * NWAVES) misc::conv_item_exp(p, it, scr, ln); }
    }
    if constexpr (reps_tab[2] > 1) { xcd_barrier(bar);
    if (IN(2)) {
        pg8::Gemm g{(const bf16_t*)(ws + WS_H), (const bf16_t*)(ws + WS_WIN), D};
        pg8::StaticOrder S; S.init(NROWS / 256, NPROJ_PAD / 256, G, bx);
        pg8::EpiProj E{(bf16_t*)(ws + WS_P), (float*)(ws + WS_GZ), (const float*)(ws + WS_ROPE)};
        pg8::gemm_phase<pg8::EpiProj, pg8::StaticOrder, false>(lds + RING_OFF, g, S, E, nullptr);
    }
    }
    SEAM(2);
    if (IN(3)) {
        scan::run_c1(p, lds, bx);
    }
    SEAM(3);
    if (IN(4)) {
        scan::run_c2(p, lds, bx);
    }
    if constexpr (reps_tab[3] > 1) { xcd_barrier(bar);
    if (IN(3)) {
        scan::run_c1(p, lds, bx);
    }
    SEAM(3);
    if (IN(4)) {
        scan::run_c2(p, lds, bx);
    }
    }
    SEAM(4);
    if (IN(5)) {
        scan::run_c3(p, lds, bx, (bf16_t*)(ws + WS_H));
    }
    if constexpr (reps_tab[5] > 1) { xcd_barrier(bar);
    if (IN(5)) {
        scan::run_c3(p, lds, bx, (bf16_t*)(ws + WS_H));
    }
    }
    SEAM(5);
    if (IN(6)) {
        pg8::Gemm g{(const bf16_t*)(ws + WS_H), (const bf16_t*)(ws + WS_WOUT), D};
        pg8::StaticOrder S; S.init(NLAT / 256, D / 256, G, bx);
        pg8::EpiOut E{(bf16_t*)(ws + WS_XO), (const float*)(ws + WS_MOD)};
        pg8::gemm_phase<pg8::EpiOut, pg8::StaticOrder, false>(lds + RING_OFF, g, S, E, nullptr);
    }
    if constexpr (reps_tab[6] > 1) { xcd_barrier(bar);
    if (IN(6)) {
        pg8::Gemm g{(const bf16_t*)(ws + WS_H), (const bf16_t*)(ws + WS_WOUT), D};
        pg8::StaticOrder S; S.init(NLAT / 256, D / 256, G, bx);
        pg8::EpiOut E{(bf16_t*)(ws + WS_XO), (const float*)(ws + WS_MOD)};
        pg8::gemm_phase<pg8::EpiOut, pg8::StaticOrder, false>(lds + RING_OFF, g, S, E, nullptr);
    }
    }
    SEAM(6);
    if (IN(7)) {
        misc::stage_router(p, (LAS float*)lds, tid); __syncthreads();
        misc::norm2_router_rows(p, (const LAS float*)lds, gw, NGW, ln);
        __syncthreads();
        LAS float* scr = (LAS float*)(lds + wv * misc::TSCR);
        for (int it = gw; it < CONV_SPLIT; it += NGW) misc::conv_item_exp(p, it, scr, ln);
    }
    if constexpr (reps_tab[7] > 1) { xcd_barrier(bar);
    if (IN(7)) {
        misc::stage_router(p, (LAS float*)lds, tid); __syncthreads();
        misc::norm2_router_rows(p, (const LAS float*)lds, gw, NGW, ln);
        __syncthreads();
        LAS float* scr = (LAS float*)(lds + wv * misc::TSCR);
        for (int it = gw; it < CONV_SPLIT; it += NGW) misc::conv_item_exp(p, it, scr, ln);
    }
    }
    SEAM(7);
    if (IN(8)) { if (bx < 32) misc::topk_set(p, lds, bx);
        else { LAS float* scr = (LAS float*)(lds + wv * misc::TSCR); for (int it = CONV_SPLIT + (bx - 32) * NWAVES + wv; it < misc::IT_EXP - CONV_TAIL; it += (G - 32) * NWAVES) misc::conv_item_exp(p, it, scr, ln); } }
    if constexpr (reps_tab[8] > 1) { xcd_barrier(bar);
    if (IN(8)) { if (bx < 32) misc::topk_set(p, lds, bx);
        else { LAS float* scr = (LAS float*)(lds + wv * misc::TSCR); for (int it = CONV_SPLIT + (bx - 32) * NWAVES + wv; it < misc::IT_EXP - CONV_TAIL; it += (G - 32) * NWAVES) misc::conv_item_exp(p, it, scr, ln); } }
    }
    SEAM(8);
    if (IN(9)) {
        LAS unsigned* gtab = (LAS unsigned*)(lds + GTAB_OFF);
        pg8::MoeUpOrder S{bx};
        const int* IDX = (const int*)(ws + WS_IDX);
        { int idxv[6];
#pragma unroll
          for (int q6 = 0; q6 < 6; ++q6) { const int e = tid + q6 * NTHR, ec = e < 11 * 256 ? e : 11 * 256 - 1; pg8::Unit u; S.next(ec >> 8, u); idxv[q6] = IDX[u.pm * 256 + (ec & 255)]; }
#pragma unroll
          for (int q6 = 0; q6 < 6; ++q6) { const int e = tid + q6 * NTHR; if (e < 11 * 256) { pg8::Unit u; S.next(e >> 8, u); gtab[e] = (unsigned)((u.pm >> 7) * SEQ + (idxv[q6] & (SEQ - 1))) * (unsigned)D; } } }
        __syncthreads();
        pg8::Gemm g{(const bf16_t*)(ws + WS_H), (const bf16_t*)(ws + WS_WGU), D};
        pg8::EpiAct E{(unsigned char*)(ws + WS_ACT), 1.0f / 32.0f, 8.0f};
        pg8::gemm_phase<pg8::EpiAct, pg8::MoeUpOrder, true, true>(lds + RING_OFF, g, S, E, gtab);
    }
    if constexpr (reps_tab[9] > 1) { xcd_barrier(bar);
    if (IN(9)) {
        LAS unsigned* gtab = (LAS unsigned*)(lds + GTAB_OFF);
        pg8::MoeUpOrder S{bx};
        const int* IDX = (const int*)(ws + WS_IDX);
        { int idxv[6];
#pragma unroll
          for (int q6 = 0; q6 < 6; ++q6) { const int e = tid + q6 * NTHR, ec = e < 11 * 256 ? e : 11 * 256 - 1; pg8::Unit u; S.next(ec >> 8, u); idxv[q6] = IDX[u.pm * 256 + (ec & 255)]; }
#pragma unroll
          for (int q6 = 0; q6 < 6; ++q6) { const int e = tid + q6 * NTHR; if (e < 11 * 256) { pg8::Unit u; S.next(e >> 8, u); gtab[e] = (unsigned)((u.pm >> 7) * SEQ + (idxv[q6] & (SEQ - 1))) * (unsigned)D; } } }
        __syncthreads();
        pg8::Gemm g{(const bf16_t*)(ws + WS_H), (const bf16_t*)(ws + WS_WGU), D};
        pg8::EpiAct E{(unsigned char*)(ws + WS_ACT), 1.0f / 32.0f, 8.0f};
        pg8::gemm_phase<pg8::EpiAct, pg8::MoeUpOrder, true, true>(lds + RING_OFF, g, S, E, gtab);
    }
    }
    SEAM(9);
    if (IN(10)) {
        pg8::MoeDownOrder S{bx};
        pg8::Gemm g{(const bf16_t*)(ws + WS_ACT), (const bf16_t*)((const unsigned char*)p.out + OUT_WD), FFP};
        pg8::EpiDown E{(unsigned char*)(ws + WS_YE), (const float*)(ws + WS_GATE), 16.0f / 256.0f};
        pg8::gemm_phase<pg8::EpiDown, pg8::MoeDownOrder, false, true>(lds + RING_OFF, g, S, E, nullptr);
    }
    if constexpr (reps_tab[10] > 1) { xcd_barrier(bar);
    if (IN(10)) {
        pg8::MoeDownOrder S{bx};
        pg8::Gemm g{(const bf16_t*)(ws + WS_ACT), (const bf16_t*)((const unsigned char*)p.out + OUT_WD), FFP};
        pg8::EpiDown E{(unsigned char*)(ws + WS_YE), (const float*)(ws + WS_GATE), 16.0f / 256.0f};
        pg8::gemm_phase<pg8::EpiDown, pg8::MoeDownOrder, false, true>(lds + RING_OFF, g, S, E, nullptr);
    }
    }
    SEAM(10);
    if (IN(11)) { misc::final_rows(p, gw, NGW, ln); }
#undef IN
#undef SEAM
}

#ifndef USE_COOP
#define USE_COOP 1
#endif
extern "C" void kernel_launch(void* const* d_in, const int* in_sizes, int n_in, void* d_out, int out_size, void* d_ws, size_t ws_size, hipStream_t stream) {
    static int ready = 0;
    if (!ready) {
        if (n_in != 20 || in_sizes[0] != NLAT * D || out_size != NLAT * D || ws_size < WS_END) { fprintf(stderr, "kernel_launch: unexpected problem (n_in %d, out %d, ws %zu); nothing launched\n", n_in, out_size, ws_size); ready = -1; return; }
        if (hipFuncSetAttribute((const void*)mk_fwd, hipFuncAttributeMaxDynamicSharedMemorySize, LDS_BYTES) != hipSuccess) { fprintf(stderr, "kernel_launch: hipFuncSetAttribute failed\n"); ready = -1; return; }
        int dev = 0, cus = 0, per_cu = 0;
        (void)hipGetDevice(&dev); (void)hipDeviceGetAttribute(&cus, hipDeviceAttributeMultiprocessorCount, dev);
        (void)hipOccupancyMaxActiveBlocksPerMultiprocessor(&per_cu, (const void*)mk_fwd, NTHR, LDS_BYTES);
        if (cus * per_cu < 256) { fprintf(stderr, "kernel_launch: this kernel needs 256 co-resident workgroups (device reports %d CUs x %d); nothing launched\n", cus, per_cu); ready = -1; return; }
        ready = 1;
    }
    if (ready < 0) return;
    Args a{};
    const float** f = (const float**)&a.p;
    for (int i = 0; i < 20; ++i) f[i] = (const float*)d_in[i];
    a.p.out = (float*)d_out; a.p.ws = (unsigned char*)d_ws; a.ph_lo = 0; a.ph_hi = 12;
    (void)hipMemsetAsync((char*)d_ws + WS_CTL, 0, 64 * 1024, stream);
    void* args[] = {&a};
#if USE_COOP
    const hipError_t e = hipLaunchCooperativeKernel((const void*)mk_fwd, dim3(256), dim3(NTHR), args, LDS_BYTES, stream);
#else
    const hipError_t e = hipLaunchKernel((const void*)mk_fwd, dim3(256), dim3(NTHR), args, LDS_BYTES, stream);
#endif
    if (e != hipSuccess) fprintf(stderr, "kernel_launch: launch failed: %s\n", hipGetErrorString(e));
}
```

```cpp
#include <hip/hip_runtime.h>
#include <stdint.h>
#include <stdio.h>

typedef unsigned short bf16_t;
typedef unsigned int u32;

#ifndef USE_NT
#define USE_NT 1
#endif
#if USE_NT
#define NTL(T, p_) __builtin_nontemporal_load((const T*)(p_))
#define NTS(T, p_, v_) __builtin_nontemporal_store((v_), (T*)(p_))
#else
#define NTL(T, p_) (*(const T*)(p_))
#define NTS(T, p_, v_) (*(T*)(p_) = (v_))
#endif
#ifndef ALL_ST_NT
#define ALL_ST_NT 0
#endif
#ifndef ALL_ST_WT
#define ALL_ST_WT 0
#endif
#ifndef GEMM_IN_NT
#define GEMM_IN_NT 0
#endif
#if GEMM_IN_NT && USE_NT
#define STG(T, p_, v_) __builtin_nontemporal_store((v_), (T*)(p_))
#else
#define STG(T, p_, v_) STS(T, p_, v_)
#endif
typedef unsigned stw_u32x4 __attribute__((ext_vector_type(4)));
typedef unsigned stw_u32x2 __attribute__((ext_vector_type(2)));
__device__ __forceinline__ void st_wt(void* p_, stw_u32x4 v_) { asm volatile("global_store_dwordx4 %0, %1, off sc1\n\ts_nop 2" :: "v"(p_), "v"(v_) : "memory"); }
__device__ __forceinline__ void st_wt(void* p_, stw_u32x2 v_) { asm volatile("global_store_dwordx2 %0, %1, off sc1" :: "v"(p_), "v"(v_) : "memory"); }
__device__ __forceinline__ void st_wt(void* p_, unsigned v_) { asm volatile("global_store_dword %0, %1, off sc1" :: "v"(p_), "v"(v_) : "memory"); }
#if ALL_ST_NT && USE_NT
#define STS(T, p_, v_) __builtin_nontemporal_store((v_), (T*)(p_))
#elif ALL_ST_WT
#define STS(T, p_, v_) st_wt((void*)(p_), (v_))
#else
#define STS(T, p_, v_) (*(T*)(p_) = (v_))
#endif
constexpr int D = 1024, BATCH = 2, SEQ = 16384, CTX = 256;
constexpr int NLAT = BATCH * SEQ;
constexpr int NCTX = BATCH * CTX;
constexpr int NROWS = NLAT + NCTX;
constexpr int NADA = 6;
constexpr int NE = 16, CAP = 2048, FF = 1408, FFP = 1536;
constexpr int NSLOT = BATCH * NE * CAP;
constexpr float EPS = 1e-6f;
constexpr int C_GQ = 0, C_GK = 256, C_GV = 512, C_GG = 1024, C_RQ = 1536, C_RK = 2048, C_RV = 2560, C_RG = 3072, C_GZ = 3584;
constexpr int PW = 3584;
constexpr int NPROJ = 3616, NPROJ_PAD = 3840;
__host__ __device__ __forceinline__ size_t ptile(int row, int col) { return ((size_t)((row >> 6) * 28 + (col >> 7)) * 64 + (row & 63)) * 128 + (col & 127); }

constexpr size_t MiB = 1u << 20;
constexpr size_t WS_CTL = 0;
constexpr size_t WS_MOD = 1 * MiB;
constexpr size_t WS_ROPE = WS_MOD + 128 * 1024;
constexpr size_t WS_DCH = 2 * MiB;
constexpr size_t WS_WIN = 4 * MiB;
constexpr size_t WS_WOUT = 12 * MiB;
constexpr size_t WS_GZ = 14 * MiB;
constexpr size_t WS_H = 19 * MiB;
constexpr size_t WS_P = 84 * MiB;
constexpr size_t WS_US = 312 * MiB;
constexpr size_t WS_WGU = 84 * MiB;
constexpr size_t OUT_WD = 100 * MiB;
constexpr size_t WS_ACT = 216 * MiB;
constexpr size_t WS_XO = 312 * MiB;
constexpr size_t WS_AFF = 392 * MiB;
constexpr size_t WS_IDX = 394 * MiB;
constexpr size_t WS_GATE = 395 * MiB;
constexpr size_t WS_INV = 396 * MiB;
constexpr size_t WS_YE = 19 * MiB;
constexpr size_t WS_END = 508 * MiB;

__device__ __forceinline__ float bf2f(bf16_t v) { return __uint_as_float(((u32)v) << 16); }
__device__ __forceinline__ bf16_t f2bf(float f) { u32 u = __float_as_uint(f); return (bf16_t)((u + 0x7fffu + ((u >> 16) & 1u)) >> 16); }
__device__ __forceinline__ float siluf(float x) { return x / (1.0f + __expf(-x)); }
__device__ __forceinline__ float log_sigmoidf(float x) { return fminf(x, 0.f) - log1pf(__expf(-fabsf(x))); }
template <int CTRL, int RM> __device__ __forceinline__ float dppf(float v) { return __builtin_bit_cast(float, __builtin_amdgcn_update_dpp(0, __builtin_bit_cast(int, v), CTRL, RM, 0xF, false)); }
__device__ __forceinline__ float wave_sum(float v) {
    v += dppf<0xB1, 0xF>(v);
    v += dppf<0x4E, 0xF>(v);
    v += dppf<0x124, 0xF>(v);
    v += dppf<0x128, 0xF>(v);
    v += dppf<0x142, 0xA>(v);
    v += dppf<0x143, 0xC>(v);
    return __builtin_bit_cast(float, __builtin_amdgcn_readlane(__builtin_bit_cast(int, v), 63));
}
template <int CTRL, int RM> __device__ __forceinline__ float dppk(float v) { return __builtin_bit_cast(float, __builtin_amdgcn_update_dpp(__builtin_bit_cast(int, v), __builtin_bit_cast(int, v), CTRL, RM, 0xF, false)); }
__device__ __forceinline__ float wave_max(float v) {
    v = fmaxf(v, dppk<0xB1, 0xF>(v)); v = fmaxf(v, dppk<0x4E, 0xF>(v)); v = fmaxf(v, dppk<0x124, 0xF>(v)); v = fmaxf(v, dppk<0x128, 0xF>(v));
    v = fmaxf(v, dppk<0x142, 0xA>(v)); v = fmaxf(v, dppk<0x143, 0xC>(v));
    return __builtin_bit_cast(float, __builtin_amdgcn_readlane(__builtin_bit_cast(int, v), 63));
}
__host__ __device__ inline int proj_src_col(int n) {
    if (n < 1024) return n;
    if (n < 1536) return 1056 + (n - 1024);
    if (n < 2560) {
        const int base = (n < 2048) ? 1568 : 2080, m = (n < 2048) ? n - 1536 : n - 2048;
        const int hd = m >> 7, p = m & 127, g = p >> 3, nn = (p >> 2) & 1, e = p & 3;
        return base + hd * 128 + 64 * nn + 4 * g + e;
    }
    if (n < 3072) return 2592 + (n - 2560);
    if (n < 3584) return 3104 + (n - 3072);
    return 1024 + (n - 3584);
}

struct Ptrs {
    const float *x, *c, *ctx, *c_ctx, *w_ada, *b_ada, *norm1_w, *w_in, *gla_gate_w, *gla_gate_b, *ret_decay_logit, *gla_norm_w, *ret_norm_w,
        *w_out, *norm2_w, *w_router, *w_exp_gate, *w_exp_up, *w_exp_down, *final_norm_w;
    float* out;
    unsigned char* ws;
};


constexpr int NWAVES = 8, NTHR = NWAVES * 64;
#define LAS __attribute__((address_space(3)))
#define GAS __attribute__((address_space(1)))
typedef short bf16x8 __attribute__((ext_vector_type(8)));
typedef float f32x4 __attribute__((ext_vector_type(4)));
typedef float f32x2 __attribute__((ext_vector_type(2)));
typedef unsigned u32x4 __attribute__((ext_vector_type(4)));
typedef unsigned u32x2 __attribute__((ext_vector_type(2)));
typedef int i32x4 __attribute__((ext_vector_type(4)));
typedef int i32x8 __attribute__((ext_vector_type(8)));
#ifndef PG8_RELAX
#define PG8_RELAX 1
#ifndef PG8_RELAXW
#define PG8_RELAXW 0
#endif
#endif
#ifndef ACT_ST_NT
#define ACT_ST_NT 0
#endif
#ifndef PG8_A_AUX
#define PG8_A_AUX 0
#endif
#ifndef PG8_ALIGN_DEFAULT
#define PG8_ALIGN_DEFAULT true
#endif
namespace pg8 {
constexpr int BM = 256, BK = 64, HALF = 128, HTB = HALF * BK * 2  , STAGE_BYTES = 8 * HTB, NXCD = 8, WGM = 8;
__host__ __device__ __forceinline__ int lds_byte(int r, int c) { const int st = (r >> 4) * 2 + (c >> 5), rr = r & 15, cc = c & 31, ob = rr * 64 + cc * 2; return st * 1024 + (ob ^ (((ob >> 9) & 1) << 5)); }
__host__ __device__ __forceinline__ void stage_rc(int b, int& R, int& C) { const int st = b / 1024, sb = b % 1024, swz = sb ^ (((sb >> 9) & 1) << 5); R = (st >> 1) * 16 + swz / 64; C = (st & 1) * 32 + (swz % 64) / 2; }
__host__ __device__ __forceinline__ int perm32(int rho) { const int n = rho >> 4, i = rho & 15; return 8 * (i >> 2) + 4 * n + (i & 3); }

struct Unit { int pm, pn; };
struct Gemm { const bf16_t* A; const bf16_t* Bt; int K; };

struct StaticOrder {
    int nM, nN, nwg, G, c;
    __device__ void init(int nM_, int nN_, int G_, int c_) { nM = nM_; nN = nN_; nwg = nM * nN; G = G_; c = c_; }
    __device__ bool next(int i, Unit& u) const {
        const long L = (long)i * G + c; if (L >= nwg) return false;
        int wgid = (int)L; { const int q = nwg / NXCD, r = nwg % NXCD, xcd = wgid % NXCD, off = wgid / NXCD; wgid = (xcd < r ? xcd * (q + 1) : r * (q + 1) + (xcd - r) * q) + off; }
        const int nig = WGM * nN, gid = wgid / nig, fm = gid * WGM, gsz = (nM - fm) < WGM ? (nM - fm) : WGM;
        u.pm = fm + ((wgid % nig) % gsz); u.pn = (wgid % nig) / gsz; return true;
    }
};
struct MoeUpOrder {
    int c;
    __device__ bool next(int i, Unit& u) const {
        if (i >= 11) return false;
        const int g = i * 8 + (c & 7), j = c >> 3, combo = 4 * g + (j >> 3), mt = j & 7, be = combo / 11, pn = combo % 11;
        u.pm = be * 8 + mt; u.pn = (be & 15) * 11 + pn; return true;
    }
};
struct MoeDownOrder {
    int c;
    __device__ bool next(int i, Unit& u) const {
        if (i >= 4) return false;
        const int be = i * 8 + (c & 7), j = c >> 3, mt = j & 7, pn = j >> 3;
        u.pm = be * 8 + mt; u.pn = (be & 15) * 4 + pn; return true;
    }
};

__device__ __forceinline__ float fast_silu(float a) { return a * __builtin_amdgcn_rcpf(1.0f + __expf(-a)); }
typedef __bf16 bf16x2_t __attribute__((ext_vector_type(2)));
__device__ __forceinline__ unsigned cvt_pk_bf16(float lo, float hi) { const f32x2 v = {lo, hi}; const bf16x2_t r = __builtin_convertvector(v, bf16x2_t); return __builtin_bit_cast(unsigned, r); }

__device__ __forceinline__ unsigned pk_fp8x4(float a, float b, float c, float d) {
    a = __builtin_amdgcn_fmed3f(a, -448.f, 448.f); b = __builtin_amdgcn_fmed3f(b, -448.f, 448.f); c = __builtin_amdgcn_fmed3f(c, -448.f, 448.f); d = __builtin_amdgcn_fmed3f(d, -448.f, 448.f);
    int w = 0; w = __builtin_amdgcn_cvt_pk_fp8_f32(a, b, w, false); w = __builtin_amdgcn_cvt_pk_fp8_f32(c, d, w, true); return (unsigned)w;
}
template <class Epi, class Sched, bool GATHER, bool F8 = false, bool ALIGN_EPI = PG8_ALIGN_DEFAULT>
__device__ __forceinline__ void gemm_phase(LAS unsigned char* lds, const Gemm g, const Sched& S, const Epi& E, const LAS unsigned* gtab) {
    const int tid = threadIdx.x, wid = __builtin_amdgcn_readfirstlane(tid >> 6), lane = tid & 63, wr = wid >> 2, wc = wid & 3, fr = lane & 15, fq = lane >> 4;
    constexpr int ESZ = F8 ? 1 : 2;
    const int K = g.K, nt = K * ESZ / (BK * 2);
    int sR[2], sC[2];
    unsigned voffB[2], voffA[2];
#pragma unroll
    for (int i = 0; i < 2; ++i) { stage_rc(tid * 16 + i * 8192, sR[i], sC[i]); const int Rb = Epi::PERM ? ((sR[i] & ~31) + perm32(sR[i] & 31)) : sR[i];
        voffB[i] = (unsigned)(Rb * K * ESZ + sC[i] * 2); voffA[i] = (unsigned)(sR[i] * K * ESZ + sC[i] * 2); }
    const size_t kstep = (size_t)(BK * 2);
    const size_t hstep = (size_t)HALF * K * ESZ;
    const size_t tstep = 2 * hstep;
    const unsigned ldsw = (unsigned)wid * 1024u;
    const int aoff = lds_byte(wr * 64 + fr, fq * 8), boff = lds_byte(wc * 32 + fr, fq * 8);
    const int sw8 = (fq & 1) * 8;
    const int aoff8a = lds_byte(wr * 64 + fr, fq * 16 + sw8), aoff8b = lds_byte(wr * 64 + fr, fq * 16 + (8 - sw8)), boff8a = lds_byte(wc * 32 + fr, fq * 16 + sw8), boff8b = lds_byte(wc * 32 + fr, fq * 16 + (8 - sw8));
#define PG8_SA(b, h) (((b) * 2 + (h)) * HTB)
#define PG8_SB(b, h) ((4 + (b) * 2 + (h)) * HTB)
#define PG8_STAGE_X(bufoff, gbase, voff, aux_) do { _Pragma("unroll") for (int _i = 0; _i < 2; ++_i) \
        __builtin_amdgcn_global_load_lds((const unsigned*)((const char*)(gbase) + (voff)[_i]), (LAS unsigned*)(lds + (bufoff) + ldsw + _i * 8192), 16, 0, aux_); } while (0)
#define PG8_STAGE(bufoff, gbase, voff) PG8_STAGE_X(bufoff, gbase, voff, 0)
#define PG8_LDA(dst, b, h) do { if constexpr (F8) { _Pragma("unroll") for (int m = 0; m < 4; ++m) { const i32x4 lo_ = *(const LAS i32x4*)(lds + PG8_SA(b, h) + aoff8a + m * 2048), hi_ = *(const LAS i32x4*)(lds + PG8_SA(b, h) + aoff8b + m * 2048); \
            dst##8[m] = __builtin_shufflevector(lo_, hi_, 0, 1, 2, 3, 4, 5, 6, 7); } } \
        else { _Pragma("unroll") for (int m = 0; m < 4; ++m) _Pragma("unroll") for (int k = 0; k < 2; ++k) dst[m][k] = *(const LAS bf16x8*)(lds + PG8_SA(b, h) + aoff + m * 2048 + k * 1024); } } while (0)
#define PG8_LDB(dst, b, h) do { if constexpr (F8) { _Pragma("unroll") for (int n = 0; n < 2; ++n) { const i32x4 lo_ = *(const LAS i32x4*)(lds + PG8_SB(b, h) + boff8a + n * 2048), hi_ = *(const LAS i32x4*)(lds + PG8_SB(b, h) + boff8b + n * 2048); \
            dst##8[n] = __builtin_shufflevector(lo_, hi_, 0, 1, 2, 3, 4, 5, 6, 7); } } \
        else { _Pragma("unroll") for (int n = 0; n < 2; ++n) _Pragma("unroll") for (int k = 0; k < 2; ++k) dst[n][k] = *(const LAS bf16x8*)(lds + PG8_SB(b, h) + boff + n * 2048 + k * 1024); } } while (0)
#define PG8_MMA(ai, bj, At, Bt) do { __builtin_amdgcn_s_setprio(1); if constexpr (F8) { _Pragma("unroll") for (int m = 0; m < 4; ++m) _Pragma("unroll") for (int n = 0; n < 2; ++n) \
            asm volatile("v_mfma_f32_16x16x128_f8f6f4 %0, %1, %2, %0" : "+v"(acc[ai][bj][m][n]) : "v"(Bt##8[n]), "v"(At##8[m])); } \
        else { _Pragma("unroll") for (int m = 0; m < 4; ++m) _Pragma("unroll") for (int n = 0; n < 2; ++n) _Pragma("unroll") for (int k = 0; k < 2; ++k) \
            acc[ai][bj][m][n] = __builtin_amdgcn_mfma_f32_16x16x32_bf16(Bt[n][k], At[m][k], acc[ai][bj][m][n], 0, 0, 0); } __builtin_amdgcn_s_setprio(0); } while (0)
#define PG8_WAIT_V(n) asm volatile("s_waitcnt vmcnt(" #n ")" ::: "memory")
#define PG8_WAIT_VX(rel_) do { if (rel_) asm volatile("s_waitcnt vmcnt(%0)" :: "n"(8 + Epi::NS) : "memory"); else asm volatile("s_waitcnt vmcnt(8)" ::: "memory"); } while (0)
#define PG8_WAIT_L(n) asm volatile("s_waitcnt lgkmcnt(" #n ")" ::: "memory")
#define PG8_BAR __builtin_amdgcn_s_barrier()
#define PG8_SCHED __builtin_amdgcn_sched_barrier(0)
#define PG8_HOFF(h) (GATHER ? (size_t)0 : (size_t)(h) * hstep)
#define PG8_STAGE_A(bufoff, base_, h_, uq_) do { if constexpr (GATHER) { unsigned vo_[2]; _Pragma("unroll") for (int _i = 0; _i < 2; ++_i) vo_[_i] = gtab[(uq_) * 256 + (h_) * HALF + sR[_i]] + (unsigned)sC[_i] * 2u; PG8_STAGE_X(bufoff, base_, vo_, PG8_A_AUX); } \
        else { PG8_STAGE_X(bufoff, (base_) + PG8_HOFF(h_), voffA, PG8_A_AUX); } } while (0)
    Unit cur, nxt; int ui = 0;
    if (!S.next(0, cur)) return;
    f32x4 acc[2][2][4][2];
#pragma unroll
    for (int a = 0; a < 2; ++a)
#pragma unroll
        for (int b = 0; b < 2; ++b)
#pragma unroll
            for (int m = 0; m < 4; ++m)
#pragma unroll
                for (int n = 0; n < 2; ++n) acc[a][b][m][n] = (f32x4){0.f, 0.f, 0.f, 0.f};
    bf16x8 At[4][2], B0[2][2], B1[2][2]; i32x8 At8[4], B08[2], B18[2];
    const char* cA = (const char*)g.A + (GATHER ? (size_t)0 : (size_t)cur.pm * tstep); const char* cB = (const char*)g.Bt + (size_t)cur.pn * tstep;
    PG8_STAGE(PG8_SB(0, 0), cB, voffB); PG8_STAGE(PG8_SB(0, 1), cB + hstep, voffB); PG8_STAGE_A(PG8_SA(0, 0), cA, 0, 0); PG8_STAGE_A(PG8_SA(0, 1), cA, 1, 0);
    if (wr == 1) PG8_BAR;
    PG8_WAIT_V(2); PG8_BAR;
    PG8_STAGE(PG8_SB(1, 0), cB + kstep, voffB); PG8_STAGE_A(PG8_SA(1, 0), cA + kstep, 0, 0); PG8_STAGE(PG8_SB(1, 1), cB + hstep + kstep, voffB);
    PG8_WAIT_V(6); PG8_BAR;
    bool relax = false;
    for (;;) {
        const bool has_next = S.next(ui + 1, nxt);
        const char* nA = GATHER ? cA : (has_next ? (const char*)g.A + (size_t)nxt.pm * tstep : cA); const char* nB = has_next ? (const char*)g.Bt + (size_t)nxt.pn * tstep : cB;
#pragma unroll 1
        for (int t = 0; t < nt; t += 2) {
            const bool last = (t == nt - 2);
            const bool fresh = ALIGN_EPI && Epi::NS > 0 && ui > 0 && t == 0;
            const bool rel = fresh && relax;
            const char* a1 = cA + (size_t)(t + 1) * kstep;
            const char* a2 = last ? nA : cA + (size_t)(t + 2) * kstep; const char* b2 = last ? nB : cB + (size_t)(t + 2) * kstep;
            const char* a3 = a2 + kstep; const char* b3 = b2 + kstep;
            const int uq = (last && has_next) ? ui + 1 : ui;
            PG8_LDB(B0, 0, 0); PG8_LDB(B1, 0, 1); PG8_SCHED; PG8_LDA(At, 0, 0); if (!fresh) PG8_STAGE_A(PG8_SA(1, 1), a1, 1, ui);
            PG8_WAIT_VX(rel); PG8_WAIT_L(0); PG8_BAR; PG8_MMA(0, 0, At, B0); PG8_MMA(0, 1, At, B1); PG8_BAR; PG8_SCHED;
            PG8_LDA(At, 0, 1); PG8_STAGE(PG8_SB(0, 0), b2, voffB); PG8_STAGE(PG8_SB(0, 1), b2 + hstep, voffB); PG8_STAGE_A(PG8_SA(0, 0), a2, 0, uq);
            PG8_WAIT_VX(rel); PG8_WAIT_L(0); PG8_BAR; PG8_MMA(1, 0, At, B0); PG8_MMA(1, 1, At, B1); PG8_BAR; PG8_SCHED;
            PG8_LDB(B0, 1, 0); PG8_LDB(B1, 1, 1); PG8_SCHED; PG8_LDA(At, 1, 0); PG8_STAGE_A(PG8_SA(0, 1), a2, 1, uq);
            PG8_WAIT_VX(rel); PG8_WAIT_L(0); PG8_BAR; PG8_MMA(0, 0, At, B0); PG8_MMA(0, 1, At, B1); PG8_BAR; PG8_SCHED;
            PG8_LDA(At, 1, 1); PG8_STAGE(PG8_SB(1, 0), b3, voffB); PG8_STAGE(PG8_SB(1, 1), b3 + hstep, voffB); PG8_STAGE_A(PG8_SA(1, 0), a3, 0, uq);
            PG8_WAIT_V(8); PG8_WAIT_L(0); PG8_BAR; PG8_MMA(1, 0, At, B0); PG8_MMA(1, 1, At, B1); PG8_BAR; PG8_SCHED;
        }
        if constexpr (ALIGN_EPI) { if (wr == 0) PG8_BAR; }
        if constexpr (ALIGN_EPI && Epi::NS > 0) {
            PG8_STAGE_A(PG8_SA(1, 1), nA + kstep, 1, (has_next ? ui + 1 : ui)); relax = PG8_RELAXW && E.stores_all(cur); }
        if constexpr (F8) { asm volatile("s_nop 15\n\ts_nop 15" ::: "memory"); PG8_SCHED; }
        E(acc, cur, ui, wr, wc, fr, fq);
        if (!has_next) break;
#pragma unroll
        for (int a = 0; a < 2; ++a)
#pragma unroll
            for (int b = 0; b < 2; ++b)
#pragma unroll
                for (int m = 0; m < 4; ++m)
#pragma unroll
                    for (int n = 0; n < 2; ++n) acc[a][b][m][n] = (f32x4){0.f, 0.f, 0.f, 0.f};
        cur = nxt; cA = nA; cB = nB; ++ui;
        if constexpr (ALIGN_EPI) { if (wr == 1) PG8_BAR; }
    }
    PG8_WAIT_V(0);
    if constexpr (!ALIGN_EPI) { if (wr == 0) PG8_BAR; }
    PG8_BAR;
#undef PG8_SA
#undef PG8_SB
#undef PG8_STAGE
#undef PG8_STAGE_X
#undef PG8_LDA
#undef PG8_LDB
#undef PG8_MMA
#undef PG8_WAIT_V
#undef PG8_WAIT_VX
#undef PG8_WAIT_L
#undef PG8_BAR
#undef PG8_SCHED
#undef PG8_STAGE_A
#undef PG8_HOFF
}


struct EpiProj {
    static constexpr bool PERM = true; static constexpr int NS = PG8_RELAX ? 16 : 0;
    __device__ __forceinline__ bool stores_all(const Unit& u) const { return u.pn != 14; }
    bf16_t* P; float* GZ; const float* tab;
    __device__ __forceinline__ void operator()(const f32x4 (&acc)[2][2][4][2], const Unit& u, int ui, int wr, int wc, int fr, int fq) const {
        const int pn = u.pn, row0 = u.pm * BM + wr * 64 + fr, colw = wc * 32 + 8 * fq;
        if (pn == 14) {
            if (wc == 0) {
#pragma unroll
                for (int ai = 0; ai < 2; ++ai)
#pragma unroll
                    for (int m = 0; m < 4; ++m) { float* o = GZ + (size_t)(row0 + ai * HALF + m * 16) * 32 + 8 * fq; *(f32x4*)o = acc[ai][0][m][0]; *(f32x4*)(o + 4) = acc[ai][0][m][1]; }
            }
            return;
        }
        const int mode = (pn == 0) ? 1 : ((pn >= 6 && pn <= 9) ? 3 : 0);
        const float rks = (pn >= 8) ? 0.08838834764831845f : 1.0f;
        const bool ntst = (pn == 0) || (pn >= 4 && pn <= 7) || (pn >= 12);
        const bool lowhalf = wc < 2;
        const int f0 = (16 * wc + 4 * fq) & 31;
        float invt[4];
#pragma unroll
        for (int e = 0; e < 4; ++e) invt[e] = __builtin_amdgcn_exp2f(-(float)(f0 + e) * (13.287712379549449f / 32.0f)) * 0.15915494309189535f;
#pragma unroll
        for (int ai = 0; ai < 2; ++ai)
#pragma unroll
            for (int m = 0; m < 4; ++m) {
                const int row = row0 + ai * HALF + m * 16;
                bf16_t* rowp = P + ptile(row, pn * BM + colw);
                float c[4] = {1.f, 1.f, 1.f, 1.f}, s[4] = {0.f, 0.f, 0.f, 0.f};
                if (mode == 3) { const int t = row & (SEQ - 1); const float pos = (row < NLAT) ? (float)(lowhalf ? (t >> 6) : (t & 63)) : 0.f;
#pragma unroll
                    for (int e = 0; e < 4; ++e) { const float tr = __builtin_amdgcn_fractf(pos * invt[e]); c[e] = __builtin_amdgcn_cosf(tr); s[e] = __builtin_amdgcn_sinf(tr); } }
#pragma unroll
                for (int bj = 0; bj < 2; ++bj) {
                    f32x4 v0 = acc[ai][bj][m][0], v1 = acc[ai][bj][m][1];
                    if (mode == 1) { v0 = v0 * 0.125f; v1 = v1 * 0.125f; }
                    else if (mode == 3) {
                        v0 = v0 * rks; v1 = v1 * rks;
#pragma unroll
                        for (int e = 0; e < 4; ++e) { const float a1 = v0[e], a2 = v1[e]; v0[e] = a1 * c[e] - a2 * s[e]; v1[e] = a1 * s[e] + a2 * c[e]; }
                    }
                    u32x4 w; w.x = cvt_pk_bf16(v0[0], v0[1]); w.y = cvt_pk_bf16(v0[2], v0[3]); w.z = cvt_pk_bf16(v1[0], v1[1]); w.w = cvt_pk_bf16(v1[2], v1[3]);
                    if (ntst) NTS(u32x4, rowp + bj * 8192, w); else STS(u32x4, rowp + bj * 8192, w);
                }
            }
    }
};
struct EpiOut {
    static constexpr bool PERM = true; static constexpr int NS = PG8_RELAX ? 16 : 0;
    __device__ __forceinline__ bool stores_all(const Unit&) const { return true; }
    bf16_t* XO; const LAS float* m2l;
    __device__ __forceinline__ void operator()(const f32x4 (&acc)[2][2][4][2], const Unit& u, int ui, int wr, int wc, int fr, int fq) const {
        const int col0 = u.pn * BM + wc * 32 + 8 * fq, b = (u.pm * BM) / SEQ;
        const LAS float* m2 = m2l + b * D;
        f32x4 mv[2][2];
#pragma unroll
        for (int bj = 0; bj < 2; ++bj)
#pragma unroll
            for (int n = 0; n < 2; ++n) mv[bj][n] = *(const LAS f32x4*)(m2 + col0 + bj * HALF + 4 * n);
#pragma unroll
        for (int ai = 0; ai < 2; ++ai)
#pragma unroll
            for (int m = 0; m < 4; ++m) { bf16_t* rowp = XO + (size_t)(u.pm * BM + ai * HALF + wr * 64 + m * 16 + fr) * D + col0;
#pragma unroll
                for (int bj = 0; bj < 2; ++bj) { const f32x4 v0 = mv[bj][0] * acc[ai][bj][m][0], v1 = mv[bj][1] * acc[ai][bj][m][1];
                    u32x4 w; w.x = cvt_pk_bf16(v0[0], v0[1]); w.y = cvt_pk_bf16(v0[2], v0[3]); w.z = cvt_pk_bf16(v1[0], v1[1]); w.w = cvt_pk_bf16(v1[2], v1[3]);
                    STS(u32x4, rowp + bj * HALF, w); } }
    }
};
struct EpiAct {
    static constexpr bool PERM = true; static constexpr int NS = PG8_RELAX ? 8 : 0;
    __device__ __forceinline__ bool stores_all(const Unit&) const { return true; }
    unsigned char* ACT; float wscale, ascale;
    __device__ __forceinline__ void operator()(const f32x4 (&acc)[2][2][4][2], const Unit& u, int ui, int wr, int wc, int fr, int fq) const {
        const int pnl = u.pn % 11, col0 = pnl * HALF + wc * 32 + 8 * fq;
        const float c1 = -1.4426950408889634f * wscale, kinv = 1.0f / (wscale * wscale * ascale);
#pragma unroll
        for (int ai = 0; ai < 2; ++ai)
#pragma unroll
            for (int m = 0; m < 4; ++m) { unsigned char* rowp = ACT + (size_t)(u.pm * BM + ai * HALF + wr * 64 + m * 16 + fr) * FFP;
                float vv[2][4];
#pragma unroll
                for (int n = 0; n < 2; ++n)
#pragma unroll
                    for (int hh = 0; hh < 2; ++hh) { const f32x2 gg = {acc[ai][0][m][n][2 * hh], acc[ai][0][m][n][2 * hh + 1]}, uu = {acc[ai][1][m][n][2 * hh], acc[ai][1][m][n][2 * hh + 1]};
                        const f32x2 tt = gg * (f32x2){c1, c1}; const f32x2 ee = {__builtin_amdgcn_exp2f(tt[0]), __builtin_amdgcn_exp2f(tt[1])};
                        const f32x2 dd = __builtin_elementwise_fma(ee, (f32x2){kinv, kinv}, (f32x2){kinv, kinv}); const f32x2 rr = {__builtin_amdgcn_rcpf(dd[0]), __builtin_amdgcn_rcpf(dd[1])};
                        const f32x2 pp = (gg * uu) * rr; vv[n][2 * hh] = pp[0]; vv[n][2 * hh + 1] = pp[1]; }
                u32x2 w; w.x = pk_fp8x4(vv[0][0], vv[0][1], vv[0][2], vv[0][3]); w.y = pk_fp8x4(vv[1][0], vv[1][1], vv[1][2], vv[1][3]);
                if (ACT_ST_NT) NTS(u32x2, rowp + col0, w); else STG(u32x2, rowp + col0, w);
                if (pnl == 10) *(u32x2*)(rowp + FF + wc * 32 + 8 * fq) = (u32x2){0u, 0u}; }
    }
};
struct EpiDown {
    static constexpr bool PERM = true; static constexpr int NS = PG8_RELAX ? 16 : 0;
    __device__ __forceinline__ bool stores_all(const Unit&) const { return true; }
    unsigned char* YE; const LAS float* gate; float oscale;
    __device__ __forceinline__ void operator()(const f32x4 (&acc)[2][2][4][2], const Unit& u, int ui, int wr, int wc, int fr, int fq) const {
        const int col0 = (u.pn & 3) * BM + wc * 32 + 8 * fq;
        float gts[2][4];
#pragma unroll
        for (int ai = 0; ai < 2; ++ai)
#pragma unroll
            for (int m = 0; m < 4; ++m) gts[ai][m] = gate[ui * BM + ai * HALF + wr * 64 + m * 16 + fr];
#pragma unroll
        for (int ai = 0; ai < 2; ++ai)
#pragma unroll
            for (int m = 0; m < 4; ++m) { const int row = u.pm * BM + ai * HALF + wr * 64 + m * 16 + fr; const float gt = gts[ai][m] * oscale; unsigned char* rowp = YE + (size_t)row * D + col0;
#pragma unroll
                for (int bj = 0; bj < 2; ++bj) { const f32x4 v0 = acc[ai][bj][m][0] * gt, v1 = acc[ai][bj][m][1] * gt;
                    u32x2 w; w.x = pk_fp8x4(v0[0], v0[1], v0[2], v0[3]); w.y = pk_fp8x4(v1[0], v1[1], v1[2], v1[3]);
                    STS(u32x2, rowp + bj * HALF, w); } }
    }
};
}

namespace scan {
constexpr int RS = 72;
constexpr int RS2 = 136;
constexpr int OS = 132;
constexpr int NSL = 260;
constexpr size_t GLA_SLOT = 128 * 64, RET_SLOT = 128 * 128;
constexpr size_t US_RET_OFF = (size_t)16 * NSL * GLA_SLOT;
__device__ __forceinline__ int slot_row0(int b, int slot) { return slot < 4 ? NLAT + b * CTX + slot * 64 : b * SEQ + (slot - 4) * 64; }
__device__ __forceinline__ int slot_at(int dir, int step) { return dir ? (step < 4 ? 3 - step : 263 - step) : step; }
__device__ __forceinline__ f32x4 mfma16(bf16x8 a, bf16x8 b, f32x4 c) { return __builtin_amdgcn_mfma_f32_16x16x32_bf16(a, b, c, 0, 0, 0); }
__device__ __forceinline__ bf16x8 lds_frag(const LAS bf16_t* base, int off) { return *(const LAS bf16x8*)(base + off); }
__device__ __forceinline__ int tsw_w(int row, int j) { return row * RS + ((((j >> 3) ^ ((row >> 4) & 7)) << 3) | (j & 7)); }
__device__ __forceinline__ int tsw_r(int row, int chunk) { return row * RS + ((chunk ^ ((row >> 4) & 7)) << 3); }
__device__ __forceinline__ bf16x8 lds_frag_pi(const LAS bf16_t* base, int off  ) {
    typedef short s4 __attribute__((ext_vector_type(4)));
    const s4 lo = *(const LAS s4*)(base + off), hi = *(const LAS s4*)(base + off + 16);
    return (bf16x8){lo[0], lo[1], lo[2], lo[3], hi[0], hi[1], hi[2], hi[3]};
}
__device__ __forceinline__ unsigned pk(float lo, float hi) { return pg8::cvt_pk_bf16(lo, hi); }
__device__ __forceinline__ bf16_t f2bf_hw(float x) { return (bf16_t)(pg8::cvt_pk_bf16(x, 0.f) & 0xffffu); }
__device__ __forceinline__ float sum8(float v) { v += dppf<0xB1, 0xF>(v); v += dppf<0x4E, 0xF>(v); v += dppf<0x141, 0xF>(v); return v; }
__device__ __forceinline__ unsigned char* bc_base(const Ptrs& p, int bh) { return p.ws + WS_US + 2 * US_RET_OFF + (size_t)(bh * 2) * NSL * RET_SLOT * 2 + (size_t)NSL * RET_SLOT; }
typedef _Float16 f16x2_t __attribute__((ext_vector_type(2)));
__device__ __forceinline__ unsigned pk_h2(float a, float b) { const f32x2 v = {a, b}; const f16x2_t h = __builtin_convertvector(v, f16x2_t); return __builtin_bit_cast(unsigned, h); }
__device__ __forceinline__ f32x2 un_h2(unsigned u) { const f16x2_t h = __builtin_bit_cast(f16x2_t, u); return __builtin_convertvector(h, f32x2); }
__device__ __forceinline__ u32x2 pack_state8(const f32x4 a0, const f32x4 a1) { u32x2 o; o.x = pg8::pk_fp8x4(a0[0], a0[1], a0[2], a0[3]); o.y = pg8::pk_fp8x4(a1[0], a1[1], a1[2], a1[3]); return o; }
__device__ __forceinline__ bf16x8 unpack_state8(const u32x2 w) {
    const f32x2 a = __builtin_amdgcn_cvt_pk_f32_fp8((int)w.x, false), b = __builtin_amdgcn_cvt_pk_f32_fp8((int)w.x, true), c = __builtin_amdgcn_cvt_pk_f32_fp8((int)w.y, false), d = __builtin_amdgcn_cvt_pk_f32_fp8((int)w.y, true);
    const u32x4 r = {pk(a[0], a[1]), pk(b[0], b[1]), pk(c[0], c[1]), pk(d[0], d[1])};
    return __builtin_bit_cast(bf16x8, r);
}

typedef float f32x4m __attribute__((ext_vector_type(4)));
__device__ __forceinline__ void gla_stepA(const float (&wm)[2][2][4], float bf, float bb, int w, int lane, const LAS float* gz_s, LAS float* PR, LAS float* tot, float (&bi)[8], float (&ci)[8], float& allf, float& allb) {
    { const int it = w >> 1, c = lane & 15, q = lane >> 4;
      float a_f[4], a_b[4];
#pragma unroll
      for (int sx = 0; sx < 4; ++sx) { a_f[sx] = gz_s[(16 * it + c) * 36 + 4 * sx + q]; a_b[sx] = gz_s[(16 * it + c) * 36 + 16 + 4 * sx + q]; }
#pragma unroll
      for (int kk = 0; kk < 2; ++kk) { const int kt = 2 * (w & 1) + kk; f32x4 df = {0.f, 0.f, 0.f, 0.f}, db = {0.f, 0.f, 0.f, 0.f};
#pragma unroll
          for (int sx = 0; sx < 4; ++sx) { df = __builtin_amdgcn_mfma_f32_16x16x4f32(a_f[sx], wm[0][kk][sx], df, 0, 0, 0); db = __builtin_amdgcn_mfma_f32_16x16x4f32(a_b[sx], wm[1][kk][sx], db, 0, 0, 0); }
#pragma unroll
          for (int r = 0; r < 4; ++r) { PR[(16 * it + 4 * q + r) * 65 + 16 * kt + c] = df[r]; PR[64 * 65 + (16 * it + 4 * q + r) * 65 + 16 * kt + c] = db[r]; } } }
    __syncthreads();
    float laf[8], lab[8];
#pragma unroll
    for (int tt = 0; tt < 8; ++tt) {
        const float pf = bf + PR[(8 * w + tt) * 65 + lane], pb = bb + PR[64 * 65 + (8 * w + tt) * 65 + lane];
        laf[tt] = (fminf(pf, 0.f) - 0.6931471805599453f * __builtin_amdgcn_logf(1.0f + __builtin_amdgcn_exp2f(-1.4426950408889634f * fabsf(pf)))) * 0.0625f;
        lab[tt] = (fminf(pb, 0.f) - 0.6931471805599453f * __builtin_amdgcn_logf(1.0f + __builtin_amdgcn_exp2f(-1.4426950408889634f * fabsf(pb)))) * 0.0625f;
    }
#pragma unroll
    for (int tt = 1; tt < 8; ++tt) laf[tt] += laf[tt - 1];
#pragma unroll
    for (int tt = 6; tt >= 0; --tt) lab[tt] += lab[tt + 1];
    tot[w * 64 + lane] = laf[7]; tot[512 + w * 64 + lane] = lab[0];
    __syncthreads();
    float offf = 0.f, offb = 0.f; allf = 0.f; allb = 0.f;
#pragma unroll
    for (int w2 = 0; w2 < 8; ++w2) { const float tf = tot[w2 * 64 + lane], tb = tot[512 + w2 * 64 + lane]; allf += tf; allb += tb; if (w2 < w) offf += tf; if (w2 > w) offb += tb; }
#pragma unroll
    for (int tt = 0; tt < 8; ++tt) { bi[tt] = offf + laf[tt]; ci[tt] = offb + lab[tt]; }
}
__device__ __forceinline__ void load_gate_wm(const Ptrs& p, int h, int w, int lane, float (&wm)[2][2][4]) {
#pragma unroll
    for (int dir = 0; dir < 2; ++dir)
#pragma unroll
        for (int kk = 0; kk < 2; ++kk)
#pragma unroll
            for (int sx = 0; sx < 4; ++sx) wm[dir][kk][sx] = p.gla_gate_w[(dir * 16 + 4 * sx + (lane >> 4)) * 256 + h * 64 + 16 * (2 * (w & 1) + kk) + (lane & 15)];
}
__device__ __forceinline__ int img_off(int row, int ch) { return 256 * row + 16 * (ch ^ (((row & 3) << 2) | ((row >> 2) & 3))); }
__device__ __forceinline__ void stage_vt_regs(const u32x4 a, const u32x4 b, LAS bf16_t* VT, int tid) {
    const int j = tid >> 3, vg = tid & 7; LAS unsigned char* img = (LAS unsigned char*)VT;
    *(LAS u32x4*)(img + img_off(j, vg)) = a; *(LAS u32x4*)(img + img_off(j, 8 + vg)) = b;
}
typedef short s16x4 __attribute__((ext_vector_type(4)));
__device__ __forceinline__ bf16x8 tr_frag(const LAS bf16_t* T, int lane, int cb, int ks) {
    const LAS unsigned char* img = (const LAS unsigned char*)T;
    const int g = lane >> 4, qq = (lane & 15) >> 2, pp = lane & 3, r0 = 32 * ks + 8 * g + qq, ch = 2 * cb + (pp >> 1);
    const s16x4 lo = __builtin_amdgcn_ds_read_tr16_b64_v4i16((LAS s16x4*)(img + img_off(r0, ch) + 8 * (pp & 1)));
    const s16x4 hi = __builtin_amdgcn_ds_read_tr16_b64_v4i16((LAS s16x4*)(img + img_off(r0 + 4, ch) + 8 * (pp & 1)));
    return (bf16x8){lo[0], lo[1], lo[2], lo[3], hi[0], hi[1], hi[2], hi[3]};
}
#ifndef C1_NT
#define C1_NT 1
#endif
#if C1_NT
#define C1NTL(T, p_) NTL(T, p_)
#else
#define C1NTL(T, p_) (*(const T*)(p_))
#endif
#ifndef S_F8_GLA
#define S_F8_GLA 1
#endif
#ifndef S_F8_RET
#define S_F8_RET 1
#endif
#ifndef C1G_REP
#define C1G_REP 1
#endif
#ifndef C1R_REP
#define C1R_REP 1
#endif
#ifndef C2_NB
#define C2_NB 13
#endif
#define SCAN_FENCE() asm volatile("" ::: "memory")

__device__ __forceinline__ void run_c1(const Ptrs& p, LAS unsigned char* lds, int bx) {
    const int tid = threadIdx.x, w = __builtin_amdgcn_readfirstlane(tid >> 6), lane = tid & 63, c = lane & 15, q = lane >> 4;
    const int bh = bx >> 5, b = bh >> 2, h = bh & 3, s0 = bx & 31;
    const bf16_t* P = (const bf16_t*)(p.ws + WS_P);
    const int jrow = tid >> 3, g8 = tid & 7;
#define C1_DUMMY(n_, g_) do { _Pragma("unroll") for (int d_ = 0; d_ < (n_); ++d_) *(u32x2*)(p.ws + 524288 + ((g_) * 8 + d_) * 4096 + tid * 8) = (u32x2){0u, 0u}; } while (0)
    {
        LAS float* gz_s = (LAS float*)lds; LAS float* tot = (LAS float*)(lds + 91648); LAS float* PR = (LAS float*)(lds + 58368);
        LAS bf16_t* KfT = (LAS bf16_t*)(lds + 12288); LAS bf16_t* KbT = (LAS bf16_t*)(lds + 21504); LAS bf16_t* VT = (LAS bf16_t*)(lds + 30720); LAS bf16_t* Kraw = (LAS bf16_t*)(lds + 49152);
        float wm[2][2][4]; load_gate_wm(p, h, w, lane, wm);
        const float bf = p.gla_gate_b[h * 64 + lane], bb = p.gla_gate_b[256 + h * 64 + lane];
        f32x4 gzv_A, gzv_B; u32x4 va_A, vb_A, kv_A, va_B, vb_B, kv_B;
#define C1G_LOAD(S, slot_) do { const int r0_ = slot_row0(b, (slot_)); gzv_##S = C1NTL(f32x4, (const f32x4*)((const float*)(p.ws + WS_GZ) + (size_t)r0_ * 32) + tid); \
            const bf16_t* rv_ = P + ptile(r0_ + jrow, C_GV + h * 128 + g8 * 8); va_##S = C1NTL(u32x4, rv_); vb_##S = C1NTL(u32x4, rv_ + 64); \
            kv_##S = C1NTL(u32x4, P + ptile(r0_ + jrow, C_GK + h * 64 + g8 * 8)); } while (0)
#define C1G_ITEM(S, slot, PF) do { \
            *(LAS f32x4*)(gz_s + jrow * 36 + g8 * 4) = gzv_##S; stage_vt_regs(va_##S, vb_##S, VT, tid); *(LAS u32x4*)(Kraw + jrow * RS + g8 * 8) = kv_##S; \
            __syncthreads(); \
            if (PF && (slot) + 64 < NSL) C1G_LOAD(S, (slot) + 64); \
            float bi[8], ci[8], allf, allb; \
            gla_stepA(wm, bf, bb, w, lane, gz_s, PR, tot, bi, ci, allf, allb); \
            { u32x4 b4_, c4_; b4_.x = pk_h2(bi[0], bi[1]); b4_.y = pk_h2(bi[2], bi[3]); b4_.z = pk_h2(bi[4], bi[5]); b4_.w = pk_h2(bi[6], bi[7]); \
              c4_.x = pk_h2(ci[0], ci[1]); c4_.y = pk_h2(ci[2], ci[3]); c4_.z = pk_h2(ci[4], ci[5]); c4_.w = pk_h2(ci[6], ci[7]); \
              u32x4* bc_ = (u32x4*)(bc_base(p, bh) + ((size_t)(slot) * NTHR + tid) * 32); bc_[0] = b4_; bc_[1] = c4_; } \
            { float ef[8], eb[8]; \
            _Pragma("unroll") \
              for (int tt = 0; tt < 8; ++tt) { const float kk = bf2f(Kraw[(8 * w + tt) * RS + lane]); ef[tt] = kk * __expf(allf - bi[tt]); eb[tt] = kk * __expf(allb - ci[tt]); } \
              u32x4 wf_, wb_; wf_.x = pk(ef[0], ef[1]); wf_.y = pk(ef[2], ef[3]); wf_.z = pk(ef[4], ef[5]); wf_.w = pk(ef[6], ef[7]); \
              wb_.x = pk(eb[0], eb[1]); wb_.y = pk(eb[2], eb[3]); wb_.z = pk(eb[4], eb[5]); wb_.w = pk(eb[6], eb[7]); \
              *(LAS u32x4*)(KfT + lane * RS + 8 * w) = wf_; *(LAS u32x4*)(KbT + lane * RS + 8 * w) = wb_; } \
            float* DCH = (float*)(p.ws + WS_DCH); \
            DCH[((size_t)(bh * 2 + 0) * NSL + (slot)) * 64 + lane] = __expf(allf); DCH[((size_t)(bh * 2 + 1) * NSL + (slot)) * 64 + lane] = __expf(allb);     \
            __syncthreads(); \
            unsigned char* US = (unsigned char*)p.out; \
            bf16x8 Bv[2]; \
            _Pragma("unroll") \
            for (int js = 0; js < 2; ++js) Bv[js] = tr_frag(VT, lane, w, js); \
            _Pragma("unroll") \
            for (int dir = 0; dir < 2; ++dir) { const LAS bf16_t* KT = dir ? KbT : KfT; \
            _Pragma("unroll") \
                for (int ks = 0; ks < 2; ++ks) { f32x4 a0 = {0.f, 0.f, 0.f, 0.f}, a1 = {0.f, 0.f, 0.f, 0.f}; \
            _Pragma("unroll") \
                    for (int js = 0; js < 2; ++js) { a0 = mfma16(lds_frag(KT, (32 * ks + c) * RS + 32 * js + 8 * q), Bv[js], a0); a1 = mfma16(lds_frag(KT, (32 * ks + 16 + c) * RS + 32 * js + 8 * q), Bv[js], a1); } \
                    STS(u32x2, US + ((size_t)(bh * 2 + dir) * NSL + (slot)) * GLA_SLOT + ((w * 2 + ks) * 64 + lane) * 8, pack_state8(a0, a1)); } } \
            __syncthreads(); \
        } while (0)
        for (int rep1_ = 0; rep1_ < C1G_REP; ++rep1_) {
        C1G_LOAD(A, s0); C1_DUMMY(8, 0); C1G_LOAD(B, s0 + 32); C1_DUMMY(8, 1);
        int slot = s0;
        for (; slot + 32 < NSL; slot += 64) {
            C1G_ITEM(A, slot, 1);
            C1G_ITEM(B, slot + 32, 1);
        }
        if (slot < NSL) C1G_ITEM(A, slot, 0);
        }
#undef C1G_ITEM
#undef C1G_LOAD
    }
    {
        LAS bf16_t* Kr = (LAS bf16_t*)lds; LAS bf16_t* Vr = (LAS bf16_t*)(lds + 18432);
        const float lgf = log_sigmoidf(p.ret_decay_logit[h]), lgb = log_sigmoidf(p.ret_decay_logit[4 + h]);
        float sfv[2][8], sbv[2][8];
#pragma unroll
        for (int js = 0; js < 2; ++js)
#pragma unroll
            for (int e = 0; e < 8; ++e) { const int j = 32 * js + 8 * q + e; sfv[js][e] = __expf(lgf * (float)(63 - j)); sbv[js][e] = __expf(lgb * (float)j); }
        u32x4 ka_A, kb_A, va_A, vb_A, ka_B, kb_B, va_B, vb_B;
#define C1R_LOAD(S, slot_) do { const int rr_ = slot_row0(b, (slot_)) + jrow; const bf16_t* rk_ = P + ptile(rr_, C_RK + h * 128 + g8 * 8); const bf16_t* rv_ = P + ptile(rr_, C_RV + h * 128 + g8 * 8); \
            ka_##S = C1NTL(u32x4, rk_); kb_##S = C1NTL(u32x4, rk_ + 64); va_##S = C1NTL(u32x4, rv_); vb_##S = C1NTL(u32x4, rv_ + 64); } while (0)
#define C1R_SCALE(dst, raw, s_) do { const u32x4 rw_ = __builtin_bit_cast(u32x4, raw); u32x4 o_; \
            o_.x = pk(__uint_as_float(rw_.x << 16) * s_[0], __uint_as_float(rw_.x & 0xffff0000u) * s_[1]); o_.y = pk(__uint_as_float(rw_.y << 16) * s_[2], __uint_as_float(rw_.y & 0xffff0000u) * s_[3]); \
            o_.z = pk(__uint_as_float(rw_.z << 16) * s_[4], __uint_as_float(rw_.z & 0xffff0000u) * s_[5]); o_.w = pk(__uint_as_float(rw_.w << 16) * s_[6], __uint_as_float(rw_.w & 0xffff0000u) * s_[7]); \
            dst = __builtin_bit_cast(bf16x8, o_); } while (0)
#define C1R_ITEM(S, slot, PF) do { \
            stage_vt_regs(ka_##S, kb_##S, Kr, tid); stage_vt_regs(va_##S, vb_##S, Vr, tid); \
            __syncthreads(); \
            if (PF && (slot) + 64 < NSL) C1R_LOAD(S, (slot) + 64); \
            unsigned char* US = (unsigned char*)p.out + US_RET_OFF; \
            bf16x8 Bv[2][2]; \
            _Pragma("unroll") \
            for (int js = 0; js < 2; ++js) { const bf16x8 raw_ = tr_frag(Vr, lane, w, js); C1R_SCALE(Bv[0][js], raw_, sfv[js]); C1R_SCALE(Bv[1][js], raw_, sbv[js]); } \
            _Pragma("unroll") \
            for (int ks = 0; ks < 4; ++ks) { f32x4 a0 = {0.f, 0.f, 0.f, 0.f}, a1 = {0.f, 0.f, 0.f, 0.f}, b0 = {0.f, 0.f, 0.f, 0.f}, b1 = {0.f, 0.f, 0.f, 0.f}; \
            _Pragma("unroll") \
                for (int js = 0; js < 2; ++js) { const bf16x8 k0_ = tr_frag(Kr, lane, 2 * ks, js), k1_ = tr_frag(Kr, lane, 2 * ks + 1, js); \
                    a0 = mfma16(k0_, Bv[0][js], a0); a1 = mfma16(k1_, Bv[0][js], a1); b0 = mfma16(k0_, Bv[1][js], b0); b1 = mfma16(k1_, Bv[1][js], b1); } \
                STS(u32x2, US + ((size_t)(bh * 2 + 0) * NSL + (slot)) * RET_SLOT + ((w * 4 + ks) * 64 + lane) * 8, pack_state8(a0, a1)); \
                STS(u32x2, US + ((size_t)(bh * 2 + 1) * NSL + (slot)) * RET_SLOT + ((w * 4 + ks) * 64 + lane) * 8, pack_state8(b0, b1)); } \
            __syncthreads(); \
        } while (0)
        for (int rep2_ = 0; rep2_ < C1R_REP; ++rep2_) {
        const int s0r = (s0 + 28) & 31;
        C1R_LOAD(A, s0r); C1_DUMMY(8, 2); C1R_LOAD(B, s0r + 32); C1_DUMMY(8, 3);
        int slot = s0r;
        for (; slot + 32 < NSL; slot += 64) {
            C1R_ITEM(A, slot, 1);
            C1R_ITEM(B, slot + 32, 1);
        }
        if (slot < NSL) C1R_ITEM(A, slot, 0);
        }
#undef C1R_ITEM
#undef C1R_LOAD
#undef C1R_SCALE
    }
#undef C1_DUMMY
}
__device__ __forceinline__ void run_c2(const Ptrs& p, LAS unsigned char* lds, int bx) {
    constexpr int NB = C2_NB, GLA_ELEMS = 16 * 8192;
    const int tid = threadIdx.x;
    LAS float* dl = (LAS float*)lds;
    const int e_blk = bx * 1536, c0 = e_blk >> 13;
    if (e_blk < GLA_ELEMS) {
        const int c1 = ((e_blk + 1535) >> 13) < 15 ? ((e_blk + 1535) >> 13) : 15;
        const f32x4* src = (const f32x4*)((const float*)(p.ws + WS_DCH) + (size_t)c0 * NSL * 64);
        const int n4 = (c1 - c0 + 1) * NSL * 16;
        for (int i0 = tid; i0 < n4; i0 += 4 * NTHR) {
            f32x4 dv[4];
#pragma unroll
            for (int q4 = 0; q4 < 4; ++q4) { const int i = i0 + q4 * NTHR; dv[q4] = src[i < n4 ? i : i0]; }
#pragma unroll
            for (int q4 = 0; q4 < 4; ++q4) { const int i = i0 + q4 * NTHR; if (i < n4) ((LAS f32x4*)dl)[i] = dv[q4]; } }
    }
    __syncthreads();
    if (tid < 192) {
        const int e = e_blk + tid * 8;
        const bool isG = e < GLA_ELEMS;
        const int er = isG ? e : e - GLA_ELEMS;
        const int chain = isG ? (er >> 13) : (er >> 14), el = isG ? (er & 8191) : (er & 16383);
        const size_t SLOT = isG ? GLA_SLOT : RET_SLOT;
        const int dir = chain & 1, h = (chain >> 1) & 3;
        const size_t off = (isG ? 0 : US_RET_OFF) + (size_t)chain * NSL * SLOT + el;
        const unsigned char* ubase = (const unsigned char*)p.out + off;
        bf16_t* sbase = (bf16_t*)(p.ws + WS_US) + off;
        const bool s8 = isG ? (S_F8_GLA != 0) : (S_F8_RET != 0);
        const float dconst = __expf(64.0f * log_sigmoidf(p.ret_decay_logit[dir * 4 + h]));
        const int kb = 32 * ((el >> 9) & 1) + 4 * (((el >> 3) & 63) >> 4);
        const LAS float* dlc = dl + (isG ? (chain - c0) : 0) * NSL * 64 + kb;
        f32x4 s0 = {0.f, 0.f, 0.f, 0.f}, s1 = {0.f, 0.f, 0.f, 0.f};
        u32x2 uA[NB], uB[NB];
#define C2_LOAD(U_, bt_) do { _Pragma("unroll") for (int i = 0; i < NB; ++i) { const int slot = slot_at(dir, (bt_) * NB + i); U_[i] = NTL(u32x2, ubase + (size_t)slot * SLOT); } } while (0)
#define C2_PROC(U_, bt_) do { _Pragma("unroll") for (int i = 0; i < NB; ++i) { const int slot = slot_at(dir, (bt_) * NB + i); \
        if (s8) STS(u32x2, (unsigned char*)(p.ws + WS_US) + off * 2 - el + (size_t)slot * SLOT, pack_state8(s0, s1)); else { u32x4 o_; o_.x = pk(s0[0], s0[1]); o_.y = pk(s0[2], s0[3]); o_.z = pk(s1[0], s1[1]); o_.w = pk(s1[2], s1[3]); *(u32x4*)(sbase + (size_t)slot * SLOT) = o_; } \
        const f32x2 a_ = __builtin_amdgcn_cvt_pk_f32_fp8((int)U_[i].x, false), b_ = __builtin_amdgcn_cvt_pk_f32_fp8((int)U_[i].x, true), c_ = __builtin_amdgcn_cvt_pk_f32_fp8((int)U_[i].y, false), d_ = __builtin_amdgcn_cvt_pk_f32_fp8((int)U_[i].y, true); \
        const f32x4 u0 = {a_[0], a_[1], b_[0], b_[1]}, u1 = {c_[0], c_[1], d_[0], d_[1]}; \
        if (isG) { const f32x4 d0 = *(const LAS f32x4*)(dlc + slot * 64), d1 = *(const LAS f32x4*)(dlc + slot * 64 + 16); s0 = s0 * d0 + u0; s1 = s1 * d1 + u1; } else { s0 = s0 * dconst + u0; s1 = s1 * dconst + u1; } } } while (0)
        C2_LOAD(uA, 0);
        for (int bt = 0; bt < NSL / NB; bt += 2) {
            C2_LOAD(uB, bt + 1);
            C2_PROC(uA, bt);
            if (bt + 2 < NSL / NB) C2_LOAD(uA, bt + 2);
            C2_PROC(uB, bt + 1);
        }
#undef C2_LOAD
#undef C2_PROC
    }
    __syncthreads();
}
__device__ __forceinline__ void run_c3(const Ptrs& p, LAS unsigned char* lds, int bx, bf16_t* Y) {
    const int tid = threadIdx.x, w = __builtin_amdgcn_readfirstlane(tid >> 6), lane = tid & 63, c = lane & 15, q = lane >> 4;
    const int bh = bx >> 5, b = bh >> 2, h = bh & 3, n0 = bx & 31;
    const bf16_t* P = (const bf16_t*)(p.ws + WS_P);
    const int jrow = tid >> 3, g8 = tid & 7;
#define C3_SB() do {} while (0)
    {
        LAS bf16_t* QF = (LAS bf16_t*)(lds + 12288); LAS bf16_t* QB = (LAS bf16_t*)(lds + 21504); LAS bf16_t* KF = (LAS bf16_t*)(lds + 30720); LAS bf16_t* KB = (LAS bf16_t*)(lds + 39936);
        LAS bf16_t* VT = (LAS bf16_t*)(lds + 49152); LAS bf16_t* Pm = (LAS bf16_t*)(lds + 67584); LAS float* Os = (LAS float*)(lds + 76800);
        static_assert(S_F8_RET == 1, "the log-decay prefixes from C1 live in the unused half of the fp8-S region");
        f32x4 nwv[4];
#pragma unroll
        for (int k = 0; k < 4; ++k) nwv[k] = *(const f32x4*)(p.gla_norm_w + h * 128 + 16 * g8 + 4 * k);
        const bf16_t* US = (const bf16_t*)(p.ws + WS_US);
        u32x4 bcA, bcB, va, vb, qv, kv; bf16x8 Sf[2], Sb[2]; u32x2 Sf8[2], Sb8[2]; u32x4 ga, gb;
#define C3G_LOAD1(n_) do { const int r0_ = b * SEQ + (n_) * 64; { const u32x4* bc_ = (const u32x4*)(bc_base(p, bh) + ((size_t)(4 + (n_)) * NTHR + tid) * 32); bcA = NTL(u32x4, bc_); bcB = NTL(u32x4, bc_ + 1); } \
            const bf16_t* rv_ = P + ptile(r0_ + jrow, C_GV + h * 128 + g8 * 8); va = NTL(u32x4, rv_); vb = NTL(u32x4, rv_ + 64); \
            qv = NTL(u32x4, P + ptile(r0_ + jrow, C_GQ + h * 64 + g8 * 8)); kv = NTL(u32x4, P + ptile(r0_ + jrow, C_GK + h * 64 + g8 * 8)); } while (0)
#define C3G_LOADS(n_) do { _Pragma("unroll") for (int ks = 0; ks < 2; ++ks) { if (S_F8_GLA) { \
                    Sf8[ks] = NTL(u32x2, (const unsigned char*)US + (size_t)(bh * 2 + 0) * NSL * GLA_SLOT * 2 + (size_t)(4 + (n_)) * GLA_SLOT + ((w * 2 + ks) * 64 + lane) * 8); \
                    Sb8[ks] = NTL(u32x2, (const unsigned char*)US + (size_t)(bh * 2 + 1) * NSL * GLA_SLOT * 2 + (size_t)(4 + (n_)) * GLA_SLOT + ((w * 2 + ks) * 64 + lane) * 8); } else { \
                    Sf[ks] = *(const bf16x8*)(US + ((size_t)(bh * 2 + 0) * NSL + 4 + (n_)) * GLA_SLOT + ((w * 2 + ks) * 64 + lane) * 8); \
                    Sb[ks] = *(const bf16x8*)(US + ((size_t)(bh * 2 + 1) * NSL + 4 + (n_)) * GLA_SLOT + ((w * 2 + ks) * 64 + lane) * 8); } } } while (0)
#define C3G_LOADG(n_) do { const bf16_t* rg_ = P + ptile(b * SEQ + (n_) * 64 + jrow, C_GG + h * 128 + 16 * g8); ga = NTL(u32x4, rg_); gb = NTL(u32x4, rg_ + 8); } while (0)
        C3G_LOAD1(n0); C3G_LOADS(n0); C3G_LOADG(n0);
        for (int n = n0; n < 256; n += 32) {
            const int row0 = b * SEQ + n * 64, nn = (n + 32 < 256) ? n + 32 : n;
            stage_vt_regs(va, vb, VT, tid);
            *(LAS u32x4*)(QF + jrow * RS + g8 * 8) = qv; *(LAS u32x4*)(KF + jrow * RS + g8 * 8) = kv;
            float bi[8], ci[8];
            { const unsigned bw_[4] = {bcA.x, bcA.y, bcA.z, bcA.w}, cw_[4] = {bcB.x, bcB.y, bcB.z, bcB.w};
#pragma unroll
              for (int e2 = 0; e2 < 4; ++e2) { const f32x2 b2 = un_h2(bw_[e2]), c2 = un_h2(cw_[e2]); bi[2 * e2] = b2[0]; bi[2 * e2 + 1] = b2[1]; ci[2 * e2] = c2[0]; ci[2 * e2 + 1] = c2[1]; } }
            __syncthreads();
            C3G_LOAD1(nn);
#pragma unroll
            for (int tt = 0; tt < 8; ++tt) { const int i = 8 * w + tt; const float qq = bf2f(QF[i * RS + lane]), kk = bf2f(KF[i * RS + lane]);
                QF[i * RS + lane] = f2bf_hw(qq * __expf(bi[tt])); QB[i * RS + lane] = f2bf_hw(qq * __expf(ci[tt]));
                KF[i * RS + lane] = f2bf_hw(kk * __expf(fminf(-bi[tt], 80.f))); KB[i * RS + lane] = f2bf_hw(kk * __expf(fminf(-ci[tt], 80.f))); }
            __syncthreads();
            { const int it = w & 3, i = 16 * it + c;
              bf16x8 qf[2], qb[2];
#pragma unroll
              for (int ks = 0; ks < 2; ++ks) { qf[ks] = lds_frag(QF, i * RS + 32 * ks + 8 * q); qb[ks] = lds_frag(QB, i * RS + 32 * ks + 8 * q); }
#pragma unroll
              for (int jj = 0; jj < 2; ++jj) { const int jt = 2 * (w >> 2) + jj; f32x4 af = {0.f, 0.f, 0.f, 0.f}, ab = {0.f, 0.f, 0.f, 0.f};
#pragma unroll
                  for (int ks = 0; ks < 2; ++ks) { af = mfma16(lds_frag(KF, (16 * jt + c) * RS + 32 * ks + 8 * q), qf[ks], af); ab = mfma16(lds_frag(KB, (16 * jt + c) * RS + 32 * ks + 8 * q), qb[ks], ab); }
                  float v[4];
#pragma unroll
                  for (int r = 0; r < 4; ++r) { const int j = 16 * jt + 4 * q + r; v[r] = (j <= i ? af[r] : 0.f) + (j >= i ? ab[r] : 0.f); }
                  u32x2 o; o.x = pk(v[0], v[1]); o.y = pk(v[2], v[3]); *(LAS u32x2*)(Pm + i * RS + 16 * jt + 4 * q) = o; } }
            __syncthreads();
            if (S_F8_GLA) {
#pragma unroll
                for (int ks = 0; ks < 2; ++ks) { Sf[ks] = unpack_state8(Sf8[ks]); Sb[ks] = unpack_state8(Sb8[ks]); } }
            { bf16x8 Bv[2], fr[2][6];
#pragma unroll
              for (int js = 0; js < 2; ++js) Bv[js] = tr_frag(VT, lane, w, js);
#define C3G_FR(F, it_) do { const int i_ = 16 * (it_) + c; F[0] = lds_frag(Pm, i_ * RS + 8 * q); F[1] = lds_frag(Pm, i_ * RS + 32 + 8 * q); F[2] = lds_frag_pi(QF, i_ * RS + 4 * q); F[3] = lds_frag_pi(QF, i_ * RS + 32 + 4 * q); \
                  F[4] = lds_frag_pi(QB, i_ * RS + 4 * q); F[5] = lds_frag_pi(QB, i_ * RS + 32 + 4 * q); } while (0)
              C3G_FR(fr[0], 0);
#pragma unroll
              for (int it = 0; it < 4; ++it) {
                  if (it < 3) C3G_FR(fr[(it + 1) & 1], it + 1);
                  C3_SB();
                  const bf16x8 (&F)[6] = fr[it & 1];
                  f32x4 a0 = mfma16(F[0], Bv[0], (f32x4){0.f, 0.f, 0.f, 0.f}), a1 = mfma16(F[2], Sf[0], (f32x4){0.f, 0.f, 0.f, 0.f});
                  a0 = mfma16(F[1], Bv[1], a0); a1 = mfma16(F[3], Sf[1], a1); a0 = mfma16(F[4], Sb[0], a0); a1 = mfma16(F[5], Sb[1], a1);
#pragma unroll
                  for (int r = 0; r < 4; ++r) Os[(16 * it + 4 * q + r) * OS + 16 * w + c] = a0[r] + a1[r];
                  C3_SB(); }
#undef C3G_FR
            }
            C3G_LOADS(nn);
            __syncthreads();
            { const LAS float* orow = Os + jrow * OS + 16 * g8;
              f32x4 o4[4];
#pragma unroll
              for (int k = 0; k < 4; ++k) o4[k] = *(const LAS f32x4*)(orow + 4 * k);
              float ss = 0.f;
#pragma unroll
              for (int k = 0; k < 4; ++k)
#pragma unroll
                  for (int e = 0; e < 4; ++e) ss = fmaf(o4[k][e], o4[k][e], ss);
              ss = sum8(ss);
              const float r = __builtin_amdgcn_rsqf(ss * (1.f / 128.f) + EPS);
              const unsigned gw[8] = {ga.x, ga.y, ga.z, ga.w, gb.x, gb.y, gb.z, gb.w}; unsigned ow[8];
#pragma unroll
              for (int k = 0; k < 4; ++k)
#pragma unroll
                  for (int hh = 0; hh < 2; ++hh) { const unsigned g = gw[2 * k + hh];
                      ow[2 * k + hh] = pk(o4[k][2 * hh] * r * nwv[k][2 * hh] * pg8::fast_silu(__uint_as_float(g << 16)), o4[k][2 * hh + 1] * r * nwv[k][2 * hh + 1] * pg8::fast_silu(__uint_as_float(g & 0xffff0000u))); }
              bf16_t* yp = Y + (size_t)(row0 + jrow) * D + h * 128 + 16 * g8;
              STG(u32x4, yp, ((u32x4){ow[0], ow[1], ow[2], ow[3]})); STG(u32x4, yp + 8, ((u32x4){ow[4], ow[5], ow[6], ow[7]})); }
            C3G_LOADG(nn);
        }
        __syncthreads();
#undef C3G_LOAD1
#undef C3G_LOADS
#undef C3G_LOADG
    }
    {
        LAS bf16_t* Qs = (LAS bf16_t*)lds; LAS bf16_t* Ks = (LAS bf16_t*)(lds + 17408); LAS bf16_t* VT = (LAS bf16_t*)(lds + 34816); LAS bf16_t* Pm = (LAS bf16_t*)(lds + 53248);
        LAS float* Os = (LAS float*)(lds + 62464); LAS float* pwf = (LAS float*)(lds + 96256); LAS float* pwb = pwf + 80;
        const float lgf = log_sigmoidf(p.ret_decay_logit[h]), lgb = log_sigmoidf(p.ret_decay_logit[4 + h]);
        if (tid < 65) { pwf[tid] = __expf(lgf * (float)tid); pwb[tid] = __expf(lgb * (float)tid); }
        f32x4 nwv[4];
#pragma unroll
        for (int k = 0; k < 4; ++k) nwv[k] = *(const f32x4*)(p.ret_norm_w + h * 128 + 16 * g8 + 4 * k);
        const bf16_t* US = (const bf16_t*)(p.ws + WS_US) + US_RET_OFF;
        float dmr[2][4], dwfr[4][4], dwbr[4][4];
#pragma unroll
        for (int jj = 0; jj < 2; ++jj)
#pragma unroll
            for (int r = 0; r < 4; ++r) { const int dd = (16 * (w & 3) + c) - (16 * (2 * (w >> 2) + jj) + 4 * q + r);
                dmr[jj][r] = (dd >= 0 ? __expf(lgf * (float)dd) : 0.f) + (dd <= 0 ? __expf(lgb * (float)(-dd)) : 0.f); }
#pragma unroll
        for (int it = 0; it < 4; ++it)
#pragma unroll
            for (int r = 0; r < 4; ++r) { const int ii = 16 * it + 4 * q + r; dwfr[it][r] = __expf(lgf * (float)(ii + 1)); dwbr[it][r] = __expf(lgb * (float)(64 - ii)); }
        u32x4 qa, qb2, ka, kb2, va, vb; bf16x8 Sf[4], Sb[4]; u32x2 Sf8[4], Sb8[4]; u32x4 ga, gb;
#define C3R_LOAD1(n_) do { const int r0_ = b * SEQ + (n_) * 64; const bf16_t* rq_ = P + ptile(r0_ + jrow, C_RQ + h * 128 + g8 * 8); const bf16_t* rk_ = P + ptile(r0_ + jrow, C_RK + h * 128 + g8 * 8); const bf16_t* rv_ = P + ptile(r0_ + jrow, C_RV + h * 128 + g8 * 8); \
            qa = NTL(u32x4, rq_); qb2 = NTL(u32x4, rq_ + 64); ka = NTL(u32x4, rk_); kb2 = NTL(u32x4, rk_ + 64); \
            va = NTL(u32x4, rv_); vb = NTL(u32x4, rv_ + 64); } while (0)
#define C3R_LOADS(n_) do { _Pragma("unroll") for (int ks = 0; ks < 4; ++ks) { if (S_F8_RET) { \
                    Sf8[ks] = NTL(u32x2, (const unsigned char*)US + (size_t)(bh * 2 + 0) * NSL * RET_SLOT * 2 + (size_t)(4 + (n_)) * RET_SLOT + ((w * 4 + ks) * 64 + lane) * 8); \
                    Sb8[ks] = NTL(u32x2, (const unsigned char*)US + (size_t)(bh * 2 + 1) * NSL * RET_SLOT * 2 + (size_t)(4 + (n_)) * RET_SLOT + ((w * 4 + ks) * 64 + lane) * 8); } else { \
                    Sf[ks] = *(const bf16x8*)(US + ((size_t)(bh * 2 + 0) * NSL + 4 + (n_)) * RET_SLOT + ((w * 4 + ks) * 64 + lane) * 8); \
                    Sb[ks] = *(const bf16x8*)(US + ((size_t)(bh * 2 + 1) * NSL + 4 + (n_)) * RET_SLOT + ((w * 4 + ks) * 64 + lane) * 8); } } } while (0)
#define C3R_LOADG(n_) do { const bf16_t* rg_ = P + ptile(b * SEQ + (n_) * 64 + jrow, C_RG + h * 128 + 16 * g8); ga = NTL(u32x4, rg_); gb = NTL(u32x4, rg_ + 8); } while (0)
        C3R_LOAD1(n0); C3R_LOADS(n0); C3R_LOADG(n0);
        for (int n = n0; n < 256; n += 32) {
            const int row0 = b * SEQ + n * 64, nn = (n + 32 < 256) ? n + 32 : n;
            *(LAS u32x4*)(Qs + jrow * RS2 + g8 * 8) = qa; *(LAS u32x4*)(Qs + jrow * RS2 + 64 + g8 * 8) = qb2;
            *(LAS u32x4*)(Ks + jrow * RS2 + g8 * 8) = ka; *(LAS u32x4*)(Ks + jrow * RS2 + 64 + g8 * 8) = kb2;
            stage_vt_regs(va, vb, VT, tid);
            __syncthreads();
            C3R_LOAD1(nn);
            { const int it = w & 3, i = 16 * it + c;
              bf16x8 qf[4];
#pragma unroll
              for (int ks = 0; ks < 4; ++ks) qf[ks] = lds_frag(Qs, i * RS2 + 32 * ks + 8 * q);
#pragma unroll
              for (int jj = 0; jj < 2; ++jj) { const int jt = 2 * (w >> 2) + jj; f32x4 a = {0.f, 0.f, 0.f, 0.f};
#pragma unroll
                  for (int ks = 0; ks < 4; ++ks) a = mfma16(lds_frag(Ks, (16 * jt + c) * RS2 + 32 * ks + 8 * q), qf[ks], a);
                  float v[4];
#pragma unroll
                  for (int r = 0; r < 4; ++r) v[r] = a[r] * dmr[jj][r];
                  u32x2 o; o.x = pk(v[0], v[1]); o.y = pk(v[2], v[3]); *(LAS u32x2*)(Pm + i * RS + 16 * jt + 4 * q) = o; } }
            __syncthreads();
            if (S_F8_RET) {
#pragma unroll
                for (int ks = 0; ks < 4; ++ks) { Sf[ks] = unpack_state8(Sf8[ks]); Sb[ks] = unpack_state8(Sb8[ks]); } }
            { bf16x8 Bv[2], fr[2][6]; f32x4 dwf[2], dwb[2];
#pragma unroll
              for (int js = 0; js < 2; ++js) Bv[js] = tr_frag(VT, lane, w, js);
#define C3R_FR(F, WF, WB, it_) do { const int i_ = 16 * (it_) + c; F[0] = lds_frag(Pm, i_ * RS + 8 * q); F[1] = lds_frag(Pm, i_ * RS + 32 + 8 * q); \
                  _Pragma("unroll") for (int ks = 0; ks < 4; ++ks) F[2 + ks] = lds_frag_pi(Qs, i_ * RS2 + 32 * ks + 4 * q); \
                  (void)WF; (void)WB; } while (0)
              C3R_FR(fr[0], dwf[0], dwb[0], 0);
#pragma unroll
              for (int it = 0; it < 4; ++it) {
                  if (it < 3) C3R_FR(fr[(it + 1) & 1], dwf[(it + 1) & 1], dwb[(it + 1) & 1], it + 1);
                  C3_SB();
                  const bf16x8 (&F)[6] = fr[it & 1];
                  f32x4 a = mfma16(F[0], Bv[0], (f32x4){0.f, 0.f, 0.f, 0.f}), af = mfma16(F[2], Sf[0], (f32x4){0.f, 0.f, 0.f, 0.f}), ab = mfma16(F[2], Sb[0], (f32x4){0.f, 0.f, 0.f, 0.f});
                  a = mfma16(F[1], Bv[1], a); af = mfma16(F[3], Sf[1], af); ab = mfma16(F[3], Sb[1], ab);
                  af = mfma16(F[4], Sf[2], af); ab = mfma16(F[4], Sb[2], ab); af = mfma16(F[5], Sf[3], af); ab = mfma16(F[5], Sb[3], ab);
#pragma unroll
                  for (int r = 0; r < 4; ++r) Os[(16 * it + 4 * q + r) * OS + 16 * w + c] = a[r] + dwfr[it][r] * af[r] + dwbr[it][r] * ab[r];
                  C3_SB(); }
#undef C3R_FR
            }
            C3R_LOADS(nn);
            __syncthreads();
            { const LAS float* orow = Os + jrow * OS + 16 * g8;
              f32x4 o4[4];
#pragma unroll
              for (int k = 0; k < 4; ++k) o4[k] = *(const LAS f32x4*)(orow + 4 * k);
              float s1 = 0.f;
#pragma unroll
              for (int k = 0; k < 4; ++k) s1 += (o4[k][0] + o4[k][1]) + (o4[k][2] + o4[k][3]);
              const float mu = sum8(s1) * (1.f / 128.f);
              float ss = 0.f;
#pragma unroll
              for (int k = 0; k < 4; ++k)
#pragma unroll
                  for (int e = 0; e < 4; ++e) { o4[k][e] -= mu; ss = fmaf(o4[k][e], o4[k][e], ss); }
              ss = sum8(ss);
              const float r = __builtin_amdgcn_rsqf(ss * (1.f / 128.f) + EPS);
              const unsigned gw[8] = {ga.x, ga.y, ga.z, ga.w, gb.x, gb.y, gb.z, gb.w}; unsigned ow[8];
#pragma unroll
              for (int k = 0; k < 4; ++k)
#pragma unroll
                  for (int hh = 0; hh < 2; ++hh) { const unsigned g = gw[2 * k + hh];
                      ow[2 * k + hh] = pk(o4[k][2 * hh] * r * nwv[k][2 * hh] * pg8::fast_silu(__uint_as_float(g << 16)), o4[k][2 * hh + 1] * r * nwv[k][2 * hh + 1] * pg8::fast_silu(__uint_as_float(g & 0xffff0000u))); }
              bf16_t* yp = Y + (size_t)(row0 + jrow) * D + 512 + h * 128 + 16 * g8;
              STG(u32x4, yp, ((u32x4){ow[0], ow[1], ow[2], ow[3]})); STG(u32x4, yp + 8, ((u32x4){ow[4], ow[5], ow[6], ow[7]})); }
            C3R_LOADG(nn);
        }
        __syncthreads();
#undef C3R_LOAD1
#undef C3R_LOADS
#undef C3R_LOADG
    }
#undef C3_SB
}
}

namespace misc {
__device__ __forceinline__ void p0_mod(const Ptrs& p, LAS unsigned char* lds, int bx) {
    LAS float* sc = (LAS float*)lds;
    LAS float* red = sc + 3 * D;
    const int tid = threadIdx.x;
    { float cv[6];
#pragma unroll
      for (int q6 = 0; q6 < 6; ++q6) { const int i = tid + q6 * NTHR, r = i >> 10, k = i & 1023; cv[q6] = (r < 2) ? p.c[r * D + k] : p.c_ctx[k]; }
#pragma unroll
      for (int q6 = 0; q6 < 6; ++q6) sc[tid + q6 * NTHR] = siluf(cv[q6]); }
    __syncthreads();
    const int kg = tid >> 5, cl = tid & 31, col = 24 * bx + cl;
    float a0 = 0.f, a1 = 0.f, a2 = 0.f;
    if (cl < 24) {
#pragma unroll 16
        for (int k = kg * 64; k < kg * 64 + 64; ++k) { const float w = NTL(float, p.w_ada + (size_t)k * (NADA * D) + col); a0 += sc[k] * w; a1 += sc[D + k] * w; a2 += sc[2 * D + k] * w; }
    }
    red[(kg * 3 + 0) * 32 + cl] = a0; red[(kg * 3 + 1) * 32 + cl] = a1; red[(kg * 3 + 2) * 32 + cl] = a2;
    __syncthreads();
    if (tid < 96) { const int r = tid >> 5, c2 = tid & 31; if (c2 < 24) { float s = 0.f;
#pragma unroll
        for (int g = 0; g < 16; ++g) s += red[(g * 3 + r) * 32 + c2];
        const int cc = 24 * bx + c2; ((float*)(p.ws + WS_MOD))[r * NADA * D + cc] = s + p.b_ada[cc]; } }
    __syncthreads();
}
constexpr int TSCR = 64 * 65 * 4;
__device__ __forceinline__ void transpose_tile(const float* src, int ldsrc, int k0, int n0s, bf16_t* dst, int ldt, int n0d, LAS float* scr, int lane) {
    const int kr = lane >> 4, nq = lane & 15;
    f32x4 v[16];
#pragma unroll
    for (int i = 0; i < 16; ++i) v[i] = NTL(f32x4, src + (size_t)(k0 + 4 * i + kr) * ldsrc + n0s + 4 * nq);
#pragma unroll
    for (int i = 0; i < 16; ++i) { LAS float* s = scr + (4 * i + kr) * 65 + 4 * nq; s[0] = v[i][0]; s[1] = v[i][1]; s[2] = v[i][2]; s[3] = v[i][3]; }
    asm volatile("s_waitcnt lgkmcnt(0)" ::: "memory");
    const int c = lane & 7, ns = lane >> 3;
#pragma unroll
    for (int j = 0; j < 8; ++j) { const int n = ns + 8 * j; const LAS float* s = scr + (8 * c) * 65 + n;
        u32x4 o; o.x = pg8::cvt_pk_bf16(s[0 * 65], s[1 * 65]); o.y = pg8::cvt_pk_bf16(s[2 * 65], s[3 * 65]); o.z = pg8::cvt_pk_bf16(s[4 * 65], s[5 * 65]); o.w = pg8::cvt_pk_bf16(s[6 * 65], s[7 * 65]);
        *(u32x4*)(dst + (size_t)(n0d + n) * ldt + k0 + 8 * c) = o; }
    asm volatile("s_waitcnt lgkmcnt(0)" ::: "memory");
}
using pg8::pk_fp8x4;
__device__ __forceinline__ void zero_tile_f8(unsigned char* dst, int ldt, int n0d, int k0, int lane) {
    const int c = lane & 3, ns = lane >> 2;
#pragma unroll
    for (int j = 0; j < 4; ++j) *(u32x4*)(dst + (size_t)(n0d + ns + 16 * j) * ldt + k0 + 16 * c) = (u32x4){0u, 0u, 0u, 0u};
}
template <bool NTST> __device__ __forceinline__ void transpose_tile_f8(const float* src, int ldsrc, int k0, int n0s, unsigned char* dst, int ldt, int n0d, float scale, LAS float* scr, int lane) {
    const int kr = lane >> 4, nq = lane & 15;
    f32x4 v[16];
#pragma unroll
    for (int i = 0; i < 16; ++i) v[i] = NTL(f32x4, src + (size_t)(k0 + 4 * i + kr) * ldsrc + n0s + 4 * nq);
#pragma unroll
    for (int i = 0; i < 16; ++i) { LAS float* s = scr + (4 * i + kr) * 65 + 4 * nq; s[0] = v[i][0] * scale; s[1] = v[i][1] * scale; s[2] = v[i][2] * scale; s[3] = v[i][3] * scale; }
    asm volatile("s_waitcnt lgkmcnt(0)" ::: "memory");
    const int c = lane & 3, ns = lane >> 2;
#pragma unroll
    for (int j = 0; j < 4; ++j) { const int n = ns + 16 * j; const LAS float* s = scr + (16 * c) * 65 + n;
        u32x4 o; o.x = pk_fp8x4(s[0 * 65], s[1 * 65], s[2 * 65], s[3 * 65]); o.y = pk_fp8x4(s[4 * 65], s[5 * 65], s[6 * 65], s[7 * 65]);
        o.z = pk_fp8x4(s[8 * 65], s[9 * 65], s[10 * 65], s[11 * 65]); o.w = pk_fp8x4(s[12 * 65], s[13 * 65], s[14 * 65], s[15 * 65]);
        if constexpr (NTST) NTS(u32x4, dst + (size_t)(n0d + n) * ldt + k0 + 16 * c, o); else STG(u32x4, dst + (size_t)(n0d + n) * ldt + k0 + 16 * c, o); }
    asm volatile("s_waitcnt lgkmcnt(0)" ::: "memory");
}
__device__ __forceinline__ void transpose_item(const float* src, int ldsrc, int k0, int col  , bf16_t* dst, int ldt, int n0, LAS float* scr, int lane) {
    const int colc = col >= 0 ? col : 0;
#pragma unroll 8
    for (int i = 0; i < 32; ++i) { const int kk = 2 * i + (lane >> 5); const float x_ = NTL(float, src + (size_t)(k0 + kk) * ldsrc + colc); scr[kk * 33 + (lane & 31)] = (col >= 0) ? x_ : 0.f; }
    asm volatile("s_waitcnt lgkmcnt(0)" ::: "memory");
    const int c = lane & 7;
#pragma unroll
    for (int j = 0; j < 4; ++j) { const int n = (lane >> 3) + 8 * j; const LAS float* s = scr + (8 * c) * 33 + n;
        u32x4 o; o.x = pg8::cvt_pk_bf16(s[0 * 33], s[1 * 33]); o.y = pg8::cvt_pk_bf16(s[2 * 33], s[3 * 33]); o.z = pg8::cvt_pk_bf16(s[4 * 33], s[5 * 33]); o.w = pg8::cvt_pk_bf16(s[6 * 33], s[7 * 33]);
        *(u32x4*)(dst + (size_t)(n0 + n) * ldt + k0 + 8 * c) = o; }
    asm volatile("s_waitcnt lgkmcnt(0)" ::: "memory");
}
constexpr int IT_WIN = 16 * 120, IT_WOUT = 16 * 16, IT_P0 = IT_WIN + IT_WOUT;
constexpr int IT_WGU = 16 * 2 * 22 * 16, IT_WD = 16 * 16 * 24, IT_EXP = IT_WGU + IT_WD;
__device__ __forceinline__ void conv_item_p0(const Ptrs& p, int it, LAS float* scr, int lane) {
    if (it < IT_WIN) { const int kb = it / 120, nb = it % 120, n = nb * 32 + (lane & 31); const int col = (n < NPROJ) ? proj_src_col(n) : -1;
        transpose_item(p.w_in, NPROJ, kb * 64, col, (bf16_t*)(p.ws + WS_WIN), D, nb * 32, scr, lane); }
    else { it -= IT_WIN; const int kb = it >> 4, nb = it & 15; transpose_tile(p.w_out, D, kb * 64, nb * 64, (bf16_t*)(p.ws + WS_WOUT), D, nb * 64, scr, lane); }
}
__device__ __forceinline__ void conv_item_exp(const Ptrs& p, int it, LAS float* scr, int lane) {
    if (it < IT_WGU) { const int kb = it & 15, nt = (it >> 4) % 22, half = ((it >> 4) / 22) & 1, e = (it >> 4) / 44; const int f0 = nt * 64, r0 = (f0 >> 7) * 256 + half * 128 + (f0 & 127);
        const float* src = (half ? p.w_exp_up : p.w_exp_gate) + (size_t)e * D * FF;
        transpose_tile_f8<false>(src, FF, kb * 64, f0, (unsigned char*)(p.ws + WS_WGU) + (size_t)e * 2816 * D, D, r0, 32.0f, scr, lane); }
    else { it -= IT_WGU; const int kb = it % 24, nb = (it / 24) & 15, e = it / (24 * 16); unsigned char* dst = (unsigned char*)p.out + OUT_WD + (size_t)e * D * FFP;
        if (kb < 22) transpose_tile_f8<true>(p.w_exp_down + (size_t)e * FF * D, D, kb * 64, nb * 64, dst, FFP, nb * 64, 32.0f, scr, lane); else zero_tile_f8(dst, FFP, nb * 64, kb * 64, lane); }
}
__device__ __forceinline__ void h_rows(const Ptrs& p, int row0, int rstep, int lane) {
    f32x4 xn[4], scn[4], shn[4];
#define H_LOAD(r_) do { const float* s_ = ((r_) < NLAT) ? p.x + (size_t)(r_) * D : p.ctx + (size_t)((r_) - NLAT) * D; _Pragma("unroll") for (int j = 0; j < 4; ++j) xn[j] = NTL(f32x4, s_ + j * 256 + lane * 4); \
        const float* mod_ = (const float*)(p.ws + WS_MOD) + (((r_) < NLAT) ? (r_) / SEQ : 2) * NADA * D; \
        _Pragma("unroll") for (int j = 0; j < 4; ++j) { scn[j] = *(const f32x4*)(mod_ + D + j * 256 + lane * 4); shn[j] = *(const f32x4*)(mod_ + j * 256 + lane * 4); } } while (0)
    if (row0 >= NROWS) return;
    H_LOAD(row0);
    __builtin_amdgcn_sched_barrier(0);
    f32x4 w4[4];
#pragma unroll
    for (int j = 0; j < 4; ++j) w4[j] = *(const f32x4*)(p.norm1_w + j * 256 + lane * 4);
    for (int row = row0; row < NROWS; row += rstep) {
        f32x4 v[4], sc[4], sh[4]; float ss = 0.f;
#pragma unroll
        for (int j = 0; j < 4; ++j) { v[j] = xn[j]; sc[j] = scn[j]; sh[j] = shn[j]; ss += v[j][0] * v[j][0] + v[j][1] * v[j][1] + v[j][2] * v[j][2] + v[j][3] * v[j][3]; }
        { const int rn = (row + rstep < NROWS) ? row + rstep : row; H_LOAD(rn); }
        const float rstd = rsqrtf(wave_sum(ss) * (1.0f / D) + EPS);
        bf16_t* dst = (bf16_t*)(p.ws + WS_H) + (size_t)row * D;
#pragma unroll
        for (int j = 0; j < 4; ++j) { const int d = j * 256 + lane * 4;
            f32x4 o;
#pragma unroll
            for (int e = 0; e < 4; ++e) o[e] = v[j][e] * rstd * w4[j][e] * (1.0f + sc[j][e]) + sh[j][e];
            u32x2 pkd; pkd.x = pg8::cvt_pk_bf16(o[0], o[1]); pkd.y = pg8::cvt_pk_bf16(o[2], o[3]); STG(u32x2, dst + d, pkd); }
    }
#undef H_LOAD
}
__device__ __forceinline__ void stage_router(const Ptrs& p, LAS float* Wl, int tid) {
    for (int idx = tid; idx < D * NE / 4; idx += NTHR) { const int d = idx >> 2, q4 = idx & 3, j = d >> 8, ln = (d >> 2) & 63, e4 = d & 3;
        *(LAS f32x4*)(Wl + (((j * 4 + e4) * 4 + q4) * 64 + ln) * 4) = *(const f32x4*)(p.w_router + (size_t)d * NE + 4 * q4); }
}
__device__ __forceinline__ void norm2_router_rows(const Ptrs& p, const LAS float* Wl, int row0, int rstep, int lane) {
    const bf16_t* XO = (const bf16_t*)(p.ws + WS_XO);
    f32x4 xn[4], scn[4], shn[4]; u32x2 on[4];
#define N2_LOAD(r_) do { _Pragma("unroll") for (int j = 0; j < 4; ++j) { xn[j] = NTL(f32x4, p.x + (size_t)(r_) * D + j * 256 + lane * 4); on[j] = NTL(u32x2, XO + (size_t)(r_) * D + j * 256 + lane * 4); } \
        const float* mod_ = (const float*)(p.ws + WS_MOD) + ((r_) / SEQ) * NADA * D; \
        _Pragma("unroll") for (int j = 0; j < 4; ++j) { scn[j] = *(const f32x4*)(mod_ + 4 * D + j * 256 + lane * 4); shn[j] = *(const f32x4*)(mod_ + 3 * D + j * 256 + lane * 4); } } while (0)
    if (row0 >= NLAT) return;
    N2_LOAD(row0);
    __builtin_amdgcn_sched_barrier(0);
    f32x4 w4[4];
#pragma unroll
    for (int j = 0; j < 4; ++j) w4[j] = *(const f32x4*)(p.norm2_w + j * 256 + lane * 4);
    for (int row = row0; row < NLAT; row += rstep) {
        const int b = row / SEQ, t = row % SEQ;
        f32x4 v[4], scv[4], shv[4]; float ss = 0.f;
#pragma unroll
        for (int j = 0; j < 4; ++j) { scv[j] = scn[j]; shv[j] = shn[j]; }
#pragma unroll
        for (int j = 0; j < 4; ++j) { v[j] = xn[j]; v[j][0] += __uint_as_float(on[j].x << 16); v[j][1] += __uint_as_float(on[j].x & 0xffff0000u); v[j][2] += __uint_as_float(on[j].y << 16); v[j][3] += __uint_as_float(on[j].y & 0xffff0000u);
            ss += v[j][0] * v[j][0] + v[j][1] * v[j][1] + v[j][2] * v[j][2] + v[j][3] * v[j][3];
            u32x2 x1w; x1w.x = pg8::cvt_pk_bf16(v[j][0], v[j][1]); x1w.y = pg8::cvt_pk_bf16(v[j][2], v[j][3]); NTS(u32x2, (bf16_t*)(p.ws + WS_XO) + (size_t)row * D + j * 256 + lane * 4, x1w); }
        { const int rn = (row + rstep < NLAT) ? row + rstep : row; N2_LOAD(rn); }
        const float rstd = rsqrtf(wave_sum(ss) * (1.0f / D) + EPS);
        unsigned char* dst = (unsigned char*)(p.ws + WS_H) + (size_t)row * D;
        f32x2 lg2[8];
#pragma unroll
        for (int e = 0; e < 8; ++e) lg2[e] = (f32x2){0.f, 0.f};
        int wl_off = 0; asm volatile("" : "+v"(wl_off));
#pragma unroll
        for (int j = 0; j < 4; ++j) { const int d = j * 256 + lane * 4; const f32x4 sc = scv[j], sh = shv[j];
            f32x4 ww[4][4];
#pragma unroll
            for (int e4 = 0; e4 < 4; ++e4)
#pragma unroll
                for (int q = 0; q < 4; ++q) ww[e4][q] = *(const LAS f32x4*)(Wl + wl_off + (((j * 4 + e4) * 4 + q) * 64 + lane) * 4);
            f32x4 o;
#pragma unroll
            for (int e4 = 0; e4 < 4; ++e4) { o[e4] = v[j][e4] * rstd * w4[j][e4] * (1.0f + sc[e4]) + sh[e4]; const f32x2 o2 = {o[e4], o[e4]};
#pragma unroll
                for (int q = 0; q < 4; ++q) { lg2[2 * q] = __builtin_elementwise_fma(o2, (f32x2){ww[e4][q][0], ww[e4][q][1]}, lg2[2 * q]); lg2[2 * q + 1] = __builtin_elementwise_fma(o2, (f32x2){ww[e4][q][2], ww[e4][q][3]}, lg2[2 * q + 1]); } }
            STG(unsigned, dst + d, pk_fp8x4(o[0], o[1], o[2], o[3])); }
        float lg[NE];
#pragma unroll
        for (int q = 0; q < 4; ++q) { lg[4 * q] = lg2[2 * q][0]; lg[4 * q + 1] = lg2[2 * q][1]; lg[4 * q + 2] = lg2[2 * q + 1][0]; lg[4 * q + 3] = lg2[2 * q + 1][1]; }
        float r8[8], r4[4], r2[2], r1;
        { const bool hi = lane & 32;
#pragma unroll
          for (int j = 0; j < 8; ++j) { const float keep = hi ? lg[8 + j] : lg[j], send = hi ? lg[j] : lg[8 + j]; r8[j] = keep + __shfl_xor(send, 32); } }
        { const bool hi = lane & 16;
#pragma unroll
          for (int j = 0; j < 4; ++j) { const float keep = hi ? r8[4 + j] : r8[j], send = hi ? r8[j] : r8[4 + j]; r4[j] = keep + __shfl_xor(send, 16); } }
        { const bool hi = lane & 8;
#pragma unroll
          for (int j = 0; j < 2; ++j) { const float keep = hi ? r4[2 + j] : r4[j], send = hi ? r4[j] : r4[2 + j]; r2[j] = keep + __shfl_xor(send, 8); } }
        { const bool hi = lane & 4; const float keep = hi ? r2[1] : r2[0], send = hi ? r2[0] : r2[1]; r1 = keep + __shfl_xor(send, 4); }
        r1 += __shfl_xor(r1, 2); r1 += __shfl_xor(r1, 1);
        const float mx = wave_max(r1);
        const float ex = __expf(r1 - mx); const float den = wave_sum(ex) * 0.25f;
        if ((lane & 3) == 0) ((float*)(p.ws + WS_AFF))[((size_t)b * NE + ((lane >> 2) & 15)) * SEQ + t] = ex / den;
    }
#undef N2_LOAD
}
__device__ __forceinline__ void topk_set(const Ptrs& p, LAS unsigned char* lds, int be) {
    LAS unsigned* key = (LAS unsigned*)lds;
    LAS unsigned* hist = key + SEQ;
    LAS unsigned* sh = hist + 256;
    const int tid = threadIdx.x, lane = tid & 63, w = tid >> 6;
    const unsigned* A = (const unsigned*)(p.ws + WS_AFF) + (size_t)be * SEQ;
    { u32x4 kv[8];
#pragma unroll
      for (int q8 = 0; q8 < 8; ++q8) kv[q8] = ((const u32x4*)A)[tid + q8 * NTHR];
#pragma unroll
      for (int q8 = 0; q8 < 8; ++q8) ((LAS u32x4*)key)[tid + q8 * NTHR] = kv[q8]; }
    if (tid == 0) { sh[0] = 0u; sh[1] = (unsigned)CAP; }
    __syncthreads();
#pragma unroll 1
    for (int pass = 0; pass < 4; ++pass) {
        const int shift = 24 - 8 * pass;
        if (tid < 256) hist[tid] = 0u;
        __syncthreads();
        const unsigned prefix = sh[0], kneed = sh[1];
        const unsigned himask = (pass == 0) ? 0u : (0xffffffffu << (shift + 8));
        for (int i = tid; i < SEQ; i += NTHR) { const unsigned kx = key[i]; if ((kx & himask) == prefix) __hip_atomic_fetch_add(&hist[(kx >> shift) & 255u], 1u, __ATOMIC_RELAXED, __HIP_MEMORY_SCOPE_WORKGROUP); }
        __syncthreads();
        if (w == 0) {
            unsigned c4[4]; unsigned s = 0u;
#pragma unroll
            for (int j = 0; j < 4; ++j) { c4[j] = hist[255 - (lane * 4 + j)]; s += c4[j]; }
            unsigned incl = s;
#pragma unroll
            for (int o = 1; o < 64; o <<= 1) { const unsigned t = __shfl_up(incl, o); if (lane >= o) incl += t; }
            const unsigned excl = incl - s;
            if (excl < kneed && kneed <= incl) { unsigned acc = excl;
#pragma unroll
                for (int j = 0; j < 4; ++j) { if (acc < kneed && kneed <= acc + c4[j]) { const unsigned bin = 255u - (unsigned)(lane * 4 + j); sh[0] = prefix | (bin << shift); sh[1] = kneed - acc; } acc += c4[j]; } }
        }
        __syncthreads();
    }
    const unsigned T = sh[0], need_eq = sh[1];
    unsigned kreg[32];
#pragma unroll
    for (int q8 = 0; q8 < 8; ++q8) { const u32x4 k4 = ((const u32x4*)A)[tid * 8 + q8]; kreg[4 * q8] = k4.x; kreg[4 * q8 + 1] = k4.y; kreg[4 * q8 + 2] = k4.z; kreg[4 * q8 + 3] = k4.w; }
    unsigned cg = 0u, ce = 0u;
#pragma unroll
    for (int i = 0; i < 32; ++i) { const unsigned kx = kreg[i]; cg += (kx > T) ? 1u : 0u; ce += (kx == T) ? 1u : 0u; }
    unsigned ig = cg, ie = ce;
#pragma unroll
    for (int o = 1; o < 64; o <<= 1) { const unsigned tg = __shfl_up(ig, o), te = __shfl_up(ie, o); if (lane >= o) { ig += tg; ie += te; } }
    if (lane == 63) { sh[16 + w] = ig; sh[32 + w] = ie; }
    __syncthreads();
    unsigned og = 0u, oe = 0u, totg = 0u;
#pragma unroll
    for (int w2 = 0; w2 < 8; ++w2) { const unsigned a = sh[16 + w2], b2 = sh[32 + w2]; if (w2 < w) { og += a; oe += b2; } totg += a; }
    unsigned pg = og + ig - cg, pe = oe + ie - ce;
    int* IDX = (int*)(p.ws + WS_IDX) + be * CAP; float* GATE = (float*)(p.ws + WS_GATE) + be * CAP; int* INV = (int*)(p.ws + WS_INV);
    const int b = be / NE, e = be % NE;
#pragma unroll
    for (int i = 0; i < 32; ++i) { const int t = tid * 32 + i; const unsigned kx = kreg[i]; int slot = -1;
        if (kx > T) slot = (int)(pg++); else if (kx == T) { if (pe < need_eq) slot = (int)(totg + pe); ++pe; }
        if (slot >= 0) { IDX[slot] = t; GATE[slot] = __uint_as_float(kx); }
        INV[((size_t)b * SEQ + t) * NE + e] = slot; }
    __syncthreads();
}
__device__ __forceinline__ void final_rows(const Ptrs& p, int row0, int rstep, int lane) {
    const bf16_t* XO = (const bf16_t*)(p.ws + WS_XO); const unsigned char* YE = (const unsigned char*)(p.ws + WS_YE); const int* INV = (const int*)(p.ws + WS_INV);
    u32x2 on[4]; int invn = -1; f32x4 m4n[4];
#define FN_LOAD(r_) do { _Pragma("unroll") for (int j = 0; j < 4; ++j) { on[j] = NTL(u32x2, XO + (size_t)(r_) * D + j * 256 + lane * 4); } \
        invn = NTL(int, INV + (size_t)(r_) * NE + (lane & (NE - 1))); \
        const float* mod_ = (const float*)(p.ws + WS_MOD) + ((r_) / SEQ) * NADA * D + 5 * D; \
        _Pragma("unroll") for (int j = 0; j < 4; ++j) m4n[j] = *(const f32x4*)(mod_ + j * 256 + lane * 4); } while (0)
    if (row0 >= NLAT) return;
    FN_LOAD(row0);
    __builtin_amdgcn_sched_barrier(0);
    f32x4 fw[4];
#pragma unroll
    for (int j = 0; j < 4; ++j) fw[j] = *(const f32x4*)(p.final_norm_w + j * 256 + lane * 4);
    u32x2 oc[4]; f32x4 m4[4]; int myinv;
#define FN_TAKE() do { _Pragma("unroll") for (int j = 0; j < 4; ++j) { oc[j] = on[j]; m4[j] = m4n[j]; } myinv = (lane < NE) ? invn : -1; } while (0)
    FN_TAKE();
    for (int row = row0; row < NLAT; row += rstep) {
        const int b = row / SEQ;
        f32x4 v[4];
#pragma unroll
        for (int j = 0; j < 4; ++j) { v[j][0] = __uint_as_float(oc[j].x << 16); v[j][1] = __uint_as_float(oc[j].x & 0xffff0000u); v[j][2] = __uint_as_float(oc[j].y << 16); v[j][3] = __uint_as_float(oc[j].y & 0xffff0000u); }
        unsigned long long mask = __ballot(myinv >= 0);
        float acc[16];
#pragma unroll
        for (int i = 0; i < 16; ++i) acc[i] = 0.f;
        unsigned yw[4][4]; bool has[4];
#pragma unroll
        for (int u = 0; u < 4; ++u) { has[u] = mask != 0ull; const int e = has[u] ? (int)__builtin_ctzll(mask) : 0; if (has[u]) mask &= mask - 1ull;
            const int s = __shfl(myinv, e); const unsigned char* y = has[u] ? YE + ((size_t)(b * NE + e) * CAP + s) * D : YE;
#pragma unroll
            for (int j = 0; j < 4; ++j) yw[u][j] = NTL(unsigned, y + j * 256 + lane * 4); }
        { const int rn = (row + rstep < NLAT) ? row + rstep : row; FN_LOAD(rn); }
#pragma unroll
        for (int u = 0; u < 4; ++u) { const float hs = has[u] ? 1.f : 0.f;
#pragma unroll
            for (int j = 0; j < 4; ++j) { const f32x2 lo_ = __builtin_amdgcn_cvt_pk_f32_fp8((int)yw[u][j], false), hi_ = __builtin_amdgcn_cvt_pk_f32_fp8((int)yw[u][j], true);
                acc[4 * j] += hs * lo_[0]; acc[4 * j + 1] += hs * lo_[1]; acc[4 * j + 2] += hs * hi_[0]; acc[4 * j + 3] += hs * hi_[1]; } }
#pragma unroll
        for (int blk = 0; blk < 3; ++blk) if (mask) {
#pragma unroll
            for (int u = 0; u < 4; ++u) { has[u] = mask != 0ull; const int e = has[u] ? (int)__builtin_ctzll(mask) : 0; if (has[u]) mask &= mask - 1ull;
                const int s = __shfl(myinv, e); const unsigned char* y = has[u] ? YE + ((size_t)(b * NE + e) * CAP + s) * D : YE;
#pragma unroll
                for (int j = 0; j < 4; ++j) yw[u][j] = NTL(unsigned, y + j * 256 + lane * 4); }
#pragma unroll
            for (int u = 0; u < 4; ++u) { const float hs = has[u] ? 1.f : 0.f;
#pragma unroll
                for (int j = 0; j < 4; ++j) { const f32x2 lo_ = __builtin_amdgcn_cvt_pk_f32_fp8((int)yw[u][j], false), hi_ = __builtin_amdgcn_cvt_pk_f32_fp8((int)yw[u][j], true);
                    acc[4 * j] += hs * lo_[0]; acc[4 * j + 1] += hs * lo_[1]; acc[4 * j + 2] += hs * hi_[0]; acc[4 * j + 3] += hs * hi_[1]; } }
        }
        float ss = 0.f;
#pragma unroll
        for (int j = 0; j < 4; ++j) {
#pragma unroll
            for (int e = 0; e < 4; ++e) { v[j][e] += m4[j][e] * (acc[4 * j + e] * 0.0625f); ss += v[j][e] * v[j][e]; } }
        const float rstd = rsqrtf(wave_sum(ss) * (1.0f / D) + EPS);
        float* xr = p.out + (size_t)row * D;
#pragma unroll
        for (int j = 0; j < 4; ++j) NTS(f32x4, xr + j * 256 + lane * 4, v[j] * rstd * fw[j]);
        FN_TAKE();
    }
#undef FN_TAKE
#undef FN_LOAD
}
}

constexpr int RING_OFF = 0, RING_BYTES = 131072;
constexpr int GTAB_OFF = RING_BYTES;
constexpr int MISC_OFF = RING_BYTES + 12288;
constexpr int LDS_BYTES = 147456;
constexpr int CW_BAR = 4096;

#define RLX_AGENT __ATOMIC_RELAXED, __HIP_MEMORY_SCOPE_AGENT
#define XB_TMO      128
#define XB_XCNT(j)  (256  + 64 * (j))
#define XB_XSUB(j)  (1280 + 64 * (j))
#define XB_XGEN(j)  (2304 + 64 * (j))
#define XB_TOP      3328
#define XB_TOPGEN   3392
#define XCD_BAR_WORDS 3456
#define XB_SPIN_CAP (1u << 18)
__device__ __forceinline__ unsigned xb_ld(unsigned* p)              { return __hip_atomic_load(p, __ATOMIC_RELAXED, __HIP_MEMORY_SCOPE_AGENT); }
__device__ __forceinline__ unsigned xb_add(unsigned* p, unsigned v) { return __hip_atomic_fetch_add(p, v, __ATOMIC_RELAXED, __HIP_MEMORY_SCOPE_AGENT); }
__device__ __forceinline__ unsigned xb_xcc_id() { return (unsigned)__builtin_amdgcn_s_getreg((3 << 11) | 20) & 0xFu; }
#define XB_SPIN(cond, bar) do { unsigned _sp = 0; while (cond) { __builtin_amdgcn_s_sleep(1); \
    if ((++_sp & 255u) == 0u) { if (xb_ld(&(bar)[XB_TMO])) break; if (_sp > XB_SPIN_CAP) { atomicAdd(&(bar)[XB_TMO], 1u); break; } } } } while (0)
struct XcdBarrier { unsigned* bar; unsigned x; volatile LAS unsigned* st; };
__device__ __forceinline__ XcdBarrier xcd_barrier_post(unsigned* bar, volatile LAS unsigned* st) {
    XcdBarrier b; b.bar = bar; b.x = xb_xcc_id(); b.st = st;
    if (threadIdx.x == 0) (void)xb_add(&bar[XB_XCNT(b.x)], 1u);
    return b;
}
__device__ __forceinline__ void xcd_barrier_complete(unsigned* bar, unsigned x, unsigned& nloc, unsigned& nx) {
    const unsigned G = gridDim.x * gridDim.y * gridDim.z;
    unsigned sum, cnt, mine, sp = 0u;
    for (;;) {
        sum = 0u; cnt = 0u; mine = 0u;
#pragma unroll
        for (unsigned j = 0; j < 16; ++j) { const unsigned c = xb_ld(&bar[XB_XCNT(j)]); sum += c; cnt += (c > 0u) ? 1u : 0u; mine = (j == x) ? c : mine; }
        if (sum == G) break;
        __builtin_amdgcn_s_sleep(1);
        if ((++sp & 255u) == 0u) { if (xb_ld(&bar[XB_TMO])) break; if (sp > XB_SPIN_CAP) { atomicAdd(&bar[XB_TMO], 1u); break; } }
    }
    nloc = mine > 0u ? mine : 1u; nx = cnt > 0u ? cnt : 1u;
}
__device__ __forceinline__ void xcd_barrier(const XcdBarrier& b) {
    asm volatile("s_waitcnt vmcnt(0)" ::: "memory");
    __syncthreads();
    if (threadIdx.x == 0) {
        unsigned* bar = b.bar;
        __builtin_amdgcn_s_waitcnt(0);
        unsigned nloc = b.st[0], nx = b.st[1];
        if (nloc == 0u) { xcd_barrier_complete(bar, b.x, nloc, nx); b.st[0] = nloc; b.st[1] = nx; }
        const unsigned old = xb_add(&bar[XB_XSUB(b.x)], 1u);
        const unsigned gen = old / nloc;
        if (old + 1u == (gen + 1u) * nloc) {
            __builtin_amdgcn_fence(__ATOMIC_RELEASE, "agent");
            asm volatile("s_waitcnt vmcnt(0)" ::: "memory");
            const unsigned og = xb_add(&bar[XB_TOP], 1u);
            const unsigned tg = og / nx;
            if (og + 1u == (tg + 1u) * nx) xb_add(&bar[XB_TOPGEN], 1u);
            else XB_SPIN(xb_ld(&bar[XB_TOPGEN]) == tg, bar);
            __builtin_amdgcn_fence(__ATOMIC_ACQUIRE, "agent");
            xb_add(&bar[XB_XGEN(b.x)], 1u);
            asm volatile("s_waitcnt vmcnt(0)" ::: "memory");
        } else {
            XB_SPIN(xb_ld(&bar[XB_XGEN(b.x)]) == gen, bar);
            __builtin_amdgcn_fence(__ATOMIC_ACQUIRE, "agent");
            asm volatile("s_waitcnt vmcnt(0)" ::: "memory");
        }
    }
    __syncthreads();
}

struct Args { Ptrs p; int ph_lo, ph_hi, dbg, pad; };

#ifndef CONV_SPLIT_V
#define CONV_SPLIT_V 4096
#endif
#ifndef CONV_TAIL_V
#define CONV_TAIL_V 4096
#endif
__global__ void __launch_bounds__(NTHR, 2) mk_fwd(Args args) {
    extern __shared__ __attribute__((aligned(16))) unsigned char lds_raw[];
    LAS unsigned char* lds = (LAS unsigned char*)lds_raw;
    volatile LAS unsigned* MISC = (volatile LAS unsigned*)(lds + MISC_OFF);
    const Ptrs& p = args.p;
    unsigned char* ws = p.ws;
    const int tid = threadIdx.x, G = gridDim.x, bx = blockIdx.x;
    for (int u = tid; u < (LDS_BYTES - MISC_OFF) / 4; u += NTHR) ((LAS unsigned*)(lds + MISC_OFF))[u] = 0u;
    __syncthreads();
    const int lo = args.ph_lo, hi = args.ph_hi;
#ifndef REPS_LIST
#define REPS_LIST 1, 1, 1, 1, 1, 1, 1, 1, 1, 1, 1, 1
#endif
    constexpr int reps_tab[12] = {REPS_LIST};
    constexpr int CONV_SPLIT = CONV_SPLIT_V;
    constexpr int CONV_TAIL = CONV_TAIL_V;
    constexpr int P2_UNITS = (NROWS / 256) * (NPROJ_PAD / 256), P2_FULL = P2_UNITS - (P2_UNITS / 256) * 256;
    XcdBarrier bar; bar.bar = (unsigned*)ws + CW_BAR; bar.x = 0; bar.st = nullptr;
    if (hi - lo > 1) bar = xcd_barrier_post((unsigned*)ws + CW_BAR, MISC + 8);
#define IN(k) (lo <= (k) && (k) < hi)
#define SEAM(k) do { if (IN(k) && IN((k) + 1)) xcd_barrier(bar); } while (0)

    const int wv = __builtin_amdgcn_readfirstlane(tid >> 6), ln = tid & 63, gw = bx * NWAVES + wv, NGW = G * NWAVES;
    if (IN(0)) {
        for (int cb = bx; cb < 256; cb += G) misc::p0_mod(p, lds, cb);
        LAS float* scr = (LAS float*)(lds + wv * misc::TSCR);
        for (int it = gw; it < misc::IT_P0; it += NGW) misc::conv_item_p0(p, it, scr, ln);
    }
    if constexpr (reps_tab[0] > 1) { xcd_barrier(bar);
    if (IN(0)) {
        for (int cb = bx; cb < 256; cb += G) misc::p0_mod(p, lds, cb);
        LAS float* scr = (LAS float*)(lds + wv * misc::TSCR);
        for (int it = gw; it < misc::IT_P0; it += NGW) misc::conv_item_p0(p, it, scr, ln);
    }
    }
    SEAM(0);
    if (IN(1)) { misc::h_rows(p, gw, NGW, ln); }
    if constexpr (reps_tab[1] > 1) { xcd_barrier(bar);
    if (IN(1)) { misc::h_rows(p, gw, NGW, ln); }
    }
    SEAM(1);
    if (IN(2)) {
        pg8::Gemm g{(const bf16_t*)(ws + WS_H), (const bf16_t*)(ws + WS_WIN), D};
        pg8::StaticOrder S; S.init(NROWS / 256, NPROJ_PAD / 256, G, bx);
        pg8::EpiProj E{(bf16_t*)(ws + WS_P), (float*)(ws + WS_GZ), (const float*)(ws + WS_ROPE)};
        pg8::gemm_phase<pg8::EpiProj, pg8::StaticOrder, false>(lds + RING_OFF, g, S, E, nullptr);
        if (CONV_TAIL > 0 && bx >= P2_FULL) { LAS float* scr = (LAS float*)(lds + wv * misc::TSCR);
            for (int it = misc::IT_EXP - CONV_TAIL + (bx - P2_FULL) * NWAVES + wv; it < misc::IT_EXP; it += (G - P2_FULL) * NWAVES) misc::conv_item_exp(p, it, scr, ln); }
    }
    if constexpr (reps_tab[2] > 1) { xcd_barrier(bar);
    if (IN(2)) {
        pg8::Gemm g{(const bf16_t*)(ws + WS_H), (const bf16_t*)(ws + WS_WIN), D};
        pg8::StaticOrder S; S.init(NROWS / 256, NPROJ_PAD / 256, G, bx);
        pg8::EpiProj E{(bf16_t*)(ws + WS_P), (float*)(ws + WS_GZ), (const float*)(ws + WS_ROPE)};
        pg8::gemm_phase<pg8::EpiProj, pg8::StaticOrder, false>(lds + RING_OFF, g, S, E, nullptr);
    }
    }
    SEAM(2);
    if (IN(3)) {
        scan::run_c1(p, lds, bx);
    }
    SEAM(3);
    if (IN(4)) {
        scan::run_c2(p, lds, bx);
    }
    if constexpr (reps_tab[3] > 1) { xcd_barrier(bar);
    if (IN(3)) {
        scan::run_c1(p, lds, bx);
    }
    SEAM(3);
    if (IN(4)) {
        scan::run_c2(p, lds, bx);
    }
    }
    SEAM(4);
    if (IN(5)) {
        scan::run_c3(p, lds, bx, (bf16_t*)(ws + WS_H));
    }
    if constexpr (reps_tab[5] > 1) { xcd_barrier(bar);
    if (IN(5)) {
        scan::run_c3(p, lds, bx, (bf16_t*)(ws + WS_H));
    }
    }
    SEAM(5);
    if (IN(6)) {
        pg8::Gemm g{(const bf16_t*)(ws + WS_H), (const bf16_t*)(ws + WS_WOUT), D};
        pg8::StaticOrder S; S.init(NLAT / 256, D / 256, G, bx);
        { LAS float* m2l = (LAS float*)(lds + GTAB_OFF);
          ((LAS f32x4*)m2l)[tid] = *(const f32x4*)((const float*)(ws + WS_MOD) + (tid >> 8) * NADA * D + 2 * D + (tid & 255) * 4); __syncthreads(); }
        pg8::EpiOut E{(bf16_t*)(ws + WS_XO), (const LAS float*)(lds + GTAB_OFF)};
        pg8::gemm_phase<pg8::EpiOut, pg8::StaticOrder, false>(lds + RING_OFF, g, S, E, nullptr);
    }
    if constexpr (reps_tab[6] > 1) { xcd_barrier(bar);
    if (IN(6)) {
        pg8::Gemm g{(const bf16_t*)(ws + WS_H), (const bf16_t*)(ws + WS_WOUT), D};
        pg8::StaticOrder S; S.init(NLAT / 256, D / 256, G, bx);
        { LAS float* m2l = (LAS float*)(lds + GTAB_OFF);
          ((LAS f32x4*)m2l)[tid] = *(const f32x4*)((const float*)(ws + WS_MOD) + (tid >> 8) * NADA * D + 2 * D + (tid & 255) * 4); __syncthreads(); }
        pg8::EpiOut E{(bf16_t*)(ws + WS_XO), (const LAS float*)(lds + GTAB_OFF)};
        pg8::gemm_phase<pg8::EpiOut, pg8::StaticOrder, false>(lds + RING_OFF, g, S, E, nullptr);
    }
    }
    SEAM(6);
    if (IN(7)) {
        misc::stage_router(p, (LAS float*)lds, tid); __syncthreads();
        misc::norm2_router_rows(p, (const LAS float*)lds, gw, NGW, ln);
        __syncthreads();
        LAS float* scr = (LAS float*)(lds + wv * misc::TSCR);
        for (int it = gw; it < CONV_SPLIT; it += NGW) misc::conv_item_exp(p, it, scr, ln);
    }
    if constexpr (reps_tab[7] > 1) { xcd_barrier(bar);
    if (IN(7)) {
        misc::stage_router(p, (LAS float*)lds, tid); __syncthreads();
        misc::norm2_router_rows(p, (const LAS float*)lds, gw, NGW, ln);
        __syncthreads();
        LAS float* scr = (LAS float*)(lds + wv * misc::TSCR);
        for (int it = gw; it < CONV_SPLIT; it += NGW) misc::conv_item_exp(p, it, scr, ln);
    }
    }
    SEAM(7);
    if (IN(8)) { if (bx < 32) misc::topk_set(p, lds, bx);
        else { LAS float* scr = (LAS float*)(lds + wv * misc::TSCR); for (int it = CONV_SPLIT + (bx - 32) * NWAVES + wv; it < misc::IT_EXP - CONV_TAIL; it += (G - 32) * NWAVES) misc::conv_item_exp(p, it, scr, ln); } }
    if constexpr (reps_tab[8] > 1) { xcd_barrier(bar);
    if (IN(8)) { if (bx < 32) misc::topk_set(p, lds, bx);
        else { LAS float* scr = (LAS float*)(lds + wv * misc::TSCR); for (int it = CONV_SPLIT + (bx - 32) * NWAVES + wv; it < misc::IT_EXP - CONV_TAIL; it += (G - 32) * NWAVES) misc::conv_item_exp(p, it, scr, ln); } }
    }
    SEAM(8);
    if (IN(9)) {
        LAS unsigned* gtab = (LAS unsigned*)(lds + GTAB_OFF);
        pg8::MoeUpOrder S{bx};
        const int* IDX = (const int*)(ws + WS_IDX);
        { int idxv[6];
#pragma unroll
          for (int q6 = 0; q6 < 6; ++q6) { const int e = tid + q6 * NTHR, ec = e < 11 * 256 ? e : 11 * 256 - 1; pg8::Unit u; S.next(ec >> 8, u); idxv[q6] = IDX[u.pm * 256 + (ec & 255)]; }
#pragma unroll
          for (int q6 = 0; q6 < 6; ++q6) { const int e = tid + q6 * NTHR; if (e < 11 * 256) { pg8::Unit u; S.next(e >> 8, u); gtab[e] = (unsigned)((u.pm >> 7) * SEQ + (idxv[q6] & (SEQ - 1))) * (unsigned)D; } } }
        __syncthreads();
        pg8::Gemm g{(const bf16_t*)(ws + WS_H), (const bf16_t*)(ws + WS_WGU), D};
        pg8::EpiAct E{(unsigned char*)(ws + WS_ACT), 1.0f / 32.0f, 8.0f};
        pg8::gemm_phase<pg8::EpiAct, pg8::MoeUpOrder, true, true>(lds + RING_OFF, g, S, E, gtab);
    }
    if constexpr (reps_tab[9] > 1) { xcd_barrier(bar);
    if (IN(9)) {
        LAS unsigned* gtab = (LAS unsigned*)(lds + GTAB_OFF);
        pg8::MoeUpOrder S{bx};
        const int* IDX = (const int*)(ws + WS_IDX);
        { int idxv[6];
#pragma unroll
          for (int q6 = 0; q6 < 6; ++q6) { const int e = tid + q6 * NTHR, ec = e < 11 * 256 ? e : 11 * 256 - 1; pg8::Unit u; S.next(ec >> 8, u); idxv[q6] = IDX[u.pm * 256 + (ec & 255)]; }
#pragma unroll
          for (int q6 = 0; q6 < 6; ++q6) { const int e = tid + q6 * NTHR; if (e < 11 * 256) { pg8::Unit u; S.next(e >> 8, u); gtab[e] = (unsigned)((u.pm >> 7) * SEQ + (idxv[q6] & (SEQ - 1))) * (unsigned)D; } } }
        __syncthreads();
        pg8::Gemm g{(const bf16_t*)(ws + WS_H), (const bf16_t*)(ws + WS_WGU), D};
        pg8::EpiAct E{(unsigned char*)(ws + WS_ACT), 1.0f / 32.0f, 8.0f};
        pg8::gemm_phase<pg8::EpiAct, pg8::MoeUpOrder, true, true>(lds + RING_OFF, g, S, E, gtab);
    }
    }
    SEAM(9);
    if (IN(10)) {
        pg8::MoeDownOrder S{bx};
        pg8::Gemm g{(const bf16_t*)(ws + WS_ACT), (const bf16_t*)((const unsigned char*)p.out + OUT_WD), FFP};
        { LAS float* gl = (LAS float*)(lds + GTAB_OFF);
#pragma unroll
          for (int q2 = 0; q2 < 2; ++q2) { const int e = tid + q2 * NTHR; pg8::Unit u; S.next(e >> 8, u); gl[e] = ((const float*)(ws + WS_GATE))[u.pm * 256 + (e & 255)]; }
          __syncthreads(); }
        pg8::EpiDown E{(unsigned char*)(ws + WS_YE), (const LAS float*)(lds + GTAB_OFF), 16.0f / 256.0f};
        pg8::gemm_phase<pg8::EpiDown, pg8::MoeDownOrder, false, true>(lds + RING_OFF, g, S, E, nullptr);
    }
    if constexpr (reps_tab[10] > 1) { xcd_barrier(bar);
    if (IN(10)) {
        pg8::MoeDownOrder S{bx};
        pg8::Gemm g{(const bf16_t*)(ws + WS_ACT), (const bf16_t*)((const unsigned char*)p.out + OUT_WD), FFP};
        { LAS float* gl = (LAS float*)(lds + GTAB_OFF);
#pragma unroll
          for (int q2 = 0; q2 < 2; ++q2) { const int e = tid + q2 * NTHR; pg8::Unit u; S.next(e >> 8, u); gl[e] = ((const float*)(ws + WS_GATE))[u.pm * 256 + (e & 255)]; }
          __syncthreads(); }
        pg8::EpiDown E{(unsigned char*)(ws + WS_YE), (const LAS float*)(lds + GTAB_OFF), 16.0f / 256.0f};
        pg8::gemm_phase<pg8::EpiDown, pg8::MoeDownOrder, false, true>(lds + RING_OFF, g, S, E, nullptr);
    }
    }
    SEAM(10);
    if (IN(11)) { misc::final_rows(p, gw, NGW, ln); }
#undef IN
#undef SEAM
}

#ifndef USE_COOP
#define USE_COOP 1
#endif
extern "C" void kernel_launch(void* const* d_in, const int* in_sizes, int n_in, void* d_out, int out_size, void* d_ws, size_t ws_size, hipStream_t stream) {
    static int ready = 0;
    if (!ready) {
        if (n_in != 20 || in_sizes[0] != NLAT * D || out_size != NLAT * D || ws_size < WS_END) { fprintf(stderr, "kernel_launch: unexpected problem (n_in %d, out %d, ws %zu); nothing launched\n", n_in, out_size, ws_size); ready = -1; return; }
        if (hipFuncSetAttribute((const void*)mk_fwd, hipFuncAttributeMaxDynamicSharedMemorySize, LDS_BYTES) != hipSuccess) { fprintf(stderr, "kernel_launch: hipFuncSetAttribute failed\n"); ready = -1; return; }
        int dev = 0, cus = 0, per_cu = 0;
        (void)hipGetDevice(&dev); (void)hipDeviceGetAttribute(&cus, hipDeviceAttributeMultiprocessorCount, dev);
        (void)hipOccupancyMaxActiveBlocksPerMultiprocessor(&per_cu, (const void*)mk_fwd, NTHR, LDS_BYTES);
        if (cus * per_cu < 256) { fprintf(stderr, "kernel_launch: this kernel needs 256 co-resident workgroups (device reports %d CUs x %d); nothing launched\n", cus, per_cu); ready = -1; return; }
        ready = 1;
    }
    if (ready < 0) return;
    Args a{};
    const float** f = (const float**)&a.p;
    for (int i = 0; i < 20; ++i) f[i] = (const float*)d_in[i];
    a.p.out = (float*)d_out; a.p.ws = (unsigned char*)d_ws; a.ph_lo = 0; a.ph_hi = 12;
    (void)hipMemsetAsync((char*)d_ws + WS_CTL, 0, 64 * 1024, stream);
    void* args[] = {&a};
#if USE_COOP
    const hipError_t e = hipLaunchCooperativeKernel((const void*)mk_fwd, dim3(256), dim3(NTHR), args, LDS_BYTES, stream);
#else
    const hipError_t e = hipLaunchKernel((const void*)mk_fwd, dim3(256), dim3(NTHR), args, LDS_BYTES, stream);
#endif
    if (e != hipSuccess) fprintf(stderr, "kernel_launch: launch failed: %s\n", hipGetErrorString(e));
}
```
